# Optimizing an MI355X kernel written in HIP

```python
import jax
import jax.numpy as jnp
from jax import lax
import numpy as np

D_MODEL = 2048
BATCH = 4
SEQ = 2048
DEPTH = 4

HEAD_DIM = 128
NSA_HEADS = 8
NSA_KV_HEADS = 2
NSA_GROUP = NSA_HEADS // NSA_KV_HEADS
CMP_BLOCK = 32
CMP_STRIDE = 16
SEL_BLOCK = 64
N_SEL = 16
WINDOW = 512
SEL_QUERY_BLOCK = 64
FORCE_BONUS = 1e4
DSA_HEADS = 8
KV_LATENT = 256
IDX_HEADS = 4
IDX_DIM = 64
DSA_TOPK_MAX = 256
QUERY_BLOCK = 128
GMLP_GROUPS = 8
GMLP_GROUP_DIM = 128
GMLP_WIDTH = GMLP_GROUPS * GMLP_GROUP_DIM
GMLP_CHUNK = 128
N_BRANCHES = 3
BRANCH_WIDTH = D_MODEL // 2
KV_COLS = NSA_KV_HEADS * HEAD_DIM
IN_SPLITS = (NSA_HEADS * HEAD_DIM,
             KV_COLS, KV_COLS,
             KV_COLS, KV_COLS,
             KV_COLS, KV_COLS,
             NSA_HEADS * 3,
             DSA_HEADS * HEAD_DIM,
             KV_LATENT,
             IDX_HEADS * IDX_DIM,
             IDX_DIM,
             IDX_HEADS,
             2 * GMLP_WIDTH,
             N_BRANCHES * D_MODEL)
IN_COLS = sum(IN_SPLITS)
N_GROUPS = 4
EXPERTS_PER_GROUP = 4
N_EXPERTS = N_GROUPS * EXPERTS_PER_GROUP
EXPERT_TOPK = 2
D_EXPERT = 512
DEEPNORM_ALPHA = (2 * DEPTH) ** 0.25
DEEPNORM_BETA = (8 * DEPTH) ** -0.25
LN_EPS = 1e-5
NEG_BIG = -1e30

kernel_name = 'hybrid_nsa_dsa_gmlp_hmoe_deepnorm'


def _split_cols(h, sizes):
    out, start = [], 0
    for n in sizes:
        out.append(h[..., start:start + n])
        start += n
    return out


def _layer_norm(x, g, b):
    xf = x.astype(jnp.float32)
    mu = jnp.mean(xf, axis=-1, keepdims=True)
    var = jnp.mean(jnp.square(xf - mu), axis=-1, keepdims=True)
    return ((xf - mu) * lax.rsqrt(var + LN_EPS) * g + b).astype(x.dtype)


def _rms_norm(x, g):
    xf = x.astype(jnp.float32)
    return (xf * lax.rsqrt(jnp.mean(xf * xf, axis=-1, keepdims=True) + LN_EPS) * g).astype(x.dtype)


def _masked_softmax(s, valid):
    s = jnp.where(valid, s.astype(jnp.float32), NEG_BIG)
    p = jax.nn.softmax(s, axis=-1)
    return jnp.where(valid, p, 0.0)


def _alibi_slopes(n_heads):
    return 2.0 ** (-8.0 * jnp.arange(1, n_heads + 1, dtype=jnp.float32) / n_heads)


def _nsa_mixer(q, k_cmp, v_cmp, k_slc, v_slc, k_win, v_win, gates, cmp_w1, cmp_w2, cmp_pe, slopes):
    B, S = q.shape[:2]
    scale = HEAD_DIM ** -0.5
    slopes_g = slopes.reshape(NSA_KV_HEADS, NSA_GROUP)
    t_pos = jnp.arange(S)

    n_cmp = (S - CMP_BLOCK) // CMP_STRIDE + 1
    blk_idx = jnp.arange(n_cmp)[:, None] * CMP_STRIDE + jnp.arange(CMP_BLOCK)[None, :]

    def compress(x, w1, w2, pe):
        xb = x[:, blk_idx] + pe[None, None, :, None, :]
        xb = jnp.moveaxis(xb, 3, 2).reshape(B, n_cmp, NSA_KV_HEADS, CMP_BLOCK * HEAD_DIM)
        return jax.nn.gelu(xb @ w1) @ w2

    kc = compress(k_cmp, cmp_w1[0], cmp_w2[0], cmp_pe[0])
    vc = compress(v_cmp, cmp_w1[1], cmp_w2[1], cmp_pe[1])
    cmp_start = jnp.arange(n_cmp) * CMP_STRIDE
    dist_c = (t_pos[:, None] - (cmp_start + CMP_BLOCK - 1)[None, :]).astype(jnp.float32)
    s_c = jnp.einsum('bthgd,bihd->bhgti', q, kc) * scale - slopes_g[:, :, None, None] * dist_c
    p_c = _masked_softmax(s_c, dist_c >= 0)
    o_cmp = jnp.einsum('bhgti,bihd->bthgd', p_c.astype(q.dtype), vc)

    n_slc = S // SEL_BLOCK
    slc_start = jnp.arange(n_slc) * SEL_BLOCK
    overlap = ((cmp_start[:, None] < slc_start[None, :] + SEL_BLOCK)
               & (cmp_start[:, None] + CMP_BLOCK > slc_start[None, :])).astype(jnp.float32)
    imp = jnp.einsum('bhgti,ij->bhtj', p_c, overlap)
    cur = t_pos // SEL_BLOCK
    j = jnp.arange(n_slc)[None, :]
    blk_valid = j <= cur[:, None]
    forced = (j == 0) | (j == cur[:, None]) | (j == cur[:, None] - 1)
    imp = jnp.where(blk_valid, imp + jnp.where(forced, FORCE_BONUS, 0.0), NEG_BIG)
    n_sel = min(N_SEL, n_slc)
    _, sel = lax.top_k(imp, n_sel)

    ks = k_slc.reshape(B, n_slc, SEL_BLOCK, NSA_KV_HEADS, HEAD_DIM).transpose(0, 3, 1, 2, 4)
    vs = v_slc.reshape(B, n_slc, SEL_BLOCK, NSA_KV_HEADS, HEAD_DIM).transpose(0, 3, 1, 2, 4)
    qb_len = SEL_QUERY_BLOCK
    nqb = S // qb_len
    q_blocks = q.reshape(B, nqb, qb_len, NSA_KV_HEADS, NSA_GROUP, HEAD_DIM).swapaxes(0, 1)
    sel_blocks = sel.reshape(B, NSA_KV_HEADS, nqb, qb_len, n_sel).transpose(2, 0, 1, 3, 4)
    b_ix = jnp.arange(B)[:, None, None, None]
    h_ix = jnp.arange(NSA_KV_HEADS)[None, :, None, None]
    n_keys = n_sel * SEL_BLOCK

    def sel_attend(args):
        qb, sb, start = args
        kg = ks[b_ix, h_ix, sb]
        vg = vs[b_ix, h_ix, sb]
        t = start + jnp.arange(qb_len)
        s_pos = sb[..., None] * SEL_BLOCK + jnp.arange(SEL_BLOCK)
        dist = (t[None, None, :, None, None] - s_pos).astype(jnp.float32)
        s = (jnp.einsum('bqhgd,bhqnld->bhgqnl', qb, kg) * scale
             - slopes_g[None, :, :, None, None, None] * dist[:, :, None])
        p = _masked_softmax(s.reshape(B, NSA_KV_HEADS, NSA_GROUP, qb_len, n_keys),
                            (dist >= 0).reshape(B, NSA_KV_HEADS, 1, qb_len, n_keys))
        return jnp.einsum('bhgqk,bhqkd->bqhgd', p.astype(qb.dtype),
                          vg.reshape(B, NSA_KV_HEADS, qb_len, n_keys, HEAD_DIM))

    o_slc = lax.map(sel_attend, (q_blocks, sel_blocks, jnp.arange(nqb) * qb_len))
    o_slc = o_slc.swapaxes(0, 1).reshape(B, S, NSA_KV_HEADS, NSA_GROUP, HEAD_DIM)

    nwb = S // QUERY_BLOCK
    span = WINDOW + QUERY_BLOCK
    kp = jnp.pad(k_win, ((0, 0), (WINDOW, 0), (0, 0), (0, 0)))
    vp = jnp.pad(v_win, ((0, 0), (WINDOW, 0), (0, 0), (0, 0)))
    win_idx = jnp.arange(nwb)[:, None] * QUERY_BLOCK + jnp.arange(span)[None, :]
    kw = kp[:, win_idx]
    vw = vp[:, win_idx]
    t_w = jnp.arange(nwb)[:, None] * QUERY_BLOCK + jnp.arange(QUERY_BLOCK)[None, :]
    s_w = win_idx - WINDOW
    dist_w = t_w[:, :, None] - s_w[:, None, :]
    valid_w = (dist_w >= 0) & (dist_w < WINDOW) & (s_w[:, None, :] >= 0)
    qw = q.reshape(B, nwb, QUERY_BLOCK, NSA_KV_HEADS, NSA_GROUP, HEAD_DIM)
    s = (jnp.einsum('bnqhgd,bnkhd->bhgnqk', qw, kw) * scale
         - slopes_g[:, :, None, None, None] * dist_w.astype(jnp.float32))
    p = _masked_softmax(s, valid_w)
    o_win = jnp.einsum('bhgnqk,bnkhd->bnqhgd', p.astype(q.dtype), vw)
    o_win = o_win.reshape(B, S, NSA_KV_HEADS, NSA_GROUP, HEAD_DIM)

    g = jax.nn.sigmoid(gates.astype(jnp.float32)).astype(q.dtype).reshape(B, S, NSA_KV_HEADS, NSA_GROUP, 3)
    o = g[..., 0:1] * o_cmp + g[..., 1:2] * o_slc + g[..., 2:3] * o_win
    return o.reshape(B, S, NSA_HEADS * HEAD_DIM)


def _dsa_mixer(q, c_kv, q_idx, k_idx, w_idx, w_uk, w_uv, kv_norm_g, slopes):
    B, S = q.shape[:2]
    c = _rms_norm(c_kv, kv_norm_g)
    q_lat = jnp.einsum('bthd,hcd->bthc', q, w_uk) * (HEAD_DIM ** -0.5)
    topk = min(DSA_TOPK_MAX, S // 4)
    nqb = S // QUERY_BLOCK
    s_pos = jnp.arange(S)

    def blk(a):
        return a.reshape((B, nqb, QUERY_BLOCK) + a.shape[2:]).swapaxes(0, 1)

    def attend(args):
        ql, qi, wi, start = args
        t = start + jnp.arange(QUERY_BLOCK)
        rel = jax.nn.relu(jnp.einsum('bqhd,bsd->bqhs', qi, k_idx))
        score = jnp.einsum('bqhs,bqh->bqs', rel, wi).astype(jnp.float32)
        score = jnp.where(s_pos[None, None, :] <= t[None, :, None], score, -jnp.inf)
        _, sel = lax.top_k(score, topk)
        cg = jax.vmap(lambda cb, ib: cb[ib])(c, sel)
        dist = (t[None, :, None] - sel).astype(jnp.float32)
        logits = (jnp.einsum('bqhc,bqkc->bhqk', ql, cg)
                  - slopes[None, :, None, None] * dist[:, None])
        p = _masked_softmax(logits, (dist >= 0)[:, None])
        return jnp.einsum('bhqk,bqkc->bqhc', p.astype(cg.dtype), cg)

    o_lat = lax.map(attend, (blk(q_lat), blk(q_idx), blk(w_idx), jnp.arange(nqb) * QUERY_BLOCK))
    o_lat = o_lat.swapaxes(0, 1).reshape(B, S, DSA_HEADS, KV_LATENT)
    o = jnp.einsum('bthc,hcd->bthd', o_lat, w_uv)
    return o.reshape(B, S, DSA_HEADS * HEAD_DIM)


def _gmlp_mixer(uv, ln_g, ln_b, w_s, b_s):
    B, S = uv.shape[:2]
    z = jax.nn.gelu(uv)
    u, v = z[..., :GMLP_WIDTH], z[..., GMLP_WIDTH:]
    v = _layer_norm(v, ln_g, ln_b)
    nc = S // GMLP_CHUNK
    v = v.reshape(B, nc, GMLP_CHUNK, GMLP_GROUPS, GMLP_GROUP_DIM)
    causal = jnp.tril(jnp.ones((GMLP_CHUNK, GMLP_CHUNK), dtype=bool))
    w = jnp.where(causal[None], w_s, 0.0).astype(v.dtype)
    mixed = jnp.einsum('gts,bcsgd->bctgd', w, v) + b_s.T[None, None, :, :, None]
    return u * mixed.reshape(B, S, GMLP_WIDTH)


def _hier_moe(x, wg_r, bg_r, we_r, be_r, w_gate, w_up, w_down):
    B, S, D = x.shape
    xt = x.reshape(B * S, D)
    n_tok = B * S
    group_prob = jax.nn.softmax((xt @ wg_r + bg_r).astype(jnp.float32), axis=-1)
    gp, gi = lax.top_k(group_prob, 1)
    exp_logits = (xt @ we_r + be_r).astype(jnp.float32).reshape(n_tok, N_GROUPS, EXPERTS_PER_GROUP)
    in_group = exp_logits[jnp.arange(n_tok), gi[:, 0]]
    top_logits, ei = lax.top_k(in_group, EXPERT_TOPK)
    weights = gp * jax.nn.softmax(top_logits, axis=-1)
    expert_id = gi * EXPERTS_PER_GROUP + ei
    combine = jnp.sum(jax.nn.one_hot(expert_id, N_EXPERTS, dtype=jnp.float32) * weights[..., None], axis=1)
    h = jax.nn.silu(jnp.einsum('td,edf->etf', xt, w_gate)) * jnp.einsum('td,edf->etf', xt, w_up)
    h = h * combine.T[:, :, None].astype(h.dtype)
    return jnp.einsum('etf,efd->td', h, w_down).reshape(B, S, D)


def setup_inputs(seed: int = 0) -> dict:
    key = jax.random.key(seed)
    ks = jax.random.split(key, 25)

    def nrm(k, shape, scale):
        return jax.random.normal(k, shape, jnp.float32) * scale

    L, D, W = DEPTH, D_MODEL, BRANCH_WIDTH
    return {
        'x': nrm(ks[0], (BATCH, SEQ, D), 1.0),
        'w_in': nrm(ks[1], (L, D, IN_COLS), D ** -0.5),
        'cmp_w1': nrm(ks[2], (L, 2, CMP_BLOCK * HEAD_DIM, HEAD_DIM), (CMP_BLOCK * HEAD_DIM) ** -0.5),
        'cmp_w2': nrm(ks[3], (L, 2, HEAD_DIM, HEAD_DIM), HEAD_DIM ** -0.5),
        'cmp_pe': nrm(ks[4], (L, 2, CMP_BLOCK, HEAD_DIM), 0.1),
        'w_uk': nrm(ks[5], (L, DSA_HEADS, KV_LATENT, HEAD_DIM), KV_LATENT ** -0.5),
        'w_uv': nrm(ks[6], (L, DSA_HEADS, KV_LATENT, HEAD_DIM), KV_LATENT ** -0.5),
        'kv_norm_g': 1.0 + nrm(ks[7], (L, KV_LATENT), 0.01),
        'gmlp_ln_g': 1.0 + nrm(ks[8], (L, GMLP_WIDTH), 0.01),
        'gmlp_ln_b': nrm(ks[9], (L, GMLP_WIDTH), 0.01),
        'gmlp_w_s': nrm(ks[10], (L, GMLP_GROUPS, GMLP_CHUNK, GMLP_CHUNK), GMLP_CHUNK ** -0.5),
        'gmlp_b_s': 1.0 + nrm(ks[11], (L, GMLP_GROUPS, GMLP_CHUNK), 0.1),
        'w_branch': nrm(ks[12], (L, N_BRANCHES, W, D), W ** -0.5 * DEEPNORM_BETA),
        'w_out': nrm(ks[13], (L, D, D), D ** -0.5 * DEEPNORM_BETA),
        'ln1_g': 1.0 + nrm(ks[14], (L, D), 0.01),
        'ln1_b': nrm(ks[15], (L, D), 0.01),
        'router_group_w': nrm(ks[16], (L, D, N_GROUPS), D ** -0.5),
        'router_group_b': nrm(ks[17], (L, N_GROUPS), 0.01),
        'router_expert_w': nrm(ks[18], (L, D, N_EXPERTS), D ** -0.5),
        'router_expert_b': nrm(ks[19], (L, N_EXPERTS), 0.01),
        'expert_w_gate': nrm(ks[20], (L, N_EXPERTS, D, D_EXPERT), D ** -0.5),
        'expert_w_up': nrm(ks[21], (L, N_EXPERTS, D, D_EXPERT), D ** -0.5 * DEEPNORM_BETA),
        'expert_w_down': nrm(ks[22], (L, N_EXPERTS, D_EXPERT, D), D_EXPERT ** -0.5 * DEEPNORM_BETA),
        'ln2_g': 1.0 + nrm(ks[23], (L, D), 0.01),
        'ln2_b': nrm(ks[24], (L, D), 0.01),
    }


def reference(x, w_in, cmp_w1, cmp_w2, cmp_pe, w_uk, w_uv, kv_norm_g, gmlp_ln_g, gmlp_ln_b,
              gmlp_w_s, gmlp_b_s, w_branch, w_out, ln1_g, ln1_b, router_group_w, router_group_b,
              router_expert_w, router_expert_b, expert_w_gate, expert_w_up, expert_w_down,
              ln2_g, ln2_b):
    B, S, D = x.shape
    slopes = _alibi_slopes(NSA_HEADS)
    for l in range(DEPTH):
        h = x @ w_in[l]
        (q_a, k_c, v_c, k_s, v_s, k_w, v_w, g_nsa, q_b, c_kv, q_idx, k_idx, w_idx,
         uv, g_merge) = _split_cols(h, IN_SPLITS)
        kv_shape = (B, S, NSA_KV_HEADS, HEAD_DIM)
        o_a = _nsa_mixer(q_a.reshape(B, S, NSA_KV_HEADS, NSA_GROUP, HEAD_DIM),
                         k_c.reshape(kv_shape), v_c.reshape(kv_shape),
                         k_s.reshape(kv_shape), v_s.reshape(kv_shape),
                         k_w.reshape(kv_shape), v_w.reshape(kv_shape),
                         g_nsa, cmp_w1[l], cmp_w2[l], cmp_pe[l], slopes)
        o_b = _dsa_mixer(q_b.reshape(B, S, DSA_HEADS, HEAD_DIM), c_kv,
                         q_idx.reshape(B, S, IDX_HEADS, IDX_DIM), k_idx, w_idx,
                         w_uk[l], w_uv[l], kv_norm_g[l], slopes)
        o_c = _gmlp_mixer(uv, gmlp_ln_g[l], gmlp_ln_b[l], gmlp_w_s[l], gmlp_b_s[l])
        branches = jnp.stack([o_a, o_b, o_c], axis=2)
        y = jnp.einsum('bsnw,nwd->bsnd', branches, w_branch[l])
        gates = jax.nn.sigmoid(g_merge.astype(jnp.float32)).astype(x.dtype).reshape(B, S, N_BRANCHES, D)
        mixed = jnp.sum(gates * y, axis=2) @ w_out[l]
        x = _layer_norm(DEEPNORM_ALPHA * x + mixed, ln1_g[l], ln1_b[l])
        ffn = _hier_moe(x, router_group_w[l], router_group_b[l], router_expert_w[l], router_expert_b[l],
                        expert_w_gate[l], expert_w_up[l], expert_w_down[l])
        x = _layer_norm(DEEPNORM_ALPHA * x + ffn, ln2_g[l], ln2_b[l])
    return x
```

```cpp
#include <hip/hip_runtime.h>
#include <cstdio>
#include <cstdint>

#ifndef MK_SINGLE
#define MK_SINGLE 1
#endif

constexpr int NB = 4, SEQ = 2048, DM = 2048, NL = 4, NTOK = NB * SEQ;
constexpr int IN_COLS = 12380, NMAIN = 12288, NSK = 128;
constexpr int NEXP = 16, DEXP = 512, MOE_ROWS = 2 * NTOK + NEXP * 256;
constexpr float LN_EPS = 1e-5f;
constexpr float ALPHA = 1.681792830507429f;
constexpr float LOG2E = 1.4426950408889634f;
constexpr float ATT_C2 = 0.08838834764831845f * LOG2E;
constexpr int LDS_BYTES = 147456;

typedef unsigned short bf16_t;
typedef short bf16x8 __attribute__((ext_vector_type(8)));
typedef short s16x4 __attribute__((ext_vector_type(4)));
typedef float f32x16 __attribute__((ext_vector_type(16)));
typedef float f32x4 __attribute__((ext_vector_type(4)));
typedef float f32x2 __attribute__((ext_vector_type(2)));
typedef unsigned u32x4 __attribute__((ext_vector_type(4)));
typedef unsigned u32x2 __attribute__((ext_vector_type(2)));

constexpr size_t al256(size_t x) { return (x + 255) & ~(size_t)255; }
constexpr size_t WS_CTL    = 0;
constexpr size_t CTL_BYTES = 65536;
constexpr size_t WS_WIN    = WS_CTL + CTL_BYTES;
constexpr size_t WS_WSK    = WS_WIN  + (size_t)NL * NMAIN * DM * 2;
constexpr size_t WS_W1     = WS_WSK  + (size_t)NL * NSK * DM * 2;
constexpr size_t WS_W2     = WS_W1   + (size_t)NL * 2 * 128 * 4096 * 2;
constexpr size_t WS_C1     = WS_W2   + (size_t)NL * 2 * 128 * 128 * 2;
constexpr size_t WS_WKVUP  = WS_C1   + (size_t)NL * 2 * 128 * 4;
constexpr size_t WS_WSTRIL = WS_WKVUP + (size_t)NL * 2048 * 256 * 2;
constexpr size_t WS_WB     = WS_WSTRIL + (size_t)NL * 8 * 128 * 128 * 2;
constexpr size_t WS_WO     = WS_WB   + (size_t)NL * 3 * 2048 * 1024 * 2;
constexpr size_t WS_WR     = WS_WO   + (size_t)NL * 2048 * 2048 * 2;
constexpr size_t WS_WGU    = WS_WR   + (size_t)NL * 2 * 32 * 2048 * 2;
constexpr size_t WS_WD     = WS_WGU  + (size_t)NL * 16 * 1024 * 2048 * 2;
constexpr size_t WS_XF     = WS_WD   + (size_t)NL * 16 * 2048 * 512 * 2;
constexpr size_t WS_XB     = WS_XF   + (size_t)NTOK * DM * 4;
constexpr size_t WS_SKF    = WS_XB   + (size_t)NTOK * DM * 2;
constexpr size_t WS_KI     = WS_SKF  + (size_t)NTOK * 32 * 4;
constexpr size_t WS_QA     = WS_KI   + (size_t)NTOK * 64 * 2;
constexpr size_t WS_KV     = WS_QA   + (size_t)NTOK * 1024 * 2;
constexpr size_t WS_QB     = WS_KV   + (size_t)NTOK * 1536 * 2;
constexpr size_t WS_HC     = WS_QB   + (size_t)NTOK * 1024 * 2;
constexpr size_t WS_PSQ    = WS_HC   + (size_t)NTOK * 256 * 2;
constexpr size_t WS_QI     = WS_PSQ  + (size_t)NTOK * 4 * 4;
constexpr size_t WS_HU     = WS_QI   + (size_t)NTOK * 256 * 2;
constexpr size_t WS_HV     = WS_HU   + (size_t)NTOK * 1024 * 2;
constexpr size_t WS_HG     = WS_HV   + (size_t)NTOK * 1024 * 2;
constexpr size_t WS_KVUP   = WS_HG   + (size_t)NTOK * 6144 * 2;
constexpr size_t WS_KC     = WS_KVUP + (size_t)NTOK * 2048 * 2;
constexpr size_t WS_MASK   = WS_KC   + (size_t)2 * 8 * 128 * 128 * 2;
constexpr size_t WS_BR     = WS_MASK + (size_t)NTOK * 32 * 8;
constexpr size_t WS_TT     = WS_BR   + (size_t)3 * NTOK * 1024 * 2;
constexpr size_t WS_MIXT   = WS_TT   + (size_t)256 * 64 * 512 * 4;
constexpr size_t WS_MIXB   = WS_MIXT + (size_t)NTOK * DM * 4;
constexpr size_t WS_X1F    = WS_MIXB + (size_t)NTOK * DM * 2;
constexpr size_t WS_X1B    = WS_X1F  + (size_t)NTOK * DM * 4;
constexpr size_t WS_TOK    = WS_X1B  + (size_t)NTOK * DM * 2;
constexpr size_t WS_ROWW   = WS_TOK  + (size_t)NTOK * 2 * 4 * 4;
constexpr size_t WS_XS     = WS_ROWW + (size_t)MOE_ROWS * 4;
constexpr size_t WS_HM     = WS_XS   + (size_t)MOE_ROWS * DM * 2;
constexpr size_t WS_Y      = WS_HM   + (size_t)MOE_ROWS * DEXP * 2;
constexpr size_t WS_END    = WS_Y    + (size_t)MOE_ROWS * DM * 2;

constexpr int CW_BAR  = 0;
constexpr int CW_Q    = 4096;
constexpr int CW_CNT  = 4096 + 64 * 8;
constexpr int CW_DBG  = 8192;

__device__ __forceinline__ bf16_t f2bf(float f) { unsigned u = __float_as_uint(f); u += 0x7FFFu + ((u >> 16) & 1u); return (bf16_t)(u >> 16); }
__device__ __forceinline__ float bf2f(bf16_t b) { return __uint_as_float(((unsigned)b) << 16); }
__device__ __forceinline__ unsigned cvtpk(float lo, float hi) { unsigned r; asm volatile("v_cvt_pk_bf16_f32 %0, %1, %2" : "=v"(r) : "v"(lo), "v"(hi)); return r; }
__device__ __forceinline__ bf16x8 pack8(f32x4 a, f32x4 b) { u32x4 w = {cvtpk(a[0], a[1]), cvtpk(a[2], a[3]), cvtpk(b[0], b[1]), cvtpk(b[2], b[3])}; return *reinterpret_cast<bf16x8*>(&w); }
__device__ __forceinline__ float fast_sigmoid(float x) { return __builtin_amdgcn_rcpf(1.0f + __builtin_amdgcn_exp2f(-x * LOG2E)); }
__device__ __forceinline__ float gelu_tanh(float x) {
    const float z = 0.7978845608028654f * (x + 0.044715f * x * x * x);
    return x * __builtin_amdgcn_rcpf(1.0f + __builtin_amdgcn_exp2f(-2.0f * LOG2E * z));
}
__device__ __forceinline__ float wave_sum(float v) {
#pragma unroll
    for (int o = 32; o >= 1; o >>= 1) v += __shfl_xor(v, o);
    return v;
}

__device__ __forceinline__ int launder_v(int x) { asm volatile("" : "+v"(x)); return x; }
__device__ __forceinline__ unsigned opaque_zero() { unsigned z; asm volatile("s_mov_b32 %0, 0" : "=s"(z)); return z; }
template <class T> __device__ __forceinline__ T* launder_s(T* p) { return (T*)((unsigned long long)p + opaque_zero()); }
#define LTID launder_v((int)threadIdx.x)
#define LBID ((int)(blockIdx.x + opaque_zero()))
namespace pg8 {
#define PG8_LAS __attribute__((address_space(3)))
typedef unsigned short bf16_t;
typedef short bf16x8 __attribute__((ext_vector_type(8)));
typedef float f32x4 __attribute__((ext_vector_type(4)));
typedef unsigned u32x4 __attribute__((ext_vector_type(4)));
constexpr int BM = 256, BK = 64, HALF = 128, HTB = HALF * BK * 2  , STAGE_BYTES = 8 * HTB, NXCD = 8, WGM = 8;

__host__ __device__ __forceinline__ int lds_byte(int r, int c) { const int st = (r >> 4) * 2 + (c >> 5), rr = r & 15, cc = c & 31, ob = rr * 64 + cc * 2; return st * 1024 + (ob ^ (((ob >> 9) & 1) << 5)); }
__host__ __device__ __forceinline__ void stage_rc(int b, int& R, int& C) { const int st = b / 1024, sb = b % 1024, swz = sb ^ (((sb >> 9) & 1) << 5); R = (st >> 1) * 16 + swz / 64; C = (st & 1) * 32 + (swz % 64) / 2; }
__host__ __device__ __forceinline__ int perm32(int rho) { const int n = rho >> 4, i = rho & 15; return 8 * (i >> 2) + 4 * n + (i & 3); }

struct Unit { int pm, pn; };
struct Gemm { const bf16_t* A; const bf16_t* Bt; int M, N, K; };

struct StaticOrder {
    int nM, nN, nwg, G, c;
    __host__ __device__ void init(int M, int N, int G_, int c_) { nM = M / BM; nN = N / BM; nwg = nM * nN; G = G_; c = c_; }
    __host__ __device__ bool next(int i, Unit& u) const {
        const long L = (long)i * G + c; if (L >= nwg) return false;
        int wgid = (int)L; { const int q = nwg / NXCD, r = nwg % NXCD, xcd = wgid % NXCD, off = wgid / NXCD; wgid = (xcd < r ? xcd * (q + 1) : r * (q + 1) + (xcd - r) * q) + off; }
        const int nig = WGM * nN, gid = wgid / nig, fm = gid * WGM, gsz = (nM - fm) < WGM ? (nM - fm) : WGM;
        u.pm = fm + ((wgid % nig) % gsz); u.pn = (wgid % nig) / gsz; return true;
    }
    __device__ __forceinline__ void a_ready(const Unit&) const {}
    __device__ __forceinline__ void done(const Unit&) const {}
};
struct CountedOrder : StaticOrder {
    const unsigned* ready; unsigned need; unsigned* tmo;
    __device__ __forceinline__ void a_ready(const Unit& u) const {
        if (threadIdx.x < 64) {
            const unsigned long long t0 = __builtin_amdgcn_s_memrealtime(); unsigned polls = 0;
            while ((unsigned)__builtin_amdgcn_readfirstlane(__hip_atomic_load(ready + 64 * u.pm, __ATOMIC_RELAXED, __HIP_MEMORY_SCOPE_AGENT)) < need) {
                if ((++polls & 255u) == 0u && __builtin_amdgcn_readfirstlane(__hip_atomic_load(tmo, __ATOMIC_RELAXED, __HIP_MEMORY_SCOPE_AGENT)) != 0u) break;
                if (__builtin_amdgcn_s_memrealtime() - t0 > 2000000ull) {
                    if (threadIdx.x == 0) { unsigned expect = 0u; __hip_atomic_compare_exchange_strong(tmo + 1, &expect, 0x600u | (unsigned)(u.pm & 0xff), __ATOMIC_RELAXED, __ATOMIC_RELAXED, __HIP_MEMORY_SCOPE_AGENT); __hip_atomic_store(tmo, 1u, __ATOMIC_RELAXED, __HIP_MEMORY_SCOPE_AGENT); }
                    break; }
                __builtin_amdgcn_s_sleep(2); }
            __builtin_amdgcn_fence(__ATOMIC_ACQUIRE, "agent");
            asm volatile("s_waitcnt vmcnt(0)" ::: "memory");
        }
#if !defined(BROKEN_HOOK_NO_BARRIER)
        asm volatile("" ::: "memory"); __builtin_amdgcn_s_barrier(); asm volatile("" ::: "memory");
#endif
    }
};

__device__ __forceinline__ unsigned cvt_pk_bf16(float lo, float hi) { unsigned r; asm volatile("v_cvt_pk_bf16_f32 %0, %1, %2" : "=v"(r) : "v"(lo), "v"(hi)); return r; }
typedef float f32x2 __attribute__((ext_vector_type(2)));
__device__ __forceinline__ f32x2 gelu_pk(f32x2 v) {
    const f32x2 av = __builtin_elementwise_abs(v), d = av * 0.2316418882f + 1.0f;
    f32x2 t; t.x = __builtin_amdgcn_rcpf(d.x); t.y = __builtin_amdgcn_rcpf(d.y);
    f32x2 q = t * 0.5307027145f + (-0.7265760135f); q = q * t + 0.7107068705f; q = q * t + (-0.142248368f); q = q * t + 0.127414796f; q = q * t;
    const f32x2 s = (v * v) * (-0.72134752044f);
    f32x2 e; e.x = __builtin_amdgcn_exp2f(s.x); e.y = __builtin_amdgcn_exp2f(s.y);
    const f32x2 m = v * (q * e), r = v - m;
    f32x2 o; o.x = v.x < 0.f ? m.x : r.x; o.y = v.y < 0.f ? m.y : r.y; return o;
}

struct EpiF32 {
    static constexpr bool PERM = false, AFTER_DRAIN = false;
    float* C; int ldc; const float* bias;
    __device__ __forceinline__ void operator()(const f32x4 (&acc)[2][2][4][2], const Unit& u, int wr, int wc, int fr, int fq) const {
        const int row0 = u.pm * BM + wr * 64 + fr, col0 = u.pn * BM + wc * 32 + 4 * fq;
        f32x4 bv[2][2];
#pragma unroll
        for (int bj = 0; bj < 2; ++bj)
#pragma unroll
            for (int n = 0; n < 2; ++n) bv[bj][n] = bias ? *(const f32x4*)(bias + col0 + bj * HALF + n * 16) : (f32x4){0.f, 0.f, 0.f, 0.f};
#pragma unroll
        for (int ai = 0; ai < 2; ++ai)
#pragma unroll
            for (int m = 0; m < 4; ++m) { float* rowp = C + (size_t)(row0 + ai * HALF + m * 16) * ldc + col0;
#pragma unroll
                for (int bj = 0; bj < 2; ++bj)
#pragma unroll
                    for (int n = 0; n < 2; ++n) *(f32x4*)(rowp + bj * HALF + n * 16) = acc[ai][bj][m][n] + bv[bj][n]; }
    }
};
template <int ACT  > struct EpiBf16 {
    static constexpr bool PERM = true, AFTER_DRAIN = false;
    bf16_t* O; int ldc; const float* bias; int split_cols; size_t split_stride;
    __device__ __forceinline__ void operator()(const f32x4 (&acc)[2][2][4][2], const Unit& u, int wr, int wc, int fr, int fq) const {
        const int row0 = u.pm * BM + wr * 64 + fr; int colt = u.pn * BM; bf16_t* base = O;
        if (split_cols) { const int t = colt / split_cols; base += (size_t)t * split_stride; colt -= t * split_cols; }
        const int col0 = colt + wc * 32 + 8 * fq, bcol0 = u.pn * BM + wc * 32 + 8 * fq;
        f32x4 bv[2][2];
#pragma unroll
        for (int bj = 0; bj < 2; ++bj)
#pragma unroll
            for (int n = 0; n < 2; ++n) bv[bj][n] = bias ? *(const f32x4*)(bias + bcol0 + bj * HALF + 4 * n) : (f32x4){0.f, 0.f, 0.f, 0.f};
#pragma unroll
        for (int ai = 0; ai < 2; ++ai)
#pragma unroll
            for (int m = 0; m < 4; ++m) { bf16_t* rowp = base + (size_t)(row0 + ai * HALF + m * 16) * ldc + col0;
#pragma unroll
                for (int bj = 0; bj < 2; ++bj) { f32x4 v0 = acc[ai][bj][m][0] + bv[bj][0], v1 = acc[ai][bj][m][1] + bv[bj][1];
                    if (ACT == 1) { f32x2 a = gelu_pk((f32x2){v0[0], v0[1]}), b = gelu_pk((f32x2){v0[2], v0[3]}), c = gelu_pk((f32x2){v1[0], v1[1]}), d = gelu_pk((f32x2){v1[2], v1[3]});
                        v0 = (f32x4){a.x, a.y, b.x, b.y}; v1 = (f32x4){c.x, c.y, d.x, d.y}; }
                    if (ACT == 2) {
#pragma unroll
                        for (int j = 0; j < 4; ++j) { v0[j] = 0.5f * v0[j] * (1.0f + erff(v0[j] * 0.70710678f)); v1[j] = 0.5f * v1[j] * (1.0f + erff(v1[j] * 0.70710678f)); } }
                    u32x4 w; w.x = cvt_pk_bf16(v0[0], v0[1]); w.y = cvt_pk_bf16(v0[2], v0[3]); w.z = cvt_pk_bf16(v1[0], v1[1]); w.w = cvt_pk_bf16(v1[2], v1[3]);
                    *(u32x4*)(rowp + bj * HALF) = w; } }
    }
};

struct PanelStats {
    unsigned* xbuf;
    unsigned* cnt;
    unsigned* tmo;
    int ntn; float eps;
    unsigned code;
    __device__ __forceinline__ bool run(const f32x4 (&v)[2][2][4][2], const Unit& u, int wr, int wc, int fr, int fq, PG8_LAS unsigned char* lds, int wid, int lane) const {
        typedef float f32x2v __attribute__((ext_vector_type(2)));
        PG8_LAS f32x2v* P = (PG8_LAS f32x2v*)lds;
        PG8_LAS f32x2v* S = (PG8_LAS f32x2v*)(lds + 8192);
        PG8_LAS unsigned* flag = (PG8_LAS unsigned*)(lds + 8192 + 2048);
#pragma unroll
        for (int ai = 0; ai < 2; ++ai)
#pragma unroll
            for (int m = 0; m < 4; ++m) {
                float s = 0.f;
#pragma unroll
                for (int bj = 0; bj < 2; ++bj)
#pragma unroll
                    for (int n = 0; n < 2; ++n) { const f32x4 x = v[ai][bj][m][n]; s += (x[0] + x[1]) + (x[2] + x[3]); }
                s += __shfl_xor(s, 16); s += __shfl_xor(s, 32);
                const float mw = s * (1.0f / 64.0f); float q = 0.f;
#pragma unroll
                for (int bj = 0; bj < 2; ++bj)
#pragma unroll
                    for (int n = 0; n < 2; ++n) { const f32x4 d = v[ai][bj][m][n] - mw; q += (d[0] * d[0] + d[1] * d[1]) + (d[2] * d[2] + d[3] * d[3]); }
                q += __shfl_xor(q, 16); q += __shfl_xor(q, 32);
                if (fq == 0) P[(ai * HALF + wr * 64 + m * 16 + fr) * 4 + wc] = (f32x2v){mw, q};
            }
        asm volatile("s_waitcnt lgkmcnt(0)" ::: "memory"); __builtin_amdgcn_s_barrier(); asm volatile("" ::: "memory");
#if defined(BROKEN_NO_WAIT)
        if (blockIdx.x >= 64) { const long long t0 = clock64(); while (clock64() - t0 < 60000) __builtin_amdgcn_s_sleep(8); }
#endif
        const int row = wid * 32 + (lane & 31);
        if (lane < 32) {
            const f32x2v a = P[row * 4 + 0], b = P[row * 4 + 1], c = P[row * 4 + 2], d = P[row * 4 + 3];
            const float mt = (a.x + b.x + c.x + d.x) * 0.25f;
            const float da = a.x - mt, db = b.x - mt, dc = c.x - mt, dd = d.x - mt;
            const float m2 = (a.y + b.y) + (c.y + d.y) + 64.0f * ((da * da + db * db) + (dc * dc + dd * dd));
            unsigned long long* slot = (unsigned long long*)xbuf + ((size_t)(u.pm * BM + row) * 4 + u.pn);
            __hip_atomic_store(slot, ((unsigned long long)__float_as_uint(m2) << 32) | __float_as_uint(mt), __ATOMIC_RELAXED, __HIP_MEMORY_SCOPE_AGENT);
        }
        asm volatile("s_waitcnt vmcnt(0)" ::: "memory");
        if (lane == 0) __hip_atomic_fetch_add(cnt + 64 * u.pm, 1u, __ATOMIC_RELAXED, __HIP_MEMORY_SCOPE_AGENT);
        if (wid == 0) {
            bool dead = false; const unsigned long long t0 = __builtin_amdgcn_s_memrealtime(); const unsigned want = 8u * (unsigned)ntn;
            for (;;) {
#if defined(BROKEN_NO_WAIT)
                break;
#endif
                if ((unsigned)__builtin_amdgcn_readfirstlane(__hip_atomic_load(cnt + 64 * u.pm, __ATOMIC_RELAXED, __HIP_MEMORY_SCOPE_AGENT)) >= want) break;
                if (__builtin_amdgcn_s_memrealtime() - t0 > 2000000ull) {
                    if (lane == 0) { unsigned expect = 0u; __hip_atomic_compare_exchange_strong(tmo + 1, &expect, code | (unsigned)(u.pm & 0xff), __ATOMIC_RELAXED, __ATOMIC_RELAXED, __HIP_MEMORY_SCOPE_AGENT);
                                     __hip_atomic_store(tmo, 1u, __ATOMIC_RELAXED, __HIP_MEMORY_SCOPE_AGENT); }
                    dead = true; break; }
                __builtin_amdgcn_s_sleep(2);
            }
            __builtin_amdgcn_fence(__ATOMIC_ACQUIRE, "agent");
            if (lane == 0) flag[0] = dead ? 1u : 0u;
        }
        asm volatile("s_waitcnt vmcnt(0) lgkmcnt(0)" ::: "memory"); __builtin_amdgcn_s_barrier(); asm volatile("" ::: "memory");
        const bool bad = flag[0] != 0u;
        if (lane < 32) {
            const unsigned long long* slot = (const unsigned long long*)xbuf + (size_t)(u.pm * BM + row) * 4; float mt[4], m2[4]; float ms = 0.f;
#pragma unroll
            for (int t = 0; t < 4; ++t) { if (t < ntn) { const unsigned long long w = __hip_atomic_load(slot + t, __ATOMIC_RELAXED, __HIP_MEMORY_SCOPE_AGENT); mt[t] = __uint_as_float((unsigned)w); m2[t] = __uint_as_float((unsigned)(w >> 32)); } else { mt[t] = 0.f; m2[t] = 0.f; } ms += mt[t]; }
            const float mean = ms / (float)ntn; float q = 0.f;
#pragma unroll
            for (int t = 0; t < 4; ++t) if (t < ntn) { const float dm = mt[t] - mean; q += m2[t] + 256.0f * dm * dm; }
            S[row] = (f32x2v){mean, 1.0f / sqrtf(q / (256.0f * (float)ntn) + eps)};
        }
        asm volatile("s_waitcnt lgkmcnt(0)" ::: "memory"); __builtin_amdgcn_s_barrier(); asm volatile("" ::: "memory");
        return bad;
    }
};
struct EpiLnRes {
    static constexpr bool PERM = false, AFTER_DRAIN = true;
    const float* base; float* out; int ldc; const float* bias; PanelStats st; unsigned poison;
    __device__ __forceinline__ void refuse(size_t i0, size_t stride, int M, int N) const { const float q = __builtin_nanf(""); for (size_t i = i0; i < (size_t)M * N; i += stride) out[(i / N) * ldc + i % N] = q;
        if (i0 == 0) { unsigned expect = 0u; __hip_atomic_compare_exchange_strong(st.tmo + 1, &expect, 0x7f0u, __ATOMIC_RELAXED, __ATOMIC_RELAXED, __HIP_MEMORY_SCOPE_AGENT); __hip_atomic_store(st.tmo, 1u, __ATOMIC_RELAXED, __HIP_MEMORY_SCOPE_AGENT); } }
    __device__ __forceinline__ void fused(f32x4 (&acc)[2][2][4][2], const Unit& u, int wr, int wc, int fr, int fq, PG8_LAS unsigned char* lds, int wid, int lane) const {
        typedef float f32x2v __attribute__((ext_vector_type(2)));
        const PG8_LAS f32x2v* S = (const PG8_LAS f32x2v*)(lds + 8192);
        const int col0 = u.pn * BM + wc * 32 + 4 * fq;
#pragma unroll
        for (int bj = 0; bj < 2; ++bj)
#pragma unroll
            for (int n = 0; n < 2; ++n) { const f32x4 bv = bias ? *(const f32x4*)(bias + col0 + bj * HALF + n * 16) : (f32x4){0.f, 0.f, 0.f, 0.f};
#pragma unroll
                for (int ai = 0; ai < 2; ++ai)
#pragma unroll
                    for (int m = 0; m < 4; ++m) acc[ai][bj][m][n] += bv; }
        const bool bad = st.run(acc, u, wr, wc, fr, fq, lds, wid, lane) || poison != 0u;
        const float qnan = __builtin_nanf("");
#pragma unroll
        for (int ai = 0; ai < 2; ++ai)
#pragma unroll
            for (int m = 0; m < 4; ++m) { const int r = ai * HALF + wr * 64 + m * 16 + fr; const f32x2v sr = S[r]; const size_t off = (size_t)(u.pm * BM + r) * ldc + col0;
#pragma unroll
                for (int bj = 0; bj < 2; ++bj)
#pragma unroll
                    for (int n = 0; n < 2; ++n) { const f32x4 bs = *(const f32x4*)(base + off + bj * HALF + n * 16); f32x4 o = bs + (acc[ai][bj][m][n] - sr.x) * sr.y;
                        if (bad) o = (f32x4){qnan, qnan, qnan, qnan}; *(f32x4*)(out + off + bj * HALF + n * 16) = o; }
                asm volatile("" ::: "memory"); }
    }
};
struct EpiLnResLn {
    static constexpr bool PERM = false, AFTER_DRAIN = true;
    const float* base; float* out; bf16_t* xn; int ldc; const float* bias; PanelStats st1, st2; unsigned poison;
    __device__ __forceinline__ void refuse(size_t i0, size_t stride, int M, int N) const { const float q = __builtin_nanf(""); for (size_t i = i0; i < (size_t)M * N; i += stride) { const size_t o = (i / N) * ldc + i % N; out[o] = q; xn[o] = (bf16_t)0x7fc0u; }
        if (i0 == 0) { unsigned expect = 0u; __hip_atomic_compare_exchange_strong(st1.tmo + 1, &expect, 0x7f0u, __ATOMIC_RELAXED, __ATOMIC_RELAXED, __HIP_MEMORY_SCOPE_AGENT); __hip_atomic_store(st1.tmo, 1u, __ATOMIC_RELAXED, __HIP_MEMORY_SCOPE_AGENT); } }
    __device__ __forceinline__ void fused(f32x4 (&acc)[2][2][4][2], const Unit& u, int wr, int wc, int fr, int fq, PG8_LAS unsigned char* lds, int wid, int lane) const {
        typedef float f32x2v __attribute__((ext_vector_type(2))); typedef unsigned u32x2v __attribute__((ext_vector_type(2)));
        const PG8_LAS f32x2v* S = (const PG8_LAS f32x2v*)(lds + 8192);
        const int col0 = u.pn * BM + wc * 32 + 4 * fq;
#pragma unroll
        for (int bj = 0; bj < 2; ++bj)
#pragma unroll
            for (int n = 0; n < 2; ++n) { const f32x4 bv = bias ? *(const f32x4*)(bias + col0 + bj * HALF + n * 16) : (f32x4){0.f, 0.f, 0.f, 0.f};
#pragma unroll
                for (int ai = 0; ai < 2; ++ai)
#pragma unroll
                    for (int m = 0; m < 4; ++m) acc[ai][bj][m][n] += bv; }
        bool bad = st1.run(acc, u, wr, wc, fr, fq, lds, wid, lane) || poison != 0u;
        const float qnan = __builtin_nanf("");
#pragma unroll
        for (int ai = 0; ai < 2; ++ai)
#pragma unroll
            for (int m = 0; m < 4; ++m) { const int r = ai * HALF + wr * 64 + m * 16 + fr; const f32x2v sr = S[r]; const size_t off = (size_t)(u.pm * BM + r) * ldc + col0;
#pragma unroll
                for (int bj = 0; bj < 2; ++bj)
#pragma unroll
                    for (int n = 0; n < 2; ++n) { const f32x4 bs = *(const f32x4*)(base + off + bj * HALF + n * 16); acc[ai][bj][m][n] = bs + (acc[ai][bj][m][n] - sr.x) * sr.y; }
                asm volatile("" : "+v"(acc[ai][0][m][0]), "+v"(acc[ai][0][m][1]), "+v"(acc[ai][1][m][0]), "+v"(acc[ai][1][m][1]));
                if (m & 1) asm volatile("" ::: "memory"); }
        const bool bad1 = bad;
        bad = st2.run(acc, u, wr, wc, fr, fq, lds, wid, lane) || bad;
#pragma unroll
        for (int ai = 0; ai < 2; ++ai)
#pragma unroll
            for (int m = 0; m < 4; ++m) { const int r = ai * HALF + wr * 64 + m * 16 + fr; const f32x2v sr = S[r]; const size_t off = (size_t)(u.pm * BM + r) * ldc + col0;
#pragma unroll
                for (int bj = 0; bj < 2; ++bj)
#pragma unroll
                    for (int n = 0; n < 2; ++n) { const f32x4 x1 = acc[ai][bj][m][n]; *(f32x4*)(out + off + bj * HALF + n * 16) = bad1 ? (f32x4){qnan, qnan, qnan, qnan} : x1;
                        const f32x4 o = (x1 - sr.x) * sr.y; u32x2v w; w.x = cvt_pk_bf16(o[0], o[1]); w.y = cvt_pk_bf16(o[2], o[3]);
                        if (bad) { w.x = 0x7fc07fc0u; w.y = 0x7fc07fc0u; } *(u32x2v*)(xn + off + bj * HALF + n * 16) = w; }
                asm volatile("" ::: "memory"); }
    }
};

template <class Epi, class Sched, bool STAMP = false>
__device__ __forceinline__ void gemm_phase(PG8_LAS unsigned char* lds, const Gemm g, const Sched& S, const Epi& E, unsigned long long* stamps) {
    const int tid = launder_v((int)threadIdx.x), wid = __builtin_amdgcn_readfirstlane(tid >> 6), lane = tid & 63, wr = wid >> 2, wc = wid & 3, fr = lane & 15, fq = lane >> 4;
    const int K = g.K, nt = K / BK;
    int ts_lo = 0, ts_hi = 0, nts = 0; const unsigned long long rt_entry = STAMP ? (unsigned long long)wall_clock64() : 0ull;
#define PG8_STAMP() do { if (STAMP && wid == 0 && nts < 64) { const unsigned long long _c = (unsigned long long)clock64(); \
        ts_lo = (lane == nts) ? (int)(unsigned)_c : ts_lo; ts_hi = (lane == nts) ? (int)(unsigned)(_c >> 32) : ts_hi; ++nts; } } while (0)
    PG8_STAMP();
    unsigned voffA[2], voffB[2];
#pragma unroll
    for (int i = 0; i < 2; ++i) { int R, C; stage_rc(tid * 16 + i * 8192, R, C); const int Rb = Epi::PERM ? ((R & ~31) + perm32(R & 31)) : R;
        voffA[i] = (unsigned)(R * K + C) * 2u; voffB[i] = (unsigned)(Rb * K + C) * 2u; }
    const size_t kstep = (size_t)(BK * 2);
    const size_t hstep = (size_t)HALF * K * 2;
    const size_t tstep = 2 * hstep;
    const unsigned ldsw = (unsigned)wid * 1024u;
    const int aoff = lds_byte(wr * 64 + fr, fq * 8), boff = lds_byte(wc * 32 + fr, fq * 8);
#define PG8_SA(b, h) (((b) * 2 + (h)) * HTB)
#define PG8_SB(b, h) ((4 + (b) * 2 + (h)) * HTB)
#define PG8_STAGE(bufoff, gbase, voff) do { _Pragma("unroll") for (int _i = 0; _i < 2; ++_i) \
        __builtin_amdgcn_global_load_lds((const unsigned*)((const char*)(gbase) + (voff)[_i]), (PG8_LAS unsigned*)(lds + (bufoff) + ldsw + _i * 8192), 16, 0, 0); } while (0)
#define PG8_LDA(dst, b, h) do { _Pragma("unroll") for (int m = 0; m < 4; ++m) _Pragma("unroll") for (int k = 0; k < 2; ++k) dst[m][k] = *(const PG8_LAS bf16x8*)(lds + PG8_SA(b, h) + aoff + m * 2048 + k * 1024); } while (0)
#define PG8_LDB(dst, b, h) do { _Pragma("unroll") for (int n = 0; n < 2; ++n) _Pragma("unroll") for (int k = 0; k < 2; ++k) dst[n][k] = *(const PG8_LAS bf16x8*)(lds + PG8_SB(b, h) + boff + n * 2048 + k * 1024); } while (0)
#define PG8_MMA(ai, bj, At, Bt) do { __builtin_amdgcn_s_setprio(1); _Pragma("unroll") for (int m = 0; m < 4; ++m) _Pragma("unroll") for (int n = 0; n < 2; ++n) _Pragma("unroll") for (int k = 0; k < 2; ++k) \
        acc[ai][bj][m][n] = __builtin_amdgcn_mfma_f32_16x16x32_bf16(Bt[n][k], At[m][k], acc[ai][bj][m][n], 0, 0, 0); __builtin_amdgcn_s_setprio(0); } while (0)
#define PG8_WAIT_V(n) asm volatile("s_waitcnt vmcnt(" #n ")" ::: "memory")
#define PG8_WAIT_L(n) asm volatile("s_waitcnt lgkmcnt(" #n ")" ::: "memory")
#define PG8_BAR __builtin_amdgcn_s_barrier()
#define PG8_SCHED __builtin_amdgcn_sched_barrier(0)
    Unit cur, nxt; int ui = 0;
    if (!S.next(0, cur)) return;
    f32x4 acc[2][2][4][2];
#pragma unroll
    for (int a = 0; a < 2; ++a)
#pragma unroll
        for (int b = 0; b < 2; ++b)
#pragma unroll
            for (int m = 0; m < 4; ++m)
#pragma unroll
                for (int n = 0; n < 2; ++n) acc[a][b][m][n] = (f32x4){0.f, 0.f, 0.f, 0.f};
    bf16x8 At[4][2], B0[2][2], B1[2][2];
    const char* cA = (const char*)g.A + (size_t)cur.pm * tstep; const char* cB = (const char*)g.Bt + (size_t)cur.pn * tstep;
    S.a_ready(cur);
    PG8_STAGE(PG8_SB(0, 0), cB, voffB); PG8_STAGE(PG8_SA(0, 0), cA, voffA); PG8_STAGE(PG8_SB(0, 1), cB + hstep, voffB); PG8_STAGE(PG8_SA(0, 1), cA + hstep, voffA);
    if (wr == 1) PG8_BAR;
    PG8_WAIT_V(4); PG8_BAR;
    PG8_STAGE(PG8_SB(1, 0), cB + kstep, voffB); PG8_STAGE(PG8_SA(1, 0), cA + kstep, voffA); PG8_STAGE(PG8_SB(1, 1), cB + hstep + kstep, voffB);
    PG8_WAIT_V(6); PG8_BAR;
    PG8_STAMP();
    for (;;) {
        const bool has_next = S.next(ui + 1, nxt);
        const char* nA = has_next ? (const char*)g.A + (size_t)nxt.pm * tstep : cA; const char* nB = has_next ? (const char*)g.Bt + (size_t)nxt.pn * tstep : cB;
        for (int t = 0; t < nt; t += 2) {
            const bool last = (t == nt - 2);
            const char* a1 = cA + (size_t)(t + 1) * kstep;
            const char* a2 = last ? nA : cA + (size_t)(t + 2) * kstep; const char* b2 = last ? nB : cB + (size_t)(t + 2) * kstep;
            const char* a3 = a2 + kstep; const char* b3 = b2 + kstep;
            if (last && has_next) S.a_ready(nxt);
            PG8_LDB(B0, 0, 0); PG8_SCHED; PG8_LDA(At, 0, 0); PG8_STAGE(PG8_SA(1, 1), a1 + hstep, voffA);
            PG8_WAIT_L(8); PG8_BAR; PG8_WAIT_L(0); PG8_MMA(0, 0, At, B0); PG8_BAR; PG8_SCHED;
            PG8_LDB(B1, 0, 1); PG8_STAGE(PG8_SB(0, 0), b2, voffB);
            PG8_BAR; PG8_WAIT_L(0); PG8_MMA(0, 1, At, B1); PG8_BAR;
            PG8_LDA(At, 0, 1); PG8_STAGE(PG8_SA(0, 0), a2, voffA);
            PG8_BAR; PG8_WAIT_L(0); PG8_MMA(1, 0, At, B0); PG8_BAR; PG8_SCHED;
            PG8_STAGE(PG8_SB(0, 1), b2 + hstep, voffB);
            PG8_WAIT_V(6); PG8_BAR; PG8_MMA(1, 1, At, B1); PG8_BAR;
            PG8_LDB(B0, 1, 0); PG8_SCHED; PG8_LDA(At, 1, 0); PG8_STAGE(PG8_SA(0, 1), a2 + hstep, voffA);
            PG8_WAIT_L(8); PG8_BAR; PG8_WAIT_L(0); PG8_MMA(0, 0, At, B0); PG8_BAR; PG8_SCHED;
            PG8_LDB(B1, 1, 1); PG8_STAGE(PG8_SB(1, 0), b3, voffB);
            PG8_BAR; PG8_WAIT_L(0); PG8_MMA(0, 1, At, B1); PG8_BAR;
            PG8_LDA(At, 1, 1); PG8_STAGE(PG8_SA(1, 0), a3, voffA);
            PG8_BAR; PG8_WAIT_L(0); PG8_MMA(1, 0, At, B0); PG8_BAR; PG8_SCHED;
            PG8_STAGE(PG8_SB(1, 1), b3 + hstep, voffB);
            PG8_WAIT_V(6); PG8_BAR; PG8_MMA(1, 1, At, B1); PG8_BAR;
        }
        PG8_STAMP();
        if constexpr (!Epi::AFTER_DRAIN) { E(acc, cur, wr, wc, fr, fq); S.done(cur); }
        PG8_STAMP();
        if (!has_next) break;
#pragma unroll
        for (int a = 0; a < 2; ++a)
#pragma unroll
            for (int b = 0; b < 2; ++b)
#pragma unroll
                for (int m = 0; m < 4; ++m)
#pragma unroll
                    for (int n = 0; n < 2; ++n) acc[a][b][m][n] = (f32x4){0.f, 0.f, 0.f, 0.f};
        cur = nxt; cA = nA; cB = nB; ++ui;
    }
    PG8_WAIT_V(0);
    if (wr == 0) PG8_BAR;
    PG8_BAR;
    if constexpr (Epi::AFTER_DRAIN) { E.fused(acc, cur, wr, wc, fr, fq, lds, wid, lane); S.done(cur); }
    PG8_STAMP();
    if (STAMP && wid == 0) { stamps[lane] = lane < nts ? (((unsigned long long)(unsigned)ts_hi << 32) | (unsigned)ts_lo) : 0ull;
        if (lane == 62) stamps[62] = rt_entry; if (lane == 63) stamps[63] = (unsigned long long)wall_clock64(); }
#undef PG8_STAMP
#undef PG8_SA
#undef PG8_SB
#undef PG8_STAGE
#undef PG8_LDA
#undef PG8_LDB
#undef PG8_MMA
#undef PG8_WAIT_V
#undef PG8_WAIT_L
#undef PG8_BAR
#undef PG8_SCHED
}
}
#define XB_TMO      128
#define XB_XCNT(j)  (256  + 64 * (j))
#define XB_XSUB(j)  (1280 + 64 * (j))
#define XB_XGEN(j)  (2304 + 64 * (j))
#define XB_TOP      3328
#define XB_TOPGEN   3392
#define XCD_BAR_WORDS 3456
#define XB_SPIN_CAP (1u << 18)
#define LAS __attribute__((address_space(3)))

__device__ __forceinline__ unsigned xb_ld(unsigned* p)              { return __hip_atomic_load(p, __ATOMIC_RELAXED, __HIP_MEMORY_SCOPE_AGENT); }
__device__ __forceinline__ unsigned xb_add(unsigned* p, unsigned v) { return __hip_atomic_fetch_add(p, v, __ATOMIC_RELAXED, __HIP_MEMORY_SCOPE_AGENT); }
__device__ __forceinline__ unsigned xb_xcc_id() { return (unsigned)__builtin_amdgcn_s_getreg((3 << 11) | 20) & 0xFu; }
#define XB_SPIN(cond, bar) do { unsigned _sp = 0; while (cond) { __builtin_amdgcn_s_sleep(1); \
    if ((++_sp & 255u) == 0u) { if (xb_ld(&(bar)[XB_TMO])) break; if (_sp > XB_SPIN_CAP) { atomicAdd(&(bar)[XB_TMO], 1u); break; } } } } while (0)

struct XcdBarrier {
    unsigned* bar; unsigned x;
    volatile LAS unsigned* st;
};

__device__ __forceinline__ XcdBarrier xcd_barrier_post(unsigned* bar, volatile LAS unsigned* st) {
    XcdBarrier b; b.bar = bar; b.x = xb_xcc_id(); b.st = st;
    if (threadIdx.x == 0) (void)xb_add(&bar[XB_XCNT(b.x)], 1u);
    return b;
}
__device__ __forceinline__ void xcd_barrier_complete(unsigned* bar, unsigned x, unsigned& nloc, unsigned& nx) {
    const unsigned G = gridDim.x * gridDim.y * gridDim.z;
    unsigned sum, cnt, mine, sp = 0u;
    for (;;) {
        sum = 0u; cnt = 0u; mine = 0u;
#pragma unroll
        for (unsigned j = 0; j < 16; ++j) { const unsigned c = xb_ld(&bar[XB_XCNT(j)]); sum += c; cnt += (c > 0u) ? 1u : 0u; mine = (j == x) ? c : mine; }
        if (sum == G) break;
        __builtin_amdgcn_s_sleep(1);
        if ((++sp & 255u) == 0u) { if (xb_ld(&bar[XB_TMO])) break; if (sp > XB_SPIN_CAP) { atomicAdd(&bar[XB_TMO], 1u); break; } }
    }
    nloc = mine > 0u ? mine : 1u; nx = cnt > 0u ? cnt : 1u;
}

__device__ __forceinline__ void xcd_barrier(const XcdBarrier& b) {
    asm volatile("s_waitcnt vmcnt(0)" ::: "memory");
    __syncthreads();
    if (threadIdx.x == 0) {
        unsigned* bar = b.bar;
        __builtin_amdgcn_s_waitcnt(0);
        unsigned nloc = b.st[0], nx = b.st[1];
        if (nloc == 0u) { xcd_barrier_complete(bar, b.x, nloc, nx); b.st[0] = nloc; b.st[1] = nx; }
        const unsigned old = xb_add(&bar[XB_XSUB(b.x)], 1u);
        const unsigned gen = old / nloc;
        if (old + 1u == (gen + 1u) * nloc) {
            __builtin_amdgcn_fence(__ATOMIC_RELEASE, "agent");
            asm volatile("s_waitcnt vmcnt(0)" ::: "memory");
            const unsigned og = xb_add(&bar[XB_TOP], 1u);
            const unsigned tg = og / nx;
            if (og + 1u == (tg + 1u) * nx) xb_add(&bar[XB_TOPGEN], 1u);
            else XB_SPIN(xb_ld(&bar[XB_TOPGEN]) == tg, bar);
            __builtin_amdgcn_fence(__ATOMIC_ACQUIRE, "agent");
            xb_add(&bar[XB_XGEN(b.x)], 1u);
            asm volatile("s_waitcnt vmcnt(0)" ::: "memory");
        } else {
            XB_SPIN(xb_ld(&bar[XB_XGEN(b.x)]) == gen, bar);
            __builtin_amdgcn_fence(__ATOMIC_ACQUIRE, "agent");
            asm volatile("s_waitcnt vmcnt(0)" ::: "memory");
        }
    }
    __syncthreads();
}

struct Args { const float* in[25]; float* out; unsigned char* ws; int ph_lo, ph_hi; };
#define LAS __attribute__((address_space(3)))

struct CvtJob { const float* src; int ld; int ncols; int K; const float* kscale; int kind; bf16_t* dst; bf16_t* dst2; };
__device__ __forceinline__ bf16_t* cvt_dst_row(const CvtJob& j, int c) {
    switch (j.kind) {
    case 0: return j.dst + (size_t)c * j.K;
    case 1: {
        if (c < 2560) return j.dst + (size_t)c * DM;
        if (c < 2584) return j.dst2 + (size_t)(c - 2560) * DM;
        if (c < 4120) return j.dst + (size_t)(c - 24) * DM;
        if (c < 4184) return j.dst2 + (size_t)(24 + c - 4120) * DM;
        if (c < 4188) return j.dst2 + (size_t)(88 + c - 4184) * DM;
        return j.dst + (size_t)(c - 92) * DM; }
    case 2: return j.dst + ((size_t)(c >> 7) * 256 + (c & 127)) * j.K;
    default: return j.dst + ((size_t)(c >> 7) * 256 + 128 + (c & 127)) * j.K;
    }
}
__device__ __forceinline__ void cvt_tile(LAS float* tl, const CvtJob& j, int kt, int ct) {
    const int tid = LTID, k0 = kt * 64, c0 = ct * 64;
    { const int jj = tid & 63, i0 = tid >> 6; const bool ok = (c0 + jj) < j.ncols;
#pragma unroll
      for (int m = 0; m < 8; ++m) { const int i = i0 + 8 * m; tl[i * 65 + jj] = ok ? j.src[(size_t)(k0 + i) * j.ld + c0 + jj] : 0.f; } }
    __syncthreads();
    { const int n = tid >> 3, ks = tid & 7;
      if (c0 + n < j.ncols) { bf16_t* d = cvt_dst_row(j, c0 + n);
        if (d) { float v[8];
#pragma unroll
          for (int e = 0; e < 8; ++e) { v[e] = tl[(8 * ks + e) * 65 + n]; if (j.kscale) v[e] *= j.kscale[k0 + 8 * ks + e]; }
          u32x4 w = {cvtpk(v[0], v[1]), cvtpk(v[2], v[3]), cvtpk(v[4], v[5]), cvtpk(v[6], v[7])};
          *(u32x4*)(d + k0 + 8 * ks) = w; } } }
    __syncthreads();
}
constexpr int PT_WIN = 32 * 194, PT_W1 = 2 * 64 * 2, PT_W2 = 2 * 2 * 2, PT_WUK = 8 * 4 * 2, PT_WB = 3 * 16 * 32, PT_WO = 32 * 32, PT_EX = 16 * 32 * 8, PT_DN = 16 * 8 * 32;
constexpr int PT_LAYER = PT_WIN + PT_W1 + PT_W2 + 2 * PT_WUK + PT_WB + PT_WO + 2 * PT_EX + PT_DN;

__device__ __forceinline__ void p0_prologue(const Args& a, LAS unsigned char* lds) {
    LAS float* tl = (LAS float*)lds;
    unsigned char* ws = launder_s(a.ws);
    const int G = gridDim.x, wg = LBID, tid = LTID;
    for (int ti = wg; ti < NL * PT_LAYER; ti += G) {
        const int l = ti / PT_LAYER; int r = ti % PT_LAYER;
        CvtJob j; j.kscale = nullptr; j.dst2 = nullptr; int kt, ct;
        if (r < PT_WIN) { j.src = a.in[1] + (size_t)l * DM * IN_COLS; j.ld = IN_COLS; j.ncols = IN_COLS; j.K = DM; j.kind = 1;
            j.dst = (bf16_t*)(ws + WS_WIN) + (size_t)l * NMAIN * DM; j.dst2 = (bf16_t*)(ws + WS_WSK) + (size_t)l * NSK * DM; kt = r % 32; ct = r / 32; }
        else if ((r -= PT_WIN) < PT_W1) { const int kv = r / 128; r %= 128; j.src = a.in[2] + ((size_t)l * 2 + kv) * 4096 * 128; j.ld = 128; j.ncols = 128; j.K = 4096; j.kind = 0;
            j.dst = (bf16_t*)(ws + WS_W1) + ((size_t)l * 2 + kv) * 128 * 4096; kt = r % 64; ct = r / 64; }
        else if ((r -= PT_W1) < PT_W2) { const int kv = r / 4; r %= 4; j.src = a.in[3] + ((size_t)l * 2 + kv) * 128 * 128; j.ld = 128; j.ncols = 128; j.K = 128; j.kind = 0;
            j.dst = (bf16_t*)(ws + WS_W2) + ((size_t)l * 2 + kv) * 128 * 128; kt = r % 2; ct = r / 2; }
        else if ((r -= PT_W2) < 2 * PT_WUK) { const int which = r / PT_WUK; r %= PT_WUK; const int h = r / 8; r %= 8;
            j.src = a.in[which ? 6 : 5] + ((size_t)l * 8 + h) * 256 * 128; j.ld = 128; j.ncols = 128; j.K = 256; j.kind = 0; j.kscale = a.in[7] + (size_t)l * 256;
            j.dst = (bf16_t*)(ws + WS_WKVUP) + ((size_t)l * 2048 + which * 1024 + h * 128) * 256; kt = r % 4; ct = r / 4; }
        else if ((r -= 2 * PT_WUK) < PT_WB) { const int n = r / 512; r %= 512; j.src = a.in[12] + ((size_t)l * 3 + n) * 1024 * 2048; j.ld = 2048; j.ncols = 2048; j.K = 1024; j.kind = 0;
            j.dst = (bf16_t*)(ws + WS_WB) + ((size_t)l * 3 + n) * 2048 * 1024; kt = r % 16; ct = r / 16; }
        else if ((r -= PT_WB) < PT_WO) { j.src = a.in[13] + (size_t)l * 2048 * 2048; j.ld = 2048; j.ncols = 2048; j.K = 2048; j.kind = 0;
            j.dst = (bf16_t*)(ws + WS_WO) + (size_t)l * 2048 * 2048; kt = r % 32; ct = r / 32; }
        else if ((r -= PT_WO) < 2 * PT_EX) { const int which = r / PT_EX; r %= PT_EX; const int e = r / 256; r %= 256;
            j.src = a.in[which ? 21 : 20] + ((size_t)l * 16 + e) * 2048 * 512; j.ld = 512; j.ncols = 512; j.K = 2048; j.kind = which ? 3 : 2;
            j.dst = (bf16_t*)(ws + WS_WGU) + ((size_t)l * 16 + e) * 1024 * 2048; kt = r % 32; ct = r / 32; }
        else { r -= 2 * PT_EX; const int e = r / 256; r %= 256;
            j.src = a.in[22] + ((size_t)l * 16 + e) * 512 * 2048; j.ld = 2048; j.ncols = 2048; j.K = 512; j.kind = 0;
            j.dst = (bf16_t*)(ws + WS_WD) + ((size_t)l * 16 + e) * 2048 * 512; kt = r % 8; ct = r / 8; }
        cvt_tile(tl, j, kt, ct);
    }
    const size_t gtid = (size_t)wg * 512 + tid, gn = (size_t)G * 512;
    for (size_t i = gtid; i < (size_t)NL * 36 * DM; i += gn) { const size_t l = i / (36 * DM), r = i % (36 * DM); ((bf16_t*)(ws + WS_WSK))[(l * NSK + 92) * DM + r] = 0; }
    for (size_t i = gtid; i < (size_t)NL * 8 * 128 * 128; i += gn) { const int s = (int)(i & 127), t = (int)((i >> 7) & 127); ((bf16_t*)(ws + WS_WSTRIL))[i] = (s <= t) ? f2bf(a.in[10][i]) : (bf16_t)0; }
    for (size_t i = gtid; i < (size_t)NL * 32 * DM; i += gn) { const int k = (int)(i % DM), n = (int)((i / DM) % 32), l = (int)(i / ((size_t)32 * DM));
        float v = 0.f; if (n < 4) v = a.in[16][((size_t)l * DM + k) * 4 + n]; else if (n < 20) v = a.in[18][((size_t)l * DM + k) * 16 + (n - 4)];
        const bf16_t h = f2bf(v); const bf16_t lo = f2bf(v - bf2f(h));
        bf16_t* d = (bf16_t*)(ws + WS_WR) + (size_t)l * 2 * 32 * DM; d[(size_t)n * DM + k] = h; d[(size_t)(32 + n) * DM + k] = lo; }
    for (int job = wg; job < NL * 2; job += G) {
        const float* pe = a.in[4] + (size_t)job * 4096; const float* w1 = a.in[2] + (size_t)job * 4096 * 128;
        const int n = tid & 127, q = tid >> 7; float s = 0.f;
        for (int k = q * 1024; k < (q + 1) * 1024; ++k) s += pe[k] * w1[(size_t)k * 128 + n];
        tl[q * 128 + n] = s; __syncthreads();
        if (tid < 128) ((float*)(ws + WS_C1))[job * 128 + tid] = (tl[tid] + tl[128 + tid]) + (tl[256 + tid] + tl[384 + tid]);
        __syncthreads();
    }
    for (size_t i = gtid; i < (size_t)NTOK * DM / 8; i += gn) { const f32x4 v0 = *(const f32x4*)(a.in[0] + i * 8), v1 = *(const f32x4*)(a.in[0] + i * 8 + 4);
        *(bf16x8*)((bf16_t*)(ws + WS_XB) + i * 8) = pack8(v0, v1); }
}

#define MFMA32(a, b, c) __builtin_amdgcn_mfma_f32_32x32x16_bf16((a), (b), (c), 0, 0, 0)
__device__ __forceinline__ int crow(int r, int hi) { return (r & 3) + 8 * (r >> 2) + 4 * hi; }

__device__ __forceinline__ void skinny_item(const Args& a, int l, LAS unsigned char* lds) {
    unsigned char* ws = launder_s(a.ws);
    const int tid = LTID, wid = __builtin_amdgcn_readfirstlane(tid >> 6), lane = tid & 63, r32 = lane & 31, hi = lane >> 5;
    const bf16_t* xb = (const bf16_t*)(ws + WS_XB); const bf16_t* wsk = (const bf16_t*)(ws + WS_WSK) + (size_t)l * NSK * DM;
    for (int it = LBID; it < NTOK / 32; it += gridDim.x) {
        const int row0 = it * 32;
        f32x16 acc[3] = {};
        const bf16_t* ap = xb + (size_t)(row0 + r32) * DM + 256 * wid + 8 * hi;
        const bf16_t* bp = wsk + (size_t)r32 * DM + 256 * wid + 8 * hi;
#pragma unroll 4
        for (int ks = 0; ks < 16; ++ks) {
            const bf16x8 af = *(const bf16x8*)(ap + 16 * ks);
#pragma unroll
            for (int nb = 0; nb < 3; ++nb) { const bf16x8 bfr = *(const bf16x8*)(bp + (size_t)nb * 32 * DM + 16 * ks); acc[nb] = MFMA32(af, bfr, acc[nb]); }
        }
        LAS float* red = (LAS float*)lds;
#pragma unroll
        for (int nb = 0; nb < 3; ++nb)
#pragma unroll
            for (int r = 0; r < 16; ++r) red[((wid * 3 + nb) * 16 + r) * 64 + lane] = acc[nb][r];
        __syncthreads();
        for (int i = tid; i < 3 * 16 * 64; i += 512) {
            float s = 0.f;
#pragma unroll
            for (int w = 0; w < 8; ++w) s += red[w * 3072 + i];
            const int ln = i & 63, r = (i >> 6) & 15, nb = i >> 10;
            const int row = row0 + crow(r, ln >> 5), n = nb * 32 + (ln & 31);
            if (n < 24) ((float*)(ws + WS_SKF))[(size_t)row * 32 + n] = fast_sigmoid(s);
            else if (n < 88) ((bf16_t*)(ws + WS_KI))[(size_t)row * 64 + (n - 24)] = f2bf(s);
            else if (n < 92) ((float*)(ws + WS_SKF))[(size_t)row * 32 + 24 + (n - 88)] = s;
        }
        __syncthreads();
    }
}

struct EpiInProj {
    static constexpr bool PERM = true, AFTER_DRAIN = false;
    unsigned char* ws;
    __device__ __forceinline__ void operator()(const f32x4 (&acc)[2][2][4][2], const pg8::Unit& u, int wr, int wc, int fr, int fq) const {
        const int pn = u.pn; size_t off; int ld, ct, act = 0;
        if (pn < 4)       { off = WS_QA; ld = 1024; ct = pn; }
        else if (pn < 10) { off = WS_KV; ld = 1536; ct = pn - 4; }
        else if (pn < 14) { off = WS_QB; ld = 1024; ct = pn - 10; }
        else if (pn < 15) { off = WS_HC; ld = 256;  ct = 0; }
        else if (pn < 16) { off = WS_QI; ld = 256;  ct = 0; }
        else if (pn < 20) { off = WS_HU; ld = 1024; ct = pn - 16; act = 1; }
        else if (pn < 24) { off = WS_HV; ld = 1024; ct = pn - 20; act = 1; }
        else              { off = WS_HG; ld = 6144; ct = pn - 24; act = 2; }
        bf16_t* base = (bf16_t*)(ws + off);
        const int row0 = u.pm * 256 + wr * 64 + fr, col0 = ct * 256 + wc * 32 + 8 * fq;
#pragma unroll
        for (int ai = 0; ai < 2; ++ai)
#pragma unroll
            for (int m = 0; m < 4; ++m) {
                const int row = row0 + ai * 128 + m * 16; bf16_t* rowp = base + (size_t)row * ld + col0;
                float sq = 0.f;
#pragma unroll
                for (int bj = 0; bj < 2; ++bj) {
                    f32x4 v0 = acc[ai][bj][m][0], v1 = acc[ai][bj][m][1];
                    if (act == 1) {
#pragma unroll
                        for (int e = 0; e < 4; ++e) { v0[e] = gelu_tanh(v0[e]); v1[e] = gelu_tanh(v1[e]); } }
                    else if (act == 2) {
#pragma unroll
                        for (int e = 0; e < 4; ++e) { v0[e] = fast_sigmoid(v0[e]); v1[e] = fast_sigmoid(v1[e]); } }
                    if (pn == 14) {
#pragma unroll
                        for (int e = 0; e < 4; ++e) sq += v0[e] * v0[e] + v1[e] * v1[e]; }
                    u32x4 w; w.x = cvtpk(v0[0], v0[1]); w.y = cvtpk(v0[2], v0[3]); w.z = cvtpk(v1[0], v1[1]); w.w = cvtpk(v1[2], v1[3]);
                    *(u32x4*)(rowp + bj * 128) = w;
                }
                if (pn == 14) { sq += __shfl_xor(sq, 16); sq += __shfl_xor(sq, 32); if (fq == 0) ((float*)(ws + WS_PSQ))[(size_t)row * 4 + wc] = sq; }
            }
    }
};

namespace att {
constexpr int SHM = 16384;
constexpr int L_V = 0, L_K = 2 * SHM, L_WS = 4 * SHM;
constexpr int L_IMP = 69632;
constexpr int L_SELM = L_IMP + 4 * 64 * 33 * 4;
constexpr int L_MISC = L_SELM + 512;
#define KSWZ(row, colB) ((row) * 256 + ((colB) ^ (((row) & 7) << 4)))
__device__ __forceinline__ int v_st(int k, int c) { const int kk = (k & ~0xC) | ((k & 4) << 1) | ((k & 8) >> 1); return ((kk >> 3) * 4 + (c >> 5)) * 512 + ((kk & 7) * 32 + (c & 31)) * 2; }
__device__ __forceinline__ int v_rd_base(int lane) { return ((lane & 3) << 3) | (((lane >> 2) & 3) << 6) | (((lane >> 4) & 1) << 5) | (((lane >> 5) & 1) << 8); }

struct Ctx { int tid, wid, lane, r32, hi, sr, sc, kws, vst0, vst1, vb0; LAS char* lds; LAS float* li_l; LAS float* al_l; };
__device__ __forceinline__ Ctx make_ctx(LAS unsigned char* lds) {
    Ctx c; c.tid = LTID; c.wid = __builtin_amdgcn_readfirstlane(c.tid >> 6); c.lane = c.tid & 63; c.r32 = c.lane & 31; c.hi = c.lane >> 5;
    c.sr = c.tid >> 4; c.sc = (c.tid & 15) * 8; c.kws = KSWZ(c.sr, c.sc * 2); c.vst0 = v_st(c.sr, c.sc); c.vst1 = v_st(32 + c.sr, c.sc);
    c.lds = (LAS char*)lds; c.vb0 = (int)(unsigned)(uintptr_t)(c.lds + L_V) + v_rd_base(c.lane);
    c.li_l = (LAS float*)(c.lds + L_WS + c.wid * 256); c.al_l = c.li_l + 32; return c;
}
struct Stage { bf16x8 k0, k1, v0, v1; };
__device__ __forceinline__ void stage_load(Stage& s, const Ctx& c, const bf16_t* K, int ldk, const bf16_t* V, int ldv, int key0) {
    s.v0 = *(const bf16x8*)(V + (size_t)(key0 + c.sr) * ldv + c.sc); s.v1 = *(const bf16x8*)(V + (size_t)(key0 + 32 + c.sr) * ldv + c.sc);
    s.k0 = *(const bf16x8*)(K + (size_t)(key0 + c.sr) * ldk + c.sc); s.k1 = *(const bf16x8*)(K + (size_t)(key0 + 32 + c.sr) * ldk + c.sc);
}
template <int BUF> __device__ __forceinline__ void stage_write(const Stage& s, const Ctx& c) {
    *(LAS bf16x8*)(c.lds + L_K + BUF * SHM + c.kws) = s.k0; *(LAS bf16x8*)(c.lds + L_K + BUF * SHM + c.kws + 32 * 256) = s.k1;
    *(LAS bf16x8*)(c.lds + L_V + BUF * SHM + c.vst0) = s.v0; *(LAS bf16x8*)(c.lds + L_V + BUF * SHM + c.vst1) = s.v1;
}
template <int KB> __device__ __forceinline__ void qkt(f32x16& p0, f32x16& p1, const Ctx& c, const bf16x8 (&qr)[8]) {
    p0 = f32x16{}; p1 = f32x16{};
    LAS const char* kb[4];
#pragma unroll
    for (int dd = 0; dd < 4; ++dd) kb[dd] = c.lds + L_K + KB * SHM + KSWZ(c.r32, (dd * 16 + c.hi * 8) * 2);
#pragma unroll
    for (int d0 = 0; d0 < 8; ++d0) { LAS const char* a = kb[d0 & 3] + (d0 >> 2) * 128;
        const bf16x8 b0 = *(LAS const bf16x8*)a; const bf16x8 b1 = *(LAS const bf16x8*)(a + 32 * 256);
        p0 = MFMA32(b0, qr[d0], p0); p1 = MFMA32(b1, qr[d0], p1); }
}
template <int VB> __device__ __forceinline__ void pv_tile(f32x16 (&o)[4], int vb0, bf16x8 pa0, bf16x8 pa1, bf16x8 pa2, bf16x8 pa3) {
#define TRRD(dst, off) asm volatile("ds_read_b64_tr_b16 %0, %1 offset:%2" : "=&v"(dst) : "v"(vb0), "i"(off) : "memory")
#define PV_D0(d0) do { s16x4 l0, l1, l2, l3, h0, h1, h2, h3; constexpr int b_ = VB * SHM + (d0) * 512; \
        TRRD(l0, b_); TRRD(h0, b_ + 2048); TRRD(l1, b_ + 4096); TRRD(h1, b_ + 6144); TRRD(l2, b_ + 8192); TRRD(h2, b_ + 10240); TRRD(l3, b_ + 12288); TRRD(h3, b_ + 14336); \
        asm volatile("s_waitcnt lgkmcnt(0)" ::: "memory"); __builtin_amdgcn_sched_barrier(0); \
        o[d0] = MFMA32(pa0, ((bf16x8){l0[0], l0[1], l0[2], l0[3], h0[0], h0[1], h0[2], h0[3]}), o[d0]); \
        o[d0] = MFMA32(pa1, ((bf16x8){l1[0], l1[1], l1[2], l1[3], h1[0], h1[1], h1[2], h1[3]}), o[d0]); \
        o[d0] = MFMA32(pa2, ((bf16x8){l2[0], l2[1], l2[2], l2[3], h2[0], h2[1], h2[2], h2[3]}), o[d0]); \
        o[d0] = MFMA32(pa3, ((bf16x8){l3[0], l3[1], l3[2], l3[3], h3[0], h3[1], h3[2], h3[3]}), o[d0]); } while (0)
    PV_D0(0); PV_D0(1); PV_D0(2); PV_D0(3);
#undef PV_D0
#undef TRRD
}
__device__ __forceinline__ float pair_max(float v) { auto rr = __builtin_amdgcn_permlane32_swap(__float_as_uint(v), __float_as_uint(v), false, false); return fmaxf(__uint_as_float(rr[0]), __uint_as_float(rr[1])); }
__device__ __forceinline__ float pair_sum(float v) { auto rr = __builtin_amdgcn_permlane32_swap(__float_as_uint(v), __float_as_uint(v), false, false); return __uint_as_float(rr[0]) + __uint_as_float(rr[1]); }
#define PK4(P, B_, OUT) do { unsigned xa0_ = cvtpk(P[B_+0], P[B_+1]), xa1_ = cvtpk(P[B_+2], P[B_+3]); \
        unsigned xb0_ = cvtpk(P[B_+4], P[B_+5]), xb1_ = cvtpk(P[B_+6], P[B_+7]); \
        auto xr0_ = __builtin_amdgcn_permlane32_swap(xa0_, xb0_, false, false); auto xr1_ = __builtin_amdgcn_permlane32_swap(xa1_, xb1_, false, false); \
        u32x4 xw_ = {xr0_[0], xr1_[0], xr0_[1], xr1_[1]}; OUT = *reinterpret_cast<bf16x8*>(&xw_); } while (0)

enum { MODE_WIN = 0, MODE_SEL = 1, MODE_BITS = 2, MODE_CMP = 3 };
template <int MODE> __device__ __forceinline__ void bias_mask(f32x16& p0, f32x16& p1, float bias0, float slope2k, int dq, unsigned W, bool rowsel, unsigned wlo, unsigned whi, int lim) {
    const float NEG = -__builtin_inff();
#pragma unroll
    for (int r = 0; r < 16; ++r) {
        const int cc = (r & 3) + 8 * (r >> 2);
        const float y0 = fmaf(p0[r], ATT_C2, fmaf(slope2k, (float)cc, bias0)), y1 = fmaf(p1[r], ATT_C2, fmaf(slope2k, (float)(cc + 32), bias0));
        bool ok0, ok1;
        if (MODE == MODE_WIN)       { ok0 = (unsigned)(dq - cc) < W; ok1 = (unsigned)(dq - cc - 32) < W; }
        else if (MODE == MODE_SEL)  { ok0 = rowsel && (dq - cc >= 0); ok1 = rowsel && (dq - cc - 32 >= 0); }
        else if (MODE == MODE_BITS) { ok0 = (wlo >> cc) & 1u; ok1 = (whi >> cc) & 1u; }
        else                        { ok0 = cc <= lim; ok1 = cc + 32 <= lim; }
        p0[r] = ok0 ? y0 : NEG; p1[r] = ok1 ? y1 : NEG;
    }
}
__device__ __forceinline__ void softmax_step(f32x16& p0, f32x16& p1, float& m, float& l, f32x16 (&o)[4], const Ctx& c, bf16x8& pa0, bf16x8& pa1, bf16x8& pa2, bf16x8& pa3) {
    float pmax = p0[0];
#pragma unroll
    for (int r = 1; r < 16; ++r) pmax = fmaxf(pmax, p0[r]);
#pragma unroll
    for (int r = 0; r < 16; ++r) pmax = fmaxf(pmax, p1[r]);
    pmax = pair_max(pmax);
    const float mn = fmaxf(m, pmax), alpha = __builtin_amdgcn_exp2f(m - mn); m = mn;
#pragma unroll
    for (int r = 0; r < 16; ++r) { p0[r] = __builtin_amdgcn_exp2f(p0[r] - mn); p1[r] = __builtin_amdgcn_exp2f(p1[r] - mn); }
    float ps = 0.f;
#pragma unroll
    for (int r = 0; r < 16; ++r) ps += p0[r] + p1[r];
    ps = pair_sum(ps); l = l * alpha + ps;
    PK4(p0, 0, pa0); PK4(p0, 8, pa1); PK4(p1, 0, pa2); PK4(p1, 8, pa3);
    if (__any(alpha < 1.f)) {
        if (c.hi == 0) c.al_l[c.r32] = alpha;
        asm volatile("s_waitcnt lgkmcnt(0)" ::: "memory");
#pragma unroll
        for (int r = 0; r < 16; ++r) { const float al = c.al_l[crow(r, c.hi)];
#pragma unroll
            for (int d = 0; d < 4; ++d) o[d][r] *= al; }
    }
}
struct BranchArgs {
    const bf16_t* K; const bf16_t* V; int ldk, ldv;
    unsigned tilemask;
    int t; float slope2;
    unsigned rowsel;
    const unsigned long long* mrow;
    unsigned W;
};
template <int MODE, int BUF> __device__ __forceinline__ void branch_step(const Ctx& c, const bf16x8 (&qr)[8], const BranchArgs& A, int j, unsigned long long mw, f32x16 (&o)[4], float& m, float& l) {
    f32x16 p0, p1; bf16x8 pa0, pa1, pa2, pa3;
    qkt<BUF>(p0, p1, c, qr);
    const int kb = j * 64, dq = A.t - kb - 4 * c.hi;
    if (MODE == MODE_CMP) {
        bias_mask<MODE>(p0, p1, -A.slope2 * (float)(A.t - 31 - 16 * (kb + 4 * c.hi)), A.slope2 * 16.f, 0, 0u, false, 0u, 0u, (int)A.W - kb - 4 * c.hi);
    } else {
        const float bias0 = -A.slope2 * (float)dq;
        bias_mask<MODE>(p0, p1, bias0, A.slope2, dq, A.W, (A.rowsel >> j) & 1u, (unsigned)(mw >> (4 * c.hi)), (unsigned)(mw >> (32 + 4 * c.hi)), 0);
    }
    softmax_step(p0, p1, m, l, o, c, pa0, pa1, pa2, pa3);
    pv_tile<BUF>(o, c.vb0, pa0, pa1, pa2, pa3);
}
template <int MODE> __device__ __forceinline__ void attn_branch(const Ctx& c, const bf16x8 (&qr)[8], const BranchArgs& A, f32x16 (&o)[4], float& l, float& m) {
    m = -1e30f; l = 0.f;
#pragma unroll
    for (int d = 0; d < 4; ++d) o[d] = f32x16{};
    unsigned rest = A.tilemask; int j = __builtin_ctz(rest); rest &= rest - 1;
    Stage sg; unsigned long long mw = 0, mwn = 0;
    stage_load(sg, c, A.K, A.ldk, A.V, A.ldv, j * 64);
    if (MODE == MODE_BITS) mw = A.mrow[j];
    stage_write<0>(sg, c);
    __syncthreads();
    for (;;) {
        { const bool has_next = rest != 0u; const int jn = has_next ? __builtin_ctz(rest) : j; rest &= rest - 1;
          if (has_next) { stage_load(sg, c, A.K, A.ldk, A.V, A.ldv, jn * 64); if (MODE == MODE_BITS) mwn = A.mrow[jn]; }
          branch_step<MODE, 0>(c, qr, A, j, mw, o, m, l);
          if (has_next) stage_write<1>(sg, c);
          __syncthreads();
          if (!has_next) break; j = jn; mw = mwn; }
        { const bool has_next = rest != 0u; const int jn = has_next ? __builtin_ctz(rest) : j; rest &= rest - 1;
          if (has_next) { stage_load(sg, c, A.K, A.ldk, A.V, A.ldv, jn * 64); if (MODE == MODE_BITS) mwn = A.mrow[jn]; }
          branch_step<MODE, 1>(c, qr, A, j, mw, o, m, l);
          if (has_next) stage_write<0>(sg, c);
          __syncthreads();
          if (!has_next) break; j = jn; mw = mwn; }
    }
}
__device__ __forceinline__ void row_coef(const Ctx& c, float coef, float (&cf)[16]) {
    if (c.hi == 0) c.li_l[c.r32] = coef;
    asm volatile("s_waitcnt lgkmcnt(0)" ::: "memory");
#pragma unroll
    for (int r = 0; r < 16; ++r) cf[r] = c.li_l[crow(r, c.hi)];
    asm volatile("s_waitcnt lgkmcnt(0)" ::: "memory");
}
__device__ __forceinline__ void store_rows_bf16(const Ctx& c, const f32x16 (&v)[4], bf16_t* base, size_t rowstride) {
#pragma unroll
    for (int r = 0; r < 16; ++r) { bf16_t* rp = base + (size_t)crow(r, c.hi) * rowstride;
#pragma unroll
        for (int d0 = 0; d0 < 4; ++d0) { const float x = v[d0][r]; const float xn = __shfl_xor(x, 1);
            if ((c.r32 & 1) == 0) *(unsigned*)(rp + d0 * 32 + c.r32) = cvtpk(x, xn); } }
}

__device__ __forceinline__ void nsa_item(const Args& a, LAS unsigned char* ldsu, int b, int hkv, int qb) {
    unsigned char* ws = launder_s(a.ws); Ctx c = make_ctx(ldsu);
    const int g = c.wid >> 1, half = c.wid & 1, head = hkv * 4 + g;
    const int tl = half * 32 + c.r32, t = qb * 64 + tl;
    const size_t tok = (size_t)b * SEQ + t;
    const float slope2 = __builtin_amdgcn_exp2f(-(float)(head + 1)) * LOG2E;
    bf16x8 qr[8];
    { const bf16_t* qp = (const bf16_t*)(ws + WS_QA) + tok * 1024 + head * 128 + c.hi * 8;
#pragma unroll
      for (int d0 = 0; d0 < 8; ++d0) qr[d0] = *(const bf16x8*)(qp + d0 * 16); }
    const float* gate = (const float*)(ws + WS_SKF) + tok * 32 + head * 3;
    float* TT = (float*)(ws + WS_TT) + ((size_t)LBID * 512 + c.tid) * 64;
    f32x16 o[4]; float cf[16];
    BranchArgs A; A.t = t; A.slope2 = slope2; A.mrow = nullptr; A.rowsel = 0;
#ifndef NSA_NO_CMP
    {
        const bf16_t* KC = (const bf16_t*)(ws + WS_KC) + (size_t)(b * 2 + hkv) * 128 * 128;
        const bool two = qb >= 16;
        int lim = (t - 31) >> 4; lim = lim > 126 ? 126 : lim;
        A.K = KC; A.V = KC + (size_t)8 * 128 * 128; A.ldk = 128; A.ldv = 128; A.tilemask = two ? 3u : 1u; A.W = (unsigned)lim;
        float l, m; attn_branch<MODE_CMP>(c, qr, A, o, l, m);
        const float inv = l > 0.f ? 1.0f / l : 0.f;
        if (two) {
            LAS float* IMP = (LAS float*)(c.lds + L_IMP) + (g * 64 + tl) * 33;
            float prev = 0.f;
#define IMP_TILE(BUF) do { f32x16 p0, p1; qkt<BUF>(p0, p1, c, qr); \
                bias_mask<MODE_CMP>(p0, p1, -slope2 * (float)(t - 31 - 16 * (BUF * 64 + 4 * c.hi)), slope2 * 16.f, 0, 0u, false, 0u, 0u, lim - BUF * 64 - 4 * c.hi); \
                _Pragma("unroll") for (int r = 0; r < 16; ++r) { p0[r] = __builtin_amdgcn_exp2f(p0[r] - m) * inv; p1[r] = __builtin_amdgcn_exp2f(p1[r] - m) * inv; } \
                _Pragma("unroll") for (int k = 0; k < 8; ++k) { const int mm = k & 3; \
                    const float s4 = (k < 4) ? (p0[4 * mm] + p0[4 * mm + 1]) + (p0[4 * mm + 2] + p0[4 * mm + 3]) : (p1[4 * mm] + p1[4 * mm + 1]) + (p1[4 * mm + 2] + p1[4 * mm + 3]); \
                    const float lst = (k < 4) ? p0[4 * mm + 3] : p1[4 * mm + 3]; \
                    auto rr = __builtin_amdgcn_permlane32_swap(__float_as_uint(lst), __float_as_uint(lst), false, false); \
                    const float from_lo = __uint_as_float(rr[0]), from_hi = __uint_as_float(rr[1]); \
                    IMP[2 * (BUF * 8 + k) + c.hi] = s4 + (c.hi ? from_lo : prev);     \
                    prev = from_hi; } } while (0)
            IMP_TILE(0); IMP_TILE(1);
#undef IMP_TILE
        }
        row_coef(c, gate[0] * inv, cf);
#pragma unroll
        for (int d0 = 0; d0 < 4; ++d0)
#pragma unroll
            for (int r4 = 0; r4 < 4; ++r4) { f32x4 v = {o[d0][4 * r4] * cf[4 * r4], o[d0][4 * r4 + 1] * cf[4 * r4 + 1], o[d0][4 * r4 + 2] * cf[4 * r4 + 2], o[d0][4 * r4 + 3] * cf[4 * r4 + 3]}; *(f32x4*)(TT + d0 * 16 + r4 * 4) = v; }
        __syncthreads();
    }
#endif
#ifndef NSA_NO_SELECT
    {
        LAS unsigned* SELM = (LAS unsigned*)(c.lds + L_SELM);
        if (c.wid == 0) {
            unsigned sel;
            if (qb <= 15) sel = (2u << qb) - 1u;
            else {
                LAS const float* I0 = (LAS const float*)(c.lds + L_IMP) + c.lane * 33;
                float v[32];
#pragma unroll
                for (int j = 0; j < 32; ++j) v[j] = (I0[j] + I0[64 * 33 + j]) + (I0[2 * 64 * 33 + j] + I0[3 * 64 * 33 + j]);
                sel = 1u | (1u << qb) | (1u << (qb - 1));
#pragma unroll
                for (int j = 1; j < 30; ++j) {
                    int rank = 0;
#pragma unroll
                    for (int j2 = 1; j2 < 30; ++j2) { const bool in2 = j2 <= qb - 2; const bool before = (v[j2] > v[j]) || (v[j2] == v[j] && j2 < j); rank += (in2 && before) ? 1 : 0; }
                    if (j <= qb - 2 && rank < 13) sel |= 1u << j;
                }
            }
            SELM[c.lane] = sel;
            unsigned any = sel;
#pragma unroll
            for (int ofs = 32; ofs >= 1; ofs >>= 1) any |= (unsigned)__shfl_xor((int)any, ofs);
            if (c.lane == 0) SELM[64] = any;
        }
        __syncthreads();
    }
#endif
    A.ldk = 1536; A.ldv = 1536; A.W = 0x7fffffffu;
    const bf16_t* KVb = (const bf16_t*)(ws + WS_KV) + (size_t)b * SEQ * 1536 + hkv * 128;
#ifndef NSA_NO_SEL
    {
        c = make_ctx(ldsu); ws = launder_s(ws);
        LAS const unsigned* SELM = (LAS const unsigned*)(c.lds + L_SELM);
        A.K = KVb + 512; A.V = KVb + 768; A.rowsel = SELM[tl];
        A.tilemask = (unsigned)__builtin_amdgcn_readfirstlane((int)SELM[64]) & ((2u << qb) - 1u);
        float l, m; attn_branch<MODE_SEL>(c, qr, A, o, l, m);
        row_coef(c, gate[1] * (l > 0.f ? 1.0f / l : 0.f), cf);
#pragma unroll
        for (int d0 = 0; d0 < 4; ++d0) {
#pragma unroll
            for (int r4 = 0; r4 < 4; ++r4) { f32x4 v = *(const f32x4*)(TT + d0 * 16 + r4 * 4);
                v[0] += o[d0][4 * r4] * cf[4 * r4]; v[1] += o[d0][4 * r4 + 1] * cf[4 * r4 + 1]; v[2] += o[d0][4 * r4 + 2] * cf[4 * r4 + 2]; v[3] += o[d0][4 * r4 + 3] * cf[4 * r4 + 3]; *(f32x4*)(TT + d0 * 16 + r4 * 4) = v; }
            asm volatile("" ::: "memory"); }
    }
#endif
#ifndef NSA_NO_WIN
    {
        c = make_ctx(ldsu); ws = launder_s(ws);
        A.K = KVb + 1024; A.V = KVb + 1280; A.W = 512u;
        const int jlo = qb >= 8 ? qb - 8 : 0;
        A.tilemask = ((2u << qb) - 1u) & ~((1u << jlo) - 1u);
        float l, m; attn_branch<MODE_WIN>(c, qr, A, o, l, m);
        row_coef(c, gate[2] * (l > 0.f ? 1.0f / l : 0.f), cf);
#pragma unroll
        for (int d0 = 0; d0 < 4; ++d0) {
#pragma unroll
            for (int r4 = 0; r4 < 4; ++r4) { const f32x4 v = *(const f32x4*)(TT + d0 * 16 + r4 * 4);
                o[d0][4 * r4] = v[0] + o[d0][4 * r4] * cf[4 * r4]; o[d0][4 * r4 + 1] = v[1] + o[d0][4 * r4 + 1] * cf[4 * r4 + 1]; o[d0][4 * r4 + 2] = v[2] + o[d0][4 * r4 + 2] * cf[4 * r4 + 2]; o[d0][4 * r4 + 3] = v[3] + o[d0][4 * r4 + 3] * cf[4 * r4 + 3]; }
            asm volatile("" ::: "memory"); }
        store_rows_bf16(c, o, (bf16_t*)(ws + WS_BR) + ((size_t)b * SEQ + qb * 64 + half * 32) * 1024 + head * 128, 1024);
    }
#endif
}

__device__ __forceinline__ void dsa_item(const Args& a, LAS unsigned char* ldsu, int b, int h, int qb) {
    unsigned char* ws = launder_s(a.ws); const Ctx c = make_ctx(ldsu);
    const int t = qb * 256 + c.wid * 32 + c.r32; const size_t tok = (size_t)b * SEQ + t;
    bf16x8 qr[8];
    { const bf16_t* qp = (const bf16_t*)(ws + WS_QB) + tok * 1024 + h * 128 + c.hi * 8;
#pragma unroll
      for (int d0 = 0; d0 < 8; ++d0) qr[d0] = *(const bf16x8*)(qp + d0 * 16); }
    BranchArgs A; A.ldk = 2048; A.ldv = 2048; A.t = t; A.slope2 = __builtin_amdgcn_exp2f(-(float)(h + 1)) * LOG2E; A.W = 0; A.rowsel = 0;
    const bf16_t* kv = (const bf16_t*)(ws + WS_KVUP) + (size_t)b * SEQ * 2048 + h * 128;
    A.K = kv; A.V = kv + 1024; A.mrow = (const unsigned long long*)(ws + WS_MASK) + tok * 32;
    const int nt = 4 * qb + 4; A.tilemask = nt >= 32 ? 0xffffffffu : ((1u << nt) - 1u);
    f32x16 o[4]; float l, m, cf[16];
    attn_branch<MODE_BITS>(c, qr, A, o, l, m);
    row_coef(c, l > 0.f ? 1.0f / l : 0.f, cf);
#pragma unroll
    for (int d0 = 0; d0 < 4; ++d0)
#pragma unroll
        for (int r = 0; r < 16; ++r) o[d0][r] *= cf[r];
    store_rows_bf16(c, o, (bf16_t*)(ws + WS_BR) + (size_t)NTOK * 1024 + ((size_t)b * SEQ + qb * 256 + c.wid * 32) * 1024 + h * 128, 1024);
}

__device__ __forceinline__ void gmlp_item(const Args& a, LAS unsigned char* ldsu, int l, int b, int ch, int gp) {
    unsigned char* ws = launder_s(a.ws); const Ctx c = make_ctx(ldsu);
    const size_t tok0 = (size_t)b * SEQ + ch * 128;
    const bf16_t* HV = (const bf16_t*)(ws + WS_HV);
#pragma unroll
    for (int gs = 0; gs < 2; ++gs)
#pragma unroll
        for (int st = 0; st < 2; ++st) {
            const bf16_t* vp = HV + (tok0 + st * 64) * 1024 + (2 * gp + gs) * 128 + c.sc;
            const bf16x8 x0 = *(const bf16x8*)(vp + (size_t)c.sr * 1024), x1 = *(const bf16x8*)(vp + (size_t)(32 + c.sr) * 1024);
            *(LAS bf16x8*)(c.lds + L_V + (2 * gs + st) * SHM + c.vst0) = x0; *(LAS bf16x8*)(c.lds + L_V + (2 * gs + st) * SHM + c.vst1) = x1;
        }
    __syncthreads();
    const int gs = c.wid >> 2, wq = c.wid & 3, g = 2 * gp + gs;
    const bf16_t* Wp = (const bf16_t*)(ws + WS_WSTRIL) + (((size_t)l * 8 + g) * 128 + wq * 32 + c.r32) * 128 + c.hi * 8;
    f32x16 o[4] = {};
    bf16x8 pa0 = *(const bf16x8*)(Wp), pa1 = *(const bf16x8*)(Wp + 16), pa2 = *(const bf16x8*)(Wp + 32), pa3 = *(const bf16x8*)(Wp + 48);
    if (gs == 0) pv_tile<0>(o, c.vb0, pa0, pa1, pa2, pa3); else pv_tile<2>(o, c.vb0, pa0, pa1, pa2, pa3);
    if (wq >= 2) {
        pa0 = *(const bf16x8*)(Wp + 64); pa1 = *(const bf16x8*)(Wp + 80); pa2 = *(const bf16x8*)(Wp + 96); pa3 = *(const bf16x8*)(Wp + 112);
        if (gs == 0) pv_tile<1>(o, c.vb0, pa0, pa1, pa2, pa3); else pv_tile<3>(o, c.vb0, pa0, pa1, pa2, pa3);
    }
    const float* bs = a.in[11] + ((size_t)l * 8 + g) * 128 + wq * 32;
    const bf16_t* HU = (const bf16_t*)(ws + WS_HU) + (tok0 + wq * 32) * 1024 + g * 128;
#pragma unroll
    for (int r = 0; r < 16; ++r) { const int rr = crow(r, c.hi); const float bias = bs[rr];
#pragma unroll
        for (int d0 = 0; d0 < 4; ++d0) o[d0][r] = (o[d0][r] + bias) * bf2f(HU[(size_t)rr * 1024 + d0 * 32 + c.r32]); }
    store_rows_bf16(c, o, (bf16_t*)(ws + WS_BR) + (size_t)2 * NTOK * 1024 + (tok0 + wq * 32) * 1024 + g * 128, 1024);
    __syncthreads();
}
}

struct EpiKvUp {
    static constexpr bool PERM = true, AFTER_DRAIN = false;
    unsigned char* ws;
    __device__ __forceinline__ void operator()(const f32x4 (&acc)[2][2][4][2], const pg8::Unit& u, int wr, int wc, int fr, int fq) const {
        bf16_t* base = (bf16_t*)(ws + WS_KVUP); const float* psq = (const float*)(ws + WS_PSQ);
        const int row0 = u.pm * 256 + wr * 64 + fr, col0 = u.pn * 256 + wc * 32 + 8 * fq;
#pragma unroll
        for (int ai = 0; ai < 2; ++ai)
#pragma unroll
            for (int m = 0; m < 4; ++m) {
                const int row = row0 + ai * 128 + m * 16; const f32x4 q = *(const f32x4*)(psq + (size_t)row * 4);
                const float rs = __builtin_amdgcn_rsqf(((q[0] + q[1]) + (q[2] + q[3])) * (1.0f / 256.0f) + LN_EPS);
                bf16_t* rowp = base + (size_t)row * 2048 + col0;
#pragma unroll
                for (int bj = 0; bj < 2; ++bj) { const f32x4 v0 = acc[ai][bj][m][0] * rs, v1 = acc[ai][bj][m][1] * rs;
                    u32x4 w; w.x = cvtpk(v0[0], v0[1]); w.y = cvtpk(v0[2], v0[3]); w.z = cvtpk(v1[0], v1[1]); w.w = cvtpk(v1[2], v1[3]);
                    *(u32x4*)(rowp + bj * 128) = w; }
                asm volatile("" ::: "memory");
            }
    }
};

__device__ __forceinline__ void gmlp_ln_rows(const Args& a, int l) {
    unsigned char* ws = launder_s(a.ws); const int tid = LTID, wid = tid >> 6, lane = tid & 63;
    const float* g = a.in[8] + (size_t)l * 1024; const float* bta = a.in[9] + (size_t)l * 1024;
    for (int row = LBID * 8 + wid; row < NTOK; row += gridDim.x * 8) {
        bf16_t* p = (bf16_t*)(ws + WS_HV) + (size_t)row * 1024 + lane * 8;
        const bf16x8 x0 = *(const bf16x8*)p, x1 = *(const bf16x8*)(p + 512);
        float v[16];
#pragma unroll
        for (int e = 0; e < 8; ++e) { v[e] = bf2f((bf16_t)x0[e]); v[8 + e] = bf2f((bf16_t)x1[e]); }
        float s = 0.f;
#pragma unroll
        for (int e = 0; e < 16; ++e) s += v[e];
        const float mean = wave_sum(s) * (1.0f / 1024.0f);
        float q = 0.f;
#pragma unroll
        for (int e = 0; e < 16; ++e) { const float d = v[e] - mean; q += d * d; }
        const float rstd = 1.0f / sqrtf(wave_sum(q) * (1.0f / 1024.0f) + LN_EPS);
        float o[16];
#pragma unroll
        for (int e = 0; e < 8; ++e) { o[e] = (v[e] - mean) * rstd * g[lane * 8 + e] + bta[lane * 8 + e]; o[8 + e] = (v[8 + e] - mean) * rstd * g[512 + lane * 8 + e] + bta[512 + lane * 8 + e]; }
        u32x4 w0 = {cvtpk(o[0], o[1]), cvtpk(o[2], o[3]), cvtpk(o[4], o[5]), cvtpk(o[6], o[7])}, w1 = {cvtpk(o[8], o[9]), cvtpk(o[10], o[11]), cvtpk(o[12], o[13]), cvtpk(o[14], o[15])};
        *(u32x4*)p = w0; *(u32x4*)(p + 512) = w1;
    }
}

__device__ __forceinline__ void compress_item(const Args& a, int l, LAS unsigned char* lds, int item) {
    unsigned char* ws = launder_s(a.ws);
    const int tid = LTID, wid = __builtin_amdgcn_readfirstlane(tid >> 6), lane = tid & 63, r32 = lane & 31, hi = lane >> 5;
    const int kv = item >> 5, rt = item & 31;
    const int R = rt * 32 + r32, bh = R >> 7; int i = R & 127; if (i > 126) i = 126;
    const int b = bh >> 1, hkv = bh & 1;
    const bf16_t* src = (const bf16_t*)(ws + WS_KV) + ((size_t)b * SEQ + 16 * i + 4 * wid) * 1536 + kv * 256 + hkv * 128 + hi * 8;
    const bf16_t* w1 = (const bf16_t*)(ws + WS_W1) + ((size_t)l * 2 + kv) * 128 * 4096 + (size_t)r32 * 4096 + wid * 512 + hi * 8;
    f32x16 acc[4] = {};
#pragma unroll 2
    for (int tk = 0; tk < 4; ++tk)
#pragma unroll
        for (int dk = 0; dk < 8; ++dk) {
            const bf16x8 af = *(const bf16x8*)(src + (size_t)tk * 1536 + dk * 16);
#pragma unroll
            for (int nb = 0; nb < 4; ++nb) { const bf16x8 bfr = *(const bf16x8*)(w1 + (size_t)nb * 32 * 4096 + tk * 128 + dk * 16); acc[nb] = MFMA32(af, bfr, acc[nb]); }
        }
    LAS float* red = (LAS float*)lds;
#pragma unroll
    for (int nb = 0; nb < 4; ++nb)
#pragma unroll
        for (int r = 0; r < 16; ++r) red[((wid * 4 + nb) * 16 + r) * 64 + lane] = acc[nb][r];
    __syncthreads();
    LAS bf16_t* G = (LAS bf16_t*)(lds + 131072);
    const float* c1 = (const float*)(ws + WS_C1) + ((size_t)l * 2 + kv) * 128;
    for (int idx = tid; idx < 4096; idx += 512) {
        float s = 0.f;
#pragma unroll
        for (int w = 0; w < 8; ++w) s += red[w * 4096 + idx];
        const int ln = idx & 63, r = (idx >> 6) & 15, nb = idx >> 10;
        const int row = crow(r, ln >> 5), n = nb * 32 + (ln & 31);
        G[row * 136 + n] = f2bf(gelu_tanh(s + c1[n]));
    }
    __syncthreads();
    if (wid < 4) {
        const bf16_t* w2 = (const bf16_t*)(ws + WS_W2) + ((size_t)l * 2 + kv) * 128 * 128 + (size_t)(wid * 32 + r32) * 128 + hi * 8;
        f32x16 o = {};
#pragma unroll
        for (int ks = 0; ks < 8; ++ks) { const bf16x8 af = *(LAS const bf16x8*)(G + r32 * 136 + ks * 16 + hi * 8); const bf16x8 bfr = *(const bf16x8*)(w2 + ks * 16); o = MFMA32(af, bfr, o); }
        bf16_t* dst = (bf16_t*)(ws + WS_KC) + (size_t)kv * 8 * 128 * 128;
#pragma unroll
        for (int r = 0; r < 16; ++r) { const int RR = rt * 32 + crow(r, hi); dst[(size_t)RR * 128 + wid * 32 + r32] = f2bf(o[r]); }
    }
    __syncthreads();
}

__device__ __forceinline__ unsigned sortable(float f) { unsigned u = __float_as_uint(f); if ((u << 1) == 0u) u = 0u; return (u & 0x80000000u) ? ~u : (u | 0x80000000u); }
__device__ __forceinline__ void indexer_item(const Args& a, LAS unsigned char* lds, int item) {
    unsigned char* ws = launder_s(a.ws);
    const int tid = LTID, wid = __builtin_amdgcn_readfirstlane(tid >> 6), lane = tid & 63, r32 = lane & 31, hi = lane >> 5;
    const int b = item >> 7, t0 = (item & 127) * 16;
    unsigned long long* MASK = (unsigned long long*)(ws + WS_MASK);
    if (t0 + 16 <= 256) {
        for (int q = wid * 2; q < wid * 2 + 2; ++q) { const int t = t0 + q;
            if (lane < 32) { const int lo = lane * 64; unsigned long long w = 0ull; if (t >= lo + 63) w = ~0ull; else if (t >= lo) w = (2ull << (t - lo)) - 1ull;
                MASK[((size_t)b * SEQ + t) * 32 + lane] = w; } }
        return;
    }
    LAS unsigned* SC = (LAS unsigned*)lds;
    LAS float* WI = (LAS float*)(lds + 131072);
    if (tid < 64) WI[tid] = ((const float*)(ws + WS_SKF))[((size_t)b * SEQ + t0 + (tid >> 2)) * 32 + 24 + (tid & 3)];
    bf16x8 aq[2][4];
#pragma unroll
    for (int rb = 0; rb < 2; ++rb) { const bf16_t* qp = (const bf16_t*)(ws + WS_QI) + ((size_t)b * SEQ + t0 + rb * 8 + (r32 >> 2)) * 256 + (r32 & 3) * 64 + hi * 8;
#pragma unroll
        for (int ks = 0; ks < 4; ++ks) aq[rb][ks] = *(const bf16x8*)(qp + ks * 16); }
    __syncthreads();
    const int nch = (t0 + 16 + 31) >> 5;
    const bf16_t* KI = (const bf16_t*)(ws + WS_KI) + (size_t)b * SEQ * 64;
    for (int ch = wid; ch < nch; ch += 8) {
        const bf16_t* kp = KI + (size_t)(ch * 32 + r32) * 64 + hi * 8;
        bf16x8 bk[4];
#pragma unroll
        for (int ks = 0; ks < 4; ++ks) bk[ks] = *(const bf16x8*)(kp + ks * 16);
#pragma unroll
        for (int rb = 0; rb < 2; ++rb) {
            f32x16 s = {};
#pragma unroll
            for (int ks = 0; ks < 4; ++ks) s = MFMA32(aq[rb][ks], bk[ks], s);
#pragma unroll
            for (int mq = 0; mq < 4; ++mq) { const int q = rb * 8 + 2 * mq + hi;
                float sc = 0.f;
#pragma unroll
                for (int h = 0; h < 4; ++h) sc += fmaxf(s[mq * 4 + h], 0.f) * WI[q * 4 + h];
                const int key = ch * 32 + r32;
                SC[q * 2048 + key] = (key <= t0 + q) ? sortable(sc) : 0u; }
        }
    }
    __syncthreads();
    for (int q = wid * 2; q < wid * 2 + 2; ++q) {
        const int t = t0 + q; const int nw = (t >> 6) + 1;
        unsigned kk[32];
#pragma unroll
        for (int i = 0; i < 32; ++i) kk[i] = (i < nw && (i * 64 + lane) < nch * 32) ? SC[q * 2048 + i * 64 + lane] : 0u;
        unsigned T = 0u; bool exact = false;
        for (int bit = 31; bit >= 0; --bit) {
            const unsigned cand = T | (1u << bit); int cnt = 0;
#pragma unroll
            for (int i = 0; i < 32; ++i) cnt += __popcll(__ballot(kk[i] >= cand));
            if (cnt >= 256) { T = cand; if (cnt == 256) { exact = true; break; } }
        }
        int need = 0;
        if (!exact) { int ngt = 0;
#pragma unroll
            for (int i = 0; i < 32; ++i) ngt += __popcll(__ballot(kk[i] > T));
            need = 256 - ngt; }
        unsigned long long mine = 0ull;
#pragma unroll
        for (int i = 0; i < 32; ++i) {
            unsigned long long w;
            if (exact) w = __ballot(kk[i] >= T);
            else { w = __ballot(kk[i] > T); unsigned long long eq = __ballot(kk[i] == T);
                   const int ne = __popcll(eq);
                   if (ne <= need) { w |= eq; need -= ne; }
                   else { while (need > 0) { const unsigned long long low = eq & (0ull - eq); w |= low; eq ^= low; --need; } } }
            if (lane == i) mine = w;
        }
        if (lane < 32) MASK[((size_t)b * SEQ + t) * 32 + lane] = mine;
    }
    __syncthreads();
}

template <int NBR> struct EpiBranch {
    static constexpr bool PERM = false, AFTER_DRAIN = false;
    unsigned char* ws;
    __device__ __forceinline__ void operator()(const f32x4 (&acc)[2][2][4][2], const pg8::Unit& u, int wr, int wc, int fr, int fq) const {
        float* T = (float*)(ws + WS_MIXT); bf16_t* O = (bf16_t*)(ws + WS_MIXB); const bf16_t* Gt = (const bf16_t*)(ws + WS_HG) + NBR * 2048;
        const int row0 = u.pm * 256 + wr * 64 + fr, col0 = u.pn * 256 + wc * 32 + 4 * fq;
#pragma unroll
        for (int ai = 0; ai < 2; ++ai)
#pragma unroll
            for (int m = 0; m < 4; ++m) { const size_t row = (size_t)(row0 + ai * 128 + m * 16);
#pragma unroll
                for (int bj = 0; bj < 2; ++bj)
#pragma unroll
                    for (int n = 0; n < 2; ++n) { const int col = col0 + bj * 128 + n * 16;
                        const u32x2 gw = *(const u32x2*)(Gt + row * 6144 + col);
                        f32x4 gv = {__uint_as_float(gw.x << 16), __uint_as_float(gw.x & 0xffff0000u), __uint_as_float(gw.y << 16), __uint_as_float(gw.y & 0xffff0000u)};
                        f32x4 v = acc[ai][bj][m][n] * gv;
                        if (NBR > 0) v += *(const f32x4*)(T + row * 2048 + col);
                        if (NBR < 2) *(f32x4*)(T + row * 2048 + col) = v;
                        else { u32x2 w; w.x = cvtpk(v[0], v[1]); w.y = cvtpk(v[2], v[3]); *(u32x2*)(O + row * 2048 + col) = w; } }
                asm volatile("" ::: "memory");
            }
    }
};
struct EpiOut {
    static constexpr bool PERM = false, AFTER_DRAIN = false;
    const float* x; float* pre;
    __device__ __forceinline__ void operator()(const f32x4 (&acc)[2][2][4][2], const pg8::Unit& u, int wr, int wc, int fr, int fq) const {
        const int row0 = u.pm * 256 + wr * 64 + fr, col0 = u.pn * 256 + wc * 32 + 4 * fq;
#pragma unroll
        for (int ai = 0; ai < 2; ++ai)
#pragma unroll
            for (int m = 0; m < 4; ++m) { const size_t off = (size_t)(row0 + ai * 128 + m * 16) * 2048 + col0;
#pragma unroll
                for (int bj = 0; bj < 2; ++bj)
#pragma unroll
                    for (int n = 0; n < 2; ++n) { const f32x4 xv = *(const f32x4*)(x + off + bj * 128 + n * 16); *(f32x4*)(pre + off + bj * 128 + n * 16) = xv * ALPHA + acc[ai][bj][m][n]; } }
    }
};

__device__ __forceinline__ void ln_row(f32x4 (&v)[8], const float* g, const float* bta, int lane) {
    float s = 0.f;
#pragma unroll
    for (int i = 0; i < 8; ++i) s += (v[i][0] + v[i][1]) + (v[i][2] + v[i][3]);
    const float mean = wave_sum(s) * (1.0f / 2048.0f);
    float q = 0.f;
#pragma unroll
    for (int i = 0; i < 8; ++i) { const f32x4 d = v[i] - mean; q += (d[0] * d[0] + d[1] * d[1]) + (d[2] * d[2] + d[3] * d[3]); }
    const float rstd = 1.0f / sqrtf(wave_sum(q) * (1.0f / 2048.0f) + LN_EPS);
#pragma unroll
    for (int i = 0; i < 8; ++i) { const f32x4 gg = *(const f32x4*)(g + i * 256 + lane * 4), bb = *(const f32x4*)(bta + i * 256 + lane * 4); v[i] = (v[i] - mean) * rstd * gg + bb; }
}

__device__ __forceinline__ void p6_ln1_route(const Args& a, int l, LAS unsigned char* lds) {
    unsigned char* ws = launder_s(a.ws);
    const int tid = LTID, wid = __builtin_amdgcn_readfirstlane(tid >> 6), lane = tid & 63, r32 = lane & 31, hi = lane >> 5;
    const float* pre = (const float*)(ws + WS_MIXT); float* x1f = (float*)(ws + WS_X1F); bf16_t* x1b = (bf16_t*)(ws + WS_X1B);
    const float* g = a.in[14] + (size_t)l * DM; const float* bta = a.in[15] + (size_t)l * DM;
    unsigned* cnt = (unsigned*)(ws + WS_CTL) + CW_CNT + l * 64;
    for (int it = LBID; it < NTOK / 32; it += gridDim.x) {
        const int row0 = it * 32;
        for (int rr = 0; rr < 4; ++rr) { const size_t row = (size_t)(row0 + wid * 4 + rr);
            f32x4 v[8];
#pragma unroll
            for (int i = 0; i < 8; ++i) v[i] = *(const f32x4*)(pre + row * DM + i * 256 + lane * 4);
            ln_row(v, g, bta, lane);
#pragma unroll
            for (int i = 0; i < 8; ++i) { *(f32x4*)(x1f + row * DM + i * 256 + lane * 4) = v[i]; u32x2 w; w.x = cvtpk(v[i][0], v[i][1]); w.y = cvtpk(v[i][2], v[i][3]); *(u32x2*)(x1b + row * DM + i * 256 + lane * 4) = w; }
        }
        asm volatile("s_waitcnt vmcnt(0)" ::: "memory");
        __syncthreads();
        f32x16 acc = {};
        { const float* xp = x1f + (size_t)(row0 + r32) * DM + 256 * wid + 8 * hi;
          const bf16_t* wh = (const bf16_t*)(ws + WS_WR) + (size_t)l * 2 * 32 * DM + (size_t)r32 * DM + 256 * wid + 8 * hi; const bf16_t* wl = wh + 32 * DM;
#pragma unroll 4
          for (int ks = 0; ks < 16; ++ks) {
              const f32x4 x0 = *(const f32x4*)(xp + ks * 16), x1 = *(const f32x4*)(xp + ks * 16 + 4);
              const bf16x8 xh = pack8(x0, x1);
              f32x4 r0, r1;
#pragma unroll
              for (int e = 0; e < 4; ++e) { r0[e] = x0[e] - bf2f((bf16_t)xh[e]); r1[e] = x1[e] - bf2f((bf16_t)xh[4 + e]); }
              const bf16x8 xl = pack8(r0, r1);
              const bf16x8 bh = *(const bf16x8*)(wh + ks * 16), bl = *(const bf16x8*)(wl + ks * 16);
              acc = MFMA32(xh, bh, acc); acc = MFMA32(xl, bh, acc); acc = MFMA32(xh, bl, acc);
          } }
        LAS float* red = (LAS float*)lds;
#pragma unroll
        for (int r = 0; r < 16; ++r) red[(wid * 16 + r) * 64 + lane] = acc[r];
        __syncthreads();
        LAS float* LG = (LAS float*)(lds + 32768);
        for (int idx = tid; idx < 1024; idx += 512) { float s = 0.f;
#pragma unroll
            for (int w = 0; w < 8; ++w) s += red[w * 1024 + idx];
            const int ln = idx & 63, r = idx >> 6; LG[crow(r, ln >> 5) * 33 + (ln & 31)] = s; }
        __syncthreads();
        if (tid < 32) {
            const int row = row0 + tid; LAS const float* lg = LG + tid * 33;
            float gl[4];
#pragma unroll
            for (int j = 0; j < 4; ++j) gl[j] = lg[j] + a.in[17][l * 4 + j];
            int gi = 0; float gm = gl[0];
#pragma unroll
            for (int j = 1; j < 4; ++j) if (gl[j] > gm) { gm = gl[j]; gi = j; }
            float den = 0.f;
#pragma unroll
            for (int j = 0; j < 4; ++j) den += expf(gl[j] - gm);
            const float gp = 1.0f / den;
            float el[4];
#pragma unroll
            for (int j = 0; j < 4; ++j) el[j] = lg[4 + gi * 4 + j] + a.in[19][l * 16 + gi * 4 + j];
            int e1 = 0; float m1 = el[0];
#pragma unroll
            for (int j = 1; j < 4; ++j) if (el[j] > m1) { m1 = el[j]; e1 = j; }
            int e2 = -1; float m2 = 0.f;
#pragma unroll
            for (int j = 0; j < 4; ++j) if (j != e1 && (e2 < 0 || el[j] > m2)) { m2 = el[j]; e2 = j; }
            const float ex = expf(m2 - m1), w1 = 1.0f / (1.0f + ex), w2 = ex / (1.0f + ex);
            const int E1 = gi * 4 + e1, E2 = gi * 4 + e2;
            const unsigned p1 = __hip_atomic_fetch_add(cnt + E1, 1u, __ATOMIC_RELAXED, __HIP_MEMORY_SCOPE_AGENT);
            const unsigned p2 = __hip_atomic_fetch_add(cnt + E2, 1u, __ATOMIC_RELAXED, __HIP_MEMORY_SCOPE_AGENT);
            int* tk = (int*)(ws + WS_TOK); float* tw = (float*)(ws + WS_TOK) + 4 * NTOK;
            tk[row * 2] = E1; tk[row * 2 + 1] = E2; tk[2 * NTOK + row * 2] = (int)p1; tk[2 * NTOK + row * 2 + 1] = (int)p2;
            tw[row * 2] = gp * w1; tw[row * 2 + 1] = gp * w2;
        }
        __syncthreads();
    }
}

__device__ __forceinline__ int moe_offsets(const Args& a, int l, LAS int* off) {
    const unsigned* cnt = (const unsigned*)(a.ws + WS_CTL) + CW_CNT + l * 64;
    if (LTID == 0) { int o = 0; for (int e = 0; e < NEXP; ++e) { off[e] = o; const int c = (int)__hip_atomic_load(cnt + e, __ATOMIC_RELAXED, __HIP_MEMORY_SCOPE_AGENT); o += (c + 255) & ~255; } off[NEXP] = o; }
    __syncthreads();
    return off[NEXP] >> 8;
}
__device__ __forceinline__ void p7_gather(const Args& a, int l, LAS unsigned char* lds) {
    unsigned char* ws = launder_s(a.ws); LAS int* off = (LAS int*)lds;
    moe_offsets(a, l, off);
    const int tid = LTID, wid = tid >> 6, lane = tid & 63;
    const int* tk = (const int*)(ws + WS_TOK); const float* tw = (const float*)(ws + WS_TOK) + 4 * NTOK; int* trow = (int*)(ws + WS_TOK) + 6 * NTOK;
    const bf16_t* x1b = (const bf16_t*)(ws + WS_X1B); bf16_t* xs = (bf16_t*)(ws + WS_XS); float* roww = (float*)(ws + WS_ROWW);
    for (int p = LBID * 8 + wid; p < 2 * NTOK; p += gridDim.x * 8) {
        const int row = off[tk[p]] + tk[2 * NTOK + p];
        const u32x4* s = (const u32x4*)(x1b + (size_t)(p >> 1) * DM); u32x4* d = (u32x4*)(xs + (size_t)row * DM);
#pragma unroll
        for (int i = 0; i < 4; ++i) d[i * 64 + lane] = s[i * 64 + lane];
        if (lane == 0) { roww[row] = tw[p]; trow[p] = row; }
    }
}
struct MoeSched {
    LAS const int* te; int ntiles, ncol, G, c;
    __device__ __forceinline__ bool next(int i, pg8::Unit& u) const {
        const int L = i * G + c; if (L >= ntiles * ncol) return false;
        const int pm = L / ncol, pl = L % ncol; u.pm = pm; u.pn = te[pm] * ncol + pl; return true;
    }
    __device__ __forceinline__ void a_ready(const pg8::Unit&) const {}
    __device__ __forceinline__ void done(const pg8::Unit&) const {}
};
__device__ __forceinline__ int moe_tile_table(const Args& a, int l, LAS int* off, LAS int* te) {
    const int nt = moe_offsets(a, l, off);
    const int tid_ = LTID;
    if (tid_ < 128) { const int pm = tid_; if (pm < nt) { int e = 0; for (int k = 1; k < NEXP; ++k) if ((off[k] >> 8) <= pm) e = k; te[pm] = e; } }
    __syncthreads();
    return nt;
}
struct EpiGateUp {
    static constexpr bool PERM = true, AFTER_DRAIN = false;
    unsigned char* ws;
    __device__ __forceinline__ void operator()(const f32x4 (&acc)[2][2][4][2], const pg8::Unit& u, int wr, int wc, int fr, int fq) const {
        bf16_t* hm = (bf16_t*)(ws + WS_HM); const float* roww = (const float*)(ws + WS_ROWW);
        const int row0 = u.pm * 256 + wr * 64 + fr, col0 = (u.pn & 3) * 128 + wc * 32 + 8 * fq;
#pragma unroll
        for (int ai = 0; ai < 2; ++ai)
#pragma unroll
            for (int m = 0; m < 4; ++m) { const int row = row0 + ai * 128 + m * 16; const float rw = roww[row];
                float o[8];
#pragma unroll
                for (int n = 0; n < 2; ++n)
#pragma unroll
                    for (int e = 0; e < 4; ++e) { const float gt = acc[ai][0][m][n][e], up = acc[ai][1][m][n][e]; o[n * 4 + e] = gt * fast_sigmoid(gt) * up * rw; }
                u32x4 w = {cvtpk(o[0], o[1]), cvtpk(o[2], o[3]), cvtpk(o[4], o[5]), cvtpk(o[6], o[7])};
                *(u32x4*)(hm + (size_t)row * DEXP + col0) = w; }
    }
};
struct EpiDown {
    static constexpr bool PERM = true, AFTER_DRAIN = false;
    unsigned char* ws;
    __device__ __forceinline__ void operator()(const f32x4 (&acc)[2][2][4][2], const pg8::Unit& u, int wr, int wc, int fr, int fq) const {
        bf16_t* y = (bf16_t*)(ws + WS_Y);
        const int row0 = u.pm * 256 + wr * 64 + fr, col0 = (u.pn & 7) * 256 + wc * 32 + 8 * fq;
#pragma unroll
        for (int ai = 0; ai < 2; ++ai)
#pragma unroll
            for (int m = 0; m < 4; ++m) { bf16_t* rowp = y + (size_t)(row0 + ai * 128 + m * 16) * DM + col0;
#pragma unroll
                for (int bj = 0; bj < 2; ++bj) { const f32x4 v0 = acc[ai][bj][m][0], v1 = acc[ai][bj][m][1];
                    u32x4 w = {cvtpk(v0[0], v0[1]), cvtpk(v0[2], v0[3]), cvtpk(v1[0], v1[1]), cvtpk(v1[2], v1[3])};
                    *(u32x4*)(rowp + bj * 128) = w; } }
    }
};
__device__ __forceinline__ void p10_ln2(const Args& a, int l) {
    unsigned char* ws = launder_s(a.ws); const int tid = LTID, wid = tid >> 6, lane = tid & 63;
    const float* x1f = (const float*)(ws + WS_X1F); const bf16_t* y = (const bf16_t*)(ws + WS_Y); const int* trow = (const int*)(ws + WS_TOK) + 6 * NTOK;
    float* xo = (l == NL - 1) ? a.out : (float*)(ws + WS_XF); bf16_t* xb = (bf16_t*)(ws + WS_XB);
    const float* g = a.in[23] + (size_t)l * DM; const float* bta = a.in[24] + (size_t)l * DM;
    for (int row = LBID * 8 + wid; row < NTOK; row += gridDim.x * 8) {
        const bf16_t* y0 = y + (size_t)trow[row * 2] * DM; const bf16_t* y1 = y + (size_t)trow[row * 2 + 1] * DM;
        f32x4 v[8];
#pragma unroll
        for (int i = 0; i < 8; ++i) { const int cidx = i * 256 + lane * 4; const f32x4 xv = *(const f32x4*)(x1f + (size_t)row * DM + cidx);
            const u32x2 a0 = *(const u32x2*)(y0 + cidx), a1 = *(const u32x2*)(y1 + cidx);
            const f32x4 f0 = {__uint_as_float(a0.x << 16), __uint_as_float(a0.x & 0xffff0000u), __uint_as_float(a0.y << 16), __uint_as_float(a0.y & 0xffff0000u)};
            const f32x4 f1 = {__uint_as_float(a1.x << 16), __uint_as_float(a1.x & 0xffff0000u), __uint_as_float(a1.y << 16), __uint_as_float(a1.y & 0xffff0000u)};
            v[i] = xv * ALPHA + (f0 + f1); }
        ln_row(v, g, bta, lane);
#pragma unroll
        for (int i = 0; i < 8; ++i) { const int cidx = i * 256 + lane * 4; *(f32x4*)(xo + (size_t)row * DM + cidx) = v[i];
            u32x2 w; w.x = cvtpk(v[i][0], v[i][1]); w.y = cvtpk(v[i][2], v[i][3]); *(u32x2*)(xb + (size_t)row * DM + cidx) = w; }
    }
}

struct ItemTable { unsigned short v[768]; };
constexpr int item_cost(int type, int idx) {
    if (type == 0) { const int qb = idx & 31; return 4 + qb + ((qb + 1) < 9 ? (qb + 1) : 9); }
    if (type == 1) { const int qb = idx & 7; return 4 * (qb + 1) + 1; }
    return 1;
}
constexpr ItemTable make_items() {
    ItemTable t{}; int pos = 0;
    for (int cst = 64; cst >= 0; --cst) for (int id = 0; id < 768; ++id) { const int type = id >> 8, idx = id & 255; if (item_cost(type, idx) == cst) t.v[pos++] = (unsigned short)((type << 12) | idx); }
    return t;
}
__device__ const ItemTable g_items = make_items();

constexpr int N_PHASES = 1 + NL * 10;
#ifndef PH_MASK
#define PH_MASK 0x7ff
#endif
#define PH_ON(k) (((PH_MASK) >> (k)) & 1)
__global__ void __launch_bounds__(512, 2) mk_fwd(Args a) {
    extern __shared__ __attribute__((aligned(16))) unsigned char lds_raw[];
    LAS unsigned char* lds = (LAS unsigned char*)lds_raw;
    unsigned char* ws0 = a.ws;
    unsigned* ctl = (unsigned*)(ws0 + WS_CTL);
    const int tid = threadIdx.x, G = gridDim.x, wg = blockIdx.x;
#if MK_SINGLE
    if (tid < 4) ((LAS unsigned*)(lds + LDS_BYTES - 16))[tid] = 0u;
    __syncthreads();
    XcdBarrier bar = xcd_barrier_post(ctl + CW_BAR, (volatile LAS unsigned*)(lds + LDS_BYTES - 16));
#define GRID_BAR() do { XcdBarrier bb_ = bar; bb_.bar = launder_s(bb_.bar); bb_.x = bar.x + opaque_zero(); xcd_barrier(bb_); } while (0)
#else
#define GRID_BAR() do { } while (0)
#endif
#if MK_SINGLE
#define IN(k) true
#else
    const int lo = a.ph_lo, hi = a.ph_hi;
#define IN(k) (lo <= (k) && (k) < hi)
#endif
#define SEAM(k) do { if (IN(k) && IN((k) + 1)) GRID_BAR(); } while (0)

    if (PH_ON(10) && IN(0)) { p0_prologue(a, lds); }
    SEAM(0);
    for (int l = 0; l < NL; ++l) {
        const int p = 1 + l * 10;
        unsigned char* ws = launder_s(ws0);
        if (PH_ON(0) && IN(p + 0)) { ws = launder_s(ws);
            skinny_item(a, l, lds);
            pg8::Gemm g{(const bf16_t*)(ws + WS_XB), (const bf16_t*)(ws + WS_WIN) + (size_t)l * NMAIN * DM, NTOK, NMAIN, DM};
            pg8::StaticOrder S; S.init(NTOK, NMAIN, G, wg); EpiInProj E{ws};
            pg8::gemm_phase<EpiInProj, pg8::StaticOrder, false>(lds, g, S, E, nullptr);
        }
        SEAM(p + 0);
        if (PH_ON(1) && IN(p + 1)) { ws = launder_s(ws);
#ifndef SUBM
#define SUBM 0xff
#endif
            if (SUBM & 1) { pg8::Gemm g{(const bf16_t*)(ws + WS_HC), (const bf16_t*)(ws + WS_WKVUP) + (size_t)l * 2048 * 256, NTOK, 2048, 256};
              pg8::StaticOrder S; S.init(NTOK, 2048, G, wg); EpiKvUp E{ws};
              pg8::gemm_phase<EpiKvUp, pg8::StaticOrder, false>(lds, g, S, E, nullptr); }
            if (SUBM & 2) gmlp_ln_rows(a, l);
            if (SUBM & 4) for (int it = wg; it < 64; it += G) compress_item(a, l, lds, it);
            if (SUBM & 8) for (int it = wg; it < 256; it += G) { indexer_item(a, lds, it); indexer_item(a, lds, 511 - it); }
        }
        SEAM(p + 1);
        if (PH_ON(2) && IN(p + 2)) { ws = launder_s(ws);
            LAS unsigned* slot = (LAS unsigned*)(lds + att::L_MISC); const int tq = LTID;
            for (;;) {
                if (tq == 0) slot[0] = __hip_atomic_fetch_add(ctl + CW_Q + l * 64, 1u, __ATOMIC_RELAXED, __HIP_MEMORY_SCOPE_AGENT);
                __syncthreads();
                const unsigned qi = slot[0];
                __syncthreads();
                if (qi >= 768u) break;
                const unsigned it = g_items.v[qi]; const int type = it >> 12, idx = it & 255;
                if ((SUBM & 16) && type == 0) att::nsa_item(a, lds, idx >> 6, (idx >> 5) & 1, idx & 31);
                else if ((SUBM & 32) && type == 1) att::dsa_item(a, lds, idx >> 6, (idx >> 3) & 7, idx & 7);
                else if ((SUBM & 64) && type == 2) att::gmlp_item(a, lds, l, idx >> 6, (idx >> 2) & 15, idx & 3);
            }
        }
        SEAM(p + 2);
        if (PH_ON(3) && IN(p + 3)) { ws = launder_s(ws);
            pg8::StaticOrder S; S.init(NTOK, DM, G, wg);
            { pg8::Gemm g{(const bf16_t*)(ws + WS_BR), (const bf16_t*)(ws + WS_WB) + ((size_t)l * 3 + 0) * 2048 * 1024, NTOK, DM, 1024}; EpiBranch<0> E{ws}; pg8::gemm_phase<EpiBranch<0>, pg8::StaticOrder, false>(lds, g, S, E, nullptr); }
            { pg8::Gemm g{(const bf16_t*)(ws + WS_BR) + (size_t)NTOK * 1024, (const bf16_t*)(ws + WS_WB) + ((size_t)l * 3 + 1) * 2048 * 1024, NTOK, DM, 1024}; EpiBranch<1> E{ws}; pg8::gemm_phase<EpiBranch<1>, pg8::StaticOrder, false>(lds, g, S, E, nullptr); }
            { pg8::Gemm g{(const bf16_t*)(ws + WS_BR) + (size_t)2 * NTOK * 1024, (const bf16_t*)(ws + WS_WB) + ((size_t)l * 3 + 2) * 2048 * 1024, NTOK, DM, 1024}; EpiBranch<2> E{ws}; pg8::gemm_phase<EpiBranch<2>, pg8::StaticOrder, false>(lds, g, S, E, nullptr); }
        }
        SEAM(p + 3);
        if (PH_ON(4) && IN(p + 4)) { ws = launder_s(ws);
            pg8::Gemm g{(const bf16_t*)(ws + WS_MIXB), (const bf16_t*)(ws + WS_WO) + (size_t)l * DM * DM, NTOK, DM, DM};
            pg8::StaticOrder S; S.init(NTOK, DM, G, wg); EpiOut E{l == 0 ? a.in[0] : (const float*)(ws + WS_XF), (float*)(ws + WS_MIXT)};
            pg8::gemm_phase<EpiOut, pg8::StaticOrder, false>(lds, g, S, E, nullptr);
        }
        SEAM(p + 4);
        if (PH_ON(5) && IN(p + 5)) p6_ln1_route(a, l, lds);
        SEAM(p + 5);
        if (PH_ON(6) && IN(p + 6)) p7_gather(a, l, lds);
        SEAM(p + 6);
        if (PH_ON(7) && IN(p + 7)) { ws = launder_s(ws);
            LAS int* off = (LAS int*)(lds + 131072); LAS int* te = off + 32;
            const int nt = moe_tile_table(a, l, off, te);
            pg8::Gemm g{(const bf16_t*)(ws + WS_XS), (const bf16_t*)(ws + WS_WGU) + (size_t)l * 16 * 1024 * 2048, 0, 0, DM};
            MoeSched S{te, nt, 4, G, wg}; EpiGateUp E{ws};
            pg8::gemm_phase<EpiGateUp, MoeSched, false>(lds, g, S, E, nullptr);
        }
        SEAM(p + 7);
        if (PH_ON(8) && IN(p + 8)) { ws = launder_s(ws);
            LAS int* off = (LAS int*)(lds + 131072); LAS int* te = off + 32;
            const int nt = moe_tile_table(a, l, off, te);
            pg8::Gemm g{(const bf16_t*)(ws + WS_HM), (const bf16_t*)(ws + WS_WD) + (size_t)l * 16 * 2048 * 512, 0, 0, DEXP};
            MoeSched S{te, nt, 8, G, wg}; EpiDown E{ws};
            pg8::gemm_phase<EpiDown, MoeSched, false>(lds, g, S, E, nullptr);
        }
        SEAM(p + 8);
        if (PH_ON(9) && IN(p + 9)) p10_ln2(a, l);
        SEAM(p + 9);
    }
#undef IN
#undef SEAM
}

extern "C" void kernel_launch(void* const* d_in, const int* in_sizes, int n_in, void* d_out, int out_size, void* d_ws, size_t ws_size, hipStream_t stream) {
    static int grid = 0;
    if (grid == 0) {
        if (n_in != 25 || out_size != NTOK * DM || ws_size < WS_END) { fprintf(stderr, "kernel_launch: expected 25 inputs, out %d, ws >= %zu; got n_in %d out %d ws %zu\n", NTOK * DM, (size_t)WS_END, n_in, out_size, ws_size); grid = -1; return; }
        int dev = 0, cus = 0, per_cu = 0;
        if (hipGetDevice(&dev) != hipSuccess || hipDeviceGetAttribute(&cus, hipDeviceAttributeMultiprocessorCount, dev) != hipSuccess) { fprintf(stderr, "kernel_launch: device query failed\n"); grid = -1; return; }
        if (hipFuncSetAttribute((const void*)mk_fwd, hipFuncAttributeMaxDynamicSharedMemorySize, LDS_BYTES) != hipSuccess) { fprintf(stderr, "kernel_launch: hipFuncSetAttribute failed\n"); grid = -1; return; }
        if (hipOccupancyMaxActiveBlocksPerMultiprocessor(&per_cu, (const void*)mk_fwd, 512, LDS_BYTES) != hipSuccess || per_cu < 1) fprintf(stderr, "kernel_launch: occupancy query reports %d blocks per CU\n", per_cu);
        (void)hipGetLastError();
        grid = cus;
    }
    if (grid < 0) return;
    (void)hipMemsetAsync((char*)d_ws + WS_CTL, 0, CTL_BYTES, stream);
    Args a{};
    for (int i = 0; i < 25; ++i) a.in[i] = (const float*)d_in[i];
    a.out = (float*)d_out; a.ws = (unsigned char*)d_ws;
#if MK_SINGLE
    a.ph_lo = 0; a.ph_hi = N_PHASES;
    hipLaunchKernelGGL(mk_fwd, dim3(grid), dim3(512), LDS_BYTES, stream, a);
#else
    for (int p = 0; p < N_PHASES; ++p) { a.ph_lo = p; a.ph_hi = p + 1; hipLaunchKernelGGL(mk_fwd, dim3(grid), dim3(512), LDS_BYTES, stream, a); }
#endif
    const hipError_t le = hipPeekAtLastError();
    if (le != hipSuccess) fprintf(stderr, "kernel_launch: launch failed: %s\n", hipGetErrorName(le));
}
```

```cpp
#include <hip/hip_runtime.h>
#include <cstdio>
#include <cstdint>

#ifndef MK_SINGLE
#define MK_SINGLE 1
#endif

constexpr int NB = 4, SEQ = 2048, DM = 2048, NL = 4, NTOK = NB * SEQ;
constexpr int IN_COLS = 12380, NMAIN = 12288, NSK = 128;
constexpr int NEXP = 16, DEXP = 512, MOE_ROWS = 2 * NTOK + NEXP * 256;
constexpr float LN_EPS = 1e-5f;
constexpr float ALPHA = 1.681792830507429f;
constexpr float LOG2E = 1.4426950408889634f;
constexpr float ATT_C2 = 0.08838834764831845f * LOG2E;
constexpr int LDS_BYTES = 147456;

typedef unsigned short bf16_t;
typedef short bf16x8 __attribute__((ext_vector_type(8)));
typedef short s16x4 __attribute__((ext_vector_type(4)));
typedef float f32x16 __attribute__((ext_vector_type(16)));
typedef float f32x4 __attribute__((ext_vector_type(4)));
typedef float f32x2 __attribute__((ext_vector_type(2)));
typedef unsigned u32x4 __attribute__((ext_vector_type(4)));
typedef unsigned u32x2 __attribute__((ext_vector_type(2)));

constexpr size_t al256(size_t x) { return (x + 255) & ~(size_t)255; }
constexpr size_t WS_CTL    = 0;
constexpr size_t CTL_BYTES = 65536;
constexpr size_t WS_WIN    = WS_CTL + CTL_BYTES;
constexpr size_t WS_WSK    = WS_WIN  + (size_t)NL * NMAIN * DM * 2;
constexpr size_t WS_W1     = WS_WSK  + (size_t)NL * NSK * DM * 2;
constexpr size_t WS_W2     = WS_W1   + (size_t)NL * 2 * 128 * 4096 * 2;
constexpr size_t WS_C1     = WS_W2   + (size_t)NL * 2 * 128 * 128 * 2;
constexpr size_t WS_WKVUP  = WS_C1   + (size_t)NL * 2 * 128 * 4;
constexpr size_t WS_WSTRIL = WS_WKVUP + (size_t)NL * 2048 * 256 * 2;
constexpr size_t WS_WB     = WS_WSTRIL + (size_t)NL * 8 * 128 * 128 * 2;
constexpr size_t WS_WO     = WS_WB   + (size_t)NL * 3 * 2048 * 1024 * 2;
constexpr size_t WS_WR     = WS_WO   + (size_t)NL * 2048 * 2048 * 2;
constexpr size_t WS_WGU    = WS_WR   + (size_t)NL * 2 * 32 * 2048 * 2;
constexpr size_t WS_WD     = WS_WGU  + (size_t)NL * 16 * 1024 * 2048 * 2;
constexpr size_t WS_XF     = WS_WD   + (size_t)NL * 16 * 2048 * 512 * 2;
constexpr size_t WS_XB     = WS_XF   + (size_t)NTOK * DM * 4;
constexpr size_t WS_SKF    = WS_XB   + (size_t)NTOK * DM * 2;
constexpr size_t WS_KI     = WS_SKF  + (size_t)NTOK * 32 * 4;
constexpr size_t WS_QA     = WS_KI   + (size_t)NTOK * 64 * 2;
constexpr size_t WS_KV     = WS_QA   + (size_t)NTOK * 1024 * 2;
constexpr size_t WS_QB     = WS_KV   + (size_t)NTOK * 1536 * 2;
constexpr size_t WS_HC     = WS_QB   + (size_t)NTOK * 1024 * 2;
constexpr size_t WS_PSQ    = WS_HC   + (size_t)NTOK * 256 * 2;
constexpr size_t WS_QI     = WS_PSQ  + (size_t)NTOK * 4 * 4;
constexpr size_t WS_HU     = WS_QI   + (size_t)NTOK * 256 * 2;
constexpr size_t WS_HV     = WS_HU   + (size_t)NTOK * 1024 * 2;
constexpr size_t WS_HG     = WS_HV   + (size_t)NTOK * 1024 * 2;
constexpr size_t WS_KVUP   = WS_HG   + (size_t)NTOK * 6144 * 2;
constexpr size_t WS_KC     = WS_KVUP + (size_t)NTOK * 2048 * 2;
constexpr size_t WS_MASK   = WS_KC   + (size_t)2 * 8 * 128 * 128 * 2;
constexpr size_t WS_BR     = WS_MASK + (size_t)NTOK * 32 * 8;
constexpr size_t WS_TT     = WS_BR   + (size_t)3 * NTOK * 1024 * 2;
constexpr size_t WS_MIXT   = WS_TT   + (size_t)256 * 64 * 512 * 4;
constexpr size_t WS_MIXB   = WS_MIXT + (size_t)NTOK * DM * 4;
constexpr size_t WS_X1F    = WS_MIXB + (size_t)NTOK * DM * 2;
constexpr size_t WS_X1B    = WS_X1F  + (size_t)NTOK * DM * 4;
constexpr size_t WS_TOK    = WS_X1B  + (size_t)NTOK * DM * 2;
constexpr size_t WS_ROWW   = WS_TOK  + (size_t)NTOK * 2 * 4 * 4;
constexpr size_t WS_XS     = WS_ROWW + (size_t)MOE_ROWS * 4;
constexpr size_t WS_HM     = WS_XS   + (size_t)MOE_ROWS * DM * 2;
constexpr size_t WS_Y      = WS_HM   + (size_t)MOE_ROWS * DEXP * 2;
constexpr size_t WS_END    = WS_Y    + (size_t)MOE_ROWS * DM * 2;

constexpr int CW_BAR  = 0;
constexpr int CW_Q    = 4096;
constexpr int CW_CNT  = 4096 + 64 * 8;
constexpr int CW_DBG  = 8192;

__device__ __forceinline__ bf16_t f2bf(float f) { unsigned u = __float_as_uint(f); u += 0x7FFFu + ((u >> 16) & 1u); return (bf16_t)(u >> 16); }
__device__ __forceinline__ float bf2f(bf16_t b) { return __uint_as_float(((unsigned)b) << 16); }
__device__ __forceinline__ unsigned cvtpk(float lo, float hi) { unsigned r; asm volatile("v_cvt_pk_bf16_f32 %0, %1, %2" : "=v"(r) : "v"(lo), "v"(hi)); return r; }
__device__ __forceinline__ bf16x8 pack8(f32x4 a, f32x4 b) { u32x4 w = {cvtpk(a[0], a[1]), cvtpk(a[2], a[3]), cvtpk(b[0], b[1]), cvtpk(b[2], b[3])}; return *reinterpret_cast<bf16x8*>(&w); }
__device__ __forceinline__ float fast_sigmoid(float x) { return __builtin_amdgcn_rcpf(1.0f + __builtin_amdgcn_exp2f(-x * LOG2E)); }
__device__ __forceinline__ float gelu_tanh(float x) {
    const float z = 0.7978845608028654f * (x + 0.044715f * x * x * x);
    return x * __builtin_amdgcn_rcpf(1.0f + __builtin_amdgcn_exp2f(-2.0f * LOG2E * z));
}
__device__ __forceinline__ float wave_sum(float v) {
#pragma unroll
    for (int o = 32; o >= 1; o >>= 1) v += __shfl_xor(v, o);
    return v;
}

__device__ __forceinline__ int launder_v(int x) { asm volatile("" : "+v"(x)); return x; }
__device__ __forceinline__ unsigned opaque_zero() { unsigned z; asm volatile("s_mov_b32 %0, 0" : "=s"(z)); return z; }
template <class T> __device__ __forceinline__ T* launder_s(T* p) { return (T*)((unsigned long long)p + opaque_zero()); }
#define LTID launder_v((int)threadIdx.x)
#define LBID ((int)(blockIdx.x + opaque_zero()))
namespace pg8 {
#define PG8_LAS __attribute__((address_space(3)))
typedef unsigned short bf16_t;
typedef short bf16x8 __attribute__((ext_vector_type(8)));
typedef float f32x4 __attribute__((ext_vector_type(4)));
typedef unsigned u32x4 __attribute__((ext_vector_type(4)));
constexpr int BM = 256, BK = 64, HALF = 128, HTB = HALF * BK * 2  , STAGE_BYTES = 8 * HTB, NXCD = 8, WGM = 8;

__host__ __device__ __forceinline__ int lds_byte(int r, int c) { const int st = (r >> 4) * 2 + (c >> 5), rr = r & 15, cc = c & 31, ob = rr * 64 + cc * 2; return st * 1024 + (ob ^ (((ob >> 9) & 1) << 5)); }
__host__ __device__ __forceinline__ void stage_rc(int b, int& R, int& C) { const int st = b / 1024, sb = b % 1024, swz = sb ^ (((sb >> 9) & 1) << 5); R = (st >> 1) * 16 + swz / 64; C = (st & 1) * 32 + (swz % 64) / 2; }
__host__ __device__ __forceinline__ int perm32(int rho) { const int n = rho >> 4, i = rho & 15; return 8 * (i >> 2) + 4 * n + (i & 3); }

struct Unit { int pm, pn; };
struct Gemm { const bf16_t* A; const bf16_t* Bt; int M, N, K; };

struct StaticOrder {
    int nM, nN, nwg, G, c;
    __host__ __device__ void init(int M, int N, int G_, int c_) { nM = M / BM; nN = N / BM; nwg = nM * nN; G = G_; c = c_; }
    __host__ __device__ bool next(int i, Unit& u) const {
        const long L = (long)i * G + c; if (L >= nwg) return false;
        int wgid = (int)L; { const int q = nwg / NXCD, r = nwg % NXCD, xcd = wgid % NXCD, off = wgid / NXCD; wgid = (xcd < r ? xcd * (q + 1) : r * (q + 1) + (xcd - r) * q) + off; }
        const int nig = WGM * nN, gid = wgid / nig, fm = gid * WGM, gsz = (nM - fm) < WGM ? (nM - fm) : WGM;
        u.pm = fm + ((wgid % nig) % gsz); u.pn = (wgid % nig) / gsz; return true;
    }
    __device__ __forceinline__ void a_ready(const Unit&) const {}
    __device__ __forceinline__ void done(const Unit&) const {}
};
struct CountedOrder : StaticOrder {
    const unsigned* ready; unsigned need; unsigned* tmo;
    __device__ __forceinline__ void a_ready(const Unit& u) const {
        if (threadIdx.x < 64) {
            const unsigned long long t0 = __builtin_amdgcn_s_memrealtime(); unsigned polls = 0;
            while ((unsigned)__builtin_amdgcn_readfirstlane(__hip_atomic_load(ready + 64 * u.pm, __ATOMIC_RELAXED, __HIP_MEMORY_SCOPE_AGENT)) < need) {
                if ((++polls & 255u) == 0u && __builtin_amdgcn_readfirstlane(__hip_atomic_load(tmo, __ATOMIC_RELAXED, __HIP_MEMORY_SCOPE_AGENT)) != 0u) break;
                if (__builtin_amdgcn_s_memrealtime() - t0 > 2000000ull) {
                    if (threadIdx.x == 0) { unsigned expect = 0u; __hip_atomic_compare_exchange_strong(tmo + 1, &expect, 0x600u | (unsigned)(u.pm & 0xff), __ATOMIC_RELAXED, __ATOMIC_RELAXED, __HIP_MEMORY_SCOPE_AGENT); __hip_atomic_store(tmo, 1u, __ATOMIC_RELAXED, __HIP_MEMORY_SCOPE_AGENT); }
                    break; }
                __builtin_amdgcn_s_sleep(2); }
            __builtin_amdgcn_fence(__ATOMIC_ACQUIRE, "agent");
            asm volatile("s_waitcnt vmcnt(0)" ::: "memory");
        }
#if !defined(BROKEN_HOOK_NO_BARRIER)
        asm volatile("" ::: "memory"); __builtin_amdgcn_s_barrier(); asm volatile("" ::: "memory");
#endif
    }
};

__device__ __forceinline__ unsigned cvt_pk_bf16(float lo, float hi) { unsigned r; asm volatile("v_cvt_pk_bf16_f32 %0, %1, %2" : "=v"(r) : "v"(lo), "v"(hi)); return r; }
typedef float f32x2 __attribute__((ext_vector_type(2)));
__device__ __forceinline__ f32x2 gelu_pk(f32x2 v) {
    const f32x2 av = __builtin_elementwise_abs(v), d = av * 0.2316418882f + 1.0f;
    f32x2 t; t.x = __builtin_amdgcn_rcpf(d.x); t.y = __builtin_amdgcn_rcpf(d.y);
    f32x2 q = t * 0.5307027145f + (-0.7265760135f); q = q * t + 0.7107068705f; q = q * t + (-0.142248368f); q = q * t + 0.127414796f; q = q * t;
    const f32x2 s = (v * v) * (-0.72134752044f);
    f32x2 e; e.x = __builtin_amdgcn_exp2f(s.x); e.y = __builtin_amdgcn_exp2f(s.y);
    const f32x2 m = v * (q * e), r = v - m;
    f32x2 o; o.x = v.x < 0.f ? m.x : r.x; o.y = v.y < 0.f ? m.y : r.y; return o;
}

struct EpiF32 {
    static constexpr bool PERM = false, AFTER_DRAIN = false;
    float* C; int ldc; const float* bias;
    __device__ __forceinline__ void operator()(const f32x4 (&acc)[2][2][4][2], const Unit& u, int wr, int wc, int fr, int fq) const {
        const int row0 = u.pm * BM + wr * 64 + fr, col0 = u.pn * BM + wc * 32 + 4 * fq;
        f32x4 bv[2][2];
#pragma unroll
        for (int bj = 0; bj < 2; ++bj)
#pragma unroll
            for (int n = 0; n < 2; ++n) bv[bj][n] = bias ? *(const f32x4*)(bias + col0 + bj * HALF + n * 16) : (f32x4){0.f, 0.f, 0.f, 0.f};
#pragma unroll
        for (int ai = 0; ai < 2; ++ai)
#pragma unroll
            for (int m = 0; m < 4; ++m) { float* rowp = C + (size_t)(row0 + ai * HALF + m * 16) * ldc + col0;
#pragma unroll
                for (int bj = 0; bj < 2; ++bj)
#pragma unroll
                    for (int n = 0; n < 2; ++n) *(f32x4*)(rowp + bj * HALF + n * 16) = acc[ai][bj][m][n] + bv[bj][n]; }
    }
};
template <int ACT  > struct EpiBf16 {
    static constexpr bool PERM = true, AFTER_DRAIN = false;
    bf16_t* O; int ldc; const float* bias; int split_cols; size_t split_stride;
    __device__ __forceinline__ void operator()(const f32x4 (&acc)[2][2][4][2], const Unit& u, int wr, int wc, int fr, int fq) const {
        const int row0 = u.pm * BM + wr * 64 + fr; int colt = u.pn * BM; bf16_t* base = O;
        if (split_cols) { const int t = colt / split_cols; base += (size_t)t * split_stride; colt -= t * split_cols; }
        const int col0 = colt + wc * 32 + 8 * fq, bcol0 = u.pn * BM + wc * 32 + 8 * fq;
        f32x4 bv[2][2];
#pragma unroll
        for (int bj = 0; bj < 2; ++bj)
#pragma unroll
            for (int n = 0; n < 2; ++n) bv[bj][n] = bias ? *(const f32x4*)(bias + bcol0 + bj * HALF + 4 * n) : (f32x4){0.f, 0.f, 0.f, 0.f};
#pragma unroll
        for (int ai = 0; ai < 2; ++ai)
#pragma unroll
            for (int m = 0; m < 4; ++m) { bf16_t* rowp = base + (size_t)(row0 + ai * HALF + m * 16) * ldc + col0;
#pragma unroll
                for (int bj = 0; bj < 2; ++bj) { f32x4 v0 = acc[ai][bj][m][0] + bv[bj][0], v1 = acc[ai][bj][m][1] + bv[bj][1];
                    if (ACT == 1) { f32x2 a = gelu_pk((f32x2){v0[0], v0[1]}), b = gelu_pk((f32x2){v0[2], v0[3]}), c = gelu_pk((f32x2){v1[0], v1[1]}), d = gelu_pk((f32x2){v1[2], v1[3]});
                        v0 = (f32x4){a.x, a.y, b.x, b.y}; v1 = (f32x4){c.x, c.y, d.x, d.y}; }
                    if (ACT == 2) {
#pragma unroll
                        for (int j = 0; j < 4; ++j) { v0[j] = 0.5f * v0[j] * (1.0f + erff(v0[j] * 0.70710678f)); v1[j] = 0.5f * v1[j] * (1.0f + erff(v1[j] * 0.70710678f)); } }
                    u32x4 w; w.x = cvt_pk_bf16(v0[0], v0[1]); w.y = cvt_pk_bf16(v0[2], v0[3]); w.z = cvt_pk_bf16(v1[0], v1[1]); w.w = cvt_pk_bf16(v1[2], v1[3]);
                    *(u32x4*)(rowp + bj * HALF) = w; } }
    }
};

struct PanelStats {
    unsigned* xbuf;
    unsigned* cnt;
    unsigned* tmo;
    int ntn; float eps;
    unsigned code;
    __device__ __forceinline__ bool run(const f32x4 (&v)[2][2][4][2], const Unit& u, int wr, int wc, int fr, int fq, PG8_LAS unsigned char* lds, int wid, int lane) const {
        typedef float f32x2v __attribute__((ext_vector_type(2)));
        PG8_LAS f32x2v* P = (PG8_LAS f32x2v*)lds;
        PG8_LAS f32x2v* S = (PG8_LAS f32x2v*)(lds + 8192);
        PG8_LAS unsigned* flag = (PG8_LAS unsigned*)(lds + 8192 + 2048);
#pragma unroll
        for (int ai = 0; ai < 2; ++ai)
#pragma unroll
            for (int m = 0; m < 4; ++m) {
                float s = 0.f;
#pragma unroll
                for (int bj = 0; bj < 2; ++bj)
#pragma unroll
                    for (int n = 0; n < 2; ++n) { const f32x4 x = v[ai][bj][m][n]; s += (x[0] + x[1]) + (x[2] + x[3]); }
                s += __shfl_xor(s, 16); s += __shfl_xor(s, 32);
                const float mw = s * (1.0f / 64.0f); float q = 0.f;
#pragma unroll
                for (int bj = 0; bj < 2; ++bj)
#pragma unroll
                    for (int n = 0; n < 2; ++n) { const f32x4 d = v[ai][bj][m][n] - mw; q += (d[0] * d[0] + d[1] * d[1]) + (d[2] * d[2] + d[3] * d[3]); }
                q += __shfl_xor(q, 16); q += __shfl_xor(q, 32);
                if (fq == 0) P[(ai * HALF + wr * 64 + m * 16 + fr) * 4 + wc] = (f32x2v){mw, q};
            }
        asm volatile("s_waitcnt lgkmcnt(0)" ::: "memory"); __builtin_amdgcn_s_barrier(); asm volatile("" ::: "memory");
#if defined(BROKEN_NO_WAIT)
        if (blockIdx.x >= 64) { const long long t0 = clock64(); while (clock64() - t0 < 60000) __builtin_amdgcn_s_sleep(8); }
#endif
        const int row = wid * 32 + (lane & 31);
        if (lane < 32) {
            const f32x2v a = P[row * 4 + 0], b = P[row * 4 + 1], c = P[row * 4 + 2], d = P[row * 4 + 3];
            const float mt = (a.x + b.x + c.x + d.x) * 0.25f;
            const float da = a.x - mt, db = b.x - mt, dc = c.x - mt, dd = d.x - mt;
            const float m2 = (a.y + b.y) + (c.y + d.y) + 64.0f * ((da * da + db * db) + (dc * dc + dd * dd));
            unsigned long long* slot = (unsigned long long*)xbuf + ((size_t)(u.pm * BM + row) * 4 + u.pn);
            __hip_atomic_store(slot, ((unsigned long long)__float_as_uint(m2) << 32) | __float_as_uint(mt), __ATOMIC_RELAXED, __HIP_MEMORY_SCOPE_AGENT);
        }
        asm volatile("s_waitcnt vmcnt(0)" ::: "memory");
        if (lane == 0) __hip_atomic_fetch_add(cnt + 64 * u.pm, 1u, __ATOMIC_RELAXED, __HIP_MEMORY_SCOPE_AGENT);
        if (wid == 0) {
            bool dead = false; const unsigned long long t0 = __builtin_amdgcn_s_memrealtime(); const unsigned want = 8u * (unsigned)ntn;
            for (;;) {
#if defined(BROKEN_NO_WAIT)
                break;
#endif
                if ((unsigned)__builtin_amdgcn_readfirstlane(__hip_atomic_load(cnt + 64 * u.pm, __ATOMIC_RELAXED, __HIP_MEMORY_SCOPE_AGENT)) >= want) break;
                if (__builtin_amdgcn_s_memrealtime() - t0 > 2000000ull) {
                    if (lane == 0) { unsigned expect = 0u; __hip_atomic_compare_exchange_strong(tmo + 1, &expect, code | (unsigned)(u.pm & 0xff), __ATOMIC_RELAXED, __ATOMIC_RELAXED, __HIP_MEMORY_SCOPE_AGENT);
                                     __hip_atomic_store(tmo, 1u, __ATOMIC_RELAXED, __HIP_MEMORY_SCOPE_AGENT); }
                    dead = true; break; }
                __builtin_amdgcn_s_sleep(2);
            }
            __builtin_amdgcn_fence(__ATOMIC_ACQUIRE, "agent");
            if (lane == 0) flag[0] = dead ? 1u : 0u;
        }
        asm volatile("s_waitcnt vmcnt(0) lgkmcnt(0)" ::: "memory"); __builtin_amdgcn_s_barrier(); asm volatile("" ::: "memory");
        const bool bad = flag[0] != 0u;
        if (lane < 32) {
            const unsigned long long* slot = (const unsigned long long*)xbuf + (size_t)(u.pm * BM + row) * 4; float mt[4], m2[4]; float ms = 0.f;
#pragma unroll
            for (int t = 0; t < 4; ++t) { if (t < ntn) { const unsigned long long w = __hip_atomic_load(slot + t, __ATOMIC_RELAXED, __HIP_MEMORY_SCOPE_AGENT); mt[t] = __uint_as_float((unsigned)w); m2[t] = __uint_as_float((unsigned)(w >> 32)); } else { mt[t] = 0.f; m2[t] = 0.f; } ms += mt[t]; }
            const float mean = ms / (float)ntn; float q = 0.f;
#pragma unroll
            for (int t = 0; t < 4; ++t) if (t < ntn) { const float dm = mt[t] - mean; q += m2[t] + 256.0f * dm * dm; }
            S[row] = (f32x2v){mean, 1.0f / sqrtf(q / (256.0f * (float)ntn) + eps)};
        }
        asm volatile("s_waitcnt lgkmcnt(0)" ::: "memory"); __builtin_amdgcn_s_barrier(); asm volatile("" ::: "memory");
        return bad;
    }
};
struct EpiLnRes {
    static constexpr bool PERM = false, AFTER_DRAIN = true;
    const float* base; float* out; int ldc; const float* bias; PanelStats st; unsigned poison;
    __device__ __forceinline__ void refuse(size_t i0, size_t stride, int M, int N) const { const float q = __builtin_nanf(""); for (size_t i = i0; i < (size_t)M * N; i += stride) out[(i / N) * ldc + i % N] = q;
        if (i0 == 0) { unsigned expect = 0u; __hip_atomic_compare_exchange_strong(st.tmo + 1, &expect, 0x7f0u, __ATOMIC_RELAXED, __ATOMIC_RELAXED, __HIP_MEMORY_SCOPE_AGENT); __hip_atomic_store(st.tmo, 1u, __ATOMIC_RELAXED, __HIP_MEMORY_SCOPE_AGENT); } }
    __device__ __forceinline__ void fused(f32x4 (&acc)[2][2][4][2], const Unit& u, int wr, int wc, int fr, int fq, PG8_LAS unsigned char* lds, int wid, int lane) const {
        typedef float f32x2v __attribute__((ext_vector_type(2)));
        const PG8_LAS f32x2v* S = (const PG8_LAS f32x2v*)(lds + 8192);
        const int col0 = u.pn * BM + wc * 32 + 4 * fq;
#pragma unroll
        for (int bj = 0; bj < 2; ++bj)
#pragma unroll
            for (int n = 0; n < 2; ++n) { const f32x4 bv = bias ? *(const f32x4*)(bias + col0 + bj * HALF + n * 16) : (f32x4){0.f, 0.f, 0.f, 0.f};
#pragma unroll
                for (int ai = 0; ai < 2; ++ai)
#pragma unroll
                    for (int m = 0; m < 4; ++m) acc[ai][bj][m][n] += bv; }
        const bool bad = st.run(acc, u, wr, wc, fr, fq, lds, wid, lane) || poison != 0u;
        const float qnan = __builtin_nanf("");
#pragma unroll
        for (int ai = 0; ai < 2; ++ai)
#pragma unroll
            for (int m = 0; m < 4; ++m) { const int r = ai * HALF + wr * 64 + m * 16 + fr; const f32x2v sr = S[r]; const size_t off = (size_t)(u.pm * BM + r) * ldc + col0;
#pragma unroll
                for (int bj = 0; bj < 2; ++bj)
#pragma unroll
                    for (int n = 0; n < 2; ++n) { const f32x4 bs = *(const f32x4*)(base + off + bj * HALF + n * 16); f32x4 o = bs + (acc[ai][bj][m][n] - sr.x) * sr.y;
                        if (bad) o = (f32x4){qnan, qnan, qnan, qnan}; *(f32x4*)(out + off + bj * HALF + n * 16) = o; }
                asm volatile("" ::: "memory"); }
    }
};
struct EpiLnResLn {
    static constexpr bool PERM = false, AFTER_DRAIN = true;
    const float* base; float* out; bf16_t* xn; int ldc; const float* bias; PanelStats st1, st2; unsigned poison;
    __device__ __forceinline__ void refuse(size_t i0, size_t stride, int M, int N) const { const float q = __builtin_nanf(""); for (size_t i = i0; i < (size_t)M * N; i += stride) { const size_t o = (i / N) * ldc + i % N; out[o] = q; xn[o] = (bf16_t)0x7fc0u; }
        if (i0 == 0) { unsigned expect = 0u; __hip_atomic_compare_exchange_strong(st1.tmo + 1, &expect, 0x7f0u, __ATOMIC_RELAXED, __ATOMIC_RELAXED, __HIP_MEMORY_SCOPE_AGENT); __hip_atomic_store(st1.tmo, 1u, __ATOMIC_RELAXED, __HIP_MEMORY_SCOPE_AGENT); } }
    __device__ __forceinline__ void fused(f32x4 (&acc)[2][2][4][2], const Unit& u, int wr, int wc, int fr, int fq, PG8_LAS unsigned char* lds, int wid, int lane) const {
        typedef float f32x2v __attribute__((ext_vector_type(2))); typedef unsigned u32x2v __attribute__((ext_vector_type(2)));
        const PG8_LAS f32x2v* S = (const PG8_LAS f32x2v*)(lds + 8192);
        const int col0 = u.pn * BM + wc * 32 + 4 * fq;
#pragma unroll
        for (int bj = 0; bj < 2; ++bj)
#pragma unroll
            for (int n = 0; n < 2; ++n) { const f32x4 bv = bias ? *(const f32x4*)(bias + col0 + bj * HALF + n * 16) : (f32x4){0.f, 0.f, 0.f, 0.f};
#pragma unroll
                for (int ai = 0; ai < 2; ++ai)
#pragma unroll
                    for (int m = 0; m < 4; ++m) acc[ai][bj][m][n] += bv; }
        bool bad = st1.run(acc, u, wr, wc, fr, fq, lds, wid, lane) || poison != 0u;
        const float qnan = __builtin_nanf("");
#pragma unroll
        for (int ai = 0; ai < 2; ++ai)
#pragma unroll
            for (int m = 0; m < 4; ++m) { const int r = ai * HALF + wr * 64 + m * 16 + fr; const f32x2v sr = S[r]; const size_t off = (size_t)(u.pm * BM + r) * ldc + col0;
#pragma unroll
                for (int bj = 0; bj < 2; ++bj)
#pragma unroll
                    for (int n = 0; n < 2; ++n) { const f32x4 bs = *(const f32x4*)(base + off + bj * HALF + n * 16); acc[ai][bj][m][n] = bs + (acc[ai][bj][m][n] - sr.x) * sr.y; }
                asm volatile("" : "+v"(acc[ai][0][m][0]), "+v"(acc[ai][0][m][1]), "+v"(acc[ai][1][m][0]), "+v"(acc[ai][1][m][1]));
                if (m & 1) asm volatile("" ::: "memory"); }
        const bool bad1 = bad;
        bad = st2.run(acc, u, wr, wc, fr, fq, lds, wid, lane) || bad;
#pragma unroll
        for (int ai = 0; ai < 2; ++ai)
#pragma unroll
            for (int m = 0; m < 4; ++m) { const int r = ai * HALF + wr * 64 + m * 16 + fr; const f32x2v sr = S[r]; const size_t off = (size_t)(u.pm * BM + r) * ldc + col0;
#pragma unroll
                for (int bj = 0; bj < 2; ++bj)
#pragma unroll
                    for (int n = 0; n < 2; ++n) { const f32x4 x1 = acc[ai][bj][m][n]; *(f32x4*)(out + off + bj * HALF + n * 16) = bad1 ? (f32x4){qnan, qnan, qnan, qnan} : x1;
                        const f32x4 o = (x1 - sr.x) * sr.y; u32x2v w; w.x = cvt_pk_bf16(o[0], o[1]); w.y = cvt_pk_bf16(o[2], o[3]);
                        if (bad) { w.x = 0x7fc07fc0u; w.y = 0x7fc07fc0u; } *(u32x2v*)(xn + off + bj * HALF + n * 16) = w; }
                asm volatile("" ::: "memory"); }
    }
};

template <class Epi, class Sched, bool STAMP = false>
__device__ __forceinline__ void gemm_phase(PG8_LAS unsigned char* lds, const Gemm g, const Sched& S, const Epi& E, unsigned long long* stamps) {
    const int tid = launder_v((int)threadIdx.x), wid = __builtin_amdgcn_readfirstlane(tid >> 6), lane = tid & 63, wr = wid >> 2, wc = wid & 3, fr = lane & 15, fq = lane >> 4;
    const int K = g.K, nt = K / BK;
    int ts_lo = 0, ts_hi = 0, nts = 0; const unsigned long long rt_entry = STAMP ? (unsigned long long)wall_clock64() : 0ull;
#define PG8_STAMP() do { if (STAMP && wid == 0 && nts < 64) { const unsigned long long _c = (unsigned long long)clock64(); \
        ts_lo = (lane == nts) ? (int)(unsigned)_c : ts_lo; ts_hi = (lane == nts) ? (int)(unsigned)(_c >> 32) : ts_hi; ++nts; } } while (0)
    PG8_STAMP();
    unsigned voffA[2], voffB[2];
#pragma unroll
    for (int i = 0; i < 2; ++i) { int R, C; stage_rc(tid * 16 + i * 8192, R, C); const int Rb = Epi::PERM ? ((R & ~31) + perm32(R & 31)) : R;
        voffA[i] = (unsigned)(R * K + C) * 2u; voffB[i] = (unsigned)(Rb * K + C) * 2u; }
    const size_t kstep = (size_t)(BK * 2);
    const size_t hstep = (size_t)HALF * K * 2;
    const size_t tstep = 2 * hstep;
    const unsigned ldsw = (unsigned)wid * 1024u;
    const int aoff = lds_byte(wr * 64 + fr, fq * 8), boff = lds_byte(wc * 32 + fr, fq * 8);
#define PG8_SA(b, h) (((b) * 2 + (h)) * HTB)
#define PG8_SB(b, h) ((4 + (b) * 2 + (h)) * HTB)
#define PG8_STAGE(bufoff, gbase, voff) do { _Pragma("unroll") for (int _i = 0; _i < 2; ++_i) \
        __builtin_amdgcn_global_load_lds((const unsigned*)((const char*)(gbase) + (voff)[_i]), (PG8_LAS unsigned*)(lds + (bufoff) + ldsw + _i * 8192), 16, 0, 0); } while (0)
#define PG8_LDA(dst, b, h) do { _Pragma("unroll") for (int m = 0; m < 4; ++m) _Pragma("unroll") for (int k = 0; k < 2; ++k) dst[m][k] = *(const PG8_LAS bf16x8*)(lds + PG8_SA(b, h) + aoff + m * 2048 + k * 1024); } while (0)
#define PG8_LDB(dst, b, h) do { _Pragma("unroll") for (int n = 0; n < 2; ++n) _Pragma("unroll") for (int k = 0; k < 2; ++k) dst[n][k] = *(const PG8_LAS bf16x8*)(lds + PG8_SB(b, h) + boff + n * 2048 + k * 1024); } while (0)
#define PG8_MMA(ai, bj, At, Bt) do { __builtin_amdgcn_s_setprio(1); _Pragma("unroll") for (int m = 0; m < 4; ++m) _Pragma("unroll") for (int n = 0; n < 2; ++n) _Pragma("unroll") for (int k = 0; k < 2; ++k) \
        acc[ai][bj][m][n] = __builtin_amdgcn_mfma_f32_16x16x32_bf16(Bt[n][k], At[m][k], acc[ai][bj][m][n], 0, 0, 0); __builtin_amdgcn_s_setprio(0); } while (0)
#define PG8_WAIT_V(n) asm volatile("s_waitcnt vmcnt(" #n ")" ::: "memory")
#define PG8_WAIT_L(n) asm volatile("s_waitcnt lgkmcnt(" #n ")" ::: "memory")
#define PG8_BAR __builtin_amdgcn_s_barrier()
#define PG8_SCHED __builtin_amdgcn_sched_barrier(0)
    Unit cur, nxt; int ui = 0;
    if (!S.next(0, cur)) return;
    f32x4 acc[2][2][4][2];
#pragma unroll
    for (int a = 0; a < 2; ++a)
#pragma unroll
        for (int b = 0; b < 2; ++b)
#pragma unroll
            for (int m = 0; m < 4; ++m)
#pragma unroll
                for (int n = 0; n < 2; ++n) acc[a][b][m][n] = (f32x4){0.f, 0.f, 0.f, 0.f};
    bf16x8 At[4][2], B0[2][2], B1[2][2];
    const char* cA = (const char*)g.A + (size_t)cur.pm * tstep; const char* cB = (const char*)g.Bt + (size_t)cur.pn * tstep;
    S.a_ready(cur);
    PG8_STAGE(PG8_SB(0, 0), cB, voffB); PG8_STAGE(PG8_SA(0, 0), cA, voffA); PG8_STAGE(PG8_SB(0, 1), cB + hstep, voffB); PG8_STAGE(PG8_SA(0, 1), cA + hstep, voffA);
    if (wr == 1) PG8_BAR;
    PG8_WAIT_V(4); PG8_BAR;
    PG8_STAGE(PG8_SB(1, 0), cB + kstep, voffB); PG8_STAGE(PG8_SA(1, 0), cA + kstep, voffA); PG8_STAGE(PG8_SB(1, 1), cB + hstep + kstep, voffB);
    PG8_WAIT_V(6); PG8_BAR;
    PG8_STAMP();
    for (;;) {
        const bool has_next = S.next(ui + 1, nxt);
        const char* nA = has_next ? (const char*)g.A + (size_t)nxt.pm * tstep : cA; const char* nB = has_next ? (const char*)g.Bt + (size_t)nxt.pn * tstep : cB;
        for (int t = 0; t < nt; t += 2) {
            const bool last = (t == nt - 2);
            const char* a1 = cA + (size_t)(t + 1) * kstep;
            const char* a2 = last ? nA : cA + (size_t)(t + 2) * kstep; const char* b2 = last ? nB : cB + (size_t)(t + 2) * kstep;
            const char* a3 = a2 + kstep; const char* b3 = b2 + kstep;
            if (last && has_next) S.a_ready(nxt);
            PG8_LDB(B0, 0, 0); PG8_SCHED; PG8_LDA(At, 0, 0); PG8_STAGE(PG8_SA(1, 1), a1 + hstep, voffA);
            PG8_WAIT_L(8); PG8_BAR; PG8_WAIT_L(0); PG8_MMA(0, 0, At, B0); PG8_BAR; PG8_SCHED;
            PG8_LDB(B1, 0, 1); PG8_STAGE(PG8_SB(0, 0), b2, voffB);
            PG8_BAR; PG8_WAIT_L(0); PG8_MMA(0, 1, At, B1); PG8_BAR;
            PG8_LDA(At, 0, 1); PG8_STAGE(PG8_SA(0, 0), a2, voffA);
            PG8_BAR; PG8_WAIT_L(0); PG8_MMA(1, 0, At, B0); PG8_BAR; PG8_SCHED;
            PG8_STAGE(PG8_SB(0, 1), b2 + hstep, voffB);
            PG8_WAIT_V(6); PG8_BAR; PG8_MMA(1, 1, At, B1); PG8_BAR;
            PG8_LDB(B0, 1, 0); PG8_SCHED; PG8_LDA(At, 1, 0); PG8_STAGE(PG8_SA(0, 1), a2 + hstep, voffA);
            PG8_WAIT_L(8); PG8_BAR; PG8_WAIT_L(0); PG8_MMA(0, 0, At, B0); PG8_BAR; PG8_SCHED;
            PG8_LDB(B1, 1, 1); PG8_STAGE(PG8_SB(1, 0), b3, voffB);
            PG8_BAR; PG8_WAIT_L(0); PG8_MMA(0, 1, At, B1); PG8_BAR;
            PG8_LDA(At, 1, 1); PG8_STAGE(PG8_SA(1, 0), a3, voffA);
            PG8_BAR; PG8_WAIT_L(0); PG8_MMA(1, 0, At, B0); PG8_BAR; PG8_SCHED;
            PG8_STAGE(PG8_SB(1, 1), b3 + hstep, voffB);
            PG8_WAIT_V(6); PG8_BAR; PG8_MMA(1, 1, At, B1); PG8_BAR;
        }
        PG8_STAMP();
        if constexpr (!Epi::AFTER_DRAIN) { E(acc, cur, wr, wc, fr, fq); S.done(cur); }
        PG8_STAMP();
        if (!has_next) break;
#pragma unroll
        for (int a = 0; a < 2; ++a)
#pragma unroll
            for (int b = 0; b < 2; ++b)
#pragma unroll
                for (int m = 0; m < 4; ++m)
#pragma unroll
                    for (int n = 0; n < 2; ++n) acc[a][b][m][n] = (f32x4){0.f, 0.f, 0.f, 0.f};
        cur = nxt; cA = nA; cB = nB; ++ui;
    }
    PG8_WAIT_V(0);
    if (wr == 0) PG8_BAR;
    PG8_BAR;
    if constexpr (Epi::AFTER_DRAIN) { E.fused(acc, cur, wr, wc, fr, fq, lds, wid, lane); S.done(cur); }
    PG8_STAMP();
    if (STAMP && wid == 0) { stamps[lane] = lane < nts ? (((unsigned long long)(unsigned)ts_hi << 32) | (unsigned)ts_lo) : 0ull;
        if (lane == 62) stamps[62] = rt_entry; if (lane == 63) stamps[63] = (unsigned long long)wall_clock64(); }
#undef PG8_STAMP
#undef PG8_SA
#undef PG8_SB
#undef PG8_STAGE
#undef PG8_LDA
#undef PG8_LDB
#undef PG8_MMA
#undef PG8_WAIT_V
#undef PG8_WAIT_L
#undef PG8_BAR
#undef PG8_SCHED
}
}
#define XB_TMO      128
#define XB_XCNT(j)  (256  + 64 * (j))
#define XB_XSUB(j)  (1280 + 64 * (j))
#define XB_XGEN(j)  (2304 + 64 * (j))
#define XB_TOP      3328
#define XB_TOPGEN   3392
#define XCD_BAR_WORDS 3456
#define XB_SPIN_CAP (1u << 18)
#define LAS __attribute__((address_space(3)))

__device__ __forceinline__ unsigned xb_ld(unsigned* p)              { return __hip_atomic_load(p, __ATOMIC_RELAXED, __HIP_MEMORY_SCOPE_AGENT); }
__device__ __forceinline__ unsigned xb_add(unsigned* p, unsigned v) { return __hip_atomic_fetch_add(p, v, __ATOMIC_RELAXED, __HIP_MEMORY_SCOPE_AGENT); }
__device__ __forceinline__ unsigned xb_xcc_id() { return (unsigned)__builtin_amdgcn_s_getreg((3 << 11) | 20) & 0xFu; }
#define XB_SPIN(cond, bar) do { unsigned _sp = 0; while (cond) { __builtin_amdgcn_s_sleep(1); \
    if ((++_sp & 255u) == 0u) { if (xb_ld(&(bar)[XB_TMO])) break; if (_sp > XB_SPIN_CAP) { atomicAdd(&(bar)[XB_TMO], 1u); break; } } } } while (0)

struct XcdBarrier {
    unsigned* bar; unsigned x;
    volatile LAS unsigned* st;
};

__device__ __forceinline__ XcdBarrier xcd_barrier_post(unsigned* bar, volatile LAS unsigned* st) {
    XcdBarrier b; b.bar = bar; b.x = xb_xcc_id(); b.st = st;
    if (threadIdx.x == 0) (void)xb_add(&bar[XB_XCNT(b.x)], 1u);
    return b;
}
__device__ __forceinline__ void xcd_barrier_complete(unsigned* bar, unsigned x, unsigned& nloc, unsigned& nx) {
    const unsigned G = gridDim.x * gridDim.y * gridDim.z;
    unsigned sum, cnt, mine, sp = 0u;
    for (;;) {
        sum = 0u; cnt = 0u; mine = 0u;
#pragma unroll
        for (unsigned j = 0; j < 16; ++j) { const unsigned c = xb_ld(&bar[XB_XCNT(j)]); sum += c; cnt += (c > 0u) ? 1u : 0u; mine = (j == x) ? c : mine; }
        if (sum == G) break;
        __builtin_amdgcn_s_sleep(1);
        if ((++sp & 255u) == 0u) { if (xb_ld(&bar[XB_TMO])) break; if (sp > XB_SPIN_CAP) { atomicAdd(&bar[XB_TMO], 1u); break; } }
    }
    nloc = mine > 0u ? mine : 1u; nx = cnt > 0u ? cnt : 1u;
}

__device__ __forceinline__ void xcd_barrier(const XcdBarrier& b) {
    asm volatile("s_waitcnt vmcnt(0)" ::: "memory");
    __syncthreads();
    if (threadIdx.x == 0) {
        unsigned* bar = b.bar;
        __builtin_amdgcn_s_waitcnt(0);
        unsigned nloc = b.st[0], nx = b.st[1];
        if (nloc == 0u) { xcd_barrier_complete(bar, b.x, nloc, nx); b.st[0] = nloc; b.st[1] = nx; }
        const unsigned old = xb_add(&bar[XB_XSUB(b.x)], 1u);
        const unsigned gen = old / nloc;
        if (old + 1u == (gen + 1u) * nloc) {
            __builtin_amdgcn_fence(__ATOMIC_RELEASE, "agent");
            asm volatile("s_waitcnt vmcnt(0)" ::: "memory");
            const unsigned og = xb_add(&bar[XB_TOP], 1u);
            const unsigned tg = og / nx;
            if (og + 1u == (tg + 1u) * nx) xb_add(&bar[XB_TOPGEN], 1u);
            else XB_SPIN(xb_ld(&bar[XB_TOPGEN]) == tg, bar);
            __builtin_amdgcn_fence(__ATOMIC_ACQUIRE, "agent");
            xb_add(&bar[XB_XGEN(b.x)], 1u);
            asm volatile("s_waitcnt vmcnt(0)" ::: "memory");
        } else {
            XB_SPIN(xb_ld(&bar[XB_XGEN(b.x)]) == gen, bar);
            __builtin_amdgcn_fence(__ATOMIC_ACQUIRE, "agent");
            asm volatile("s_waitcnt vmcnt(0)" ::: "memory");
        }
    }
    __syncthreads();
}

struct Args { const float* in[25]; float* out; unsigned char* ws; int ph_lo, ph_hi, rep, sub; };
#define LAS __attribute__((address_space(3)))

struct CvtJob { const float* src; int ld; int ncols; int K; const float* kscale; int kind; bf16_t* dst; bf16_t* dst2; };
__device__ __forceinline__ bf16_t* cvt_dst_row(const CvtJob& j, int c) {
    switch (j.kind) {
    case 0: return j.dst + (size_t)c * j.K;
    case 1: {
        if (c < 2560) return j.dst + (size_t)c * DM;
        if (c < 2584) return j.dst2 + (size_t)(c - 2560) * DM;
        if (c < 4120) return j.dst + (size_t)(c - 24) * DM;
        if (c < 4184) return j.dst2 + (size_t)(24 + c - 4120) * DM;
        if (c < 4188) return j.dst2 + (size_t)(88 + c - 4184) * DM;
        return j.dst + (size_t)(c - 92) * DM; }
    case 2: return j.dst + ((size_t)(c >> 7) * 256 + (c & 127)) * j.K;
    default: return j.dst + ((size_t)(c >> 7) * 256 + 128 + (c & 127)) * j.K;
    }
}
struct CvtTile { CvtJob j; int k0, c0; };
__device__ __forceinline__ bool cvt_decode(const Args& a, unsigned char* ws, int ti, CvtTile& t) {
    if (ti >= NL * (32 * 194 + 2 * 64 * 2 + 2 * 2 * 2 + 2 * 8 * 4 * 2 + 3 * 16 * 32 + 32 * 32 + 2 * 16 * 32 * 8 + 16 * 8 * 32)) return false;
    constexpr int PT_WIN = 32 * 194, PT_W1 = 2 * 64 * 2, PT_W2 = 2 * 2 * 2, PT_WUK = 8 * 4 * 2, PT_WB = 3 * 16 * 32, PT_WO = 32 * 32, PT_EX = 16 * 32 * 8, PT_DN = 16 * 8 * 32;
    constexpr int PT_LAYER = PT_WIN + PT_W1 + PT_W2 + 2 * PT_WUK + PT_WB + PT_WO + 2 * PT_EX + PT_DN;
    const int l = ti / PT_LAYER; int r = ti % PT_LAYER; CvtJob& j = t.j; j.kscale = nullptr; j.dst2 = nullptr; int kt, ct;
    if (r < PT_WIN) { j.src = a.in[1] + (size_t)l * DM * IN_COLS; j.ld = IN_COLS; j.ncols = IN_COLS; j.K = DM; j.kind = 1;
        j.dst = (bf16_t*)(ws + WS_WIN) + (size_t)l * NMAIN * DM; j.dst2 = (bf16_t*)(ws + WS_WSK) + (size_t)l * NSK * DM; kt = r / 194; ct = r % 194; }
    else if ((r -= PT_WIN) < PT_W1) { const int kv = r / 128; r %= 128; j.src = a.in[2] + ((size_t)l * 2 + kv) * 4096 * 128; j.ld = 128; j.ncols = 128; j.K = 4096; j.kind = 0;
        j.dst = (bf16_t*)(ws + WS_W1) + ((size_t)l * 2 + kv) * 128 * 4096; kt = r / 2; ct = r % 2; }
    else if ((r -= PT_W1) < PT_W2) { const int kv = r / 4; r %= 4; j.src = a.in[3] + ((size_t)l * 2 + kv) * 128 * 128; j.ld = 128; j.ncols = 128; j.K = 128; j.kind = 0;
        j.dst = (bf16_t*)(ws + WS_W2) + ((size_t)l * 2 + kv) * 128 * 128; kt = r / 2; ct = r % 2; }
    else if ((r -= PT_W2) < 2 * PT_WUK) { const int which = r / PT_WUK; r %= PT_WUK; const int h = r / 8; r %= 8;
        j.src = a.in[which ? 6 : 5] + ((size_t)l * 8 + h) * 256 * 128; j.ld = 128; j.ncols = 128; j.K = 256; j.kind = 0; j.kscale = a.in[7] + (size_t)l * 256;
        j.dst = (bf16_t*)(ws + WS_WKVUP) + ((size_t)l * 2048 + which * 1024 + h * 128) * 256; kt = r / 2; ct = r % 2; }
    else if ((r -= 2 * PT_WUK) < PT_WB) { const int n = r / 512; r %= 512; j.src = a.in[12] + ((size_t)l * 3 + n) * 1024 * 2048; j.ld = 2048; j.ncols = 2048; j.K = 1024; j.kind = 0;
        j.dst = (bf16_t*)(ws + WS_WB) + ((size_t)l * 3 + n) * 2048 * 1024; kt = r / 32; ct = r % 32; }
    else if ((r -= PT_WB) < PT_WO) { j.src = a.in[13] + (size_t)l * 2048 * 2048; j.ld = 2048; j.ncols = 2048; j.K = 2048; j.kind = 0;
        j.dst = (bf16_t*)(ws + WS_WO) + (size_t)l * 2048 * 2048; kt = r / 32; ct = r % 32; }
    else if ((r -= PT_WO) < 2 * PT_EX) { const int which = r / PT_EX; r %= PT_EX; const int e = r / 256; r %= 256;
        j.src = a.in[which ? 21 : 20] + ((size_t)l * 16 + e) * 2048 * 512; j.ld = 512; j.ncols = 512; j.K = 2048; j.kind = which ? 3 : 2;
        j.dst = (bf16_t*)(ws + WS_WGU) + ((size_t)l * 16 + e) * 1024 * 2048; kt = r / 8; ct = r % 8; }
    else { r -= 2 * PT_EX; const int e = r / 256; r %= 256;
        j.src = a.in[22] + ((size_t)l * 16 + e) * 512 * 2048; j.ld = 2048; j.ncols = 2048; j.K = 512; j.kind = 0;
        j.dst = (bf16_t*)(ws + WS_WD) + ((size_t)l * 16 + e) * 2048 * 512; kt = r / 32; ct = r % 32; }
    t.k0 = kt * 64; t.c0 = ct * 64; return true;
}
__device__ __forceinline__ void cvt_load(const CvtTile& t, f32x4 (&v)[16], int lane) {
    const int c = t.c0 + 4 * (lane & 15); const bool ok = c < t.j.ncols;
    const float* sp = t.j.src + (size_t)(t.k0 + (lane >> 4)) * t.j.ld + c;
#pragma unroll
    for (int i = 0; i < 16; ++i) v[i] = ok ? __builtin_nontemporal_load((const f32x4*)(sp + (size_t)(4 * i) * t.j.ld)) : (f32x4){0.f, 0.f, 0.f, 0.f};
}
__device__ __forceinline__ void cvt_store(const CvtTile& t, const f32x4 (&v)[16], LAS float* T, int lane) {
#pragma unroll
    for (int i = 0; i < 16; ++i) { LAS float* p = T + (4 * i + (lane >> 4)) * 65 + 4 * (lane & 15); p[0] = v[i][0]; p[1] = v[i][1]; p[2] = v[i][2]; p[3] = v[i][3]; }
    asm volatile("s_waitcnt lgkmcnt(0)" ::: "memory");
    const int q = lane & 7;
#pragma unroll
    for (int i2 = 0; i2 < 8; ++i2) { const int cl = i2 * 8 + (lane >> 3), c = t.c0 + cl;
        float x[8];
#pragma unroll
        for (int e = 0; e < 8; ++e) x[e] = T[(8 * q + e) * 65 + cl];
        if (c < t.j.ncols) { bf16_t* d = cvt_dst_row(t.j, c);
            if (t.j.kscale) {
#pragma unroll
                for (int e = 0; e < 8; ++e) x[e] *= t.j.kscale[t.k0 + 8 * q + e]; }
            u32x4 w = {cvtpk(x[0], x[1]), cvtpk(x[2], x[3]), cvtpk(x[4], x[5]), cvtpk(x[6], x[7])};
            *(u32x4*)(d + t.k0 + 8 * q) = w; } }
    asm volatile("s_waitcnt lgkmcnt(0)" ::: "memory");
}

__device__ __forceinline__ void p0_prologue(const Args& a, LAS unsigned char* lds) {
    LAS float* tl = (LAS float*)lds;
    unsigned char* ws = launder_s(a.ws);
    const int G = gridDim.x, wg = LBID, tid = LTID, wid = tid >> 6, lane = tid & 63;
    {
        LAS float* T = tl + wid * (64 * 65);
        const int step = G * 8; int ti = wg * 8 + wid;
        CvtTile ta, tb; f32x4 va[16], vb[16];
        bool ha = cvt_decode(a, ws, ti, ta); if (ha) cvt_load(ta, va, lane);
        while (ha) {
            const bool hb = cvt_decode(a, ws, ti + step, tb); if (hb) cvt_load(tb, vb, lane);
            cvt_store(ta, va, T, lane);
            if (!hb) break;
            ti += 2 * step;
            ha = cvt_decode(a, ws, ti, ta); if (ha) cvt_load(ta, va, lane);
            cvt_store(tb, vb, T, lane);
        }
        __syncthreads();
    }
    const size_t gtid = (size_t)wg * 512 + tid, gn = (size_t)G * 512;
    for (size_t i = gtid; i < (size_t)NL * 36 * DM; i += gn) { const size_t l = i / (36 * DM), r = i % (36 * DM); ((bf16_t*)(ws + WS_WSK))[(l * NSK + 92) * DM + r] = 0; }
    for (size_t i = gtid; i < (size_t)NL * 8 * 128 * 128; i += gn) { const int s = (int)(i & 127), t = (int)((i >> 7) & 127); ((bf16_t*)(ws + WS_WSTRIL))[i] = (s <= t) ? f2bf(a.in[10][i]) : (bf16_t)0; }
    for (size_t i = gtid; i < (size_t)NL * 32 * DM; i += gn) { const int k = (int)(i % DM), n = (int)((i / DM) % 32), l = (int)(i / ((size_t)32 * DM));
        float v = 0.f; if (n < 4) v = a.in[16][((size_t)l * DM + k) * 4 + n]; else if (n < 20) v = a.in[18][((size_t)l * DM + k) * 16 + (n - 4)];
        const bf16_t h = f2bf(v); const bf16_t lo = f2bf(v - bf2f(h));
        bf16_t* d = (bf16_t*)(ws + WS_WR) + (size_t)l * 2 * 32 * DM; d[(size_t)n * DM + k] = h; d[(size_t)(32 + n) * DM + k] = lo; }
    for (int job = wg; job < NL * 2; job += G) {
        const float* pe = a.in[4] + (size_t)job * 4096; const float* w1 = a.in[2] + (size_t)job * 4096 * 128;
        const int n = tid & 127, q = tid >> 7; float s = 0.f;
        for (int k = q * 1024; k < (q + 1) * 1024; ++k) s += pe[k] * w1[(size_t)k * 128 + n];
        tl[q * 128 + n] = s; __syncthreads();
        if (tid < 128) ((float*)(ws + WS_C1))[job * 128 + tid] = (tl[tid] + tl[128 + tid]) + (tl[256 + tid] + tl[384 + tid]);
        __syncthreads();
    }
    for (size_t i = gtid; i < (size_t)NTOK * DM / 8; i += gn) { const f32x4 v0 = *(const f32x4*)(a.in[0] + i * 8), v1 = *(const f32x4*)(a.in[0] + i * 8 + 4);
        *(bf16x8*)((bf16_t*)(ws + WS_XB) + i * 8) = pack8(v0, v1); }
}

#define MFMA32(a, b, c) __builtin_amdgcn_mfma_f32_32x32x16_bf16((a), (b), (c), 0, 0, 0)
__device__ __forceinline__ int crow(int r, int hi) { return (r & 3) + 8 * (r >> 2) + 4 * hi; }

__device__ __forceinline__ void skinny_item(const Args& a, int l, LAS unsigned char* lds) {
    unsigned char* ws = launder_s(a.ws);
    const int tid = LTID, wid = __builtin_amdgcn_readfirstlane(tid >> 6), lane = tid & 63, r32 = lane & 31, hi = lane >> 5;
    const bf16_t* xb = (const bf16_t*)(ws + WS_XB); const bf16_t* wsk = (const bf16_t*)(ws + WS_WSK) + (size_t)l * NSK * DM;
    for (int it = LBID; it < NTOK / 32; it += gridDim.x) {
        const int row0 = it * 32;
        f32x16 acc[3] = {};
        const bf16_t* ap = xb + (size_t)(row0 + r32) * DM + 256 * wid + 8 * hi;
        const bf16_t* bp = wsk + (size_t)r32 * DM + 256 * wid + 8 * hi;
#pragma unroll 4
        for (int ks = 0; ks < 16; ++ks) {
            const bf16x8 af = *(const bf16x8*)(ap + 16 * ks);
#pragma unroll
            for (int nb = 0; nb < 3; ++nb) { const bf16x8 bfr = *(const bf16x8*)(bp + (size_t)nb * 32 * DM + 16 * ks); acc[nb] = MFMA32(af, bfr, acc[nb]); }
        }
        LAS float* red = (LAS float*)lds;
#pragma unroll
        for (int nb = 0; nb < 3; ++nb)
#pragma unroll
            for (int r = 0; r < 16; ++r) red[((wid * 3 + nb) * 16 + r) * 64 + lane] = acc[nb][r];
        __syncthreads();
        for (int i = tid; i < 3 * 16 * 64; i += 512) {
            float s = 0.f;
#pragma unroll
            for (int w = 0; w < 8; ++w) s += red[w * 3072 + i];
            const int ln = i & 63, r = (i >> 6) & 15, nb = i >> 10;
            const int row = row0 + crow(r, ln >> 5), n = nb * 32 + (ln & 31);
            if (n < 24) ((float*)(ws + WS_SKF))[(size_t)row * 32 + n] = fast_sigmoid(s);
            else if (n < 88) ((bf16_t*)(ws + WS_KI))[(size_t)row * 64 + (n - 24)] = f2bf(s);
            else if (n < 92) ((float*)(ws + WS_SKF))[(size_t)row * 32 + 24 + (n - 88)] = s;
        }
        __syncthreads();
    }
}

struct EpiInProj {
    static constexpr bool PERM = true, AFTER_DRAIN = false;
    unsigned char* ws;
    __device__ __forceinline__ void operator()(const f32x4 (&acc)[2][2][4][2], const pg8::Unit& u, int wr, int wc, int fr, int fq) const {
        const int pn = u.pn; size_t off; int ld, ct, act = 0;
        if (pn < 4)       { off = WS_QA; ld = 1024; ct = pn; }
        else if (pn < 10) { off = WS_KV; ld = 1536; ct = pn - 4; }
        else if (pn < 14) { off = WS_QB; ld = 1024; ct = pn - 10; }
        else if (pn < 15) { off = WS_HC; ld = 256;  ct = 0; }
        else if (pn < 16) { off = WS_QI; ld = 256;  ct = 0; }
        else if (pn < 20) { off = WS_HU; ld = 1024; ct = pn - 16; act = 1; }
        else if (pn < 24) { off = WS_HV; ld = 1024; ct = pn - 20; act = 1; }
        else              { off = WS_HG; ld = 6144; ct = pn - 24; act = 2; }
        bf16_t* base = (bf16_t*)(ws + off);
        const int row0 = u.pm * 256 + wr * 64 + fr, col0 = ct * 256 + wc * 32 + 8 * fq;
#pragma unroll
        for (int ai = 0; ai < 2; ++ai)
#pragma unroll
            for (int m = 0; m < 4; ++m) {
                const int row = row0 + ai * 128 + m * 16; bf16_t* rowp = base + (size_t)row * ld + col0;
                float sq = 0.f;
#pragma unroll
                for (int bj = 0; bj < 2; ++bj) {
                    f32x4 v0 = acc[ai][bj][m][0], v1 = acc[ai][bj][m][1];
                    if (act == 1) {
#pragma unroll
                        for (int e = 0; e < 4; ++e) { v0[e] = gelu_tanh(v0[e]); v1[e] = gelu_tanh(v1[e]); } }
                    else if (act == 2) {
#pragma unroll
                        for (int e = 0; e < 4; ++e) { v0[e] = fast_sigmoid(v0[e]); v1[e] = fast_sigmoid(v1[e]); } }
                    if (pn == 14) {
#pragma unroll
                        for (int e = 0; e < 4; ++e) sq += v0[e] * v0[e] + v1[e] * v1[e]; }
                    u32x4 w; w.x = cvtpk(v0[0], v0[1]); w.y = cvtpk(v0[2], v0[3]); w.z = cvtpk(v1[0], v1[1]); w.w = cvtpk(v1[2], v1[3]);
                    *(u32x4*)(rowp + bj * 128) = w;
                }
                if (pn == 14) { sq += __shfl_xor(sq, 16); sq += __shfl_xor(sq, 32); if (fq == 0) ((float*)(ws + WS_PSQ))[(size_t)row * 4 + wc] = sq; }
            }
    }
};

namespace att {
constexpr int SHM = 16384;
constexpr int L_V = 0, L_K = 2 * SHM, L_WS = 4 * SHM;
constexpr int L_IMP = 69632;
constexpr int L_SELM = L_IMP + 4 * 64 * 33 * 4;
constexpr int L_MISC = L_SELM + 512;
#define KSWZ(row, colB) ((row) * 256 + ((colB) ^ (((row) & 7) << 4)))
__device__ __forceinline__ int v_st(int k, int c) { const int kk = (k & ~0xC) | ((k & 4) << 1) | ((k & 8) >> 1); return ((kk >> 3) * 4 + (c >> 5)) * 512 + ((kk & 7) * 32 + (c & 31)) * 2; }
__device__ __forceinline__ int v_rd_base(int lane) { return ((lane & 3) << 3) | (((lane >> 2) & 3) << 6) | (((lane >> 4) & 1) << 5) | (((lane >> 5) & 1) << 8); }

struct Ctx { int tid, wid, lane, r32, hi, sr, sc, kws, vst0, vst1, vb0; LAS char* lds; LAS float* li_l; LAS float* al_l; };
__device__ __forceinline__ Ctx make_ctx(LAS unsigned char* lds) {
    Ctx c; c.tid = LTID; c.wid = __builtin_amdgcn_readfirstlane(c.tid >> 6); c.lane = c.tid & 63; c.r32 = c.lane & 31; c.hi = c.lane >> 5;
    c.sr = c.tid >> 4; c.sc = (c.tid & 15) * 8; c.kws = KSWZ(c.sr, c.sc * 2); c.vst0 = v_st(c.sr, c.sc); c.vst1 = v_st(32 + c.sr, c.sc);
    c.lds = (LAS char*)lds; c.vb0 = (int)(unsigned)(uintptr_t)(c.lds + L_V) + v_rd_base(c.lane);
    c.li_l = (LAS float*)(c.lds + L_WS + c.wid * 256); c.al_l = c.li_l + 32; return c;
}
struct Stage { bf16x8 k0, k1, v0, v1; };
__device__ __forceinline__ void stage_load(Stage& s, const Ctx& c, const bf16_t* K, int ldk, const bf16_t* V, int ldv, int key0) {
    s.v0 = *(const bf16x8*)(V + (size_t)(key0 + c.sr) * ldv + c.sc); s.v1 = *(const bf16x8*)(V + (size_t)(key0 + 32 + c.sr) * ldv + c.sc);
    s.k0 = *(const bf16x8*)(K + (size_t)(key0 + c.sr) * ldk + c.sc); s.k1 = *(const bf16x8*)(K + (size_t)(key0 + 32 + c.sr) * ldk + c.sc);
}
template <int BUF> __device__ __forceinline__ void stage_write(const Stage& s, const Ctx& c) {
    *(LAS bf16x8*)(c.lds + L_K + BUF * SHM + c.kws) = s.k0; *(LAS bf16x8*)(c.lds + L_K + BUF * SHM + c.kws + 32 * 256) = s.k1;
    *(LAS bf16x8*)(c.lds + L_V + BUF * SHM + c.vst0) = s.v0; *(LAS bf16x8*)(c.lds + L_V + BUF * SHM + c.vst1) = s.v1;
}
template <int KB> __device__ __forceinline__ void qkt(f32x16& p0, f32x16& p1, const Ctx& c, const bf16x8 (&qr)[8]) {
    p0 = f32x16{}; p1 = f32x16{};
    LAS const char* kb[4];
#pragma unroll
    for (int dd = 0; dd < 4; ++dd) kb[dd] = c.lds + L_K + KB * SHM + KSWZ(c.r32, (dd * 16 + c.hi * 8) * 2);
#pragma unroll
    for (int d0 = 0; d0 < 8; ++d0) { LAS const char* a = kb[d0 & 3] + (d0 >> 2) * 128;
        const bf16x8 b0 = *(LAS const bf16x8*)a; const bf16x8 b1 = *(LAS const bf16x8*)(a + 32 * 256);
        p0 = MFMA32(b0, qr[d0], p0); p1 = MFMA32(b1, qr[d0], p1); }
}
template <int VB> __device__ __forceinline__ void pv_tile(f32x16 (&o)[4], int vb0, bf16x8 pa0, bf16x8 pa1, bf16x8 pa2, bf16x8 pa3) {
#define TRRD(dst, off) asm volatile("ds_read_b64_tr_b16 %0, %1 offset:%2" : "=&v"(dst) : "v"(vb0), "i"(off) : "memory")
#define PV_D0(d0) do { s16x4 l0, l1, l2, l3, h0, h1, h2, h3; constexpr int b_ = VB * SHM + (d0) * 512; \
        TRRD(l0, b_); TRRD(h0, b_ + 2048); TRRD(l1, b_ + 4096); TRRD(h1, b_ + 6144); TRRD(l2, b_ + 8192); TRRD(h2, b_ + 10240); TRRD(l3, b_ + 12288); TRRD(h3, b_ + 14336); \
        asm volatile("s_waitcnt lgkmcnt(0)" ::: "memory"); __builtin_amdgcn_sched_barrier(0); \
        o[d0] = MFMA32(pa0, ((bf16x8){l0[0], l0[1], l0[2], l0[3], h0[0], h0[1], h0[2], h0[3]}), o[d0]); \
        o[d0] = MFMA32(pa1, ((bf16x8){l1[0], l1[1], l1[2], l1[3], h1[0], h1[1], h1[2], h1[3]}), o[d0]); \
        o[d0] = MFMA32(pa2, ((bf16x8){l2[0], l2[1], l2[2], l2[3], h2[0], h2[1], h2[2], h2[3]}), o[d0]); \
        o[d0] = MFMA32(pa3, ((bf16x8){l3[0], l3[1], l3[2], l3[3], h3[0], h3[1], h3[2], h3[3]}), o[d0]); } while (0)
    PV_D0(0); PV_D0(1); PV_D0(2); PV_D0(3);
#undef PV_D0
#undef TRRD
}
__device__ __forceinline__ float pair_max(float v) { auto rr = __builtin_amdgcn_permlane32_swap(__float_as_uint(v), __float_as_uint(v), false, false); return fmaxf(__uint_as_float(rr[0]), __uint_as_float(rr[1])); }
__device__ __forceinline__ float pair_sum(float v) { auto rr = __builtin_amdgcn_permlane32_swap(__float_as_uint(v), __float_as_uint(v), false, false); return __uint_as_float(rr[0]) + __uint_as_float(rr[1]); }
#define PK4(P, B_, OUT) do { unsigned xa0_ = cvtpk(P[B_+0], P[B_+1]), xa1_ = cvtpk(P[B_+2], P[B_+3]); \
        unsigned xb0_ = cvtpk(P[B_+4], P[B_+5]), xb1_ = cvtpk(P[B_+6], P[B_+7]); \
        auto xr0_ = __builtin_amdgcn_permlane32_swap(xa0_, xb0_, false, false); auto xr1_ = __builtin_amdgcn_permlane32_swap(xa1_, xb1_, false, false); \
        u32x4 xw_ = {xr0_[0], xr1_[0], xr0_[1], xr1_[1]}; OUT = *reinterpret_cast<bf16x8*>(&xw_); } while (0)

enum { MODE_WIN = 0, MODE_SEL = 1, MODE_BITS = 2, MODE_CMP = 3 };
template <int MODE> __device__ __forceinline__ void bias_mask(f32x16& p0, f32x16& p1, float bias0, float slope2k, int dq, unsigned W, bool rowsel, unsigned wlo, unsigned whi, int lim) {
    const float NEG = -__builtin_inff();
#pragma unroll
    for (int r = 0; r < 16; ++r) {
        const int cc = (r & 3) + 8 * (r >> 2);
        const float y0 = fmaf(p0[r], ATT_C2, fmaf(slope2k, (float)cc, bias0)), y1 = fmaf(p1[r], ATT_C2, fmaf(slope2k, (float)(cc + 32), bias0));
        bool ok0, ok1;
        if (MODE == MODE_WIN)       { ok0 = (unsigned)(dq - cc) < W; ok1 = (unsigned)(dq - cc - 32) < W; }
        else if (MODE == MODE_SEL)  { ok0 = rowsel && (dq - cc >= 0); ok1 = rowsel && (dq - cc - 32 >= 0); }
        else if (MODE == MODE_BITS) { ok0 = (wlo >> cc) & 1u; ok1 = (whi >> cc) & 1u; }
        else                        { ok0 = cc <= lim; ok1 = cc + 32 <= lim; }
        p0[r] = ok0 ? y0 : NEG; p1[r] = ok1 ? y1 : NEG;
    }
}
__device__ __forceinline__ void softmax_step(f32x16& p0, f32x16& p1, float& m, float& l, f32x16 (&o)[4], const Ctx& c, bf16x8& pa0, bf16x8& pa1, bf16x8& pa2, bf16x8& pa3) {
    float pmax = p0[0];
#pragma unroll
    for (int r = 1; r < 16; ++r) pmax = fmaxf(pmax, p0[r]);
#pragma unroll
    for (int r = 0; r < 16; ++r) pmax = fmaxf(pmax, p1[r]);
    pmax = pair_max(pmax);
    const float mn = fmaxf(m, pmax), alpha = __builtin_amdgcn_exp2f(m - mn); m = mn;
#pragma unroll
    for (int r = 0; r < 16; ++r) { p0[r] = __builtin_amdgcn_exp2f(p0[r] - mn); p1[r] = __builtin_amdgcn_exp2f(p1[r] - mn); }
    float ps = 0.f;
#pragma unroll
    for (int r = 0; r < 16; ++r) ps += p0[r] + p1[r];
    ps = pair_sum(ps); l = l * alpha + ps;
    PK4(p0, 0, pa0); PK4(p0, 8, pa1); PK4(p1, 0, pa2); PK4(p1, 8, pa3);
    if (__any(alpha < 1.f)) {
        if (c.hi == 0) c.al_l[c.r32] = alpha;
        asm volatile("s_waitcnt lgkmcnt(0)" ::: "memory");
#pragma unroll
        for (int r = 0; r < 16; ++r) { const float al = c.al_l[crow(r, c.hi)];
#pragma unroll
            for (int d = 0; d < 4; ++d) o[d][r] *= al; }
    }
}
struct BranchArgs {
    const bf16_t* K; const bf16_t* V; int ldk, ldv;
    unsigned tilemask;
    int t; float slope2;
    unsigned rowsel;
    const unsigned long long* mrow;
    unsigned W;
};
template <int MODE, int BUF> __device__ __forceinline__ void branch_step(const Ctx& c, const bf16x8 (&qr)[8], const BranchArgs& A, int j, unsigned long long mw, f32x16 (&o)[4], float& m, float& l) {
    f32x16 p0, p1; bf16x8 pa0, pa1, pa2, pa3;
    qkt<BUF>(p0, p1, c, qr);
    const int kb = j * 64, dq = A.t - kb - 4 * c.hi;
    if (MODE == MODE_CMP) {
        bias_mask<MODE>(p0, p1, -A.slope2 * (float)(A.t - 31 - 16 * (kb + 4 * c.hi)), A.slope2 * 16.f, 0, 0u, false, 0u, 0u, (int)A.W - kb - 4 * c.hi);
    } else {
        const float bias0 = -A.slope2 * (float)dq;
        bias_mask<MODE>(p0, p1, bias0, A.slope2, dq, A.W, (A.rowsel >> j) & 1u, (unsigned)(mw >> (4 * c.hi)), (unsigned)(mw >> (32 + 4 * c.hi)), 0);
    }
    softmax_step(p0, p1, m, l, o, c, pa0, pa1, pa2, pa3);
    pv_tile<BUF>(o, c.vb0, pa0, pa1, pa2, pa3);
}
template <int MODE> __device__ __forceinline__ void attn_branch(const Ctx& c, const bf16x8 (&qr)[8], const BranchArgs& A, f32x16 (&o)[4], float& l, float& m) {
    m = -1e30f; l = 0.f;
#pragma unroll
    for (int d = 0; d < 4; ++d) o[d] = f32x16{};
    unsigned rest = A.tilemask; int j = __builtin_ctz(rest); rest &= rest - 1;
    Stage sg; unsigned long long mw = 0, mwn = 0;
    stage_load(sg, c, A.K, A.ldk, A.V, A.ldv, j * 64);
    if (MODE == MODE_BITS) mw = A.mrow[j];
    stage_write<0>(sg, c);
    __syncthreads();
    for (;;) {
        { const bool has_next = rest != 0u; const int jn = has_next ? __builtin_ctz(rest) : j; rest &= rest - 1;
          if (has_next) { stage_load(sg, c, A.K, A.ldk, A.V, A.ldv, jn * 64); if (MODE == MODE_BITS) mwn = A.mrow[jn]; }
          branch_step<MODE, 0>(c, qr, A, j, mw, o, m, l);
          if (has_next) stage_write<1>(sg, c);
          __syncthreads();
          if (!has_next) break; j = jn; mw = mwn; }
        { const bool has_next = rest != 0u; const int jn = has_next ? __builtin_ctz(rest) : j; rest &= rest - 1;
          if (has_next) { stage_load(sg, c, A.K, A.ldk, A.V, A.ldv, jn * 64); if (MODE == MODE_BITS) mwn = A.mrow[jn]; }
          branch_step<MODE, 1>(c, qr, A, j, mw, o, m, l);
          if (has_next) stage_write<0>(sg, c);
          __syncthreads();
          if (!has_next) break; j = jn; mw = mwn; }
    }
}
__device__ __forceinline__ void row_coef(const Ctx& c, float coef, float (&cf)[16]) {
    if (c.hi == 0) c.li_l[c.r32] = coef;
    asm volatile("s_waitcnt lgkmcnt(0)" ::: "memory");
#pragma unroll
    for (int r = 0; r < 16; ++r) cf[r] = c.li_l[crow(r, c.hi)];
    asm volatile("s_waitcnt lgkmcnt(0)" ::: "memory");
}
__device__ __forceinline__ void store_rows_bf16(const Ctx& c, const f32x16 (&v)[4], bf16_t* base, size_t rowstride) {
#pragma unroll
    for (int r = 0; r < 16; ++r) { bf16_t* rp = base + (size_t)crow(r, c.hi) * rowstride;
#pragma unroll
        for (int d0 = 0; d0 < 4; ++d0) { const float x = v[d0][r]; const float xn = __shfl_xor(x, 1);
            if ((c.r32 & 1) == 0) *(unsigned*)(rp + d0 * 32 + c.r32) = cvtpk(x, xn); } }
}

__device__ __forceinline__ void nsa_item(const Args& a, LAS unsigned char* ldsu, int b, int hkv, int qb) {
    unsigned char* ws = launder_s(a.ws); Ctx c = make_ctx(ldsu);
    const int g = c.wid >> 1, half = c.wid & 1, head = hkv * 4 + g;
    const int tl = half * 32 + c.r32, t = qb * 64 + tl;
    const size_t tok = (size_t)b * SEQ + t;
    const float slope2 = __builtin_amdgcn_exp2f(-(float)(head + 1)) * LOG2E;
    bf16x8 qr[8];
    { const bf16_t* qp = (const bf16_t*)(ws + WS_QA) + tok * 1024 + head * 128 + c.hi * 8;
#pragma unroll
      for (int d0 = 0; d0 < 8; ++d0) qr[d0] = *(const bf16x8*)(qp + d0 * 16); }
    const float* gate = (const float*)(ws + WS_SKF) + tok * 32 + head * 3;
    float* TT = (float*)(ws + WS_TT) + ((size_t)LBID * 512 + c.tid) * 64;
    f32x16 o[4]; float cf[16];
    BranchArgs A; A.t = t; A.slope2 = slope2; A.mrow = nullptr; A.rowsel = 0;
#ifndef NSA_NO_CMP
    {
        const bf16_t* KC = (const bf16_t*)(ws + WS_KC) + (size_t)(b * 2 + hkv) * 128 * 128;
        const bool two = qb >= 16;
        int lim = (t - 31) >> 4; lim = lim > 126 ? 126 : lim;
        A.K = KC; A.V = KC + (size_t)8 * 128 * 128; A.ldk = 128; A.ldv = 128; A.tilemask = two ? 3u : 1u; A.W = (unsigned)lim;
        float l, m; attn_branch<MODE_CMP>(c, qr, A, o, l, m);
        const float inv = l > 0.f ? 1.0f / l : 0.f;
        if (two) {
            LAS float* IMP = (LAS float*)(c.lds + L_IMP) + (g * 64 + tl) * 33;
            float prev = 0.f;
#define IMP_TILE(BUF) do { f32x16 p0, p1; qkt<BUF>(p0, p1, c, qr); \
                bias_mask<MODE_CMP>(p0, p1, -slope2 * (float)(t - 31 - 16 * (BUF * 64 + 4 * c.hi)), slope2 * 16.f, 0, 0u, false, 0u, 0u, lim - BUF * 64 - 4 * c.hi); \
                _Pragma("unroll") for (int r = 0; r < 16; ++r) { p0[r] = __builtin_amdgcn_exp2f(p0[r] - m) * inv; p1[r] = __builtin_amdgcn_exp2f(p1[r] - m) * inv; } \
                _Pragma("unroll") for (int k = 0; k < 8; ++k) { const int mm = k & 3; \
                    const float s4 = (k < 4) ? (p0[4 * mm] + p0[4 * mm + 1]) + (p0[4 * mm + 2] + p0[4 * mm + 3]) : (p1[4 * mm] + p1[4 * mm + 1]) + (p1[4 * mm + 2] + p1[4 * mm + 3]); \
                    const float lst = (k < 4) ? p0[4 * mm + 3] : p1[4 * mm + 3]; \
                    auto rr = __builtin_amdgcn_permlane32_swap(__float_as_uint(lst), __float_as_uint(lst), false, false); \
                    const float from_lo = __uint_as_float(rr[0]), from_hi = __uint_as_float(rr[1]); \
                    IMP[2 * (BUF * 8 + k) + c.hi] = s4 + (c.hi ? from_lo : prev);     \
                    prev = from_hi; } } while (0)
            IMP_TILE(0); IMP_TILE(1);
#undef IMP_TILE
        }
        row_coef(c, gate[0] * inv, cf);
#pragma unroll
        for (int d0 = 0; d0 < 4; ++d0)
#pragma unroll
            for (int r4 = 0; r4 < 4; ++r4) { f32x4 v = {o[d0][4 * r4] * cf[4 * r4], o[d0][4 * r4 + 1] * cf[4 * r4 + 1], o[d0][4 * r4 + 2] * cf[4 * r4 + 2], o[d0][4 * r4 + 3] * cf[4 * r4 + 3]}; *(f32x4*)(TT + d0 * 16 + r4 * 4) = v; }
        __syncthreads();
    }
#endif
#ifndef NSA_NO_SELECT
    {
        LAS unsigned* SELM = (LAS unsigned*)(c.lds + L_SELM);
        if (c.wid == 0) {
            unsigned sel;
            if (qb <= 15) sel = (2u << qb) - 1u;
            else {
                LAS const float* I0 = (LAS const float*)(c.lds + L_IMP) + c.lane * 33;
                float v[32];
#pragma unroll
                for (int j = 0; j < 32; ++j) v[j] = (I0[j] + I0[64 * 33 + j]) + (I0[2 * 64 * 33 + j] + I0[3 * 64 * 33 + j]);
                sel = 1u | (1u << qb) | (1u << (qb - 1));
#pragma unroll
                for (int j = 1; j < 30; ++j) {
                    int rank = 0;
#pragma unroll
                    for (int j2 = 1; j2 < 30; ++j2) { const bool in2 = j2 <= qb - 2; const bool before = (v[j2] > v[j]) || (v[j2] == v[j] && j2 < j); rank += (in2 && before) ? 1 : 0; }
                    if (j <= qb - 2 && rank < 13) sel |= 1u << j;
                }
            }
            SELM[c.lane] = sel;
            unsigned any = sel;
#pragma unroll
            for (int ofs = 32; ofs >= 1; ofs >>= 1) any |= (unsigned)__shfl_xor((int)any, ofs);
            if (c.lane == 0) SELM[64] = any;
        }
        __syncthreads();
    }
#endif
    A.ldk = 1536; A.ldv = 1536; A.W = 0x7fffffffu;
    const bf16_t* KVb = (const bf16_t*)(ws + WS_KV) + (size_t)b * SEQ * 1536 + hkv * 128;
#ifndef NSA_NO_SEL
    {
        c = make_ctx(ldsu); ws = launder_s(ws);
        LAS const unsigned* SELM = (LAS const unsigned*)(c.lds + L_SELM);
        A.K = KVb + 512; A.V = KVb + 768; A.rowsel = SELM[tl];
        A.tilemask = (unsigned)__builtin_amdgcn_readfirstlane((int)SELM[64]) & ((2u << qb) - 1u);
        float l, m; attn_branch<MODE_SEL>(c, qr, A, o, l, m);
        row_coef(c, gate[1] * (l > 0.f ? 1.0f / l : 0.f), cf);
#pragma unroll
        for (int d0 = 0; d0 < 4; ++d0) {
#pragma unroll
            for (int r4 = 0; r4 < 4; ++r4) { f32x4 v = *(const f32x4*)(TT + d0 * 16 + r4 * 4);
                v[0] += o[d0][4 * r4] * cf[4 * r4]; v[1] += o[d0][4 * r4 + 1] * cf[4 * r4 + 1]; v[2] += o[d0][4 * r4 + 2] * cf[4 * r4 + 2]; v[3] += o[d0][4 * r4 + 3] * cf[4 * r4 + 3]; *(f32x4*)(TT + d0 * 16 + r4 * 4) = v; }
            asm volatile("" ::: "memory"); }
    }
#endif
#ifndef NSA_NO_WIN
    {
        c = make_ctx(ldsu); ws = launder_s(ws);
        A.K = KVb + 1024; A.V = KVb + 1280; A.W = 512u;
        const int jlo = qb >= 8 ? qb - 8 : 0;
        A.tilemask = ((2u << qb) - 1u) & ~((1u << jlo) - 1u);
        float l, m; attn_branch<MODE_WIN>(c, qr, A, o, l, m);
        row_coef(c, gate[2] * (l > 0.f ? 1.0f / l : 0.f), cf);
#pragma unroll
        for (int d0 = 0; d0 < 4; ++d0) {
#pragma unroll
            for (int r4 = 0; r4 < 4; ++r4) { const f32x4 v = *(const f32x4*)(TT + d0 * 16 + r4 * 4);
                o[d0][4 * r4] = v[0] + o[d0][4 * r4] * cf[4 * r4]; o[d0][4 * r4 + 1] = v[1] + o[d0][4 * r4 + 1] * cf[4 * r4 + 1]; o[d0][4 * r4 + 2] = v[2] + o[d0][4 * r4 + 2] * cf[4 * r4 + 2]; o[d0][4 * r4 + 3] = v[3] + o[d0][4 * r4 + 3] * cf[4 * r4 + 3]; }
            asm volatile("" ::: "memory"); }
        store_rows_bf16(c, o, (bf16_t*)(ws + WS_BR) + ((size_t)b * SEQ + qb * 64 + half * 32) * 1024 + head * 128, 1024);
    }
#endif
}

__device__ __forceinline__ void dsa_item(const Args& a, LAS unsigned char* ldsu, int b, int h, int qb) {
    unsigned char* ws = launder_s(a.ws); const Ctx c = make_ctx(ldsu);
    const int t = qb * 256 + c.wid * 32 + c.r32; const size_t tok = (size_t)b * SEQ + t;
    bf16x8 qr[8];
    { const bf16_t* qp = (const bf16_t*)(ws + WS_QB) + tok * 1024 + h * 128 + c.hi * 8;
#pragma unroll
      for (int d0 = 0; d0 < 8; ++d0) qr[d0] = *(const bf16x8*)(qp + d0 * 16); }
    BranchArgs A; A.ldk = 2048; A.ldv = 2048; A.t = t; A.slope2 = __builtin_amdgcn_exp2f(-(float)(h + 1)) * LOG2E; A.W = 0; A.rowsel = 0;
    const bf16_t* kv = (const bf16_t*)(ws + WS_KVUP) + (size_t)b * SEQ * 2048 + h * 128;
    A.K = kv; A.V = kv + 1024; A.mrow = (const unsigned long long*)(ws + WS_MASK) + tok * 32;
    const int nt = 4 * qb + 4; A.tilemask = nt >= 32 ? 0xffffffffu : ((1u << nt) - 1u);
    f32x16 o[4]; float l, m, cf[16];
    attn_branch<MODE_BITS>(c, qr, A, o, l, m);
    row_coef(c, l > 0.f ? 1.0f / l : 0.f, cf);
#pragma unroll
    for (int d0 = 0; d0 < 4; ++d0)
#pragma unroll
        for (int r = 0; r < 16; ++r) o[d0][r] *= cf[r];
    store_rows_bf16(c, o, (bf16_t*)(ws + WS_BR) + (size_t)NTOK * 1024 + ((size_t)b * SEQ + qb * 256 + c.wid * 32) * 1024 + h * 128, 1024);
}

__device__ __forceinline__ void gmlp_item(const Args& a, LAS unsigned char* ldsu, int l, int b, int ch, int gp) {
    unsigned char* ws = launder_s(a.ws); const Ctx c = make_ctx(ldsu);
    const size_t tok0 = (size_t)b * SEQ + ch * 128;
    const bf16_t* HV = (const bf16_t*)(ws + WS_HV);
#pragma unroll
    for (int gs = 0; gs < 2; ++gs)
#pragma unroll
        for (int st = 0; st < 2; ++st) {
            const bf16_t* vp = HV + (tok0 + st * 64) * 1024 + (2 * gp + gs) * 128 + c.sc;
            const bf16x8 x0 = *(const bf16x8*)(vp + (size_t)c.sr * 1024), x1 = *(const bf16x8*)(vp + (size_t)(32 + c.sr) * 1024);
            *(LAS bf16x8*)(c.lds + L_V + (2 * gs + st) * SHM + c.vst0) = x0; *(LAS bf16x8*)(c.lds + L_V + (2 * gs + st) * SHM + c.vst1) = x1;
        }
    __syncthreads();
    const int gs = c.wid >> 2, wq = c.wid & 3, g = 2 * gp + gs;
    const bf16_t* Wp = (const bf16_t*)(ws + WS_WSTRIL) + (((size_t)l * 8 + g) * 128 + wq * 32 + c.r32) * 128 + c.hi * 8;
    f32x16 o[4] = {};
    bf16x8 pa0 = *(const bf16x8*)(Wp), pa1 = *(const bf16x8*)(Wp + 16), pa2 = *(const bf16x8*)(Wp + 32), pa3 = *(const bf16x8*)(Wp + 48);
    if (gs == 0) pv_tile<0>(o, c.vb0, pa0, pa1, pa2, pa3); else pv_tile<2>(o, c.vb0, pa0, pa1, pa2, pa3);
    if (wq >= 2) {
        pa0 = *(const bf16x8*)(Wp + 64); pa1 = *(const bf16x8*)(Wp + 80); pa2 = *(const bf16x8*)(Wp + 96); pa3 = *(const bf16x8*)(Wp + 112);
        if (gs == 0) pv_tile<1>(o, c.vb0, pa0, pa1, pa2, pa3); else pv_tile<3>(o, c.vb0, pa0, pa1, pa2, pa3);
    }
    const float* bs = a.in[11] + ((size_t)l * 8 + g) * 128 + wq * 32;
    const bf16_t* HU = (const bf16_t*)(ws + WS_HU) + (tok0 + wq * 32) * 1024 + g * 128;
#pragma unroll
    for (int r = 0; r < 16; ++r) { const int rr = crow(r, c.hi); const float bias = bs[rr];
#pragma unroll
        for (int d0 = 0; d0 < 4; ++d0) o[d0][r] = (o[d0][r] + bias) * bf2f(HU[(size_t)rr * 1024 + d0 * 32 + c.r32]); }
    store_rows_bf16(c, o, (bf16_t*)(ws + WS_BR) + (size_t)2 * NTOK * 1024 + (tok0 + wq * 32) * 1024 + g * 128, 1024);
    __syncthreads();
}
}

struct EpiKvUp {
    static constexpr bool PERM = true, AFTER_DRAIN = false;
    unsigned char* ws;
    __device__ __forceinline__ void operator()(const f32x4 (&acc)[2][2][4][2], const pg8::Unit& u, int wr, int wc, int fr, int fq) const {
        bf16_t* base = (bf16_t*)(ws + WS_KVUP); const float* psq = (const float*)(ws + WS_PSQ);
        const int row0 = u.pm * 256 + wr * 64 + fr, col0 = u.pn * 256 + wc * 32 + 8 * fq;
#pragma unroll
        for (int ai = 0; ai < 2; ++ai)
#pragma unroll
            for (int m = 0; m < 4; ++m) {
                const int row = row0 + ai * 128 + m * 16; const f32x4 q = *(const f32x4*)(psq + (size_t)row * 4);
                const float rs = __builtin_amdgcn_rsqf(((q[0] + q[1]) + (q[2] + q[3])) * (1.0f / 256.0f) + LN_EPS);
                bf16_t* rowp = base + (size_t)row * 2048 + col0;
#pragma unroll
                for (int bj = 0; bj < 2; ++bj) { const f32x4 v0 = acc[ai][bj][m][0] * rs, v1 = acc[ai][bj][m][1] * rs;
                    u32x4 w; w.x = cvtpk(v0[0], v0[1]); w.y = cvtpk(v0[2], v0[3]); w.z = cvtpk(v1[0], v1[1]); w.w = cvtpk(v1[2], v1[3]);
                    *(u32x4*)(rowp + bj * 128) = w; }
                asm volatile("" ::: "memory");
            }
    }
};

__device__ __forceinline__ void gmlp_ln_rows(const Args& a, int l) {
    unsigned char* ws = launder_s(a.ws); const int tid = LTID, wid = tid >> 6, lane = tid & 63;
    const float* g = a.in[8] + (size_t)l * 1024; const float* bta = a.in[9] + (size_t)l * 1024;
    for (int row = LBID * 8 + wid; row < NTOK; row += gridDim.x * 8) {
        bf16_t* p = (bf16_t*)(ws + WS_HV) + (size_t)row * 1024 + lane * 8;
        const bf16x8 x0 = *(const bf16x8*)p, x1 = *(const bf16x8*)(p + 512);
        float v[16];
#pragma unroll
        for (int e = 0; e < 8; ++e) { v[e] = bf2f((bf16_t)x0[e]); v[8 + e] = bf2f((bf16_t)x1[e]); }
        float s = 0.f;
#pragma unroll
        for (int e = 0; e < 16; ++e) s += v[e];
        const float mean = wave_sum(s) * (1.0f / 1024.0f);
        float q = 0.f;
#pragma unroll
        for (int e = 0; e < 16; ++e) { const float d = v[e] - mean; q += d * d; }
        const float rstd = 1.0f / sqrtf(wave_sum(q) * (1.0f / 1024.0f) + LN_EPS);
        float o[16];
#pragma unroll
        for (int e = 0; e < 8; ++e) { o[e] = (v[e] - mean) * rstd * g[lane * 8 + e] + bta[lane * 8 + e]; o[8 + e] = (v[8 + e] - mean) * rstd * g[512 + lane * 8 + e] + bta[512 + lane * 8 + e]; }
        u32x4 w0 = {cvtpk(o[0], o[1]), cvtpk(o[2], o[3]), cvtpk(o[4], o[5]), cvtpk(o[6], o[7])}, w1 = {cvtpk(o[8], o[9]), cvtpk(o[10], o[11]), cvtpk(o[12], o[13]), cvtpk(o[14], o[15])};
        *(u32x4*)p = w0; *(u32x4*)(p + 512) = w1;
    }
}

__device__ __forceinline__ void compress_item(const Args& a, int l, LAS unsigned char* lds, int item) {
    unsigned char* ws = launder_s(a.ws);
    const int tid = LTID, wid = __builtin_amdgcn_readfirstlane(tid >> 6), lane = tid & 63, r32 = lane & 31, hi = lane >> 5;
    const int kv = item >> 5, rt = item & 31;
    const int R = rt * 32 + r32, bh = R >> 7; int i = R & 127; if (i > 126) i = 126;
    const int b = bh >> 1, hkv = bh & 1;
    const bf16_t* src = (const bf16_t*)(ws + WS_KV) + ((size_t)b * SEQ + 16 * i + 4 * wid) * 1536 + kv * 256 + hkv * 128 + hi * 8;
    const bf16_t* w1 = (const bf16_t*)(ws + WS_W1) + ((size_t)l * 2 + kv) * 128 * 4096 + (size_t)r32 * 4096 + wid * 512 + hi * 8;
    f32x16 acc[4] = {};
#pragma unroll 2
    for (int tk = 0; tk < 4; ++tk)
#pragma unroll
        for (int dk = 0; dk < 8; ++dk) {
            const bf16x8 af = *(const bf16x8*)(src + (size_t)tk * 1536 + dk * 16);
#pragma unroll
            for (int nb = 0; nb < 4; ++nb) { const bf16x8 bfr = *(const bf16x8*)(w1 + (size_t)nb * 32 * 4096 + tk * 128 + dk * 16); acc[nb] = MFMA32(af, bfr, acc[nb]); }
        }
    LAS float* red = (LAS float*)lds;
#pragma unroll
    for (int nb = 0; nb < 4; ++nb)
#pragma unroll
        for (int r = 0; r < 16; ++r) red[((wid * 4 + nb) * 16 + r) * 64 + lane] = acc[nb][r];
    __syncthreads();
    LAS bf16_t* G = (LAS bf16_t*)(lds + 131072);
    const float* c1 = (const float*)(ws + WS_C1) + ((size_t)l * 2 + kv) * 128;
    for (int idx = tid; idx < 4096; idx += 512) {
        float s = 0.f;
#pragma unroll
        for (int w = 0; w < 8; ++w) s += red[w * 4096 + idx];
        const int ln = idx & 63, r = (idx >> 6) & 15, nb = idx >> 10;
        const int row = crow(r, ln >> 5), n = nb * 32 + (ln & 31);
        G[row * 136 + n] = f2bf(gelu_tanh(s + c1[n]));
    }
    __syncthreads();
    if (wid < 4) {
        const bf16_t* w2 = (const bf16_t*)(ws + WS_W2) + ((size_t)l * 2 + kv) * 128 * 128 + (size_t)(wid * 32 + r32) * 128 + hi * 8;
        f32x16 o = {};
#pragma unroll
        for (int ks = 0; ks < 8; ++ks) { const bf16x8 af = *(LAS const bf16x8*)(G + r32 * 136 + ks * 16 + hi * 8); const bf16x8 bfr = *(const bf16x8*)(w2 + ks * 16); o = MFMA32(af, bfr, o); }
        bf16_t* dst = (bf16_t*)(ws + WS_KC) + (size_t)kv * 8 * 128 * 128;
#pragma unroll
        for (int r = 0; r < 16; ++r) { const int RR = rt * 32 + crow(r, hi); dst[(size_t)RR * 128 + wid * 32 + r32] = f2bf(o[r]); }
    }
    __syncthreads();
}

__device__ __forceinline__ unsigned sortable(float f) { unsigned u = __float_as_uint(f); if ((u << 1) == 0u) u = 0u; return (u & 0x80000000u) ? ~u : (u | 0x80000000u); }
__device__ __forceinline__ void indexer_item(const Args& a, LAS unsigned char* lds, int item) {
    unsigned char* ws = launder_s(a.ws);
    const int tid = LTID, wid = __builtin_amdgcn_readfirstlane(tid >> 6), lane = tid & 63, r32 = lane & 31, hi = lane >> 5;
    const int b = item >> 7, t0 = (item & 127) * 16;
    unsigned long long* MASK = (unsigned long long*)(ws + WS_MASK);
    if (t0 + 16 <= 256) {
        for (int q = wid * 2; q < wid * 2 + 2; ++q) { const int t = t0 + q;
            if (lane < 32) { const int lo = lane * 64; unsigned long long w = 0ull; if (t >= lo + 63) w = ~0ull; else if (t >= lo) w = (2ull << (t - lo)) - 1ull;
                MASK[((size_t)b * SEQ + t) * 32 + lane] = w; } }
        return;
    }
    LAS unsigned* SC = (LAS unsigned*)lds;
    LAS float* WI = (LAS float*)(lds + 131072);
    if (tid < 64) WI[tid] = ((const float*)(ws + WS_SKF))[((size_t)b * SEQ + t0 + (tid >> 2)) * 32 + 24 + (tid & 3)];
    bf16x8 aq[2][4];
#pragma unroll
    for (int rb = 0; rb < 2; ++rb) { const bf16_t* qp = (const bf16_t*)(ws + WS_QI) + ((size_t)b * SEQ + t0 + rb * 8 + (r32 >> 2)) * 256 + (r32 & 3) * 64 + hi * 8;
#pragma unroll
        for (int ks = 0; ks < 4; ++ks) aq[rb][ks] = *(const bf16x8*)(qp + ks * 16); }
    __syncthreads();
    const int nch = (t0 + 16 + 31) >> 5;
    const bf16_t* KI = (const bf16_t*)(ws + WS_KI) + (size_t)b * SEQ * 64;
    for (int ch = wid; ch < nch; ch += 8) {
        const bf16_t* kp = KI + (size_t)(ch * 32 + r32) * 64 + hi * 8;
        bf16x8 bk[4];
#pragma unroll
        for (int ks = 0; ks < 4; ++ks) bk[ks] = *(const bf16x8*)(kp + ks * 16);
#pragma unroll
        for (int rb = 0; rb < 2; ++rb) {
            f32x16 s = {};
#pragma unroll
            for (int ks = 0; ks < 4; ++ks) s = MFMA32(aq[rb][ks], bk[ks], s);
#pragma unroll
            for (int mq = 0; mq < 4; ++mq) { const int q = rb * 8 + 2 * mq + hi;
                float sc = 0.f;
#pragma unroll
                for (int h = 0; h < 4; ++h) sc += fmaxf(s[mq * 4 + h], 0.f) * WI[q * 4 + h];
                const int key = ch * 32 + r32;
                SC[q * 2048 + key] = (key <= t0 + q) ? sortable(sc) : 0u; }
        }
    }
    __syncthreads();
    for (int q = wid * 2; q < wid * 2 + 2; ++q) {
        const int t = t0 + q; const int nw = (t >> 6) + 1;
        unsigned kk[32];
#pragma unroll
        for (int i = 0; i < 32; ++i) kk[i] = (i < nw && (i * 64 + lane) < nch * 32) ? SC[q * 2048 + i * 64 + lane] : 0u;
        unsigned T = 0u; bool exact = false;
        for (int bit = 31; bit >= 0; --bit) {
            const unsigned cand = T | (1u << bit); int cnt = 0;
#pragma unroll
            for (int i = 0; i < 32; ++i) cnt += __popcll(__ballot(kk[i] >= cand));
            if (cnt >= 256) { T = cand; if (cnt == 256) { exact = true; break; } }
        }
        int need = 0;
        if (!exact) { int ngt = 0;
#pragma unroll
            for (int i = 0; i < 32; ++i) ngt += __popcll(__ballot(kk[i] > T));
            need = 256 - ngt; }
        unsigned long long mine = 0ull;
#pragma unroll
        for (int i = 0; i < 32; ++i) {
            unsigned long long w;
            if (exact) w = __ballot(kk[i] >= T);
            else { w = __ballot(kk[i] > T); unsigned long long eq = __ballot(kk[i] == T);
                   const int ne = __popcll(eq);
                   if (ne <= need) { w |= eq; need -= ne; }
                   else { while (need > 0) { const unsigned long long low = eq & (0ull - eq); w |= low; eq ^= low; --need; } } }
            if (lane == i) mine = w;
        }
        if (lane < 32) MASK[((size_t)b * SEQ + t) * 32 + lane] = mine;
    }
    __syncthreads();
}

template <int NBR> struct EpiBranch {
    static constexpr bool PERM = false, AFTER_DRAIN = false;
    unsigned char* ws;
    __device__ __forceinline__ void operator()(const f32x4 (&acc)[2][2][4][2], const pg8::Unit& u, int wr, int wc, int fr, int fq) const {
        float* T = (float*)(ws + WS_MIXT); bf16_t* O = (bf16_t*)(ws + WS_MIXB); const bf16_t* Gt = (const bf16_t*)(ws + WS_HG) + NBR * 2048;
        const int row0 = u.pm * 256 + wr * 64 + fr, col0 = u.pn * 256 + wc * 32 + 4 * fq;
#pragma unroll
        for (int ai = 0; ai < 2; ++ai)
#pragma unroll
            for (int m = 0; m < 4; ++m) { const size_t row = (size_t)(row0 + ai * 128 + m * 16);
#pragma unroll
                for (int bj = 0; bj < 2; ++bj)
#pragma unroll
                    for (int n = 0; n < 2; ++n) { const int col = col0 + bj * 128 + n * 16;
                        const u32x2 gw = *(const u32x2*)(Gt + row * 6144 + col);
                        f32x4 gv = {__uint_as_float(gw.x << 16), __uint_as_float(gw.x & 0xffff0000u), __uint_as_float(gw.y << 16), __uint_as_float(gw.y & 0xffff0000u)};
                        f32x4 v = acc[ai][bj][m][n] * gv;
                        if (NBR > 0) v += *(const f32x4*)(T + row * 2048 + col);
                        if (NBR < 2) *(f32x4*)(T + row * 2048 + col) = v;
                        else { u32x2 w; w.x = cvtpk(v[0], v[1]); w.y = cvtpk(v[2], v[3]); *(u32x2*)(O + row * 2048 + col) = w; } }
                asm volatile("" ::: "memory");
            }
    }
};
struct EpiOut {
    static constexpr bool PERM = false, AFTER_DRAIN = false;
    const float* x; float* pre;
    __device__ __forceinline__ void operator()(const f32x4 (&acc)[2][2][4][2], const pg8::Unit& u, int wr, int wc, int fr, int fq) const {
        const int row0 = u.pm * 256 + wr * 64 + fr, col0 = u.pn * 256 + wc * 32 + 4 * fq;
#pragma unroll
        for (int ai = 0; ai < 2; ++ai)
#pragma unroll
            for (int m = 0; m < 4; ++m) { const size_t off = (size_t)(row0 + ai * 128 + m * 16) * 2048 + col0;
#pragma unroll
                for (int bj = 0; bj < 2; ++bj)
#pragma unroll
                    for (int n = 0; n < 2; ++n) { const f32x4 xv = *(const f32x4*)(x + off + bj * 128 + n * 16); *(f32x4*)(pre + off + bj * 128 + n * 16) = xv * ALPHA + acc[ai][bj][m][n]; } }
    }
};

__device__ __forceinline__ void ln_row(f32x4 (&v)[8], const float* g, const float* bta, int lane) {
    float s = 0.f;
#pragma unroll
    for (int i = 0; i < 8; ++i) s += (v[i][0] + v[i][1]) + (v[i][2] + v[i][3]);
    const float mean = wave_sum(s) * (1.0f / 2048.0f);
    float q = 0.f;
#pragma unroll
    for (int i = 0; i < 8; ++i) { const f32x4 d = v[i] - mean; q += (d[0] * d[0] + d[1] * d[1]) + (d[2] * d[2] + d[3] * d[3]); }
    const float rstd = 1.0f / sqrtf(wave_sum(q) * (1.0f / 2048.0f) + LN_EPS);
#pragma unroll
    for (int i = 0; i < 8; ++i) { const f32x4 gg = *(const f32x4*)(g + i * 256 + lane * 4), bb = *(const f32x4*)(bta + i * 256 + lane * 4); v[i] = (v[i] - mean) * rstd * gg + bb; }
}

__device__ __forceinline__ void p6_ln1_route(const Args& a, int l, LAS unsigned char* lds) {
    unsigned char* ws = launder_s(a.ws);
    const int tid = LTID, wid = __builtin_amdgcn_readfirstlane(tid >> 6), lane = tid & 63, r32 = lane & 31, hi = lane >> 5;
    const float* pre = (const float*)(ws + WS_MIXT); float* x1f = (float*)(ws + WS_X1F); bf16_t* x1b = (bf16_t*)(ws + WS_X1B);
    const float* g = a.in[14] + (size_t)l * DM; const float* bta = a.in[15] + (size_t)l * DM;
    unsigned* cnt = (unsigned*)(ws + WS_CTL) + CW_CNT + l * 64;
    for (int it = LBID; it < NTOK / 32; it += gridDim.x) {
        const int row0 = it * 32;
        for (int rr = 0; rr < 4; ++rr) { const size_t row = (size_t)(row0 + wid * 4 + rr);
            f32x4 v[8];
#pragma unroll
            for (int i = 0; i < 8; ++i) v[i] = *(const f32x4*)(pre + row * DM + i * 256 + lane * 4);
            ln_row(v, g, bta, lane);
#pragma unroll
            for (int i = 0; i < 8; ++i) { *(f32x4*)(x1f + row * DM + i * 256 + lane * 4) = v[i]; u32x2 w; w.x = cvtpk(v[i][0], v[i][1]); w.y = cvtpk(v[i][2], v[i][3]); *(u32x2*)(x1b + row * DM + i * 256 + lane * 4) = w; }
        }
        asm volatile("s_waitcnt vmcnt(0)" ::: "memory");
        __syncthreads();
        f32x16 acc = {};
        { const float* xp = x1f + (size_t)(row0 + r32) * DM + 256 * wid + 8 * hi;
          const bf16_t* wh = (const bf16_t*)(ws + WS_WR) + (size_t)l * 2 * 32 * DM + (size_t)r32 * DM + 256 * wid + 8 * hi; const bf16_t* wl = wh + 32 * DM;
#pragma unroll 4
          for (int ks = 0; ks < 16; ++ks) {
              const f32x4 x0 = *(const f32x4*)(xp + ks * 16), x1 = *(const f32x4*)(xp + ks * 16 + 4);
              const bf16x8 xh = pack8(x0, x1);
              f32x4 r0, r1;
#pragma unroll
              for (int e = 0; e < 4; ++e) { r0[e] = x0[e] - bf2f((bf16_t)xh[e]); r1[e] = x1[e] - bf2f((bf16_t)xh[4 + e]); }
              const bf16x8 xl = pack8(r0, r1);
              const bf16x8 bh = *(const bf16x8*)(wh + ks * 16), bl = *(const bf16x8*)(wl + ks * 16);
              acc = MFMA32(xh, bh, acc); acc = MFMA32(xl, bh, acc); acc = MFMA32(xh, bl, acc);
          } }
        LAS float* red = (LAS float*)lds;
#pragma unroll
        for (int r = 0; r < 16; ++r) red[(wid * 16 + r) * 64 + lane] = acc[r];
        __syncthreads();
        LAS float* LG = (LAS float*)(lds + 32768);
        for (int idx = tid; idx < 1024; idx += 512) { float s = 0.f;
#pragma unroll
            for (int w = 0; w < 8; ++w) s += red[w * 1024 + idx];
            const int ln = idx & 63, r = idx >> 6; LG[crow(r, ln >> 5) * 33 + (ln & 31)] = s; }
        __syncthreads();
        if (tid < 32) {
            const int row = row0 + tid; LAS const float* lg = LG + tid * 33;
            float gl[4];
#pragma unroll
            for (int j = 0; j < 4; ++j) gl[j] = lg[j] + a.in[17][l * 4 + j];
            int gi = 0; float gm = gl[0];
#pragma unroll
            for (int j = 1; j < 4; ++j) if (gl[j] > gm) { gm = gl[j]; gi = j; }
            float den = 0.f;
#pragma unroll
            for (int j = 0; j < 4; ++j) den += expf(gl[j] - gm);
            const float gp = 1.0f / den;
            float el[4];
#pragma unroll
            for (int j = 0; j < 4; ++j) el[j] = lg[4 + gi * 4 + j] + a.in[19][l * 16 + gi * 4 + j];
            int e1 = 0; float m1 = el[0];
#pragma unroll
            for (int j = 1; j < 4; ++j) if (el[j] > m1) { m1 = el[j]; e1 = j; }
            int e2 = -1; float m2 = 0.f;
#pragma unroll
            for (int j = 0; j < 4; ++j) if (j != e1 && (e2 < 0 || el[j] > m2)) { m2 = el[j]; e2 = j; }
            const float ex = expf(m2 - m1), w1 = 1.0f / (1.0f + ex), w2 = ex / (1.0f + ex);
            const int E1 = gi * 4 + e1, E2 = gi * 4 + e2;
            const unsigned p1 = __hip_atomic_fetch_add(cnt + E1, 1u, __ATOMIC_RELAXED, __HIP_MEMORY_SCOPE_AGENT);
            const unsigned p2 = __hip_atomic_fetch_add(cnt + E2, 1u, __ATOMIC_RELAXED, __HIP_MEMORY_SCOPE_AGENT);
            int* tk = (int*)(ws + WS_TOK); float* tw = (float*)(ws + WS_TOK) + 4 * NTOK;
            tk[row * 2] = E1; tk[row * 2 + 1] = E2; tk[2 * NTOK + row * 2] = (int)p1; tk[2 * NTOK + row * 2 + 1] = (int)p2;
            tw[row * 2] = gp * w1; tw[row * 2 + 1] = gp * w2;
        }
        __syncthreads();
    }
}

__device__ __forceinline__ int moe_offsets(const Args& a, int l, LAS int* off) {
    const unsigned* cnt = (const unsigned*)(a.ws + WS_CTL) + CW_CNT + l * 64;
    if (LTID == 0) { int o = 0; for (int e = 0; e < NEXP; ++e) { off[e] = o; const int c = (int)__hip_atomic_load(cnt + e, __ATOMIC_RELAXED, __HIP_MEMORY_SCOPE_AGENT); o += (c + 255) & ~255; } off[NEXP] = o; }
    __syncthreads();
    return off[NEXP] >> 8;
}
__device__ __forceinline__ void p7_gather(const Args& a, int l, LAS unsigned char* lds) {
    unsigned char* ws = launder_s(a.ws); LAS int* off = (LAS int*)lds;
    moe_offsets(a, l, off);
    const int tid = LTID, wid = tid >> 6, lane = tid & 63;
    const int* tk = (const int*)(ws + WS_TOK); const float* tw = (const float*)(ws + WS_TOK) + 4 * NTOK; int* trow = (int*)(ws + WS_TOK) + 6 * NTOK;
    const bf16_t* x1b = (const bf16_t*)(ws + WS_X1B); bf16_t* xs = (bf16_t*)(ws + WS_XS); float* roww = (float*)(ws + WS_ROWW);
    for (int p = LBID * 8 + wid; p < 2 * NTOK; p += gridDim.x * 8) {
        const int row = off[tk[p]] + tk[2 * NTOK + p];
        const u32x4* s = (const u32x4*)(x1b + (size_t)(p >> 1) * DM); u32x4* d = (u32x4*)(xs + (size_t)row * DM);
#pragma unroll
        for (int i = 0; i < 4; ++i) d[i * 64 + lane] = s[i * 64 + lane];
        if (lane == 0) { roww[row] = tw[p]; trow[p] = row; }
    }
}
struct MoeSched {
    LAS const int* te; int ntiles, ncol, G, c;
    __device__ __forceinline__ bool next(int i, pg8::Unit& u) const {
        const int L = i * G + c; if (L >= ntiles * ncol) return false;
        const int pm = L / ncol, pl = L % ncol; u.pm = pm; u.pn = te[pm] * ncol + pl; return true;
    }
    __device__ __forceinline__ void a_ready(const pg8::Unit&) const {}
    __device__ __forceinline__ void done(const pg8::Unit&) const {}
};
__device__ __forceinline__ int moe_tile_table(const Args& a, int l, LAS int* off, LAS int* te) {
    const int nt = moe_offsets(a, l, off);
    const int tid_ = LTID;
    if (tid_ < 128) { const int pm = tid_; if (pm < nt) { int e = 0; for (int k = 1; k < NEXP; ++k) if ((off[k] >> 8) <= pm) e = k; te[pm] = e; } }
    __syncthreads();
    return nt;
}
struct EpiGateUp {
    static constexpr bool PERM = true, AFTER_DRAIN = false;
    unsigned char* ws;
    __device__ __forceinline__ void operator()(const f32x4 (&acc)[2][2][4][2], const pg8::Unit& u, int wr, int wc, int fr, int fq) const {
        bf16_t* hm = (bf16_t*)(ws + WS_HM); const float* roww = (const float*)(ws + WS_ROWW);
        const int row0 = u.pm * 256 + wr * 64 + fr, col0 = (u.pn & 3) * 128 + wc * 32 + 8 * fq;
#pragma unroll
        for (int ai = 0; ai < 2; ++ai)
#pragma unroll
            for (int m = 0; m < 4; ++m) { const int row = row0 + ai * 128 + m * 16; const float rw = roww[row];
                float o[8];
#pragma unroll
                for (int n = 0; n < 2; ++n)
#pragma unroll
                    for (int e = 0; e < 4; ++e) { const float gt = acc[ai][0][m][n][e], up = acc[ai][1][m][n][e]; o[n * 4 + e] = gt * fast_sigmoid(gt) * up * rw; }
                u32x4 w = {cvtpk(o[0], o[1]), cvtpk(o[2], o[3]), cvtpk(o[4], o[5]), cvtpk(o[6], o[7])};
                *(u32x4*)(hm + (size_t)row * DEXP + col0) = w; }
    }
};
struct EpiDown {
    static constexpr bool PERM = true, AFTER_DRAIN = false;
    unsigned char* ws;
    __device__ __forceinline__ void operator()(const f32x4 (&acc)[2][2][4][2], const pg8::Unit& u, int wr, int wc, int fr, int fq) const {
        bf16_t* y = (bf16_t*)(ws + WS_Y);
        const int row0 = u.pm * 256 + wr * 64 + fr, col0 = (u.pn & 7) * 256 + wc * 32 + 8 * fq;
#pragma unroll
        for (int ai = 0; ai < 2; ++ai)
#pragma unroll
            for (int m = 0; m < 4; ++m) { bf16_t* rowp = y + (size_t)(row0 + ai * 128 + m * 16) * DM + col0;
#pragma unroll
                for (int bj = 0; bj < 2; ++bj) { const f32x4 v0 = acc[ai][bj][m][0], v1 = acc[ai][bj][m][1];
                    u32x4 w = {cvtpk(v0[0], v0[1]), cvtpk(v0[2], v0[3]), cvtpk(v1[0], v1[1]), cvtpk(v1[2], v1[3])};
                    *(u32x4*)(rowp + bj * 128) = w; } }
    }
};
__device__ __forceinline__ void p10_ln2(const Args& a, int l) {
    unsigned char* ws = launder_s(a.ws); const int tid = LTID, wid = tid >> 6, lane = tid & 63;
    const float* x1f = (const float*)(ws + WS_X1F); const bf16_t* y = (const bf16_t*)(ws + WS_Y); const int* trow = (const int*)(ws + WS_TOK) + 6 * NTOK;
    float* xo = (l == NL - 1) ? a.out : (float*)(ws + WS_XF); bf16_t* xb = (bf16_t*)(ws + WS_XB);
    const float* g = a.in[23] + (size_t)l * DM; const float* bta = a.in[24] + (size_t)l * DM;
    for (int row = LBID * 8 + wid; row < NTOK; row += gridDim.x * 8) {
        const bf16_t* y0 = y + (size_t)trow[row * 2] * DM; const bf16_t* y1 = y + (size_t)trow[row * 2 + 1] * DM;
        f32x4 v[8];
#pragma unroll
        for (int i = 0; i < 8; ++i) { const int cidx = i * 256 + lane * 4; const f32x4 xv = *(const f32x4*)(x1f + (size_t)row * DM + cidx);
            const u32x2 a0 = *(const u32x2*)(y0 + cidx), a1 = *(const u32x2*)(y1 + cidx);
            const f32x4 f0 = {__uint_as_float(a0.x << 16), __uint_as_float(a0.x & 0xffff0000u), __uint_as_float(a0.y << 16), __uint_as_float(a0.y & 0xffff0000u)};
            const f32x4 f1 = {__uint_as_float(a1.x << 16), __uint_as_float(a1.x & 0xffff0000u), __uint_as_float(a1.y << 16), __uint_as_float(a1.y & 0xffff0000u)};
            v[i] = xv * ALPHA + (f0 + f1); }
        ln_row(v, g, bta, lane);
#pragma unroll
        for (int i = 0; i < 8; ++i) { const int cidx = i * 256 + lane * 4; *(f32x4*)(xo + (size_t)row * DM + cidx) = v[i];
            u32x2 w; w.x = cvtpk(v[i][0], v[i][1]); w.y = cvtpk(v[i][2], v[i][3]); *(u32x2*)(xb + (size_t)row * DM + cidx) = w; }
    }
}

#if defined(DBG_STAGE)
__device__ __forceinline__ void dbg_accum(unsigned* ctl, int k, float err, float ref) {
    err = wave_sum(err); ref = wave_sum(ref);
    if ((threadIdx.x & 63) == 0) { atomicAdd((float*)(ctl + CW_DBG) + 2 * k, err); atomicAdd((float*)(ctl + CW_DBG) + 2 * k + 1, ref); }
}
__device__ __forceinline__ float ldbf(const bf16_t* p) { return bf2f(*p); }
__device__ __forceinline__ float gelu_ref(float x) { return 0.5f * x * (1.0f + tanhf(0.7978845608028654f * (x + 0.044715f * x * x * x))); }
__device__ __forceinline__ float sigm_ref(float x) { return 1.0f / (1.0f + expf(-x)); }

__device__ void dbg_inproj(const Args& a, unsigned* ctl) {
    unsigned char* ws = a.ws; const int tid = threadIdx.x; const int r = (blockIdx.x * 32 + 5) % NTOK;
    const float* x = a.in[0] + (size_t)r * DM; const float* w = a.in[1];
    float err = 0.f, ref = 0.f;
    for (int c = tid; c < IN_COLS; c += 512) {
        float s = 0.f; for (int k = 0; k < DM; ++k) s += x[k] * w[(size_t)k * IN_COLS + c];
        float rv, gv; bool skip = false;
        if (c < 1024) { rv = s; gv = ldbf((const bf16_t*)(ws + WS_QA) + (size_t)r * 1024 + c); }
        else if (c < 2560) { rv = s; gv = ldbf((const bf16_t*)(ws + WS_KV) + (size_t)r * 1536 + (c - 1024)); }
        else if (c < 2584) { rv = sigm_ref(s); gv = ((const float*)(ws + WS_SKF))[(size_t)r * 32 + (c - 2560)]; }
        else if (c < 3608) { rv = s; gv = ldbf((const bf16_t*)(ws + WS_QB) + (size_t)r * 1024 + (c - 2584)); }
        else if (c < 3864) { rv = s; gv = ldbf((const bf16_t*)(ws + WS_HC) + (size_t)r * 256 + (c - 3608)); }
        else if (c < 4120) { rv = s; gv = ldbf((const bf16_t*)(ws + WS_QI) + (size_t)r * 256 + (c - 3864)); }
        else if (c < 4184) { rv = s; gv = ldbf((const bf16_t*)(ws + WS_KI) + (size_t)r * 64 + (c - 4120)); }
        else if (c < 4188) { rv = s; gv = ((const float*)(ws + WS_SKF))[(size_t)r * 32 + 24 + (c - 4184)]; }
        else if (c < 5212) { rv = gelu_ref(s); gv = ldbf((const bf16_t*)(ws + WS_HU) + (size_t)r * 1024 + (c - 4188)); }
        else if (c < 6236) { skip = true; rv = gv = 0.f; }
        else { rv = sigm_ref(s); gv = ldbf((const bf16_t*)(ws + WS_HG) + (size_t)r * 6144 + (c - 6236)); }
        if (!skip) { err += (gv - rv) * (gv - rv); ref += rv * rv; }
    }
    dbg_accum(ctl, 5, err, ref);
}
__device__ void dbg_compress(const Args& a, unsigned* ctl, LAS unsigned char* lds) {
    unsigned char* ws = a.ws; const int tid = threadIdx.x; LAS float* sh = (LAS float*)lds;
    const int kv = blockIdx.x & 1; int R = ((blockIdx.x >> 1) * 8 + 3) % 1024; if ((R & 127) == 127) R -= 1;
    const int bh = R >> 7, i = R & 127, b = bh >> 1, hkv = bh & 1;
    const float* pe = a.in[4] + (size_t)kv * 4096; const float* w1 = a.in[2] + (size_t)kv * 4096 * 128; const float* w2 = a.in[3] + (size_t)kv * 128 * 128;
    const int n = tid & 127, q = tid >> 7; float s = 0.f;
    for (int k = q * 1024; k < (q + 1) * 1024; ++k) { const int l = k >> 7, d = k & 127;
        const float xv = ldbf((const bf16_t*)(ws + WS_KV) + ((size_t)b * SEQ + 16 * i + l) * 1536 + kv * 256 + hkv * 128 + d) + pe[k]; s += xv * w1[(size_t)k * 128 + n]; }
    sh[q * 128 + n] = s; __syncthreads();
    if (tid < 128) sh[512 + tid] = gelu_ref((sh[tid] + sh[128 + tid]) + (sh[256 + tid] + sh[384 + tid]));
    __syncthreads();
    float err = 0.f, ref = 0.f;
    if (tid < 128) { float o = 0.f; for (int j = 0; j < 128; ++j) o += sh[512 + j] * w2[j * 128 + tid];
        const float gv = ldbf((const bf16_t*)(ws + WS_KC) + ((size_t)kv * 1024 + R) * 128 + tid); err = (gv - o) * (gv - o); ref = o * o; }
    dbg_accum(ctl, 2, err, ref); __syncthreads();
}
__device__ void dbg_nsa(const Args& a, unsigned* ctl, LAS unsigned char* lds) {
    unsigned char* ws = a.ws; const int tid = threadIdx.x;
    const int b = blockIdx.x & 3, hkv = (blockIdx.x >> 2) & 1, t = (blockIdx.x * 131 + 77) % SEQ, cur = t >> 6;
    LAS float* P = (LAS float*)lds;
    LAS float* O = P + 4 * 2048;
    LAS float* IMPv = O + 512;
    LAS unsigned* SEL = (LAS unsigned*)(IMPv + 32);
    LAS float* Q = IMPv + 64;
    const size_t tok = (size_t)b * SEQ + t;
    { const int g = tid >> 7, d = tid & 127; Q[tid] = ldbf((const bf16_t*)(ws + WS_QA) + tok * 1024 + (hkv * 4 + g) * 128 + d); O[tid] = 0.f; }
    __syncthreads();
    const float scale = 0.08838834764831845f;
    const bf16_t* KC = (const bf16_t*)(ws + WS_KC) + (size_t)(b * 2 + hkv) * 128 * 128; const bf16_t* VC = KC + (size_t)8 * 128 * 128;
    const bf16_t* KVb = (const bf16_t*)(ws + WS_KV) + (size_t)b * SEQ * 1536 + hkv * 128;
    { const int g = tid >> 7, i = tid & 127; const float slope = exp2f(-(float)(hkv * 4 + g + 1)); float s = -INFINITY;
      if (i < 127 && t - (16 * i + 31) >= 0) { float d = 0.f; for (int k = 0; k < 128; ++k) d += Q[g * 128 + k] * ldbf(KC + i * 128 + k); s = d * scale - slope * (float)(t - (16 * i + 31)); }
      P[g * 2048 + i] = s; }
    __syncthreads();
    if (tid < 4) { float m = -INFINITY; for (int i = 0; i < 127; ++i) m = fmaxf(m, P[tid * 2048 + i]); float l = 0.f;
        for (int i = 0; i < 128; ++i) { const float e = (i < 127 && P[tid * 2048 + i] > -INFINITY) ? expf(P[tid * 2048 + i] - m) : 0.f; P[tid * 2048 + i] = e; l += e; }
        const float inv = l > 0.f ? 1.f / l : 0.f; for (int i = 0; i < 128; ++i) P[tid * 2048 + i] *= inv; }
    __syncthreads();
    { const int g = tid >> 7, d = tid & 127; float o = 0.f; for (int i = 0; i < 127; ++i) o += P[g * 2048 + i] * ldbf(VC + i * 128 + d);
      O[tid] += ((const float*)(ws + WS_SKF))[tok * 32 + (hkv * 4 + g) * 3 + 0] * o; }
    if (tid < 32) { float v = 0.f; for (int g = 0; g < 4; ++g) for (int i = 4 * tid - 1; i <= 4 * tid + 3; ++i) if (i >= 0 && i < 127) v += P[g * 2048 + i]; IMPv[tid] = v; }
    __syncthreads();
    if (tid < 32) { const int j = tid; const bool forced = (j == 0) || (j == cur) || (j == cur - 1); IMPv[j] = (j <= cur) ? IMPv[j] + (forced ? 1e4f : 0.f) : -1e30f; }
    __syncthreads();
    if (tid == 0) {
        unsigned sel = 0; for (int n = 0; n < 16; ++n) { int bj = -1; float bv = 0.f; for (int j = 0; j < 32; ++j) { const float vj = IMPv[j]; if (!((sel >> j) & 1u) && (bj < 0 || vj > bv)) { bj = j; bv = vj; } } sel |= 1u << bj; }
        SEL[0] = sel; }
    __syncthreads();
    const unsigned sel = SEL[0];
    for (int br = 1; br <= 2; ++br) {
        const bf16_t* Kp = KVb + (br == 1 ? 512 : 1024); const bf16_t* Vp = KVb + (br == 1 ? 768 : 1280);
        for (int idx = tid; idx < 4 * 2048; idx += 512) { const int g = idx >> 11, s = idx & 2047; const float slope = exp2f(-(float)(hkv * 4 + g + 1));
            const bool ok = (s <= t) && (br == 1 ? ((sel >> (s >> 6)) & 1u) : (t - s < 512)); float sc = -INFINITY;
            if (ok) { float d = 0.f; for (int k = 0; k < 128; ++k) d += Q[g * 128 + k] * ldbf(Kp + (size_t)s * 1536 + k); sc = d * scale - slope * (float)(t - s); }
            P[idx] = sc; }
        __syncthreads();
        if (tid < 4) { float m = -INFINITY; for (int s = 0; s < 2048; ++s) m = fmaxf(m, P[tid * 2048 + s]); float l = 0.f;
            for (int s = 0; s < 2048; ++s) { const float e = P[tid * 2048 + s] > -INFINITY ? expf(P[tid * 2048 + s] - m) : 0.f; P[tid * 2048 + s] = e; l += e; }
            const float inv = l > 0.f ? 1.f / l : 0.f; for (int s = 0; s < 2048; ++s) P[tid * 2048 + s] *= inv; }
        __syncthreads();
        { const int g = tid >> 7, d = tid & 127; float o = 0.f; for (int s = 0; s <= t; ++s) { const float p = P[g * 2048 + s]; if (p != 0.f) o += p * ldbf(Vp + (size_t)s * 1536 + d); }
          O[tid] += ((const float*)(ws + WS_SKF))[tok * 32 + (hkv * 4 + g) * 3 + br] * o; }
        __syncthreads();
    }
    { const int g = tid >> 7, d = tid & 127; const float rv = O[tid], gv = ldbf((const bf16_t*)(ws + WS_BR) + tok * 1024 + (hkv * 4 + g) * 128 + d);
      dbg_accum(ctl, 1, (gv - rv) * (gv - rv), rv * rv); }
    __syncthreads();
}
__device__ void dbg_dsa(const Args& a, unsigned* ctl, LAS unsigned char* lds) {
    unsigned char* ws = a.ws; const int tid = threadIdx.x;
    const int b = blockIdx.x & 3, t = (blockIdx.x * 197 + 301) % SEQ; const size_t tok = (size_t)b * SEQ + t;
    LAS float* LG = (LAS float*)lds;
    LAS float* SC = LG + 8 * 2048;
    LAS float* QL = SC + 2048;
    LAS float* OL = QL + 2048;
    LAS unsigned char* SL = (LAS unsigned char*)(OL + 2048);
    const bf16_t* HC = (const bf16_t*)(ws + WS_HC) + (size_t)b * SEQ * 256; const float* PSQ = (const float*)(ws + WS_PSQ) + (size_t)b * SEQ * 4;
    const float* gk = a.in[7];
    for (int s = tid; s < 2048; s += 512) { float sc = -INFINITY;
        if (s <= t) { sc = 0.f; for (int h = 0; h < 4; ++h) { float d = 0.f; for (int k = 0; k < 64; ++k) d += ldbf((const bf16_t*)(ws + WS_QI) + tok * 256 + h * 64 + k) * ldbf((const bf16_t*)(ws + WS_KI) + ((size_t)b * SEQ + s) * 64 + k);
            sc += fmaxf(d, 0.f) * ((const float*)(ws + WS_SKF))[tok * 32 + 24 + h]; } }
        SC[s] = sc; }
    for (int idx = tid; idx < 2048; idx += 512) { const int h = idx >> 8, c = idx & 255; float s = 0.f;
        for (int d = 0; d < 128; ++d) s += ldbf((const bf16_t*)(ws + WS_QB) + tok * 1024 + h * 128 + d) * a.in[5][((size_t)h * 256 + c) * 128 + d];
        QL[idx] = s * 0.08838834764831845f; }
    __syncthreads();
    for (int s = tid; s < 2048; s += 512) { bool selv = false;
        if (s <= t) { if (t + 1 <= 256) selv = true; else { int rank = 0; const float v = SC[s]; for (int s2 = 0; s2 <= t; ++s2) { const float v2 = SC[s2]; rank += (v2 > v || (v2 == v && s2 < s)) ? 1 : 0; } selv = rank < 256; } }
        SL[s] = selv ? 1 : 0; }
    __syncthreads();
    for (int idx = tid; idx < 8 * 2048; idx += 512) { const int h = idx >> 11, s = idx & 2047; float lg = -INFINITY;
        if (SL[s]) { const f32x4 q4 = *(const f32x4*)(PSQ + (size_t)s * 4); const float rs = 1.0f / sqrtf(((q4[0] + q4[1]) + (q4[2] + q4[3])) / 256.f + LN_EPS);
            float d = 0.f; for (int c = 0; c < 256; ++c) d += QL[h * 256 + c] * (ldbf(HC + (size_t)s * 256 + c) * rs * gk[c]); lg = d - exp2f(-(float)(h + 1)) * (float)(t - s); }
        LG[idx] = lg; }
    __syncthreads();
    if (tid < 8) { float m = -INFINITY; for (int s = 0; s < 2048; ++s) m = fmaxf(m, LG[tid * 2048 + s]); float l = 0.f;
        for (int s = 0; s < 2048; ++s) { const float e = LG[tid * 2048 + s] > -INFINITY ? expf(LG[tid * 2048 + s] - m) : 0.f; LG[tid * 2048 + s] = e; l += e; }
        const float inv = l > 0.f ? 1.f / l : 0.f; for (int s = 0; s < 2048; ++s) LG[tid * 2048 + s] *= inv; }
    __syncthreads();
    for (int idx = tid; idx < 2048; idx += 512) { const int h = idx >> 8, c = idx & 255; float o = 0.f;
        for (int s = 0; s <= t; ++s) { const float p = LG[h * 2048 + s]; if (p != 0.f) { const f32x4 q4 = *(const f32x4*)(PSQ + (size_t)s * 4); const float rs = 1.0f / sqrtf(((q4[0] + q4[1]) + (q4[2] + q4[3])) / 256.f + LN_EPS);
            o += p * ldbf(HC + (size_t)s * 256 + c) * rs * gk[c]; } }
        OL[idx] = o; }
    __syncthreads();
    float err = 0.f, ref = 0.f;
    for (int idx = tid; idx < 1024; idx += 512) { const int h = idx >> 7, d = idx & 127; float o = 0.f; for (int c = 0; c < 256; ++c) o += OL[h * 256 + c] * a.in[6][((size_t)h * 256 + c) * 128 + d];
        const float gv = ldbf((const bf16_t*)(ws + WS_BR) + (size_t)NTOK * 1024 + tok * 1024 + idx); err += (gv - o) * (gv - o); ref += o * o; }
    dbg_accum(ctl, 3, err, ref); __syncthreads();
}
__device__ void dbg_gmlp(const Args& a, unsigned* ctl) {
    unsigned char* ws = a.ws; const int tid = threadIdx.x;
    const int b = blockIdx.x & 3, t = (blockIdx.x * 89 + 40) % SEQ, ch = t >> 7, tl = t & 127; const size_t tok = (size_t)b * SEQ + t;
    float err = 0.f, ref = 0.f;
    for (int c = tid; c < 1024; c += 512) { const int g = c >> 7; float m = a.in[11][g * 128 + tl];
        for (int s = 0; s <= tl; ++s) m += a.in[10][((size_t)g * 128 + tl) * 128 + s] * ldbf((const bf16_t*)(ws + WS_HV) + ((size_t)b * SEQ + ch * 128 + s) * 1024 + c);
        const float rv = m * ldbf((const bf16_t*)(ws + WS_HU) + tok * 1024 + c), gv = ldbf((const bf16_t*)(ws + WS_BR) + (size_t)2 * NTOK * 1024 + tok * 1024 + c);
        err += (gv - rv) * (gv - rv); ref += rv * rv; }
    dbg_accum(ctl, 4, err, ref);
}
__device__ void dbg_merge(const Args& a, unsigned* ctl, LAS unsigned char* lds) {
    unsigned char* ws = a.ws; const int tid = threadIdx.x; const int r = (blockIdx.x * 32 + 9) % NTOK; LAS float* MP = (LAS float*)lds;
    for (int d = tid; d < DM; d += 512) { float acc = 0.f;
        for (int n = 0; n < 3; ++n) { float y = 0.f; const bf16_t* br = (const bf16_t*)(ws + WS_BR) + (size_t)n * NTOK * 1024 + (size_t)r * 1024; const float* wb = a.in[12] + (size_t)n * 1024 * 2048;
            for (int w = 0; w < 1024; ++w) y += ldbf(br + w) * wb[(size_t)w * 2048 + d];
            acc += ldbf((const bf16_t*)(ws + WS_HG) + (size_t)r * 6144 + n * 2048 + d) * y; }
        MP[d] = acc; }
    __syncthreads();
    float err = 0.f, ref = 0.f;
    for (int d = tid; d < DM; d += 512) { float s = 0.f; for (int k = 0; k < DM; ++k) s += MP[k] * a.in[13][(size_t)k * 2048 + d];
        const float rv = ALPHA * a.in[0][(size_t)r * DM + d] + s, gv = ((const float*)(ws + WS_MIXT))[(size_t)r * DM + d]; err += (gv - rv) * (gv - rv); ref += rv * rv; }
    dbg_accum(ctl, 6, err, ref); __syncthreads();
}
__device__ void dbg_moe(const Args& a, unsigned* ctl, LAS unsigned char* lds) {
    unsigned char* ws = a.ws; const int tid = threadIdx.x; const int r = (blockIdx.x * 32 + 17) % NTOK;
    LAS float* X1 = (LAS float*)lds; LAS float* RED = X1 + 2048; LAS float* HH = RED + 1024; LAS float* YY = HH + 1024; LAS float* LOG = YY + 2048;
    const float* pre = (const float*)(ws + WS_MIXT) + (size_t)r * DM;
    float s = 0.f; for (int d = tid; d < DM; d += 512) s += pre[d]; RED[tid] = s; __syncthreads();
    if (tid == 0) { float m = 0.f; for (int i = 0; i < 512; ++i) m += RED[i]; RED[512] = m / DM; } __syncthreads();
    const float mean = RED[512]; __syncthreads();
    s = 0.f; for (int d = tid; d < DM; d += 512) s += (pre[d] - mean) * (pre[d] - mean); RED[tid] = s; __syncthreads();
    if (tid == 0) { float m = 0.f; for (int i = 0; i < 512; ++i) m += RED[i]; RED[513] = 1.0f / sqrtf(m / DM + LN_EPS); } __syncthreads();
    const float rstd = RED[513];
    for (int d = tid; d < DM; d += 512) X1[d] = (pre[d] - mean) * rstd * a.in[14][d] + a.in[15][d];
    __syncthreads();
    if (tid < 20) { float lg = 0.f; if (tid < 4) { for (int k = 0; k < DM; ++k) lg += X1[k] * a.in[16][(size_t)k * 4 + tid]; lg += a.in[17][tid]; } else { for (int k = 0; k < DM; ++k) lg += X1[k] * a.in[18][(size_t)k * 16 + (tid - 4)]; lg += a.in[19][tid - 4]; } LOG[tid] = lg; }
    __syncthreads();
    int gi = 0; for (int j = 1; j < 4; ++j) if (LOG[j] > LOG[gi]) gi = j;
    float den = 0.f; for (int j = 0; j < 4; ++j) den += expf(LOG[j] - LOG[gi]); const float gp = 1.f / den;
    int e1 = 0; for (int j = 1; j < 4; ++j) if (LOG[4 + gi * 4 + j] > LOG[4 + gi * 4 + e1]) e1 = j;
    int e2 = -1; for (int j = 0; j < 4; ++j) if (j != e1 && (e2 < 0 || LOG[4 + gi * 4 + j] > LOG[4 + gi * 4 + e2])) e2 = j;
    const float ex = expf(LOG[4 + gi * 4 + e2] - LOG[4 + gi * 4 + e1]); const float wv0 = gp / (1.f + ex), wv1 = gp * ex / (1.f + ex); const int ev0 = gi * 4 + e1, ev1 = gi * 4 + e2;
    for (int q = 0; q < 2; ++q) { const int e = q ? ev1 : ev0; const float* wg = a.in[20] + (size_t)e * 2048 * 512; const float* wu = a.in[21] + (size_t)e * 2048 * 512;
        float g = 0.f, u = 0.f; for (int k = 0; k < DM; ++k) { g += X1[k] * wg[(size_t)k * 512 + tid]; u += X1[k] * wu[(size_t)k * 512 + tid]; }
        HH[q * 512 + tid] = g / (1.f + expf(-g)) * u * (q ? wv1 : wv0); }
    __syncthreads();
    for (int d = tid; d < DM; d += 512) { float y = 0.f; for (int q = 0; q < 2; ++q) { const float* wd = a.in[22] + (size_t)(q ? ev1 : ev0) * 512 * 2048; for (int f = 0; f < 512; ++f) y += HH[q * 512 + f] * wd[(size_t)f * 2048 + d]; } YY[d] = ALPHA * X1[d] + y; }
    __syncthreads();
    s = 0.f; for (int d = tid; d < DM; d += 512) s += YY[d]; RED[tid] = s; __syncthreads();
    if (tid == 0) { float m = 0.f; for (int i = 0; i < 512; ++i) m += RED[i]; RED[514] = m / DM; } __syncthreads();
    const float mean2 = RED[514]; __syncthreads();
    s = 0.f; for (int d = tid; d < DM; d += 512) s += (YY[d] - mean2) * (YY[d] - mean2); RED[tid] = s; __syncthreads();
    if (tid == 0) { float m = 0.f; for (int i = 0; i < 512; ++i) m += RED[i]; RED[515] = 1.0f / sqrtf(m / DM + LN_EPS); } __syncthreads();
    const float rstd2 = RED[515];
    float err = 0.f, ref = 0.f;
    const int* trow = (const int*)(ws + WS_TOK) + 6 * NTOK; const bf16_t* Y = (const bf16_t*)(ws + WS_Y);
    for (int d = tid; d < DM; d += 512) {
#if DBG_STAGE == 8
        const float rv = (YY[d] - mean2) * rstd2 * a.in[23][d] + a.in[24][d], gv = ((const float*)(ws + WS_XF))[(size_t)r * DM + d];
#else
        const float rv = YY[d] - ALPHA * X1[d], gv = ldbf(Y + (size_t)trow[r * 2] * DM + d) + ldbf(Y + (size_t)trow[r * 2 + 1] * DM + d);
#endif
        err += (gv - rv) * (gv - rv); ref += rv * rv; }
    dbg_accum(ctl, 7, err, ref); __syncthreads();
}
__device__ void dbg_checks(const Args& a, unsigned* ctl, LAS unsigned char* lds) {
#if DBG_STAGE == 5
    dbg_inproj(a, ctl);
#elif DBG_STAGE == 2
    dbg_compress(a, ctl, lds);
#elif DBG_STAGE == 1
    dbg_nsa(a, ctl, lds);
#elif DBG_STAGE == 3
    dbg_dsa(a, ctl, lds);
#elif DBG_STAGE == 4
    dbg_gmlp(a, ctl);
#elif DBG_STAGE == 6
    dbg_merge(a, ctl, lds);
#else
    dbg_moe(a, ctl, lds);
#endif
}
__device__ void dbg_scale_output(const Args& a, unsigned* ctl) {
    const int k = (DBG_STAGE == 8) ? 7 : DBG_STAGE;
    const float err = __hip_atomic_load((float*)(ctl + CW_DBG) + 2 * k, __ATOMIC_RELAXED, __HIP_MEMORY_SCOPE_AGENT), ref = __hip_atomic_load((float*)(ctl + CW_DBG) + 2 * k + 1, __ATOMIC_RELAXED, __HIP_MEMORY_SCOPE_AGENT);
    const float E = ref > 0.f ? sqrtf(err / ref) : 1.0f; const float f = 1.0f + 3.0f * fminf(E, 1.0f);
    for (size_t i = (size_t)blockIdx.x * 512 + threadIdx.x; i < (size_t)NTOK * DM; i += (size_t)gridDim.x * 512) a.out[i] *= f;
}
#endif

struct ItemTable { unsigned short v[768]; };
constexpr int item_cost(int type, int idx) {
    if (type == 0) { const int qb = idx & 31; return 4 + qb + ((qb + 1) < 9 ? (qb + 1) : 9); }
    if (type == 1) { const int qb = idx & 7; return 4 * (qb + 1) + 1; }
    return 1;
}
constexpr ItemTable make_items() {
    ItemTable t{}; int pos = 0;
    for (int cst = 64; cst >= 0; --cst) for (int id = 0; id < 768; ++id) { const int type = id >> 8, idx = id & 255; if (item_cost(type, idx) == cst) t.v[pos++] = (unsigned short)((type << 12) | idx); }
    return t;
}
__device__ const ItemTable g_items = make_items();

constexpr int N_PHASES = 1 + NL * 10;
#ifndef PH_MASK
#define PH_MASK 0x7ff
#endif
#define PH_ON(k) (((PH_MASK) >> (k)) & 1)
__global__ void __launch_bounds__(512, 2) mk_fwd(Args a) {
    extern __shared__ __attribute__((aligned(16))) unsigned char lds_raw[];
    LAS unsigned char* lds = (LAS unsigned char*)lds_raw;
    unsigned char* ws0 = a.ws;
    unsigned* ctl = (unsigned*)(ws0 + WS_CTL);
    const int tid = threadIdx.x, G = gridDim.x, wg = blockIdx.x;
#if MK_SINGLE
    if (tid < 4) ((LAS unsigned*)(lds + LDS_BYTES - 16))[tid] = 0u;
    __syncthreads();
    XcdBarrier bar = xcd_barrier_post(ctl + CW_BAR, (volatile LAS unsigned*)(lds + LDS_BYTES - 16));
#define GRID_BAR() do { XcdBarrier bb_ = bar; bb_.bar = launder_s(bb_.bar); bb_.x = bar.x + opaque_zero(); xcd_barrier(bb_); } while (0)
#else
#define GRID_BAR() do { } while (0)
#endif
#if MK_SINGLE
#define IN(k) true
#else
    const int lo = a.ph_lo, hi = a.ph_hi;
#define IN(k) (lo <= (k) && (k) < hi)
#endif
#define SEAM(k) do { if (IN(k) && IN((k) + 1)) GRID_BAR(); } while (0)

    if (PH_ON(10) && IN(0)) { p0_prologue(a, lds); }
    SEAM(0);
    for (int l = 0; l < NL; ++l) {
        const int p = 1 + l * 10;
        unsigned char* ws = launder_s(ws0);
        if (PH_ON(0) && IN(p + 0)) { ws = launder_s(ws);
            skinny_item(a, l, lds);
            pg8::Gemm g{(const bf16_t*)(ws + WS_XB), (const bf16_t*)(ws + WS_WIN) + (size_t)l * NMAIN * DM, NTOK, NMAIN, DM};
            pg8::StaticOrder S; S.init(NTOK, NMAIN, G, wg); EpiInProj E{ws};
            pg8::gemm_phase<EpiInProj, pg8::StaticOrder, false>(lds, g, S, E, nullptr);
        }
        SEAM(p + 0);
        if (PH_ON(1) && IN(p + 1)) { ws = launder_s(ws);
            const int subm = a.sub;
            if (subm & 1) { pg8::Gemm g{(const bf16_t*)(ws + WS_HC), (const bf16_t*)(ws + WS_WKVUP) + (size_t)l * 2048 * 256, NTOK, 2048, 256};
              pg8::StaticOrder S; S.init(NTOK, 2048, G, wg); EpiKvUp E{ws};
              pg8::gemm_phase<EpiKvUp, pg8::StaticOrder, false>(lds, g, S, E, nullptr); }
            if (subm & 2) gmlp_ln_rows(a, l);
            if (subm & 4) for (int it = wg; it < 64; it += G) compress_item(a, l, lds, it);
            if (subm & 8) for (int it = wg; it < 256; it += G) { indexer_item(a, lds, it); indexer_item(a, lds, 511 - it); }
        }
        SEAM(p + 1);
        if (PH_ON(2) && IN(p + 2)) { ws = launder_s(ws);
            LAS unsigned* slot = (LAS unsigned*)(lds + att::L_MISC); const int tq = LTID;
            for (;;) {
                if (tq == 0) slot[0] = __hip_atomic_fetch_add(ctl + CW_Q + (l * 2 + a.rep) * 64, 1u, __ATOMIC_RELAXED, __HIP_MEMORY_SCOPE_AGENT);
                __syncthreads();
                const unsigned qi = slot[0];
                __syncthreads();
                if (qi >= 768u) break;
                const unsigned it = g_items.v[qi]; const int type = it >> 12, idx = it & 255;
                if (type == 0) att::nsa_item(a, lds, idx >> 6, (idx >> 5) & 1, idx & 31);
                else if (type == 1) att::dsa_item(a, lds, idx >> 6, (idx >> 3) & 7, idx & 7);
                else att::gmlp_item(a, lds, l, idx >> 6, (idx >> 2) & 15, idx & 3);
            }
        }
        SEAM(p + 2);
        if (PH_ON(3) && IN(p + 3)) { ws = launder_s(ws);
            pg8::StaticOrder S; S.init(NTOK, DM, G, wg);
            { pg8::Gemm g{(const bf16_t*)(ws + WS_BR), (const bf16_t*)(ws + WS_WB) + ((size_t)l * 3 + 0) * 2048 * 1024, NTOK, DM, 1024}; EpiBranch<0> E{ws}; pg8::gemm_phase<EpiBranch<0>, pg8::StaticOrder, false>(lds, g, S, E, nullptr); }
            { pg8::Gemm g{(const bf16_t*)(ws + WS_BR) + (size_t)NTOK * 1024, (const bf16_t*)(ws + WS_WB) + ((size_t)l * 3 + 1) * 2048 * 1024, NTOK, DM, 1024}; EpiBranch<1> E{ws}; pg8::gemm_phase<EpiBranch<1>, pg8::StaticOrder, false>(lds, g, S, E, nullptr); }
            { pg8::Gemm g{(const bf16_t*)(ws + WS_BR) + (size_t)2 * NTOK * 1024, (const bf16_t*)(ws + WS_WB) + ((size_t)l * 3 + 2) * 2048 * 1024, NTOK, DM, 1024}; EpiBranch<2> E{ws}; pg8::gemm_phase<EpiBranch<2>, pg8::StaticOrder, false>(lds, g, S, E, nullptr); }
        }
        SEAM(p + 3);
        if (PH_ON(4) && IN(p + 4)) { ws = launder_s(ws);
            pg8::Gemm g{(const bf16_t*)(ws + WS_MIXB), (const bf16_t*)(ws + WS_WO) + (size_t)l * DM * DM, NTOK, DM, DM};
            pg8::StaticOrder S; S.init(NTOK, DM, G, wg); EpiOut E{l == 0 ? a.in[0] : (const float*)(ws + WS_XF), (float*)(ws + WS_MIXT)};
            pg8::gemm_phase<EpiOut, pg8::StaticOrder, false>(lds, g, S, E, nullptr);
        }
        SEAM(p + 4);
        if (PH_ON(5) && IN(p + 5)) p6_ln1_route(a, l, lds);
        SEAM(p + 5);
        if (PH_ON(6) && IN(p + 6)) p7_gather(a, l, lds);
        SEAM(p + 6);
        if (PH_ON(7) && IN(p + 7)) { ws = launder_s(ws);
            LAS int* off = (LAS int*)(lds + 131072); LAS int* te = off + 32;
            const int nt = moe_tile_table(a, l, off, te);
            pg8::Gemm g{(const bf16_t*)(ws + WS_XS), (const bf16_t*)(ws + WS_WGU) + (size_t)l * 16 * 1024 * 2048, 0, 0, DM};
            MoeSched S{te, nt, 4, G, wg}; EpiGateUp E{ws};
            pg8::gemm_phase<EpiGateUp, MoeSched, false>(lds, g, S, E, nullptr);
        }
        SEAM(p + 7);
        if (PH_ON(8) && IN(p + 8)) { ws = launder_s(ws);
            LAS int* off = (LAS int*)(lds + 131072); LAS int* te = off + 32;
            const int nt = moe_tile_table(a, l, off, te);
            pg8::Gemm g{(const bf16_t*)(ws + WS_HM), (const bf16_t*)(ws + WS_WD) + (size_t)l * 16 * 2048 * 512, 0, 0, DEXP};
            MoeSched S{te, nt, 8, G, wg}; EpiDown E{ws};
            pg8::gemm_phase<EpiDown, MoeSched, false>(lds, g, S, E, nullptr);
        }
        SEAM(p + 8);
        if (PH_ON(9) && IN(p + 9)) p10_ln2(a, l);
        SEAM(p + 9);
    }
#undef IN
#undef SEAM
}

#if defined(DBG_STAGE)
__global__ void __launch_bounds__(512, 2) dbg_k(Args a, int what) {
    extern __shared__ __attribute__((aligned(16))) unsigned char lds_raw[];
    LAS unsigned char* lds = (LAS unsigned char*)lds_raw; unsigned* ctl = (unsigned*)(a.ws + WS_CTL);
    if (what == 0) dbg_checks(a, ctl, lds); else dbg_scale_output(a, ctl);
}
#endif
extern "C" void kernel_launch(void* const* d_in, const int* in_sizes, int n_in, void* d_out, int out_size, void* d_ws, size_t ws_size, hipStream_t stream) {
    static int grid = 0;
    if (grid == 0) {
        if (n_in != 25 || out_size != NTOK * DM || ws_size < WS_END) { fprintf(stderr, "kernel_launch: expected 25 inputs, out %d, ws >= %zu; got n_in %d out %d ws %zu\n", NTOK * DM, (size_t)WS_END, n_in, out_size, ws_size); grid = -1; return; }
        int dev = 0, cus = 0, per_cu = 0;
        if (hipGetDevice(&dev) != hipSuccess || hipDeviceGetAttribute(&cus, hipDeviceAttributeMultiprocessorCount, dev) != hipSuccess) { fprintf(stderr, "kernel_launch: device query failed\n"); grid = -1; return; }
#if defined(DBG_STAGE)
        (void)hipFuncSetAttribute((const void*)dbg_k, hipFuncAttributeMaxDynamicSharedMemorySize, LDS_BYTES);
#endif
        if (hipFuncSetAttribute((const void*)mk_fwd, hipFuncAttributeMaxDynamicSharedMemorySize, LDS_BYTES) != hipSuccess) { fprintf(stderr, "kernel_launch: hipFuncSetAttribute failed\n"); grid = -1; return; }
        if (hipOccupancyMaxActiveBlocksPerMultiprocessor(&per_cu, (const void*)mk_fwd, 512, LDS_BYTES) != hipSuccess || per_cu < 1) fprintf(stderr, "kernel_launch: occupancy query reports %d blocks per CU\n", per_cu);
        (void)hipGetLastError();
        grid = cus;
    }
    if (grid < 0) return;
    (void)hipMemsetAsync((char*)d_ws + WS_CTL, 0, CTL_BYTES, stream);
    Args a{};
    for (int i = 0; i < 25; ++i) a.in[i] = (const float*)d_in[i];
    a.out = (float*)d_out; a.ws = (unsigned char*)d_ws; a.rep = 0; a.sub = 0xff;
#if MK_SINGLE
    a.ph_lo = 0; a.ph_hi = N_PHASES;
    hipLaunchKernelGGL(mk_fwd, dim3(grid), dim3(512), LDS_BYTES, stream, a);
#else
    for (int p = 0; p < N_PHASES; ++p) { a.ph_lo = p; a.ph_hi = p + 1; hipLaunchKernelGGL(mk_fwd, dim3(grid), dim3(512), LDS_BYTES, stream, a);
#if defined(PROBE_DOUBLE)
        { const int k = p == 0 ? 10 : (p - 1) % 10; if ((PROBE_DOUBLE >> k) & 1) { a.rep = 1;
#if defined(PROBE_SUB)
            a.sub = PROBE_SUB;
#endif
            hipLaunchKernelGGL(mk_fwd, dim3(grid), dim3(512), LDS_BYTES, stream, a); a.rep = 0; a.sub = 0xff; } }
#endif
#if defined(DBG_STAGE)
        if (p == 10) hipLaunchKernelGGL(dbg_k, dim3(grid), dim3(512), LDS_BYTES, stream, a, 0);
        if (p == N_PHASES - 1) hipLaunchKernelGGL(dbg_k, dim3(grid), dim3(512), LDS_BYTES, stream, a, 1);
#endif
    }
#endif
    const hipError_t le = hipPeekAtLastError();
    if (le != hipSuccess) fprintf(stderr, "kernel_launch: launch failed: %s\n", hipGetErrorName(le));
}
```

```cpp
#include <hip/hip_runtime.h>
#include <cstdio>
#include <cstdint>

#ifndef MK_SINGLE
#define MK_SINGLE 1
#endif

constexpr int NB = 4, SEQ = 2048, DM = 2048, NL = 4, NTOK = NB * SEQ;
constexpr int IN_COLS = 12380, NMAIN = 12288, NSK = 128;
constexpr int NEXP = 16, DEXP = 512, MOE_ROWS = 2 * NTOK + NEXP * 256;
constexpr float LN_EPS = 1e-5f;
constexpr float ALPHA = 1.681792830507429f;
constexpr float LOG2E = 1.4426950408889634f;
constexpr float ATT_C2 = 0.08838834764831845f * LOG2E;
constexpr int LDS_BYTES = 147456;

typedef unsigned short bf16_t;
typedef short bf16x8 __attribute__((ext_vector_type(8)));
typedef short s16x4 __attribute__((ext_vector_type(4)));
typedef float f32x16 __attribute__((ext_vector_type(16)));
typedef float f32x4 __attribute__((ext_vector_type(4)));
typedef float f32x2 __attribute__((ext_vector_type(2)));
typedef unsigned u32x4 __attribute__((ext_vector_type(4)));
typedef unsigned u32x2 __attribute__((ext_vector_type(2)));

constexpr size_t al256(size_t x) { return (x + 255) & ~(size_t)255; }
constexpr size_t WS_CTL    = 0;
constexpr size_t CTL_BYTES = 65536;
constexpr size_t WS_WIN    = WS_CTL + CTL_BYTES;
constexpr size_t WS_WSK    = WS_WIN  + (size_t)NL * NMAIN * DM * 2;
constexpr size_t WS_W1     = WS_WSK  + (size_t)NL * NSK * DM * 2;
constexpr size_t WS_W2     = WS_W1   + (size_t)NL * 2 * 128 * 4096 * 2;
constexpr size_t WS_C1     = WS_W2   + (size_t)NL * 2 * 128 * 128 * 2;
constexpr size_t WS_WKVUP  = WS_C1   + (size_t)NL * 2 * 16 * 128 * 4;
constexpr size_t WS_WSTRIL = WS_WKVUP + (size_t)NL * 2048 * 256 * 2;
constexpr size_t WS_WB     = WS_WSTRIL + (size_t)NL * 8 * 128 * 128 * 2;
constexpr size_t WS_WO     = WS_WB   + (size_t)NL * 3 * 2048 * 1024 * 2;
constexpr size_t WS_WR     = WS_WO   + (size_t)NL * 2048 * 2048 * 2;
constexpr size_t WS_WGU    = WS_WR   + (size_t)NL * 2 * 32 * 2048 * 2;
constexpr size_t WS_WD     = WS_WGU  + (size_t)NL * 16 * 1024 * 2048 * 2;
constexpr size_t WS_XF     = WS_WD   + (size_t)NL * 16 * 2048 * 512 * 2;
constexpr size_t WS_XB     = WS_XF   + (size_t)NTOK * DM * 4;
constexpr size_t WS_SKF    = WS_XB   + (size_t)NTOK * DM * 2;
constexpr size_t WS_KI     = WS_SKF  + (size_t)NTOK * 32 * 4;
constexpr size_t WS_QA     = WS_KI   + (size_t)NTOK * 64 * 2;
constexpr size_t WS_KV     = WS_QA   + (size_t)NTOK * 1024 * 2;
constexpr size_t WS_QB     = WS_KV   + (size_t)NTOK * 1536 * 2;
constexpr size_t WS_HC     = WS_QB   + (size_t)NTOK * 1024 * 2;
constexpr size_t WS_PSQ    = WS_HC   + (size_t)NTOK * 256 * 2;
constexpr size_t WS_QI     = WS_PSQ  + (size_t)NTOK * 4 * 4;
constexpr size_t WS_HU     = WS_QI   + (size_t)NTOK * 256 * 2;
constexpr size_t WS_HV     = WS_HU   + (size_t)NTOK * 1024 * 2;
constexpr size_t WS_HG     = WS_HV   + (size_t)NTOK * 1024 * 2;
constexpr size_t WS_KVUP   = WS_HG   + (size_t)NTOK * 6144 * 2;
constexpr size_t WS_KC     = WS_KVUP + (size_t)NTOK * 2048 * 2;
constexpr size_t WS_MASK   = WS_KC   + (size_t)2 * 8 * 128 * 128 * 2;
constexpr size_t WS_BR     = WS_MASK + (size_t)NTOK * 32 * 8;
constexpr size_t WS_TT     = WS_BR   + (size_t)3 * NTOK * 1024 * 2;
constexpr size_t WS_MIXT   = WS_TT   + (size_t)256 * 64 * 512 * 4;
constexpr size_t WS_MIXB   = WS_MIXT + (size_t)NTOK * DM * 4;
constexpr size_t WS_X1F    = WS_MIXB + (size_t)NTOK * DM * 2;
constexpr size_t WS_X1B    = WS_X1F  + (size_t)NTOK * DM * 4;
constexpr size_t WS_TOK    = WS_X1B  + (size_t)NTOK * DM * 2;
constexpr size_t WS_ROWW   = WS_TOK  + (size_t)NTOK * 2 * 4 * 4;
constexpr size_t WS_XS     = WS_ROWW + (size_t)MOE_ROWS * 4;
constexpr size_t WS_HM     = WS_XS   + (size_t)MOE_ROWS * DM * 2;
constexpr size_t WS_Y      = WS_HM   + (size_t)MOE_ROWS * DEXP * 2;
constexpr size_t WS_END    = WS_Y    + (size_t)MOE_ROWS * DM * 2;

constexpr int CW_BAR  = 0;
constexpr int CW_Q    = 4096;
constexpr int CW_CNT  = 4096 + 64 * 8;
constexpr int CW_CNTW = 8704;
constexpr int CW_DBG  = 13312;

__device__ __forceinline__ bf16_t f2bf(float f) { unsigned u = __float_as_uint(f); u += 0x7FFFu + ((u >> 16) & 1u); return (bf16_t)(u >> 16); }
__device__ __forceinline__ float bf2f(bf16_t b) { return __uint_as_float(((unsigned)b) << 16); }
__device__ __forceinline__ unsigned cvtpk(float lo, float hi) { unsigned r; asm volatile("v_cvt_pk_bf16_f32 %0, %1, %2" : "=v"(r) : "v"(lo), "v"(hi)); return r; }
__device__ __forceinline__ bf16x8 pack8(f32x4 a, f32x4 b) { u32x4 w = {cvtpk(a[0], a[1]), cvtpk(a[2], a[3]), cvtpk(b[0], b[1]), cvtpk(b[2], b[3])}; return *reinterpret_cast<bf16x8*>(&w); }
__device__ __forceinline__ float fast_sigmoid(float x) { return __builtin_amdgcn_rcpf(1.0f + __builtin_amdgcn_exp2f(-x * LOG2E)); }
__device__ __forceinline__ float gelu_tanh(float x) {
    const float z = 0.7978845608028654f * (x + 0.044715f * x * x * x);
    return x * __builtin_amdgcn_rcpf(1.0f + __builtin_amdgcn_exp2f(-2.0f * LOG2E * z));
}
__device__ __forceinline__ float wave_sum(float v) {
#pragma unroll
    for (int o = 32; o >= 1; o >>= 1) v += __shfl_xor(v, o);
    return v;
}

__device__ __forceinline__ int launder_v(int x) { asm volatile("" : "+v"(x)); return x; }
__device__ __forceinline__ unsigned opaque_zero() { unsigned z; asm volatile("s_mov_b32 %0, 0" : "=s"(z)); return z; }
template <class T> __device__ __forceinline__ T* launder_s(T* p) { typedef __attribute__((address_space(1))) T GT; GT* g = (GT*)((unsigned long long)p + opaque_zero()); return (T*)g; }
#define LTID launder_v((int)threadIdx.x)
#define LBID ((int)(blockIdx.x + opaque_zero()))
namespace pg8 {
#define PG8_LAS __attribute__((address_space(3)))
typedef unsigned short bf16_t;
typedef short bf16x8 __attribute__((ext_vector_type(8)));
typedef float f32x4 __attribute__((ext_vector_type(4)));
typedef unsigned u32x4 __attribute__((ext_vector_type(4)));
constexpr int BM = 256, BK = 64, HALF = 128, HTB = HALF * BK * 2  , STAGE_BYTES = 8 * HTB, NXCD = 8, WGM = 8;

__host__ __device__ __forceinline__ int lds_byte(int r, int c) { const int st = (r >> 4) * 2 + (c >> 5), rr = r & 15, cc = c & 31, ob = rr * 64 + cc * 2; return st * 1024 + (ob ^ (((ob >> 9) & 1) << 5)); }
__host__ __device__ __forceinline__ void stage_rc(int b, int& R, int& C) { const int st = b / 1024, sb = b % 1024, swz = sb ^ (((sb >> 9) & 1) << 5); R = (st >> 1) * 16 + swz / 64; C = (st & 1) * 32 + (swz % 64) / 2; }
__host__ __device__ __forceinline__ int perm32(int rho) { const int n = rho >> 4, i = rho & 15; return 8 * (i >> 2) + 4 * n + (i & 3); }

struct Unit { int pm, pn; };
template <class E, class = void> struct has_keep { static constexpr bool v = false; };
template <class E> struct has_keep<E, decltype((void)&E::keep)> { static constexpr bool v = true; };
struct Gemm { const bf16_t* A; const bf16_t* Bt; int M, N, K; };

struct StaticOrder {
    int nM, nN, nwg, G, c;
    __host__ __device__ void init(int M, int N, int G_, int c_) { nM = M / BM; nN = N / BM; nwg = nM * nN; G = G_; c = c_; }
    __host__ __device__ bool next(int i, Unit& u) const {
        const long L = (long)i * G + c; if (L >= nwg) return false;
        int wgid = (int)L; { const int q = nwg / NXCD, r = nwg % NXCD, xcd = wgid % NXCD, off = wgid / NXCD; wgid = (xcd < r ? xcd * (q + 1) : r * (q + 1) + (xcd - r) * q) + off; }
        const int nig = WGM * nN, gid = wgid / nig, fm = gid * WGM, gsz = (nM - fm) < WGM ? (nM - fm) : WGM;
        u.pm = fm + ((wgid % nig) % gsz); u.pn = (wgid % nig) / gsz; return true;
    }
    __device__ __forceinline__ void a_ready(const Unit&) const {}
    __device__ __forceinline__ void done(const Unit&) const {}
};
struct CountedOrder : StaticOrder {
    const unsigned* ready; unsigned need; unsigned* tmo;
    __device__ __forceinline__ void a_ready(const Unit& u) const {
        if (threadIdx.x < 64) {
            const unsigned long long t0 = __builtin_amdgcn_s_memrealtime(); unsigned polls = 0;
            while ((unsigned)__builtin_amdgcn_readfirstlane(__hip_atomic_load(ready + 64 * u.pm, __ATOMIC_RELAXED, __HIP_MEMORY_SCOPE_AGENT)) < need) {
                if ((++polls & 255u) == 0u && __builtin_amdgcn_readfirstlane(__hip_atomic_load(tmo, __ATOMIC_RELAXED, __HIP_MEMORY_SCOPE_AGENT)) != 0u) break;
                if (__builtin_amdgcn_s_memrealtime() - t0 > 2000000ull) {
                    if (threadIdx.x == 0) { unsigned expect = 0u; __hip_atomic_compare_exchange_strong(tmo + 1, &expect, 0x600u | (unsigned)(u.pm & 0xff), __ATOMIC_RELAXED, __ATOMIC_RELAXED, __HIP_MEMORY_SCOPE_AGENT); __hip_atomic_store(tmo, 1u, __ATOMIC_RELAXED, __HIP_MEMORY_SCOPE_AGENT); }
                    break; }
                __builtin_amdgcn_s_sleep(2); }
            __builtin_amdgcn_fence(__ATOMIC_ACQUIRE, "agent");
            asm volatile("s_waitcnt vmcnt(0)" ::: "memory");
        }
#if !defined(BROKEN_HOOK_NO_BARRIER)
        asm volatile("" ::: "memory"); __builtin_amdgcn_s_barrier(); asm volatile("" ::: "memory");
#endif
    }
};

__device__ __forceinline__ unsigned cvt_pk_bf16(float lo, float hi) { unsigned r; asm volatile("v_cvt_pk_bf16_f32 %0, %1, %2" : "=v"(r) : "v"(lo), "v"(hi)); return r; }
typedef float f32x2 __attribute__((ext_vector_type(2)));
__device__ __forceinline__ f32x2 gelu_pk(f32x2 v) {
    const f32x2 av = __builtin_elementwise_abs(v), d = av * 0.2316418882f + 1.0f;
    f32x2 t; t.x = __builtin_amdgcn_rcpf(d.x); t.y = __builtin_amdgcn_rcpf(d.y);
    f32x2 q = t * 0.5307027145f + (-0.7265760135f); q = q * t + 0.7107068705f; q = q * t + (-0.142248368f); q = q * t + 0.127414796f; q = q * t;
    const f32x2 s = (v * v) * (-0.72134752044f);
    f32x2 e; e.x = __builtin_amdgcn_exp2f(s.x); e.y = __builtin_amdgcn_exp2f(s.y);
    const f32x2 m = v * (q * e), r = v - m;
    f32x2 o; o.x = v.x < 0.f ? m.x : r.x; o.y = v.y < 0.f ? m.y : r.y; return o;
}

struct EpiF32 {
    static constexpr bool PERM = false, AFTER_DRAIN = false;
    float* C; int ldc; const float* bias;
    __device__ __forceinline__ void operator()(const f32x4 (&acc)[2][2][4][2], const Unit& u, int wr, int wc, int fr, int fq) const {
        const int row0 = u.pm * BM + wr * 64 + fr, col0 = u.pn * BM + wc * 32 + 4 * fq;
        f32x4 bv[2][2];
#pragma unroll
        for (int bj = 0; bj < 2; ++bj)
#pragma unroll
            for (int n = 0; n < 2; ++n) bv[bj][n] = bias ? *(const f32x4*)(bias + col0 + bj * HALF + n * 16) : (f32x4){0.f, 0.f, 0.f, 0.f};
#pragma unroll
        for (int ai = 0; ai < 2; ++ai)
#pragma unroll
            for (int m = 0; m < 4; ++m) { float* rowp = C + (size_t)(row0 + ai * HALF + m * 16) * ldc + col0;
#pragma unroll
                for (int bj = 0; bj < 2; ++bj)
#pragma unroll
                    for (int n = 0; n < 2; ++n) *(f32x4*)(rowp + bj * HALF + n * 16) = acc[ai][bj][m][n] + bv[bj][n]; }
    }
};
template <int ACT  > struct EpiBf16 {
    static constexpr bool PERM = true, AFTER_DRAIN = false;
    bf16_t* O; int ldc; const float* bias; int split_cols; size_t split_stride;
    __device__ __forceinline__ void operator()(const f32x4 (&acc)[2][2][4][2], const Unit& u, int wr, int wc, int fr, int fq) const {
        const int row0 = u.pm * BM + wr * 64 + fr; int colt = u.pn * BM; bf16_t* base = O;
        if (split_cols) { const int t = colt / split_cols; base += (size_t)t * split_stride; colt -= t * split_cols; }
        const int col0 = colt + wc * 32 + 8 * fq, bcol0 = u.pn * BM + wc * 32 + 8 * fq;
        f32x4 bv[2][2];
#pragma unroll
        for (int bj = 0; bj < 2; ++bj)
#pragma unroll
            for (int n = 0; n < 2; ++n) bv[bj][n] = bias ? *(const f32x4*)(bias + bcol0 + bj * HALF + 4 * n) : (f32x4){0.f, 0.f, 0.f, 0.f};
#pragma unroll
        for (int ai = 0; ai < 2; ++ai)
#pragma unroll
            for (int m = 0; m < 4; ++m) { bf16_t* rowp = base + (size_t)(row0 + ai * HALF + m * 16) * ldc + col0;
#pragma unroll
                for (int bj = 0; bj < 2; ++bj) { f32x4 v0 = acc[ai][bj][m][0] + bv[bj][0], v1 = acc[ai][bj][m][1] + bv[bj][1];
                    if (ACT == 1) { f32x2 a = gelu_pk((f32x2){v0[0], v0[1]}), b = gelu_pk((f32x2){v0[2], v0[3]}), c = gelu_pk((f32x2){v1[0], v1[1]}), d = gelu_pk((f32x2){v1[2], v1[3]});
                        v0 = (f32x4){a.x, a.y, b.x, b.y}; v1 = (f32x4){c.x, c.y, d.x, d.y}; }
                    if (ACT == 2) {
#pragma unroll
                        for (int j = 0; j < 4; ++j) { v0[j] = 0.5f * v0[j] * (1.0f + erff(v0[j] * 0.70710678f)); v1[j] = 0.5f * v1[j] * (1.0f + erff(v1[j] * 0.70710678f)); } }
                    u32x4 w; w.x = cvt_pk_bf16(v0[0], v0[1]); w.y = cvt_pk_bf16(v0[2], v0[3]); w.z = cvt_pk_bf16(v1[0], v1[1]); w.w = cvt_pk_bf16(v1[2], v1[3]);
                    *(u32x4*)(rowp + bj * HALF) = w; } }
    }
};

struct PanelStats {
    unsigned* xbuf;
    unsigned* cnt;
    unsigned* tmo;
    int ntn; float eps;
    unsigned code;
    __device__ __forceinline__ bool run(const f32x4 (&v)[2][2][4][2], const Unit& u, int wr, int wc, int fr, int fq, PG8_LAS unsigned char* lds, int wid, int lane) const {
        typedef float f32x2v __attribute__((ext_vector_type(2)));
        PG8_LAS f32x2v* P = (PG8_LAS f32x2v*)lds;
        PG8_LAS f32x2v* S = (PG8_LAS f32x2v*)(lds + 8192);
        PG8_LAS unsigned* flag = (PG8_LAS unsigned*)(lds + 8192 + 2048);
#pragma unroll
        for (int ai = 0; ai < 2; ++ai)
#pragma unroll
            for (int m = 0; m < 4; ++m) {
                float s = 0.f;
#pragma unroll
                for (int bj = 0; bj < 2; ++bj)
#pragma unroll
                    for (int n = 0; n < 2; ++n) { const f32x4 x = v[ai][bj][m][n]; s += (x[0] + x[1]) + (x[2] + x[3]); }
                s += __shfl_xor(s, 16); s += __shfl_xor(s, 32);
                const float mw = s * (1.0f / 64.0f); float q = 0.f;
#pragma unroll
                for (int bj = 0; bj < 2; ++bj)
#pragma unroll
                    for (int n = 0; n < 2; ++n) { const f32x4 d = v[ai][bj][m][n] - mw; q += (d[0] * d[0] + d[1] * d[1]) + (d[2] * d[2] + d[3] * d[3]); }
                q += __shfl_xor(q, 16); q += __shfl_xor(q, 32);
                if (fq == 0) P[(ai * HALF + wr * 64 + m * 16 + fr) * 4 + wc] = (f32x2v){mw, q};
            }
        asm volatile("s_waitcnt lgkmcnt(0)" ::: "memory"); __builtin_amdgcn_s_barrier(); asm volatile("" ::: "memory");
#if defined(BROKEN_NO_WAIT)
        if (blockIdx.x >= 64) { const long long t0 = clock64(); while (clock64() - t0 < 60000) __builtin_amdgcn_s_sleep(8); }
#endif
        const int row = wid * 32 + (lane & 31);
        if (lane < 32) {
            const f32x2v a = P[row * 4 + 0], b = P[row * 4 + 1], c = P[row * 4 + 2], d = P[row * 4 + 3];
            const float mt = (a.x + b.x + c.x + d.x) * 0.25f;
            const float da = a.x - mt, db = b.x - mt, dc = c.x - mt, dd = d.x - mt;
            const float m2 = (a.y + b.y) + (c.y + d.y) + 64.0f * ((da * da + db * db) + (dc * dc + dd * dd));
            unsigned long long* slot = (unsigned long long*)xbuf + ((size_t)(u.pm * BM + row) * 4 + u.pn);
            __hip_atomic_store(slot, ((unsigned long long)__float_as_uint(m2) << 32) | __float_as_uint(mt), __ATOMIC_RELAXED, __HIP_MEMORY_SCOPE_AGENT);
        }
        asm volatile("s_waitcnt vmcnt(0)" ::: "memory");
        if (lane == 0) __hip_atomic_fetch_add(cnt + 64 * u.pm, 1u, __ATOMIC_RELAXED, __HIP_MEMORY_SCOPE_AGENT);
        if (wid == 0) {
            bool dead = false; const unsigned long long t0 = __builtin_amdgcn_s_memrealtime(); const unsigned want = 8u * (unsigned)ntn;
            for (;;) {
#if defined(BROKEN_NO_WAIT)
                break;
#endif
                if ((unsigned)__builtin_amdgcn_readfirstlane(__hip_atomic_load(cnt + 64 * u.pm, __ATOMIC_RELAXED, __HIP_MEMORY_SCOPE_AGENT)) >= want) break;
                if (__builtin_amdgcn_s_memrealtime() - t0 > 2000000ull) {
                    if (lane == 0) { unsigned expect = 0u; __hip_atomic_compare_exchange_strong(tmo + 1, &expect, code | (unsigned)(u.pm & 0xff), __ATOMIC_RELAXED, __ATOMIC_RELAXED, __HIP_MEMORY_SCOPE_AGENT);
                                     __hip_atomic_store(tmo, 1u, __ATOMIC_RELAXED, __HIP_MEMORY_SCOPE_AGENT); }
                    dead = true; break; }
                __builtin_amdgcn_s_sleep(2);
            }
            __builtin_amdgcn_fence(__ATOMIC_ACQUIRE, "agent");
            if (lane == 0) flag[0] = dead ? 1u : 0u;
        }
        asm volatile("s_waitcnt vmcnt(0) lgkmcnt(0)" ::: "memory"); __builtin_amdgcn_s_barrier(); asm volatile("" ::: "memory");
        const bool bad = flag[0] != 0u;
        if (lane < 32) {
            const unsigned long long* slot = (const unsigned long long*)xbuf + (size_t)(u.pm * BM + row) * 4; float mt[4], m2[4]; float ms = 0.f;
#pragma unroll
            for (int t = 0; t < 4; ++t) { if (t < ntn) { const unsigned long long w = __hip_atomic_load(slot + t, __ATOMIC_RELAXED, __HIP_MEMORY_SCOPE_AGENT); mt[t] = __uint_as_float((unsigned)w); m2[t] = __uint_as_float((unsigned)(w >> 32)); } else { mt[t] = 0.f; m2[t] = 0.f; } ms += mt[t]; }
            const float mean = ms / (float)ntn; float q = 0.f;
#pragma unroll
            for (int t = 0; t < 4; ++t) if (t < ntn) { const float dm = mt[t] - mean; q += m2[t] + 256.0f * dm * dm; }
            S[row] = (f32x2v){mean, 1.0f / sqrtf(q / (256.0f * (float)ntn) + eps)};
        }
        asm volatile("s_waitcnt lgkmcnt(0)" ::: "memory"); __builtin_amdgcn_s_barrier(); asm volatile("" ::: "memory");
        return bad;
    }
};
struct EpiLnRes {
    static constexpr bool PERM = false, AFTER_DRAIN = true;
    const float* base; float* out; int ldc; const float* bias; PanelStats st; unsigned poison;
    __device__ __forceinline__ void refuse(size_t i0, size_t stride, int M, int N) const { const float q = __builtin_nanf(""); for (size_t i = i0; i < (size_t)M * N; i += stride) out[(i / N) * ldc + i % N] = q;
        if (i0 == 0) { unsigned expect = 0u; __hip_atomic_compare_exchange_strong(st.tmo + 1, &expect, 0x7f0u, __ATOMIC_RELAXED, __ATOMIC_RELAXED, __HIP_MEMORY_SCOPE_AGENT); __hip_atomic_store(st.tmo, 1u, __ATOMIC_RELAXED, __HIP_MEMORY_SCOPE_AGENT); } }
    __device__ __forceinline__ void fused(f32x4 (&acc)[2][2][4][2], const Unit& u, int wr, int wc, int fr, int fq, PG8_LAS unsigned char* lds, int wid, int lane) const {
        typedef float f32x2v __attribute__((ext_vector_type(2)));
        const PG8_LAS f32x2v* S = (const PG8_LAS f32x2v*)(lds + 8192);
        const int col0 = u.pn * BM + wc * 32 + 4 * fq;
#pragma unroll
        for (int bj = 0; bj < 2; ++bj)
#pragma unroll
            for (int n = 0; n < 2; ++n) { const f32x4 bv = bias ? *(const f32x4*)(bias + col0 + bj * HALF + n * 16) : (f32x4){0.f, 0.f, 0.f, 0.f};
#pragma unroll
                for (int ai = 0; ai < 2; ++ai)
#pragma unroll
                    for (int m = 0; m < 4; ++m) acc[ai][bj][m][n] += bv; }
        const bool bad = st.run(acc, u, wr, wc, fr, fq, lds, wid, lane) || poison != 0u;
        const float qnan = __builtin_nanf("");
#pragma unroll
        for (int ai = 0; ai < 2; ++ai)
#pragma unroll
            for (int m = 0; m < 4; ++m) { const int r = ai * HALF + wr * 64 + m * 16 + fr; const f32x2v sr = S[r]; const size_t off = (size_t)(u.pm * BM + r) * ldc + col0;
#pragma unroll
                for (int bj = 0; bj < 2; ++bj)
#pragma unroll
                    for (int n = 0; n < 2; ++n) { const f32x4 bs = *(const f32x4*)(base + off + bj * HALF + n * 16); f32x4 o = bs + (acc[ai][bj][m][n] - sr.x) * sr.y;
                        if (bad) o = (f32x4){qnan, qnan, qnan, qnan}; *(f32x4*)(out + off + bj * HALF + n * 16) = o; }
                asm volatile("" ::: "memory"); }
    }
};
struct EpiLnResLn {
    static constexpr bool PERM = false, AFTER_DRAIN = true;
    const float* base; float* out; bf16_t* xn; int ldc; const float* bias; PanelStats st1, st2; unsigned poison;
    __device__ __forceinline__ void refuse(size_t i0, size_t stride, int M, int N) const { const float q = __builtin_nanf(""); for (size_t i = i0; i < (size_t)M * N; i += stride) { const size_t o = (i / N) * ldc + i % N; out[o] = q; xn[o] = (bf16_t)0x7fc0u; }
        if (i0 == 0) { unsigned expect = 0u; __hip_atomic_compare_exchange_strong(st1.tmo + 1, &expect, 0x7f0u, __ATOMIC_RELAXED, __ATOMIC_RELAXED, __HIP_MEMORY_SCOPE_AGENT); __hip_atomic_store(st1.tmo, 1u, __ATOMIC_RELAXED, __HIP_MEMORY_SCOPE_AGENT); } }
    __device__ __forceinline__ void fused(f32x4 (&acc)[2][2][4][2], const Unit& u, int wr, int wc, int fr, int fq, PG8_LAS unsigned char* lds, int wid, int lane) const {
        typedef float f32x2v __attribute__((ext_vector_type(2))); typedef unsigned u32x2v __attribute__((ext_vector_type(2)));
        const PG8_LAS f32x2v* S = (const PG8_LAS f32x2v*)(lds + 8192);
        const int col0 = u.pn * BM + wc * 32 + 4 * fq;
#pragma unroll
        for (int bj = 0; bj < 2; ++bj)
#pragma unroll
            for (int n = 0; n < 2; ++n) { const f32x4 bv = bias ? *(const f32x4*)(bias + col0 + bj * HALF + n * 16) : (f32x4){0.f, 0.f, 0.f, 0.f};
#pragma unroll
                for (int ai = 0; ai < 2; ++ai)
#pragma unroll
                    for (int m = 0; m < 4; ++m) acc[ai][bj][m][n] += bv; }
        bool bad = st1.run(acc, u, wr, wc, fr, fq, lds, wid, lane) || poison != 0u;
        const float qnan = __builtin_nanf("");
#pragma unroll
        for (int ai = 0; ai < 2; ++ai)
#pragma unroll
            for (int m = 0; m < 4; ++m) { const int r = ai * HALF + wr * 64 + m * 16 + fr; const f32x2v sr = S[r]; const size_t off = (size_t)(u.pm * BM + r) * ldc + col0;
#pragma unroll
                for (int bj = 0; bj < 2; ++bj)
#pragma unroll
                    for (int n = 0; n < 2; ++n) { const f32x4 bs = *(const f32x4*)(base + off + bj * HALF + n * 16); acc[ai][bj][m][n] = bs + (acc[ai][bj][m][n] - sr.x) * sr.y; }
                asm volatile("" : "+v"(acc[ai][0][m][0]), "+v"(acc[ai][0][m][1]), "+v"(acc[ai][1][m][0]), "+v"(acc[ai][1][m][1]));
                if (m & 1) asm volatile("" ::: "memory"); }
        const bool bad1 = bad;
        bad = st2.run(acc, u, wr, wc, fr, fq, lds, wid, lane) || bad;
#pragma unroll
        for (int ai = 0; ai < 2; ++ai)
#pragma unroll
            for (int m = 0; m < 4; ++m) { const int r = ai * HALF + wr * 64 + m * 16 + fr; const f32x2v sr = S[r]; const size_t off = (size_t)(u.pm * BM + r) * ldc + col0;
#pragma unroll
                for (int bj = 0; bj < 2; ++bj)
#pragma unroll
                    for (int n = 0; n < 2; ++n) { const f32x4 x1 = acc[ai][bj][m][n]; *(f32x4*)(out + off + bj * HALF + n * 16) = bad1 ? (f32x4){qnan, qnan, qnan, qnan} : x1;
                        const f32x4 o = (x1 - sr.x) * sr.y; u32x2v w; w.x = cvt_pk_bf16(o[0], o[1]); w.y = cvt_pk_bf16(o[2], o[3]);
                        if (bad) { w.x = 0x7fc07fc0u; w.y = 0x7fc07fc0u; } *(u32x2v*)(xn + off + bj * HALF + n * 16) = w; }
                asm volatile("" ::: "memory"); }
    }
};

template <class Epi, class Sched, bool STAMP = false>
__device__ __forceinline__ void gemm_phase(PG8_LAS unsigned char* lds, const Gemm g, const Sched& S, const Epi& E, unsigned long long* stamps) {
    const int tid = launder_v((int)threadIdx.x), wid = __builtin_amdgcn_readfirstlane(tid >> 6), lane = tid & 63, wr = wid >> 2, wc = wid & 3, fr = lane & 15, fq = lane >> 4;
    const int K = g.K, nt = K / BK;
    int ts_lo = 0, ts_hi = 0, nts = 0; const unsigned long long rt_entry = STAMP ? (unsigned long long)wall_clock64() : 0ull;
#define PG8_STAMP() do { if (STAMP && wid == 0 && nts < 64) { const unsigned long long _c = (unsigned long long)clock64(); \
        ts_lo = (lane == nts) ? (int)(unsigned)_c : ts_lo; ts_hi = (lane == nts) ? (int)(unsigned)(_c >> 32) : ts_hi; ++nts; } } while (0)
    PG8_STAMP();
    unsigned voffA[2], voffB[2];
#pragma unroll
    for (int i = 0; i < 2; ++i) { int R, C; stage_rc(tid * 16 + i * 8192, R, C); const int Rb = Epi::PERM ? ((R & ~31) + perm32(R & 31)) : R;
        voffA[i] = (unsigned)(R * K + C) * 2u; voffB[i] = (unsigned)(Rb * K + C) * 2u; }
    const size_t kstep = (size_t)(BK * 2);
    const size_t hstep = (size_t)HALF * K * 2;
    const size_t tstep = 2 * hstep;
    const unsigned ldsw = (unsigned)wid * 1024u;
    const int aoff = lds_byte(wr * 64 + fr, fq * 8), boff = lds_byte(wc * 32 + fr, fq * 8);
#define PG8_SA(b, h) (((b) * 2 + (h)) * HTB)
#define PG8_SB(b, h) ((4 + (b) * 2 + (h)) * HTB)
#define PG8_STAGE(bufoff, gbase, voff) do { _Pragma("unroll") for (int _i = 0; _i < 2; ++_i) \
        __builtin_amdgcn_global_load_lds((const unsigned*)((const char*)(gbase) + (voff)[_i]), (PG8_LAS unsigned*)(lds + (bufoff) + ldsw + _i * 8192), 16, 0, 0); } while (0)
#define PG8_LDA(dst, b, h) do { _Pragma("unroll") for (int m = 0; m < 4; ++m) _Pragma("unroll") for (int k = 0; k < 2; ++k) dst[m][k] = *(const PG8_LAS bf16x8*)(lds + PG8_SA(b, h) + aoff + m * 2048 + k * 1024); } while (0)
#define PG8_LDB(dst, b, h) do { _Pragma("unroll") for (int n = 0; n < 2; ++n) _Pragma("unroll") for (int k = 0; k < 2; ++k) dst[n][k] = *(const PG8_LAS bf16x8*)(lds + PG8_SB(b, h) + boff + n * 2048 + k * 1024); } while (0)
#define PG8_MMA(ai, bj, At, Bt) do { __builtin_amdgcn_s_setprio(1); _Pragma("unroll") for (int m = 0; m < 4; ++m) _Pragma("unroll") for (int n = 0; n < 2; ++n) _Pragma("unroll") for (int k = 0; k < 2; ++k) \
        acc[ai][bj][m][n] = __builtin_amdgcn_mfma_f32_16x16x32_bf16(Bt[n][k], At[m][k], acc[ai][bj][m][n], 0, 0, 0); __builtin_amdgcn_s_setprio(0); } while (0)
#define PG8_WAIT_V(n) asm volatile("s_waitcnt vmcnt(" #n ")" ::: "memory")
#define PG8_WAIT_L(n) asm volatile("s_waitcnt lgkmcnt(" #n ")" ::: "memory")
#define PG8_BAR __builtin_amdgcn_s_barrier()
#define PG8_SCHED __builtin_amdgcn_sched_barrier(0)
    Unit cur, nxt; int ui = 0;
    if (!S.next(0, cur)) return;
    f32x4 acc[2][2][4][2];
#pragma unroll
    for (int a = 0; a < 2; ++a)
#pragma unroll
        for (int b = 0; b < 2; ++b)
#pragma unroll
            for (int m = 0; m < 4; ++m)
#pragma unroll
                for (int n = 0; n < 2; ++n) acc[a][b][m][n] = (f32x4){0.f, 0.f, 0.f, 0.f};
    bf16x8 At[4][2], B0[2][2], B1[2][2];
    const char* cA = (const char*)g.A + (size_t)cur.pm * tstep; const char* cB = (const char*)g.Bt + (size_t)cur.pn * tstep;
    S.a_ready(cur);
    PG8_STAGE(PG8_SB(0, 0), cB, voffB); PG8_STAGE(PG8_SA(0, 0), cA, voffA); PG8_STAGE(PG8_SB(0, 1), cB + hstep, voffB); PG8_STAGE(PG8_SA(0, 1), cA + hstep, voffA);
    if (wr == 1) PG8_BAR;
    PG8_WAIT_V(4); PG8_BAR;
    PG8_STAGE(PG8_SB(1, 0), cB + kstep, voffB); PG8_STAGE(PG8_SA(1, 0), cA + kstep, voffA); PG8_STAGE(PG8_SB(1, 1), cB + hstep + kstep, voffB);
    PG8_WAIT_V(6); PG8_BAR;
    PG8_STAMP();
    for (;;) {
        const bool has_next = S.next(ui + 1, nxt);
        const char* nA = has_next ? (const char*)g.A + (size_t)nxt.pm * tstep : cA; const char* nB = has_next ? (const char*)g.Bt + (size_t)nxt.pn * tstep : cB;
        for (int t = 0; t < nt; t += 2) {
            const bool last = (t == nt - 2);
            const char* a1 = cA + (size_t)(t + 1) * kstep;
            const char* a2 = last ? nA : cA + (size_t)(t + 2) * kstep; const char* b2 = last ? nB : cB + (size_t)(t + 2) * kstep;
            const char* a3 = a2 + kstep; const char* b3 = b2 + kstep;
            if (last && has_next) S.a_ready(nxt);
            PG8_LDB(B0, 0, 0); PG8_SCHED; PG8_LDA(At, 0, 0); PG8_STAGE(PG8_SA(1, 1), a1 + hstep, voffA);
            PG8_WAIT_L(8); PG8_BAR; PG8_WAIT_L(0); PG8_MMA(0, 0, At, B0); PG8_BAR; PG8_SCHED;
            PG8_LDB(B1, 0, 1); PG8_STAGE(PG8_SB(0, 0), b2, voffB);
            PG8_BAR; PG8_WAIT_L(0); PG8_MMA(0, 1, At, B1); PG8_BAR;
            PG8_LDA(At, 0, 1); PG8_STAGE(PG8_SA(0, 0), a2, voffA);
            PG8_BAR; PG8_WAIT_L(0); PG8_MMA(1, 0, At, B0); PG8_BAR; PG8_SCHED;
            PG8_STAGE(PG8_SB(0, 1), b2 + hstep, voffB);
            PG8_WAIT_V(6); PG8_BAR; PG8_MMA(1, 1, At, B1); PG8_BAR;
            PG8_LDB(B0, 1, 0); PG8_SCHED; PG8_LDA(At, 1, 0); PG8_STAGE(PG8_SA(0, 1), a2 + hstep, voffA);
            PG8_WAIT_L(8); PG8_BAR; PG8_WAIT_L(0); PG8_MMA(0, 0, At, B0); PG8_BAR; PG8_SCHED;
            PG8_LDB(B1, 1, 1); PG8_STAGE(PG8_SB(1, 0), b3, voffB);
            PG8_BAR; PG8_WAIT_L(0); PG8_MMA(0, 1, At, B1); PG8_BAR;
            PG8_LDA(At, 1, 1); PG8_STAGE(PG8_SA(1, 0), a3, voffA);
            PG8_BAR; PG8_WAIT_L(0); PG8_MMA(1, 0, At, B0); PG8_BAR; PG8_SCHED;
            PG8_STAGE(PG8_SB(1, 1), b3 + hstep, voffB);
            PG8_WAIT_V(6); PG8_BAR; PG8_MMA(1, 1, At, B1); PG8_BAR;
        }
        PG8_STAMP();
        if constexpr (!Epi::AFTER_DRAIN) { E(acc, cur, wr, wc, fr, fq); S.done(cur); }
        PG8_STAMP();
        if (!has_next) break;
        bool keep_acc = false;
        if constexpr (has_keep<Epi>::v) keep_acc = E.keep(cur);
        if (!keep_acc)
#pragma unroll
        for (int a = 0; a < 2; ++a)
#pragma unroll
            for (int b = 0; b < 2; ++b)
#pragma unroll
                for (int m = 0; m < 4; ++m)
#pragma unroll
                    for (int n = 0; n < 2; ++n) acc[a][b][m][n] = (f32x4){0.f, 0.f, 0.f, 0.f};
        cur = nxt; cA = nA; cB = nB; ++ui;
    }
    PG8_WAIT_V(0);
    if (wr == 0) PG8_BAR;
    PG8_BAR;
    if constexpr (Epi::AFTER_DRAIN) { E.fused(acc, cur, wr, wc, fr, fq, lds, wid, lane); S.done(cur); }
    PG8_STAMP();
    if (STAMP && wid == 0) { stamps[lane] = lane < nts ? (((unsigned long long)(unsigned)ts_hi << 32) | (unsigned)ts_lo) : 0ull;
        if (lane == 62) stamps[62] = rt_entry; if (lane == 63) stamps[63] = (unsigned long long)wall_clock64(); }
#undef PG8_STAMP
#undef PG8_SA
#undef PG8_SB
#undef PG8_STAGE
#undef PG8_LDA
#undef PG8_LDB
#undef PG8_MMA
#undef PG8_WAIT_V
#undef PG8_WAIT_L
#undef PG8_BAR
#undef PG8_SCHED
}
}
#define XB_TMO      128
#define XB_XCNT(j)  (256  + 64 * (j))
#define XB_XSUB(j)  (1280 + 64 * (j))
#define XB_XGEN(j)  (2304 + 64 * (j))
#define XB_TOP      3328
#define XB_TOPGEN   3392
#define XCD_BAR_WORDS 3456
#define XB_SPIN_CAP (1u << 18)
#define LAS __attribute__((address_space(3)))

__device__ __forceinline__ unsigned xb_ld(unsigned* p)              { return __hip_atomic_load(p, __ATOMIC_RELAXED, __HIP_MEMORY_SCOPE_AGENT); }
__device__ __forceinline__ unsigned xb_add(unsigned* p, unsigned v) { return __hip_atomic_fetch_add(p, v, __ATOMIC_RELAXED, __HIP_MEMORY_SCOPE_AGENT); }
__device__ __forceinline__ unsigned xb_xcc_id() { return (unsigned)__builtin_amdgcn_s_getreg((3 << 11) | 20) & 0xFu; }
#define XB_SPIN(cond, bar) do { unsigned _sp = 0; while (cond) { __builtin_amdgcn_s_sleep(1); \
    if ((++_sp & 255u) == 0u) { if (xb_ld(&(bar)[XB_TMO])) break; if (_sp > XB_SPIN_CAP) { atomicAdd(&(bar)[XB_TMO], 1u); break; } } } } while (0)

struct XcdBarrier {
    unsigned* bar; unsigned x;
    volatile LAS unsigned* st;
};

__device__ __forceinline__ XcdBarrier xcd_barrier_post(unsigned* bar, volatile LAS unsigned* st) {
    XcdBarrier b; b.bar = bar; b.x = xb_xcc_id(); b.st = st;
    if (threadIdx.x == 0) (void)xb_add(&bar[XB_XCNT(b.x)], 1u);
    return b;
}
__device__ __forceinline__ void xcd_barrier_complete(unsigned* bar, unsigned x, unsigned& nloc, unsigned& nx) {
    const unsigned G = gridDim.x * gridDim.y * gridDim.z;
    unsigned sum, cnt, mine, sp = 0u;
    for (;;) {
        sum = 0u; cnt = 0u; mine = 0u;
#pragma unroll
        for (unsigned j = 0; j < 16; ++j) { const unsigned c = xb_ld(&bar[XB_XCNT(j)]); sum += c; cnt += (c > 0u) ? 1u : 0u; mine = (j == x) ? c : mine; }
        if (sum == G) break;
        __builtin_amdgcn_s_sleep(1);
        if ((++sp & 255u) == 0u) { if (xb_ld(&bar[XB_TMO])) break; if (sp > XB_SPIN_CAP) { atomicAdd(&bar[XB_TMO], 1u); break; } }
    }
    nloc = mine > 0u ? mine : 1u; nx = cnt > 0u ? cnt : 1u;
}

__device__ __forceinline__ void xcd_barrier(const XcdBarrier& b) {
    asm volatile("s_waitcnt vmcnt(0)" ::: "memory");
    __syncthreads();
    if (threadIdx.x == 0) {
        unsigned* bar = b.bar;
        __builtin_amdgcn_s_waitcnt(0);
        unsigned nloc = b.st[0], nx = b.st[1];
        if (nloc == 0u) { xcd_barrier_complete(bar, b.x, nloc, nx); b.st[0] = nloc; b.st[1] = nx; }
        const unsigned old = xb_add(&bar[XB_XSUB(b.x)], 1u);
        const unsigned gen = old / nloc;
        if (old + 1u == (gen + 1u) * nloc) {
            __builtin_amdgcn_fence(__ATOMIC_RELEASE, "agent");
            asm volatile("s_waitcnt vmcnt(0)" ::: "memory");
            const unsigned og = xb_add(&bar[XB_TOP], 1u);
            const unsigned tg = og / nx;
            if (og + 1u == (tg + 1u) * nx) xb_add(&bar[XB_TOPGEN], 1u);
            else XB_SPIN(xb_ld(&bar[XB_TOPGEN]) == tg, bar);
            __builtin_amdgcn_fence(__ATOMIC_ACQUIRE, "agent");
            xb_add(&bar[XB_XGEN(b.x)], 1u);
            asm volatile("s_waitcnt vmcnt(0)" ::: "memory");
        } else {
            XB_SPIN(xb_ld(&bar[XB_XGEN(b.x)]) == gen, bar);
            __builtin_amdgcn_fence(__ATOMIC_ACQUIRE, "agent");
            asm volatile("s_waitcnt vmcnt(0)" ::: "memory");
        }
    }
    __syncthreads();
}

struct Args { const float* in[25]; float* out; unsigned char* ws; int ph_lo, ph_hi, rep, sub; };
#define LAS __attribute__((address_space(3)))

struct CvtJob { const float* src; int ld; int ncols; int K; const float* kscale; int kind; bf16_t* dst; bf16_t* dst2; };
__device__ __forceinline__ bf16_t* cvt_dst_row(const CvtJob& j, int c) {
    switch (j.kind) {
    case 0: return j.dst + (size_t)c * j.K;
    case 1: {
        if (c < 2560) return j.dst + (size_t)c * DM;
        if (c < 2584) return j.dst2 + (size_t)(c - 2560) * DM;
        if (c < 4120) return j.dst + (size_t)(c - 24) * DM;
        if (c < 4184) return j.dst2 + (size_t)(24 + c - 4120) * DM;
        if (c < 4188) return j.dst2 + (size_t)(88 + c - 4184) * DM;
        return j.dst + (size_t)(c - 92) * DM; }
    case 2: return j.dst + ((size_t)(c >> 7) * 256 + (c & 127)) * j.K;
    default: return j.dst + ((size_t)(c >> 7) * 256 + 128 + (c & 127)) * j.K;
    }
}
struct CvtTile { CvtJob j; int k0, c0; };
__device__ __forceinline__ bool cvt_decode(const Args& a, unsigned char* ws, int ti, CvtTile& t) {
    if (ti >= NL * (32 * 194 + 2 * 64 * 2 + 2 * 2 * 2 + 2 * 8 * 4 * 2 + 3 * 16 * 32 + 32 * 32 + 2 * 16 * 32 * 8 + 16 * 8 * 32)) return false;
    constexpr int PT_WIN = 32 * 194, PT_W1 = 2 * 64 * 2, PT_W2 = 2 * 2 * 2, PT_WUK = 8 * 4 * 2, PT_WB = 3 * 16 * 32, PT_WO = 32 * 32, PT_EX = 16 * 32 * 8, PT_DN = 16 * 8 * 32;
    constexpr int PT_LAYER = PT_WIN + PT_W1 + PT_W2 + 2 * PT_WUK + PT_WB + PT_WO + 2 * PT_EX + PT_DN;
    const int l = ti / PT_LAYER; int r = ti % PT_LAYER; CvtJob& j = t.j; j.kscale = nullptr; j.dst2 = nullptr; int kt, ct;
    if (r < PT_WIN) { j.src = a.in[1] + (size_t)l * DM * IN_COLS; j.ld = IN_COLS; j.ncols = IN_COLS; j.K = DM; j.kind = 1;
        j.dst = (bf16_t*)(ws + WS_WIN) + (size_t)l * NMAIN * DM; j.dst2 = (bf16_t*)(ws + WS_WSK) + (size_t)l * NSK * DM; kt = r % 32; ct = r / 32; }
    else if ((r -= PT_WIN) < PT_W1) { const int kv = r / 128; r %= 128; j.src = a.in[2] + ((size_t)l * 2 + kv) * 4096 * 128; j.ld = 128; j.ncols = 128; j.K = 4096; j.kind = 0;
        j.dst = (bf16_t*)(ws + WS_W1) + ((size_t)l * 2 + kv) * 128 * 4096; kt = r % 64; ct = r / 64; }
    else if ((r -= PT_W1) < PT_W2) { const int kv = r / 4; r %= 4; j.src = a.in[3] + ((size_t)l * 2 + kv) * 128 * 128; j.ld = 128; j.ncols = 128; j.K = 128; j.kind = 0;
        j.dst = (bf16_t*)(ws + WS_W2) + ((size_t)l * 2 + kv) * 128 * 128; kt = r / 2; ct = r % 2; }
    else if ((r -= PT_W2) < 2 * PT_WUK) { const int which = r / PT_WUK; r %= PT_WUK; const int h = r / 8; r %= 8;
        j.src = a.in[which ? 6 : 5] + ((size_t)l * 8 + h) * 256 * 128; j.ld = 128; j.ncols = 128; j.K = 256; j.kind = 0; j.kscale = a.in[7] + (size_t)l * 256;
        j.dst = (bf16_t*)(ws + WS_WKVUP) + ((size_t)l * 2048 + which * 1024 + h * 128) * 256; kt = r / 2; ct = r % 2; }
    else if ((r -= 2 * PT_WUK) < PT_WB) { const int n = r / 512; r %= 512; j.src = a.in[12] + ((size_t)l * 3 + n) * 1024 * 2048; j.ld = 2048; j.ncols = 2048; j.K = 1024; j.kind = 0;
        j.dst = (bf16_t*)(ws + WS_WB) + ((size_t)l * 3 + n) * 2048 * 1024; kt = r % 16; ct = r / 16; }
    else if ((r -= PT_WB) < PT_WO) { j.src = a.in[13] + (size_t)l * 2048 * 2048; j.ld = 2048; j.ncols = 2048; j.K = 2048; j.kind = 0;
        j.dst = (bf16_t*)(ws + WS_WO) + (size_t)l * 2048 * 2048; kt = r % 32; ct = r / 32; }
    else if ((r -= PT_WO) < 2 * PT_EX) { const int which = r / PT_EX; r %= PT_EX; const int e = r / 256; r %= 256;
        j.src = a.in[which ? 21 : 20] + ((size_t)l * 16 + e) * 2048 * 512; j.ld = 512; j.ncols = 512; j.K = 2048; j.kind = which ? 3 : 2;
        j.dst = (bf16_t*)(ws + WS_WGU) + ((size_t)l * 16 + e) * 1024 * 2048; kt = r % 32; ct = r / 32; }
    else { r -= 2 * PT_EX; const int e = r / 256; r %= 256;
        j.src = a.in[22] + ((size_t)l * 16 + e) * 512 * 2048; j.ld = 2048; j.ncols = 2048; j.K = 512; j.kind = 0;
        j.dst = (bf16_t*)(ws + WS_WD) + ((size_t)l * 16 + e) * 2048 * 512; kt = r % 8; ct = r / 8; }
    t.k0 = kt * 64; t.c0 = ct * 64; return true;
}
__device__ __forceinline__ void cvt_load(const CvtTile& t, f32x4 (&v)[16], int lane) {
    const int c = t.c0 + 4 * (lane & 15); const bool ok = c < t.j.ncols;
    const float* sp = t.j.src + (size_t)(t.k0 + (lane >> 4)) * t.j.ld + c;
#pragma unroll
    for (int i = 0; i < 16; ++i) v[i] = ok ? *(const f32x4*)(sp + (size_t)(4 * i) * t.j.ld) : (f32x4){0.f, 0.f, 0.f, 0.f};
}
__device__ __forceinline__ void cvt_store(const CvtTile& t, const f32x4 (&v)[16], LAS float* T, int lane, bool nostore = false) {
#if defined(PROBE_P0_NOLDS)
    if (nostore) { f32x4 s = v[0];
#pragma unroll
        for (int i = 1; i < 16; ++i) s += v[i];
        if (s[0] + s[1] + s[2] + s[3] == 1.2345e30f) T[lane] = s[0];
        return; }
#endif
#pragma unroll
    for (int i = 0; i < 16; ++i) { LAS float* p = T + (4 * i + (lane >> 4)) * 65 + 4 * (lane & 15); p[0] = v[i][0]; p[1] = v[i][1]; p[2] = v[i][2]; p[3] = v[i][3]; }
    asm volatile("s_waitcnt lgkmcnt(0)" ::: "memory");
    const int q = lane & 7;
#pragma unroll
    for (int i2 = 0; i2 < 8; ++i2) { const int cl = i2 * 8 + (lane >> 3), c = t.c0 + cl;
        float x[8];
#pragma unroll
        for (int e = 0; e < 8; ++e) x[e] = T[(8 * q + e) * 65 + cl];
        if (c < t.j.ncols) { bf16_t* d = cvt_dst_row(t.j, c);
            if (t.j.kscale) {
#pragma unroll
                for (int e = 0; e < 8; ++e) x[e] *= t.j.kscale[t.k0 + 8 * q + e]; }
            u32x4 w = {cvtpk(x[0], x[1]), cvtpk(x[2], x[3]), cvtpk(x[4], x[5]), cvtpk(x[6], x[7])};
            if (!nostore || w.x == 0x12345678u) *(u32x4*)(d + t.k0 + 8 * q) = w; } }
    asm volatile("s_waitcnt lgkmcnt(0)" ::: "memory");
}

__device__ __forceinline__ void p0_prologue(const Args& a, LAS unsigned char* lds, bool nostore = false) {
    LAS float* tl = (LAS float*)lds;
    unsigned char* ws = launder_s(a.ws);
    const int G = gridDim.x, wg = LBID, tid = LTID, wid = tid >> 6, lane = tid & 63;
    {
        LAS float* T = tl + wid * (64 * 65);
        const int step = G * 8; int ti = wg * 8 + wid;
        CvtTile ta, tb; f32x4 va[16], vb[16];
        bool ha = cvt_decode(a, ws, ti, ta); if (ha) cvt_load(ta, va, lane);
        while (ha) {
            const bool hb = cvt_decode(a, ws, ti + step, tb); if (hb) cvt_load(tb, vb, lane);
            cvt_store(ta, va, T, lane, nostore);
            if (!hb) break;
            ti += 2 * step;
            ha = cvt_decode(a, ws, ti, ta); if (ha) cvt_load(ta, va, lane);
            cvt_store(tb, vb, T, lane, nostore);
        }
        __syncthreads();
    }
    const size_t gtid = (size_t)wg * 512 + tid, gn = (size_t)G * 512;
    for (size_t i = gtid; i < (size_t)NL * 36 * DM; i += gn) { const size_t l = i / (36 * DM), r = i % (36 * DM); ((bf16_t*)(ws + WS_WSK))[(l * NSK + 92) * DM + r] = 0; }
    for (size_t i = gtid; i < (size_t)NL * 8 * 128 * 128; i += gn) { const int s = (int)(i & 127), t = (int)((i >> 7) & 127); ((bf16_t*)(ws + WS_WSTRIL))[i] = (s <= t) ? f2bf(a.in[10][i]) : (bf16_t)0; }
    for (size_t i = gtid; i < (size_t)NL * 32 * DM; i += gn) { const int k = (int)(i % DM), n = (int)((i / DM) % 32), l = (int)(i / ((size_t)32 * DM));
        float v = 0.f; if (n < 4) v = a.in[16][((size_t)l * DM + k) * 4 + n]; else if (n < 20) v = a.in[18][((size_t)l * DM + k) * 16 + (n - 4)];
        const bf16_t h = f2bf(v); const bf16_t lo = f2bf(v - bf2f(h));
        bf16_t* d = (bf16_t*)(ws + WS_WR) + (size_t)l * 2 * 32 * DM; d[(size_t)n * DM + k] = h; d[(size_t)(32 + n) * DM + k] = lo; }
    for (int js = wg; js < NL * 2 * 16; js += G) {
        const int job = js >> 4, sl = js & 15;
        const float* pe = a.in[4] + (size_t)job * 4096 + sl * 256; const float* w1 = a.in[2] + (size_t)job * 4096 * 128 + (size_t)sl * 256 * 128;
        const int n = tid & 127, q = tid >> 7; float acc4[4] = {0.f, 0.f, 0.f, 0.f};
#pragma unroll 4
        for (int k = q * 64; k < (q + 1) * 64; k += 4) {
#pragma unroll
            for (int u = 0; u < 4; ++u) acc4[u] += pe[k + u] * w1[(size_t)(k + u) * 128 + n]; }
        tl[q * 128 + n] = (acc4[0] + acc4[1]) + (acc4[2] + acc4[3]); __syncthreads();
        if (tid < 128) ((float*)(ws + WS_C1))[(size_t)js * 128 + tid] = (tl[tid] + tl[128 + tid]) + (tl[256 + tid] + tl[384 + tid]);
        __syncthreads();
    }
    for (size_t i = gtid; i < (size_t)NTOK * DM / 8; i += gn) { const f32x4 v0 = *(const f32x4*)(a.in[0] + i * 8), v1 = *(const f32x4*)(a.in[0] + i * 8 + 4);
        *(bf16x8*)((bf16_t*)(ws + WS_XB) + i * 8) = pack8(v0, v1); }
}

#define MFMA32(a, b, c) __builtin_amdgcn_mfma_f32_32x32x16_bf16((a), (b), (c), 0, 0, 0)
__device__ __forceinline__ int crow(int r, int hi) { return (r & 3) + 8 * (r >> 2) + 4 * hi; }

__device__ __forceinline__ void skinny_item(const Args& a, int l, LAS unsigned char* lds) {
    unsigned char* ws = launder_s(a.ws);
    const int tid = LTID, wid = __builtin_amdgcn_readfirstlane(tid >> 6), lane = tid & 63, r32 = lane & 31, hi = lane >> 5;
    const bf16_t* xb = (const bf16_t*)(ws + WS_XB); const bf16_t* wsk = (const bf16_t*)(ws + WS_WSK) + (size_t)l * NSK * DM;
    for (int it = LBID; it < NTOK / 32; it += gridDim.x) {
        const int row0 = it * 32;
        f32x16 acc[3] = {};
        const bf16_t* ap = xb + (size_t)(row0 + r32) * DM + 256 * wid + 8 * hi;
        const bf16_t* bp = wsk + (size_t)r32 * DM + 256 * wid + 8 * hi;
#pragma unroll 4
        for (int ks = 0; ks < 16; ++ks) {
            const bf16x8 af = *(const bf16x8*)(ap + 16 * ks);
#pragma unroll
            for (int nb = 0; nb < 3; ++nb) { const bf16x8 bfr = *(const bf16x8*)(bp + (size_t)nb * 32 * DM + 16 * ks); acc[nb] = MFMA32(af, bfr, acc[nb]); }
        }
        LAS float* red = (LAS float*)lds;
#pragma unroll
        for (int nb = 0; nb < 3; ++nb)
#pragma unroll
            for (int r = 0; r < 16; ++r) red[((wid * 3 + nb) * 16 + r) * 64 + lane] = acc[nb][r];
        __syncthreads();
        for (int i = tid; i < 3 * 16 * 64; i += 512) {
            float s = 0.f;
#pragma unroll
            for (int w = 0; w < 8; ++w) s += red[w * 3072 + i];
            const int ln = i & 63, r = (i >> 6) & 15, nb = i >> 10;
            const int row = row0 + crow(r, ln >> 5), n = nb * 32 + (ln & 31);
            if (n < 24) ((float*)(ws + WS_SKF))[(size_t)row * 32 + n] = fast_sigmoid(s);
            else if (n < 88) ((bf16_t*)(ws + WS_KI))[(size_t)row * 64 + (n - 24)] = f2bf(s);
            else if (n < 92) ((float*)(ws + WS_SKF))[(size_t)row * 32 + 24 + (n - 88)] = s;
        }
        __syncthreads();
    }
}

struct EpiInProj {
    static constexpr bool PERM = true, AFTER_DRAIN = false;
    unsigned char* ws;
    __device__ __forceinline__ void operator()(const f32x4 (&acc)[2][2][4][2], const pg8::Unit& u, int wr, int wc, int fr, int fq) const {
        const int pn = u.pn; size_t off; int ld, ct, act = 0;
        if (pn < 4)       { off = WS_QA; ld = 1024; ct = pn; }
        else if (pn < 10) { off = WS_KV; ld = 1536; ct = pn - 4; }
        else if (pn < 14) { off = WS_QB; ld = 1024; ct = pn - 10; }
        else if (pn < 15) { off = WS_HC; ld = 256;  ct = 0; }
        else if (pn < 16) { off = WS_QI; ld = 256;  ct = 0; }
        else if (pn < 20) { off = WS_HU; ld = 1024; ct = pn - 16; act = 1; }
        else if (pn < 24) { off = WS_HV; ld = 1024; ct = pn - 20; act = 1; }
        else              { off = WS_HG; ld = 6144; ct = pn - 24; act = 2; }
        bf16_t* base = (bf16_t*)(ws + off);
        const int row0 = u.pm * 256 + wr * 64 + fr, col0 = ct * 256 + wc * 32 + 8 * fq;
#pragma unroll
        for (int ai = 0; ai < 2; ++ai)
#pragma unroll
            for (int m = 0; m < 4; ++m) {
                const int row = row0 + ai * 128 + m * 16; bf16_t* rowp = base + (size_t)row * ld + col0;
                float sq = 0.f;
#pragma unroll
                for (int bj = 0; bj < 2; ++bj) {
                    f32x4 v0 = acc[ai][bj][m][0], v1 = acc[ai][bj][m][1];
                    if (act == 1) {
#pragma unroll
                        for (int e = 0; e < 4; ++e) { v0[e] = gelu_tanh(v0[e]); v1[e] = gelu_tanh(v1[e]); } }
                    else if (act == 2) {
#pragma unroll
                        for (int e = 0; e < 4; ++e) { v0[e] = fast_sigmoid(v0[e]); v1[e] = fast_sigmoid(v1[e]); } }
                    if (pn == 14) {
#pragma unroll
                        for (int e = 0; e < 4; ++e) sq += v0[e] * v0[e] + v1[e] * v1[e]; }
                    u32x4 w; w.x = cvtpk(v0[0], v0[1]); w.y = cvtpk(v0[2], v0[3]); w.z = cvtpk(v1[0], v1[1]); w.w = cvtpk(v1[2], v1[3]);
                    *(u32x4*)(rowp + bj * 128) = w;
                }
                if (pn == 14) { sq += __shfl_xor(sq, 16); sq += __shfl_xor(sq, 32); if (fq == 0) ((float*)(ws + WS_PSQ))[(size_t)row * 4 + wc] = sq; }
            }
    }
};

namespace att {
constexpr int SHM = 16384;
constexpr int L_V = 0, L_K = 2 * SHM, L_WS = 4 * SHM;
constexpr int L_IMP = 69632;
constexpr int L_SELM = L_IMP + 4 * 64 * 33 * 4;
constexpr int L_MISC = L_SELM + 512;
#define KSWZ(row, colB) ((row) * 256 + ((colB) ^ (((row) & 7) << 4)))
__device__ __forceinline__ int v_st(int k, int c) { const int kk = (k & ~0xC) | ((k & 4) << 1) | ((k & 8) >> 1); return ((kk >> 3) * 4 + (c >> 5)) * 512 + ((kk & 7) * 32 + (c & 31)) * 2; }
__device__ __forceinline__ int v_rd_base(int lane) { return ((lane & 3) << 3) | (((lane >> 2) & 3) << 6) | (((lane >> 4) & 1) << 5) | (((lane >> 5) & 1) << 8); }

struct Ctx { int tid, wid, lane, r32, hi, sr, sc, kws, vst0, vst1, vb0; LAS char* lds; LAS float* li_l; LAS float* al_l; };
__device__ __forceinline__ Ctx make_ctx(LAS unsigned char* lds) {
    Ctx c; c.tid = LTID; c.wid = __builtin_amdgcn_readfirstlane(c.tid >> 6); c.lane = c.tid & 63; c.r32 = c.lane & 31; c.hi = c.lane >> 5;
    c.sr = c.tid >> 4; c.sc = (c.tid & 15) * 8; c.kws = KSWZ(c.sr, c.sc * 2); c.vst0 = v_st(c.sr, c.sc); c.vst1 = v_st(32 + c.sr, c.sc);
    c.lds = (LAS char*)lds; c.vb0 = (int)(unsigned)(uintptr_t)(c.lds + L_V) + v_rd_base(c.lane);
    c.li_l = (LAS float*)(c.lds + L_WS + c.wid * 256); c.al_l = c.li_l + 32; return c;
}
struct Stage { bf16x8 k0, k1, v0, v1; };
__device__ __forceinline__ void stage_load(Stage& s, const Ctx& c, const bf16_t* K, int ldk, const bf16_t* V, int ldv, int key0) {
    s.v0 = *(const bf16x8*)(V + (size_t)(key0 + c.sr) * ldv + c.sc); s.v1 = *(const bf16x8*)(V + (size_t)(key0 + 32 + c.sr) * ldv + c.sc);
    s.k0 = *(const bf16x8*)(K + (size_t)(key0 + c.sr) * ldk + c.sc); s.k1 = *(const bf16x8*)(K + (size_t)(key0 + 32 + c.sr) * ldk + c.sc);
}
template <int BUF> __device__ __forceinline__ void stage_write(const Stage& s, const Ctx& c) {
    *(LAS bf16x8*)(c.lds + L_K + BUF * SHM + c.kws) = s.k0; *(LAS bf16x8*)(c.lds + L_K + BUF * SHM + c.kws + 32 * 256) = s.k1;
    *(LAS bf16x8*)(c.lds + L_V + BUF * SHM + c.vst0) = s.v0; *(LAS bf16x8*)(c.lds + L_V + BUF * SHM + c.vst1) = s.v1;
}
template <int KB> __device__ __forceinline__ void qkt(f32x16& p0, f32x16& p1, const Ctx& c, const bf16x8 (&qr)[8]) {
    p0 = f32x16{}; p1 = f32x16{};
    LAS const char* kb[4];
#pragma unroll
    for (int dd = 0; dd < 4; ++dd) kb[dd] = c.lds + L_K + KB * SHM + KSWZ(c.r32, (dd * 16 + c.hi * 8) * 2);
#pragma unroll
    for (int d0 = 0; d0 < 8; ++d0) { LAS const char* a = kb[d0 & 3] + (d0 >> 2) * 128;
        const bf16x8 b0 = *(LAS const bf16x8*)a; const bf16x8 b1 = *(LAS const bf16x8*)(a + 32 * 256);
        p0 = MFMA32(b0, qr[d0], p0); p1 = MFMA32(b1, qr[d0], p1); }
}
template <int VB> __device__ __forceinline__ void pv_tile(f32x16 (&o)[4], int vb0, bf16x8 pa0, bf16x8 pa1, bf16x8 pa2, bf16x8 pa3) {
#define TRRD(dst, off) asm volatile("ds_read_b64_tr_b16 %0, %1 offset:%2" : "=&v"(dst) : "v"(vb0), "i"(off) : "memory")
#define PV_RD(L_, H_, ks) do { constexpr int b_ = VB * SHM + (ks) * 4096; TRRD(L_[0], b_); TRRD(H_[0], b_ + 2048); TRRD(L_[1], b_ + 512); TRRD(H_[1], b_ + 512 + 2048); \
        TRRD(L_[2], b_ + 1024); TRRD(H_[2], b_ + 1024 + 2048); TRRD(L_[3], b_ + 1536); TRRD(H_[3], b_ + 1536 + 2048); } while (0)
#define PV_MM(L_, H_, pa) do { _Pragma("unroll") for (int d0 = 0; d0 < 4; ++d0) \
        o[d0] = MFMA32(pa, ((bf16x8){L_[d0][0], L_[d0][1], L_[d0][2], L_[d0][3], H_[d0][0], H_[d0][1], H_[d0][2], H_[d0][3]}), o[d0]); } while (0)
    s16x4 la[4], ha[4], lb[4], hb[4];
    PV_RD(la, ha, 0);
    PV_RD(lb, hb, 1); asm volatile("s_waitcnt lgkmcnt(8)" ::: "memory"); __builtin_amdgcn_sched_barrier(0); PV_MM(la, ha, pa0); __builtin_amdgcn_sched_barrier(0);
    PV_RD(la, ha, 2); asm volatile("s_waitcnt lgkmcnt(8)" ::: "memory"); __builtin_amdgcn_sched_barrier(0); PV_MM(lb, hb, pa1); __builtin_amdgcn_sched_barrier(0);
    PV_RD(lb, hb, 3); asm volatile("s_waitcnt lgkmcnt(8)" ::: "memory"); __builtin_amdgcn_sched_barrier(0); PV_MM(la, ha, pa2); __builtin_amdgcn_sched_barrier(0);
    asm volatile("s_waitcnt lgkmcnt(0)" ::: "memory"); __builtin_amdgcn_sched_barrier(0); PV_MM(lb, hb, pa3);
#undef PV_RD
#undef PV_MM
#undef TRRD
}
__device__ __forceinline__ float pair_max(float v) { auto rr = __builtin_amdgcn_permlane32_swap(__float_as_uint(v), __float_as_uint(v), false, false); return fmaxf(__uint_as_float(rr[0]), __uint_as_float(rr[1])); }
__device__ __forceinline__ float pair_sum(float v) { auto rr = __builtin_amdgcn_permlane32_swap(__float_as_uint(v), __float_as_uint(v), false, false); return __uint_as_float(rr[0]) + __uint_as_float(rr[1]); }
#define PK4(P, B_, OUT) do { unsigned xa0_ = cvtpk(P[B_+0], P[B_+1]), xa1_ = cvtpk(P[B_+2], P[B_+3]); \
        unsigned xb0_ = cvtpk(P[B_+4], P[B_+5]), xb1_ = cvtpk(P[B_+6], P[B_+7]); \
        auto xr0_ = __builtin_amdgcn_permlane32_swap(xa0_, xb0_, false, false); auto xr1_ = __builtin_amdgcn_permlane32_swap(xa1_, xb1_, false, false); \
        u32x4 xw_ = {xr0_[0], xr1_[0], xr0_[1], xr1_[1]}; OUT = *reinterpret_cast<bf16x8*>(&xw_); } while (0)

enum { MODE_WIN = 0, MODE_SEL = 1, MODE_BITS = 2, MODE_CMP = 3 };
template <int MODE> __device__ __forceinline__ void bias_mask(f32x16& p0, f32x16& p1, float bias0, float slope2k, int dq, unsigned W, bool rowsel, unsigned wlo, unsigned whi, int lim) {
    const float NEG = -__builtin_inff();
#pragma unroll
    for (int r = 0; r < 16; ++r) {
        const int cc = (r & 3) + 8 * (r >> 2);
        const float y0 = fmaf(p0[r], ATT_C2, fmaf(slope2k, (float)cc, bias0)), y1 = fmaf(p1[r], ATT_C2, fmaf(slope2k, (float)(cc + 32), bias0));
        bool ok0, ok1;
        if (MODE == MODE_WIN)       { ok0 = (unsigned)(dq - cc) < W; ok1 = (unsigned)(dq - cc - 32) < W; }
        else if (MODE == MODE_SEL)  { ok0 = rowsel && (dq - cc >= 0); ok1 = rowsel && (dq - cc - 32 >= 0); }
        else if (MODE == MODE_BITS) { ok0 = (wlo >> cc) & 1u; ok1 = (whi >> cc) & 1u; }
        else                        { ok0 = cc <= lim; ok1 = cc + 32 <= lim; }
        p0[r] = ok0 ? y0 : NEG; p1[r] = ok1 ? y1 : NEG;
    }
}
__device__ __forceinline__ void softmax_step(f32x16& p0, f32x16& p1, float& m, float& l, f32x16 (&o)[4], const Ctx& c, bf16x8& pa0, bf16x8& pa1, bf16x8& pa2, bf16x8& pa3) {
    float pmax = p0[0];
#pragma unroll
    for (int r = 1; r < 16; ++r) pmax = fmaxf(pmax, p0[r]);
#pragma unroll
    for (int r = 0; r < 16; ++r) pmax = fmaxf(pmax, p1[r]);
    pmax = pair_max(pmax);
    const float mn = fmaxf(m, pmax), alpha = __builtin_amdgcn_exp2f(m - mn); m = mn;
#pragma unroll
    for (int r = 0; r < 16; ++r) { p0[r] = __builtin_amdgcn_exp2f(p0[r] - mn); p1[r] = __builtin_amdgcn_exp2f(p1[r] - mn); }
    float ps = 0.f;
#pragma unroll
    for (int r = 0; r < 16; ++r) ps += p0[r] + p1[r];
    ps = pair_sum(ps); l = l * alpha + ps;
    PK4(p0, 0, pa0); PK4(p0, 8, pa1); PK4(p1, 0, pa2); PK4(p1, 8, pa3);
    if (__any(alpha < 1.f)) {
        if (c.hi == 0) c.al_l[c.r32] = alpha;
        asm volatile("s_waitcnt lgkmcnt(0)" ::: "memory");
#pragma unroll
        for (int r = 0; r < 16; ++r) { const float al = c.al_l[crow(r, c.hi)];
#pragma unroll
            for (int d = 0; d < 4; ++d) o[d][r] *= al; }
    }
}
struct BranchArgs {
    const bf16_t* K; const bf16_t* V; int ldk, ldv;
    unsigned tilemask;
    int t; float slope2;
    unsigned rowsel;
    const unsigned long long* mrow;
    unsigned W;
    int tw0;
};
template <int MODE> __device__ __forceinline__ void softmax_tile(f32x16& p0, f32x16& p1, float slope2k, float s32, float bias0, bool emask, int dq, unsigned W, unsigned wlo, unsigned whi, int lim,
                                                                 float& m, float& l, f32x16 (&o)[4], const Ctx& c, bf16x8& pa0, bf16x8& pa1, bf16x8& pa2, bf16x8& pa3) {
    const float NEG = -__builtin_inff();
#pragma unroll
    for (int r = 0; r < 16; ++r) { const float cf_ = (float)((r & 3) + 8 * (r >> 2)); p0[r] = fmaf(slope2k, cf_, p0[r] * ATT_C2); p1[r] = fmaf(slope2k, cf_, p1[r] * ATT_C2); }
    if (emask) {
#pragma unroll
        for (int r = 0; r < 16; ++r) { const int cc = (r & 3) + 8 * (r >> 2); bool ok0, ok1;
            if (MODE == MODE_WIN)       { ok0 = (unsigned)(dq - cc) < W; ok1 = (unsigned)(dq - cc - 32) < W; }
            else if (MODE == MODE_SEL)  { ok0 = (dq - cc >= 0); ok1 = (dq - cc - 32 >= 0); }
            else if (MODE == MODE_BITS) { ok0 = (wlo >> cc) & 1u; ok1 = (whi >> cc) & 1u; }
            else                        { ok0 = cc <= lim; ok1 = cc + 32 <= lim; }
            p0[r] = ok0 ? p0[r] : NEG; p1[r] = ok1 ? p1[r] : NEG; }
    }
    float z0 = p0[0], z1 = p1[0];
#pragma unroll
    for (int r = 1; r < 16; ++r) { z0 = fmaxf(z0, p0[r]); z1 = fmaxf(z1, p1[r]); }
    const float pmax = pair_max(fmaxf(z0, z1 + s32) + bias0);
    const float mn = fmaxf(m, pmax), alpha = __builtin_amdgcn_exp2f(m - mn); m = mn;
    const float d0 = bias0 - mn, d1 = d0 + s32;
#pragma unroll
    for (int r = 0; r < 16; ++r) { p0[r] = __builtin_amdgcn_exp2f(p0[r] + d0); p1[r] = __builtin_amdgcn_exp2f(p1[r] + d1); }
    float ps = 0.f;
#pragma unroll
    for (int r = 0; r < 16; ++r) ps += p0[r] + p1[r];
    ps = pair_sum(ps); l = l * alpha + ps;
    PK4(p0, 0, pa0); PK4(p0, 8, pa1); PK4(p1, 0, pa2); PK4(p1, 8, pa3);
    if (__any(alpha < 1.f)) {
        if (c.hi == 0) c.al_l[c.r32] = alpha;
        asm volatile("s_waitcnt lgkmcnt(0)" ::: "memory");
#pragma unroll
        for (int r = 0; r < 16; ++r) { const float al = c.al_l[crow(r, c.hi)];
#pragma unroll
            for (int d = 0; d < 4; ++d) o[d][r] *= al; }
    }
}
template <int MODE, int BUF> __device__ __forceinline__ void branch_step(const Ctx& c, const bf16x8 (&qr)[8], const BranchArgs& A, float slope2k, float s32, int j, unsigned long long mw, f32x16 (&o)[4], float& m, float& l) {
    f32x16 p0, p1; bf16x8 pa0, pa1, pa2, pa3;
    qkt<BUF>(p0, p1, c, qr);
    const int kb = j * 64, dq = A.t - kb - 4 * c.hi;
    if (MODE == MODE_CMP) {
        softmax_tile<MODE>(p0, p1, slope2k, s32, -A.slope2 * (float)(A.t - 31 - 16 * (kb + 4 * c.hi)), true, 0, 0u, 0u, 0u, (int)A.W - kb - 4 * c.hi, m, l, o, c, pa0, pa1, pa2, pa3);
    } else {
        float bias0 = -A.slope2 * (float)dq; bool emask;
        if (MODE == MODE_WIN) emask = (kb + 63 > A.tw0) || (kb <= A.tw0 + 31 - (int)A.W);
        else if (MODE == MODE_SEL) { emask = (kb + 63 > A.tw0); if (!((A.rowsel >> j) & 1u)) bias0 = -__builtin_inff(); }
        else emask = !__all(mw == ~0ull);
        softmax_tile<MODE>(p0, p1, slope2k, s32, bias0, emask, dq, A.W, (unsigned)(mw >> (4 * c.hi)), (unsigned)(mw >> (32 + 4 * c.hi)), 0, m, l, o, c, pa0, pa1, pa2, pa3);
    }
    pv_tile<BUF>(o, c.vb0, pa0, pa1, pa2, pa3);
}
template <int MODE> __device__ __forceinline__ void attn_branch(const Ctx& c, const bf16x8 (&qr)[8], const BranchArgs& A, f32x16 (&o)[4], float& l, float& m) {
    m = -1e30f; l = 0.f;
#pragma unroll
    for (int d = 0; d < 4; ++d) o[d] = f32x16{};
    const float slope2k = (MODE == MODE_CMP) ? A.slope2 * 16.f : A.slope2, s32 = 32.f * slope2k;
    unsigned rest = A.tilemask; int j0 = __builtin_ctz(rest); rest &= rest - 1;
    bool h1 = rest != 0u; int j1 = h1 ? __builtin_ctz(rest) : j0; rest &= rest - 1;
    Stage sA, sB; unsigned long long mwA = 0, mwB = 0, mwC = 0, mwD = 0;
    stage_load(sA, c, A.K, A.ldk, A.V, A.ldv, j0 * 64); if (MODE == MODE_BITS) mwA = A.mrow[j0];
    if (h1) { stage_load(sB, c, A.K, A.ldk, A.V, A.ldv, j1 * 64); if (MODE == MODE_BITS) mwB = A.mrow[j1]; }
    stage_write<0>(sA, c);
    __syncthreads();
    for (;;) {
        const bool h2 = rest != 0u; const int j2 = h2 ? __builtin_ctz(rest) : j1; rest &= rest - 1;
        if (h2) { stage_load(sA, c, A.K, A.ldk, A.V, A.ldv, j2 * 64); if (MODE == MODE_BITS) mwC = A.mrow[j2]; }
        branch_step<MODE, 0>(c, qr, A, slope2k, s32, j0, mwA, o, m, l);
        if (h1) stage_write<1>(sB, c);
        __syncthreads();
        if (!h1) break;
        const bool h3 = rest != 0u; const int j3 = h3 ? __builtin_ctz(rest) : j2; rest &= rest - 1;
        if (h3) { stage_load(sB, c, A.K, A.ldk, A.V, A.ldv, j3 * 64); if (MODE == MODE_BITS) mwD = A.mrow[j3]; }
        branch_step<MODE, 1>(c, qr, A, slope2k, s32, j1, mwB, o, m, l);
        if (h2) stage_write<0>(sA, c);
        __syncthreads();
        if (!h2) break;
        j0 = j2; mwA = mwC; h1 = h3; j1 = j3; mwB = mwD;
    }
}
__device__ __forceinline__ void row_coef(const Ctx& c, float coef, float (&cf)[16]) {
    if (c.hi == 0) c.li_l[c.r32] = coef;
    asm volatile("s_waitcnt lgkmcnt(0)" ::: "memory");
#pragma unroll
    for (int r = 0; r < 16; ++r) cf[r] = c.li_l[crow(r, c.hi)];
    asm volatile("s_waitcnt lgkmcnt(0)" ::: "memory");
}
__device__ __forceinline__ void store_rows_bf16(const Ctx& c, const f32x16 (&v)[4], bf16_t* base, size_t rowstride) {
#pragma unroll
    for (int r = 0; r < 16; ++r) { bf16_t* rp = base + (size_t)crow(r, c.hi) * rowstride;
#pragma unroll
        for (int d0 = 0; d0 < 4; ++d0) { const float x = v[d0][r]; const float xn = __shfl_xor(x, 1);
            if ((c.r32 & 1) == 0) *(unsigned*)(rp + d0 * 32 + c.r32) = cvtpk(x, xn); } }
}

__device__ __forceinline__ void nsa_item(const Args& a, LAS unsigned char* ldsu, int b, int hkv, int qb) {
    unsigned char* ws = launder_s(a.ws); Ctx c = make_ctx(ldsu);
    const int g = c.wid >> 1, half = c.wid & 1, head = hkv * 4 + g;
    const int tl = half * 32 + c.r32, t = qb * 64 + tl;
    const size_t tok = (size_t)b * SEQ + t;
    const float slope2 = __builtin_amdgcn_exp2f(-(float)(head + 1)) * LOG2E;
    bf16x8 qr[8];
    { const bf16_t* qp = (const bf16_t*)(ws + WS_QA) + tok * 1024 + head * 128 + c.hi * 8;
#pragma unroll
      for (int d0 = 0; d0 < 8; ++d0) qr[d0] = *(const bf16x8*)(qp + d0 * 16); }
    const float* gate = (const float*)(ws + WS_SKF) + tok * 32 + head * 3;
    float* TT = (float*)(ws + WS_TT) + ((size_t)LBID * 512 + c.tid) * 64;
    f32x16 o[4]; float cf[16];
    BranchArgs A; A.t = t; A.slope2 = slope2; A.mrow = nullptr; A.rowsel = 0; A.tw0 = qb * 64 + half * 32;
#ifndef NSA_NO_CMP
    {
        const bf16_t* KC = (const bf16_t*)(ws + WS_KC) + (size_t)(b * 2 + hkv) * 128 * 128;
        const bool two = qb >= 16;
        int lim = (t - 31) >> 4; lim = lim > 126 ? 126 : lim;
        A.K = KC; A.V = KC + (size_t)8 * 128 * 128; A.ldk = 128; A.ldv = 128; A.tilemask = two ? 3u : 1u; A.W = (unsigned)lim;
        float l, m; attn_branch<MODE_CMP>(c, qr, A, o, l, m);
        const float inv = l > 0.f ? 1.0f / l : 0.f;
        if (two) {
            LAS float* IMP = (LAS float*)(c.lds + L_IMP) + (g * 64 + tl) * 33;
            float prev = 0.f;
#define IMP_TILE(BUF) do { f32x16 p0, p1; qkt<BUF>(p0, p1, c, qr); \
                bias_mask<MODE_CMP>(p0, p1, -slope2 * (float)(t - 31 - 16 * (BUF * 64 + 4 * c.hi)), slope2 * 16.f, 0, 0u, false, 0u, 0u, lim - BUF * 64 - 4 * c.hi); \
                _Pragma("unroll") for (int r = 0; r < 16; ++r) { p0[r] = __builtin_amdgcn_exp2f(p0[r] - m) * inv; p1[r] = __builtin_amdgcn_exp2f(p1[r] - m) * inv; } \
                _Pragma("unroll") for (int k = 0; k < 8; ++k) { const int mm = k & 3; \
                    const float s4 = (k < 4) ? (p0[4 * mm] + p0[4 * mm + 1]) + (p0[4 * mm + 2] + p0[4 * mm + 3]) : (p1[4 * mm] + p1[4 * mm + 1]) + (p1[4 * mm + 2] + p1[4 * mm + 3]); \
                    const float lst = (k < 4) ? p0[4 * mm + 3] : p1[4 * mm + 3]; \
                    auto rr = __builtin_amdgcn_permlane32_swap(__float_as_uint(lst), __float_as_uint(lst), false, false); \
                    const float from_lo = __uint_as_float(rr[0]), from_hi = __uint_as_float(rr[1]); \
                    IMP[2 * (BUF * 8 + k) + c.hi] = s4 + (c.hi ? from_lo : prev);     \
                    prev = from_hi; } } while (0)
            IMP_TILE(0); IMP_TILE(1);
#undef IMP_TILE
        }
        row_coef(c, gate[0] * inv, cf);
#pragma unroll
        for (int d0 = 0; d0 < 4; ++d0)
#pragma unroll
            for (int r4 = 0; r4 < 4; ++r4) { f32x4 v = {o[d0][4 * r4] * cf[4 * r4], o[d0][4 * r4 + 1] * cf[4 * r4 + 1], o[d0][4 * r4 + 2] * cf[4 * r4 + 2], o[d0][4 * r4 + 3] * cf[4 * r4 + 3]}; *(f32x4*)(TT + d0 * 16 + r4 * 4) = v; }
        __syncthreads();
    }
#endif
#ifndef NSA_NO_SELECT
    {
        LAS unsigned* SELM = (LAS unsigned*)(c.lds + L_SELM);
        if (qb <= 15) { if (c.tid <= 64) SELM[c.tid] = (2u << qb) - 1u; }
        else {
            LAS float* VS = (LAS float*)(c.lds + L_MISC + 256);
            const int tq = c.tid & 63, jg = c.tid >> 6;
            { LAS const float* I0 = (LAS const float*)(c.lds + L_IMP) + tq * 33;
#pragma unroll
              for (int e = 0; e < 4; ++e) { const int j = 4 * jg + e; VS[tq * 33 + j] = (I0[j] + I0[64 * 33 + j]) + (I0[2 * 64 * 33 + j] + I0[3 * 64 * 33 + j]); } }
            if (c.tid < 64) SELM[c.tid] = 1u | (1u << qb) | (1u << (qb - 1));
            __syncthreads();
            float vj[4]; int rank[4] = {0, 0, 0, 0};
#pragma unroll
            for (int e = 0; e < 4; ++e) vj[e] = VS[tq * 33 + 4 * jg + e];
#pragma unroll 4
            for (int j2 = 1; j2 <= qb - 2; ++j2) { const float v2 = VS[tq * 33 + j2];
#pragma unroll
                for (int e = 0; e < 4; ++e) rank[e] += ((v2 > vj[e]) || (v2 == vj[e] && j2 < 4 * jg + e)) ? 1 : 0; }
            unsigned bits = 0u;
#pragma unroll
            for (int e = 0; e < 4; ++e) { const int j = 4 * jg + e; if (j >= 1 && j <= qb - 2 && rank[e] < 13) bits |= 1u << j; }
            if (bits) __hip_atomic_fetch_or(SELM + tq, bits, __ATOMIC_RELAXED, __HIP_MEMORY_SCOPE_WORKGROUP);
            __syncthreads();
            if (c.wid == 0) { unsigned any = SELM[c.lane];
#pragma unroll
                for (int ofs = 32; ofs >= 1; ofs >>= 1) any |= (unsigned)__shfl_xor((int)any, ofs);
                if (c.lane == 0) SELM[64] = any; }
        }
        __syncthreads();
    }
#endif
    A.ldk = 1536; A.ldv = 1536; A.W = 0x7fffffffu;
    const bf16_t* KVb = (const bf16_t*)(ws + WS_KV) + (size_t)b * SEQ * 1536 + hkv * 128;
#ifndef NSA_NO_SEL
    {
        c = make_ctx(ldsu); ws = launder_s(ws);
        LAS const unsigned* SELM = (LAS const unsigned*)(c.lds + L_SELM);
        A.K = KVb + 512; A.V = KVb + 768; A.rowsel = SELM[tl];
        A.tilemask = (unsigned)__builtin_amdgcn_readfirstlane((int)SELM[64]) & ((2u << qb) - 1u);
        float l, m; attn_branch<MODE_SEL>(c, qr, A, o, l, m);
        row_coef(c, gate[1] * (l > 0.f ? 1.0f / l : 0.f), cf);
#pragma unroll
        for (int d0 = 0; d0 < 4; ++d0) {
#pragma unroll
            for (int r4 = 0; r4 < 4; ++r4) { f32x4 v = *(const f32x4*)(TT + d0 * 16 + r4 * 4);
                v[0] += o[d0][4 * r4] * cf[4 * r4]; v[1] += o[d0][4 * r4 + 1] * cf[4 * r4 + 1]; v[2] += o[d0][4 * r4 + 2] * cf[4 * r4 + 2]; v[3] += o[d0][4 * r4 + 3] * cf[4 * r4 + 3]; *(f32x4*)(TT + d0 * 16 + r4 * 4) = v; }
            asm volatile("" ::: "memory"); }
    }
#endif
#ifndef NSA_NO_WIN
    {
        c = make_ctx(ldsu); ws = launder_s(ws);
        A.K = KVb + 1024; A.V = KVb + 1280; A.W = 512u;
        const int jlo = qb >= 8 ? qb - 8 : 0;
        A.tilemask = ((2u << qb) - 1u) & ~((1u << jlo) - 1u);
        float l, m; attn_branch<MODE_WIN>(c, qr, A, o, l, m);
        row_coef(c, gate[2] * (l > 0.f ? 1.0f / l : 0.f), cf);
#pragma unroll
        for (int d0 = 0; d0 < 4; ++d0) {
#pragma unroll
            for (int r4 = 0; r4 < 4; ++r4) { const f32x4 v = *(const f32x4*)(TT + d0 * 16 + r4 * 4);
                o[d0][4 * r4] = v[0] + o[d0][4 * r4] * cf[4 * r4]; o[d0][4 * r4 + 1] = v[1] + o[d0][4 * r4 + 1] * cf[4 * r4 + 1]; o[d0][4 * r4 + 2] = v[2] + o[d0][4 * r4 + 2] * cf[4 * r4 + 2]; o[d0][4 * r4 + 3] = v[3] + o[d0][4 * r4 + 3] * cf[4 * r4 + 3]; }
            asm volatile("" ::: "memory"); }
        store_rows_bf16(c, o, (bf16_t*)(ws + WS_BR) + ((size_t)b * SEQ + qb * 64 + half * 32) * 1024 + head * 128, 1024);
    }
#endif
}

__device__ __forceinline__ void dsa_item(const Args& a, LAS unsigned char* ldsu, int b, int h, int qb) {
    unsigned char* ws = launder_s(a.ws); const Ctx c = make_ctx(ldsu);
    const int t = qb * 256 + c.wid * 32 + c.r32; const size_t tok = (size_t)b * SEQ + t;
    bf16x8 qr[8];
    { const bf16_t* qp = (const bf16_t*)(ws + WS_QB) + tok * 1024 + h * 128 + c.hi * 8;
#pragma unroll
      for (int d0 = 0; d0 < 8; ++d0) qr[d0] = *(const bf16x8*)(qp + d0 * 16); }
    BranchArgs A; A.tw0 = qb * 256 + c.wid * 32; A.ldk = 2048; A.ldv = 2048; A.t = t; A.slope2 = __builtin_amdgcn_exp2f(-(float)(h + 1)) * LOG2E; A.W = 0; A.rowsel = 0;
    const bf16_t* kv = (const bf16_t*)(ws + WS_KVUP) + (size_t)b * SEQ * 2048 + h * 128;
    A.K = kv; A.V = kv + 1024; A.mrow = (const unsigned long long*)(ws + WS_MASK) + tok * 32;
    const int nt = 4 * qb + 4; A.tilemask = nt >= 32 ? 0xffffffffu : ((1u << nt) - 1u);
    f32x16 o[4]; float l, m, cf[16];
    attn_branch<MODE_BITS>(c, qr, A, o, l, m);
    row_coef(c, l > 0.f ? 1.0f / l : 0.f, cf);
#pragma unroll
    for (int d0 = 0; d0 < 4; ++d0)
#pragma unroll
        for (int r = 0; r < 16; ++r) o[d0][r] *= cf[r];
    store_rows_bf16(c, o, (bf16_t*)(ws + WS_BR) + (size_t)NTOK * 1024 + ((size_t)b * SEQ + qb * 256 + c.wid * 32) * 1024 + h * 128, 1024);
}

__device__ __forceinline__ void gmlp_item(const Args& a, LAS unsigned char* ldsu, int l, int b, int ch, int gp) {
    unsigned char* ws = launder_s(a.ws); const Ctx c = make_ctx(ldsu);
    const size_t tok0 = (size_t)b * SEQ + ch * 128;
    const bf16_t* HV = (const bf16_t*)(ws + WS_HV);
#pragma unroll
    for (int gs = 0; gs < 2; ++gs)
#pragma unroll
        for (int st = 0; st < 2; ++st) {
            const bf16_t* vp = HV + (tok0 + st * 64) * 1024 + (2 * gp + gs) * 128 + c.sc;
            const bf16x8 x0 = *(const bf16x8*)(vp + (size_t)c.sr * 1024), x1 = *(const bf16x8*)(vp + (size_t)(32 + c.sr) * 1024);
            *(LAS bf16x8*)(c.lds + L_V + (2 * gs + st) * SHM + c.vst0) = x0; *(LAS bf16x8*)(c.lds + L_V + (2 * gs + st) * SHM + c.vst1) = x1;
        }
    __syncthreads();
    const int gs = c.wid >> 2, wq = c.wid & 3, g = 2 * gp + gs;
    const bf16_t* Wp = (const bf16_t*)(ws + WS_WSTRIL) + (((size_t)l * 8 + g) * 128 + wq * 32 + c.r32) * 128 + c.hi * 8;
    f32x16 o[4] = {};
    bf16x8 pa0 = *(const bf16x8*)(Wp), pa1 = *(const bf16x8*)(Wp + 16), pa2 = *(const bf16x8*)(Wp + 32), pa3 = *(const bf16x8*)(Wp + 48);
    if (gs == 0) pv_tile<0>(o, c.vb0, pa0, pa1, pa2, pa3); else pv_tile<2>(o, c.vb0, pa0, pa1, pa2, pa3);
    if (wq >= 2) {
        pa0 = *(const bf16x8*)(Wp + 64); pa1 = *(const bf16x8*)(Wp + 80); pa2 = *(const bf16x8*)(Wp + 96); pa3 = *(const bf16x8*)(Wp + 112);
        if (gs == 0) pv_tile<1>(o, c.vb0, pa0, pa1, pa2, pa3); else pv_tile<3>(o, c.vb0, pa0, pa1, pa2, pa3);
    }
    const float* bs = a.in[11] + ((size_t)l * 8 + g) * 128 + wq * 32;
    const bf16_t* HU = (const bf16_t*)(ws + WS_HU) + (tok0 + wq * 32) * 1024 + g * 128;
#pragma unroll
    for (int r = 0; r < 16; ++r) { const int rr = crow(r, c.hi); const float bias = bs[rr];
#pragma unroll
        for (int d0 = 0; d0 < 4; ++d0) o[d0][r] = (o[d0][r] + bias) * bf2f(HU[(size_t)rr * 1024 + d0 * 32 + c.r32]); }
    store_rows_bf16(c, o, (bf16_t*)(ws + WS_BR) + (size_t)2 * NTOK * 1024 + (tok0 + wq * 32) * 1024 + g * 128, 1024);
    __syncthreads();
}
}

struct EpiKvUp {
    static constexpr bool PERM = true, AFTER_DRAIN = false;
    unsigned char* ws;
    __device__ __forceinline__ void operator()(const f32x4 (&acc)[2][2][4][2], const pg8::Unit& u, int wr, int wc, int fr, int fq) const {
        bf16_t* base = (bf16_t*)(ws + WS_KVUP); const float* psq = (const float*)(ws + WS_PSQ);
        const int row0 = u.pm * 256 + wr * 64 + fr, col0 = u.pn * 256 + wc * 32 + 8 * fq;
#pragma unroll
        for (int ai = 0; ai < 2; ++ai)
#pragma unroll
            for (int m = 0; m < 4; ++m) {
                const int row = row0 + ai * 128 + m * 16; const f32x4 q = *(const f32x4*)(psq + (size_t)row * 4);
                const float rs = __builtin_amdgcn_rsqf(((q[0] + q[1]) + (q[2] + q[3])) * (1.0f / 256.0f) + LN_EPS);
                bf16_t* rowp = base + (size_t)row * 2048 + col0;
#pragma unroll
                for (int bj = 0; bj < 2; ++bj) { const f32x4 v0 = acc[ai][bj][m][0] * rs, v1 = acc[ai][bj][m][1] * rs;
                    u32x4 w; w.x = cvtpk(v0[0], v0[1]); w.y = cvtpk(v0[2], v0[3]); w.z = cvtpk(v1[0], v1[1]); w.w = cvtpk(v1[2], v1[3]);
                    *(u32x4*)(rowp + bj * 128) = w; }
                asm volatile("" ::: "memory");
            }
    }
};

__device__ __forceinline__ void gmlp_ln_rows(const Args& a, int l) {
    unsigned char* ws = launder_s(a.ws); const int tid = LTID, wid = tid >> 6, lane = tid & 63;
    const float* g = a.in[8] + (size_t)l * 1024; const float* bta = a.in[9] + (size_t)l * 1024;
    for (int row = LBID * 8 + wid; row < NTOK; row += gridDim.x * 8) {
        bf16_t* p = (bf16_t*)(ws + WS_HV) + (size_t)row * 1024 + lane * 8;
        const bf16x8 x0 = *(const bf16x8*)p, x1 = *(const bf16x8*)(p + 512);
        float v[16];
#pragma unroll
        for (int e = 0; e < 8; ++e) { v[e] = bf2f((bf16_t)x0[e]); v[8 + e] = bf2f((bf16_t)x1[e]); }
        float s = 0.f;
#pragma unroll
        for (int e = 0; e < 16; ++e) s += v[e];
        const float mean = wave_sum(s) * (1.0f / 1024.0f);
        float q = 0.f;
#pragma unroll
        for (int e = 0; e < 16; ++e) { const float d = v[e] - mean; q += d * d; }
        const float rstd = 1.0f / sqrtf(wave_sum(q) * (1.0f / 1024.0f) + LN_EPS);
        float o[16];
#pragma unroll
        for (int e = 0; e < 8; ++e) { o[e] = (v[e] - mean) * rstd * g[lane * 8 + e] + bta[lane * 8 + e]; o[8 + e] = (v[8 + e] - mean) * rstd * g[512 + lane * 8 + e] + bta[512 + lane * 8 + e]; }
        u32x4 w0 = {cvtpk(o[0], o[1]), cvtpk(o[2], o[3]), cvtpk(o[4], o[5]), cvtpk(o[6], o[7])}, w1 = {cvtpk(o[8], o[9]), cvtpk(o[10], o[11]), cvtpk(o[12], o[13]), cvtpk(o[14], o[15])};
        *(u32x4*)p = w0; *(u32x4*)(p + 512) = w1;
    }
}

__device__ __forceinline__ void compress_item(const Args& a, int l, LAS unsigned char* lds, int item) {
    unsigned char* ws = launder_s(a.ws);
    const int tid = LTID, wid = __builtin_amdgcn_readfirstlane(tid >> 6), lane = tid & 63, r32 = lane & 31, hi = lane >> 5;
    const int kv = item >> 5, rt = item & 31;
    const int R = rt * 32 + r32, bh = R >> 7; int i = R & 127; if (i > 126) i = 126;
    const int b = bh >> 1, hkv = bh & 1;
    const bf16_t* src = (const bf16_t*)(ws + WS_KV) + ((size_t)b * SEQ + 16 * i + 4 * wid) * 1536 + kv * 256 + hkv * 128 + hi * 8;
    const bf16_t* w1 = (const bf16_t*)(ws + WS_W1) + ((size_t)l * 2 + kv) * 128 * 4096 + (size_t)r32 * 4096 + wid * 512 + hi * 8;
    f32x16 acc[4] = {};
    bf16x8 A0[4], B0[4][4], A1[4], B1[4][4];
#define CMP_LOAD(A_, B_, c_) do { _Pragma("unroll") for (int jj = 0; jj < 4; ++jj) { const int s_ = (c_) * 4 + jj, tk_ = s_ >> 3, dk_ = s_ & 7; \
        A_[jj] = *(const bf16x8*)(src + (size_t)tk_ * 1536 + dk_ * 16); \
        _Pragma("unroll") for (int nb = 0; nb < 4; ++nb) B_[jj][nb] = *(const bf16x8*)(w1 + (size_t)nb * 32 * 4096 + tk_ * 128 + dk_ * 16); } } while (0)
#define CMP_MMA(A_, B_) do { _Pragma("unroll") for (int jj = 0; jj < 4; ++jj) _Pragma("unroll") for (int nb = 0; nb < 4; ++nb) acc[nb] = MFMA32(A_[jj], B_[jj][nb], acc[nb]); } while (0)
    CMP_LOAD(A0, B0, 0);
#pragma unroll 1
    for (int c = 0; c < 8; c += 2) {
        CMP_LOAD(A1, B1, c + 1); CMP_MMA(A0, B0);
        if (c + 2 < 8) CMP_LOAD(A0, B0, c + 2);
        CMP_MMA(A1, B1);
    }
#undef CMP_LOAD
#undef CMP_MMA
    LAS float* red = (LAS float*)lds;
#pragma unroll
    for (int nb = 0; nb < 4; ++nb)
#pragma unroll
        for (int r = 0; r < 16; ++r) red[((wid * 4 + nb) * 16 + r) * 64 + lane] = acc[nb][r];
    __syncthreads();
    LAS bf16_t* G = (LAS bf16_t*)(lds + 131072);
    const float* c1 = (const float*)(ws + WS_C1) + ((size_t)l * 2 + kv) * 16 * 128;
    for (int idx = tid; idx < 4096; idx += 512) {
        float s = 0.f;
#pragma unroll
        for (int w = 0; w < 8; ++w) s += red[w * 4096 + idx];
        const int ln = idx & 63, r = (idx >> 6) & 15, nb = idx >> 10;
        const int row = crow(r, ln >> 5), n = nb * 32 + (ln & 31);
        float cb = 0.f;
#pragma unroll
        for (int sl = 0; sl < 16; ++sl) cb += c1[sl * 128 + n];
        G[row * 136 + n] = f2bf(gelu_tanh(s + cb));
    }
    __syncthreads();
    if (wid < 4) {
        const bf16_t* w2 = (const bf16_t*)(ws + WS_W2) + ((size_t)l * 2 + kv) * 128 * 128 + (size_t)(wid * 32 + r32) * 128 + hi * 8;
        f32x16 o = {};
#pragma unroll
        for (int ks = 0; ks < 8; ++ks) { const bf16x8 af = *(LAS const bf16x8*)(G + r32 * 136 + ks * 16 + hi * 8); const bf16x8 bfr = *(const bf16x8*)(w2 + ks * 16); o = MFMA32(af, bfr, o); }
        bf16_t* dst = (bf16_t*)(ws + WS_KC) + (size_t)kv * 8 * 128 * 128;
#pragma unroll
        for (int r = 0; r < 16; ++r) { const int RR = rt * 32 + crow(r, hi); dst[(size_t)RR * 128 + wid * 32 + r32] = f2bf(o[r]); }
    }
    __syncthreads();
}

__device__ __forceinline__ unsigned sortable(float f) { unsigned u = __float_as_uint(f); if ((u << 1) == 0u) u = 0u; return (u & 0x80000000u) ? ~u : (u | 0x80000000u); }
__device__ __forceinline__ void indexer_item(const Args& a, LAS unsigned char* lds, int item) {
    unsigned char* ws = launder_s(a.ws);
    const int tid = LTID, wid = __builtin_amdgcn_readfirstlane(tid >> 6), lane = tid & 63, r32 = lane & 31, hi = lane >> 5;
    const int b = item >> 7, t0 = (item & 127) * 16;
    unsigned long long* MASK = (unsigned long long*)(ws + WS_MASK);
    if (t0 + 16 <= 256) {
        for (int q = wid * 2; q < wid * 2 + 2; ++q) { const int t = t0 + q;
            if (lane < 32) { const int lo = lane * 64; unsigned long long w = 0ull; if (t >= lo + 63) w = ~0ull; else if (t >= lo) w = (2ull << (t - lo)) - 1ull;
                MASK[((size_t)b * SEQ + t) * 32 + lane] = w; } }
        return;
    }
    LAS unsigned* SC = (LAS unsigned*)lds;
    LAS float* WI = (LAS float*)(lds + 131072);
    if (tid < 64) WI[tid] = ((const float*)(ws + WS_SKF))[((size_t)b * SEQ + t0 + (tid >> 2)) * 32 + 24 + (tid & 3)];
    bf16x8 aq[2][4];
#pragma unroll
    for (int rb = 0; rb < 2; ++rb) { const bf16_t* qp = (const bf16_t*)(ws + WS_QI) + ((size_t)b * SEQ + t0 + rb * 8 + (r32 >> 2)) * 256 + (r32 & 3) * 64 + hi * 8;
#pragma unroll
        for (int ks = 0; ks < 4; ++ks) aq[rb][ks] = *(const bf16x8*)(qp + ks * 16); }
    __syncthreads();
    const int nch = (t0 + 16 + 31) >> 5;
    const bf16_t* KI = (const bf16_t*)(ws + WS_KI) + (size_t)b * SEQ * 64;
    bf16x8 bkA[4], bkB[4];
#define IDX_LOAD(bk_, ch_) do { const bf16_t* kp_ = KI + (size_t)((ch_) * 32 + r32) * 64 + hi * 8; _Pragma("unroll") for (int ks = 0; ks < 4; ++ks) bk_[ks] = *(const bf16x8*)(kp_ + ks * 16); } while (0)
#define IDX_COMPUTE(bk_, ch_) do { _Pragma("unroll") for (int rb = 0; rb < 2; ++rb) { f32x16 s = {}; \
            _Pragma("unroll") for (int ks = 0; ks < 4; ++ks) s = MFMA32(aq[rb][ks], bk_[ks], s); \
              \
            _Pragma("unroll") for (int mq = 0; mq < 4; ++mq) { const int q = rb * 8 + 2 * mq + hi; float sc = 0.f; \
                _Pragma("unroll") for (int h = 0; h < 4; ++h) sc += fmaxf(s[mq * 4 + h], 0.f) * WI[q * 4 + h]; \
                const int key = (ch_) * 32 + r32; SC[q * 2048 + key] = (key <= t0 + q) ? sortable(sc) : 0u; } } } while (0)
    if (wid < nch) IDX_LOAD(bkA, wid);
#pragma unroll 1
    for (int ch = wid; ch < nch; ch += 16) {
        if (ch + 8 < nch) IDX_LOAD(bkB, ch + 8);
        IDX_COMPUTE(bkA, ch);
        if (ch + 8 < nch) { if (ch + 16 < nch) IDX_LOAD(bkA, ch + 16); IDX_COMPUTE(bkB, ch + 8); }
    }
#undef IDX_LOAD
#undef IDX_COMPUTE
    __syncthreads();
    for (int q = wid * 2; q < wid * 2 + 2; ++q) {
        const int t = t0 + q; const int nw = (t >> 6) + 1;
        unsigned kk[32];
#pragma unroll
        for (int i = 0; i < 32; ++i) kk[i] = (i < nw && (i * 64 + lane) < nch * 32) ? SC[q * 2048 + i * 64 + lane] : 0u;
        unsigned T = 0u; bool exact = false;
        for (int bit = 31; bit >= 0; --bit) {
            const unsigned cand = T | (1u << bit); int cnt = 0;
#pragma unroll
            for (int i = 0; i < 32; ++i) cnt += __popcll(__ballot(kk[i] >= cand));
            if (cnt >= 256) { T = cand; if (cnt == 256) { exact = true; break; } }
        }
        int need = 0;
        if (!exact) { int ngt = 0;
#pragma unroll
            for (int i = 0; i < 32; ++i) ngt += __popcll(__ballot(kk[i] > T));
            need = 256 - ngt; }
        unsigned long long mine = 0ull;
#pragma unroll
        for (int i = 0; i < 32; ++i) {
            unsigned long long w;
            if (exact) w = __ballot(kk[i] >= T);
            else { w = __ballot(kk[i] > T); unsigned long long eq = __ballot(kk[i] == T);
                   const int ne = __popcll(eq);
                   if (ne <= need) { w |= eq; need -= ne; }
                   else { while (need > 0) { const unsigned long long low = eq & (0ull - eq); w |= low; eq ^= low; --need; } } }
            if (lane == i) mine = w;
        }
        if (lane < 32) MASK[((size_t)b * SEQ + t) * 32 + lane] = mine;
    }
    __syncthreads();
}

struct BranchSched {
    int G, c;
    __device__ __forceinline__ bool next(int i, pg8::Unit& u) const {
        const int n = i % 3, idx = (i / 3) * G + c; if (idx >= 256) return false;
        pg8::StaticOrder so; so.init(NTOK, DM, 256, idx); so.next(0, u); u.pm += n * 32; u.pn += n * 8; return true;
    }
    __device__ __forceinline__ void a_ready(const pg8::Unit&) const {}
    __device__ __forceinline__ void done(const pg8::Unit&) const {}
};
struct EpiBranch {
    static constexpr bool PERM = true, AFTER_DRAIN = false;
    unsigned char* ws;
    __device__ __forceinline__ bool keep(const pg8::Unit& u) const { return (u.pm >> 5) < 2; }
    __device__ __forceinline__ void operator()(f32x4 (&acc)[2][2][4][2], const pg8::Unit& u, int wr, int wc, int fr, int fq) const {
        const int n = u.pm >> 5, pm = u.pm & 31, pn = u.pn & 7;
        bf16_t* O = (bf16_t*)(ws + WS_MIXB); const bf16_t* Gt = (const bf16_t*)(ws + WS_HG) + n * 2048;
        const int row0 = pm * 256 + wr * 64 + fr, col0 = pn * 256 + wc * 32 + 8 * fq;
#pragma unroll
        for (int ai = 0; ai < 2; ++ai)
#pragma unroll
            for (int m = 0; m < 4; ++m) { const size_t row = (size_t)(row0 + ai * 128 + m * 16);
#pragma unroll
                for (int bj = 0; bj < 2; ++bj) { const int col = col0 + bj * 128;
                    const u32x4 gw = *(const u32x4*)(Gt + row * 6144 + col);
                    float gv[8] = {__uint_as_float(gw.x << 16), __uint_as_float(gw.x & 0xffff0000u), __uint_as_float(gw.y << 16), __uint_as_float(gw.y & 0xffff0000u),
                                   __uint_as_float(gw.z << 16), __uint_as_float(gw.z & 0xffff0000u), __uint_as_float(gw.w << 16), __uint_as_float(gw.w & 0xffff0000u)};
                    if (n < 2) {
                        const u32x4 hw = *(const u32x4*)(Gt + 2048 + row * 6144 + col);
                        const float hv[8] = {__uint_as_float(hw.x << 16), __uint_as_float(hw.x & 0xffff0000u), __uint_as_float(hw.y << 16), __uint_as_float(hw.y & 0xffff0000u),
                                             __uint_as_float(hw.z << 16), __uint_as_float(hw.z & 0xffff0000u), __uint_as_float(hw.w << 16), __uint_as_float(hw.w & 0xffff0000u)};
#pragma unroll
                        for (int e = 0; e < 8; ++e) gv[e] *= __builtin_amdgcn_rcpf(fmaxf(hv[e], 1e-30f));
#pragma unroll
                        for (int e = 0; e < 4; ++e) { acc[ai][bj][m][0][e] *= gv[e]; acc[ai][bj][m][1][e] *= gv[4 + e]; }
                    } else {
                        const f32x4 v0 = acc[ai][bj][m][0], v1 = acc[ai][bj][m][1];
                        u32x4 w; w.x = cvtpk(v0[0] * gv[0], v0[1] * gv[1]); w.y = cvtpk(v0[2] * gv[2], v0[3] * gv[3]); w.z = cvtpk(v1[0] * gv[4], v1[1] * gv[5]); w.w = cvtpk(v1[2] * gv[6], v1[3] * gv[7]);
                        *(u32x4*)(O + row * 2048 + col) = w; } }
                asm volatile("" ::: "memory");
            }
    }
};
struct EpiOut {
    static constexpr bool PERM = false, AFTER_DRAIN = false;
    const float* x; float* pre;
    __device__ __forceinline__ void operator()(const f32x4 (&acc)[2][2][4][2], const pg8::Unit& u, int wr, int wc, int fr, int fq) const {
        const int row0 = u.pm * 256 + wr * 64 + fr, col0 = u.pn * 256 + wc * 32 + 4 * fq;
#pragma unroll
        for (int ai = 0; ai < 2; ++ai)
#pragma unroll
            for (int m = 0; m < 4; ++m) { const size_t off = (size_t)(row0 + ai * 128 + m * 16) * 2048 + col0;
#pragma unroll
                for (int bj = 0; bj < 2; ++bj)
#pragma unroll
                    for (int n = 0; n < 2; ++n) { const f32x4 xv = *(const f32x4*)(x + off + bj * 128 + n * 16); *(f32x4*)(pre + off + bj * 128 + n * 16) = xv * ALPHA + acc[ai][bj][m][n]; } }
    }
};

__device__ __forceinline__ void ln_row(f32x4 (&v)[8], const float* g, const float* bta, int lane) {
    float s = 0.f;
#pragma unroll
    for (int i = 0; i < 8; ++i) s += (v[i][0] + v[i][1]) + (v[i][2] + v[i][3]);
    const float mean = wave_sum(s) * (1.0f / 2048.0f);
    float q = 0.f;
#pragma unroll
    for (int i = 0; i < 8; ++i) { const f32x4 d = v[i] - mean; q += (d[0] * d[0] + d[1] * d[1]) + (d[2] * d[2] + d[3] * d[3]); }
    const float rstd = 1.0f / sqrtf(wave_sum(q) * (1.0f / 2048.0f) + LN_EPS);
#pragma unroll
    for (int i = 0; i < 8; ++i) { const f32x4 gg = *(const f32x4*)(g + i * 256 + lane * 4), bb = *(const f32x4*)(bta + i * 256 + lane * 4); v[i] = (v[i] - mean) * rstd * gg + bb; }
}

__device__ __forceinline__ void p6_ln1_route(const Args& a, int l, LAS unsigned char* lds) {
    unsigned char* ws = launder_s(a.ws);
    const int tid = LTID, wid = __builtin_amdgcn_readfirstlane(tid >> 6), lane = tid & 63, r32 = lane & 31, hi = lane >> 5;
    const float* pre = (const float*)(ws + WS_MIXT); float* x1f = (float*)(ws + WS_X1F); bf16_t* x1b = (bf16_t*)(ws + WS_X1B);
    const float* g = a.in[14] + (size_t)l * DM; const float* bta = a.in[15] + (size_t)l * DM;
    unsigned* cnt = (unsigned*)(ws + WS_CTL) + CW_CNT + l * 1024;
    for (int it = LBID; it < NTOK / 32; it += gridDim.x) {
        const int row0 = it * 32;
        for (int rr = 0; rr < 4; ++rr) { const size_t row = (size_t)(row0 + wid * 4 + rr);
            f32x4 v[8];
#pragma unroll
            for (int i = 0; i < 8; ++i) v[i] = *(const f32x4*)(pre + row * DM + i * 256 + lane * 4);
            ln_row(v, g, bta, lane);
#pragma unroll
            for (int i = 0; i < 8; ++i) { *(f32x4*)(x1f + row * DM + i * 256 + lane * 4) = v[i]; u32x2 w; w.x = cvtpk(v[i][0], v[i][1]); w.y = cvtpk(v[i][2], v[i][3]); *(u32x2*)(x1b + row * DM + i * 256 + lane * 4) = w; }
        }
        asm volatile("s_waitcnt vmcnt(0)" ::: "memory");
        __syncthreads();
        f32x16 acc = {};
        { const float* xp = x1f + (size_t)(row0 + r32) * DM + 256 * wid + 8 * hi;
          const bf16_t* wh = (const bf16_t*)(ws + WS_WR) + (size_t)l * 2 * 32 * DM + (size_t)r32 * DM + 256 * wid + 8 * hi; const bf16_t* wl = wh + 32 * DM;
#pragma unroll 4
          for (int ks = 0; ks < 16; ++ks) {
              const f32x4 x0 = *(const f32x4*)(xp + ks * 16), x1 = *(const f32x4*)(xp + ks * 16 + 4);
              const bf16x8 xh = pack8(x0, x1);
              f32x4 r0, r1;
#pragma unroll
              for (int e = 0; e < 4; ++e) { r0[e] = x0[e] - bf2f((bf16_t)xh[e]); r1[e] = x1[e] - bf2f((bf16_t)xh[4 + e]); }
              const bf16x8 xl = pack8(r0, r1);
              const bf16x8 bh = *(const bf16x8*)(wh + ks * 16), bl = *(const bf16x8*)(wl + ks * 16);
              acc = MFMA32(xh, bh, acc); acc = MFMA32(xl, bh, acc); acc = MFMA32(xh, bl, acc);
          } }
        LAS float* red = (LAS float*)lds;
#pragma unroll
        for (int r = 0; r < 16; ++r) red[(wid * 16 + r) * 64 + lane] = acc[r];
        __syncthreads();
        LAS float* LG = (LAS float*)(lds + 32768);
        if (tid < 32) ((LAS unsigned*)(lds + 40960))[tid] = 0u;
        for (int idx = tid; idx < 1024; idx += 512) { float s = 0.f;
#pragma unroll
            for (int w = 0; w < 8; ++w) s += red[w * 1024 + idx];
            const int ln = idx & 63, r = idx >> 6; LG[crow(r, ln >> 5) * 33 + (ln & 31)] = s; }
        __syncthreads();
        if (tid < 32) {
            const int row = row0 + tid; LAS const float* lg = LG + tid * 33;
            float gl[4];
#pragma unroll
            for (int j = 0; j < 4; ++j) gl[j] = lg[j] + a.in[17][l * 4 + j];
            int gi = 0; float gm = gl[0];
#pragma unroll
            for (int j = 1; j < 4; ++j) if (gl[j] > gm) { gm = gl[j]; gi = j; }
            float den = 0.f;
#pragma unroll
            for (int j = 0; j < 4; ++j) den += expf(gl[j] - gm);
            const float gp = 1.0f / den;
            float el[4];
#pragma unroll
            for (int j = 0; j < 4; ++j) el[j] = lg[4 + gi * 4 + j] + a.in[19][l * 16 + gi * 4 + j];
            int e1 = 0; float m1 = el[0];
#pragma unroll
            for (int j = 1; j < 4; ++j) if (el[j] > m1) { m1 = el[j]; e1 = j; }
            int e2 = -1; float m2 = 0.f;
#pragma unroll
            for (int j = 0; j < 4; ++j) if (j != e1 && (e2 < 0 || el[j] > m2)) { m2 = el[j]; e2 = j; }
            const float ex = expf(m2 - m1), w1 = 1.0f / (1.0f + ex), w2 = ex / (1.0f + ex);
            const int E1 = gi * 4 + e1, E2 = gi * 4 + e2;
            LAS unsigned* lc = (LAS unsigned*)(lds + 40960);
            const unsigned p1 = __hip_atomic_fetch_add(lc + E1, 1u, __ATOMIC_RELAXED, __HIP_MEMORY_SCOPE_WORKGROUP);
            const unsigned p2 = __hip_atomic_fetch_add(lc + E2, 1u, __ATOMIC_RELAXED, __HIP_MEMORY_SCOPE_WORKGROUP);
            asm volatile("s_waitcnt lgkmcnt(0)" ::: "memory");
            if (tid < 16) ((unsigned*)(ws + WS_CTL) + CW_CNTW)[it * 16 + tid] = lc[tid];
            int* tk = (int*)(ws + WS_TOK); float* tw = (float*)(ws + WS_TOK) + 4 * NTOK;
            tk[row * 2] = E1; tk[row * 2 + 1] = E2; tk[2 * NTOK + row * 2] = (int)p1; tk[2 * NTOK + row * 2 + 1] = (int)p2;
            tw[row * 2] = gp * w1; tw[row * 2 + 1] = gp * w2;
        }
        __syncthreads();
    }
}

__device__ __forceinline__ int moe_offsets(const Args& a, int l, LAS int* off) {
    const unsigned* cnt = (const unsigned*)(a.ws + WS_CTL) + CW_CNT + l * 1024;
    if (LTID == 0) { int o = 0; for (int e = 0; e < NEXP; ++e) { off[e] = o; const int c = (int)__hip_atomic_load(cnt + 64 * e, __ATOMIC_RELAXED, __HIP_MEMORY_SCOPE_AGENT); o += (c + 255) & ~255; } off[NEXP] = o; }
    __syncthreads();
    return off[NEXP] >> 8;
}
__device__ __forceinline__ void p7_gather(const Args& a, int l, LAS unsigned char* lds) {
    unsigned char* ws = launder_s(a.ws);
    const int tid = LTID, wid = tid >> 6, lane = tid & 63;
    LAS int* off = (LAS int*)lds; LAS int* PS = off + 32; LAS int* PP = PS + 512; LAS int* BASE = PP + 512;
    const unsigned* cntw = (const unsigned*)(ws + WS_CTL) + CW_CNTW;
    { const int e = tid & 15, part = tid >> 4; int s = 0;
#pragma unroll
      for (int k = 0; k < 8; ++k) s += (int)cntw[(part * 8 + k) * 16 + e];
      PS[part * 16 + e] = s; }
    __syncthreads();
    if (tid < 16) { int run = 0; for (int part = 0; part < 32; ++part) { PP[part * 16 + tid] = run; run += PS[part * 16 + tid]; } PS[tid] = run;
        if (LBID == 0) __hip_atomic_store((unsigned*)(ws + WS_CTL) + CW_CNT + l * 1024 + 64 * tid, (unsigned)run, __ATOMIC_RELAXED, __HIP_MEMORY_SCOPE_AGENT); }
    __syncthreads();
    if (tid == 0) { int o = 0; for (int e = 0; e < NEXP; ++e) { off[e] = o; o += (PS[e] + 255) & ~255; } off[NEXP] = o; }
    const int* tk = (const int*)(ws + WS_TOK); const float* tw = (const float*)(ws + WS_TOK) + 4 * NTOK; int* trow = (int*)(ws + WS_TOK) + 6 * NTOK;
    const bf16_t* x1b = (const bf16_t*)(ws + WS_X1B); bf16_t* xs = (bf16_t*)(ws + WS_XS); float* roww = (float*)(ws + WS_ROWW);
    for (int wt = LBID; wt < NTOK / 32; wt += gridDim.x) {
        __syncthreads();
        if (tid < 16) { int b = PP[(wt >> 3) * 16 + tid]; for (int w = wt & ~7; w < wt; ++w) b += (int)cntw[w * 16 + tid]; BASE[tid] = b; }
        __syncthreads();
        for (int q0 = wid * 8; q0 < wid * 8 + 8; q0 += 4) {
            u32x4 buf[4][4]; int rows[4];
#pragma unroll
            for (int k = 0; k < 4; ++k) { const int p = wt * 64 + q0 + k; const int e = tk[p]; rows[k] = off[e] + BASE[e] + tk[2 * NTOK + p];
                const u32x4* s = (const u32x4*)(x1b + (size_t)(p >> 1) * DM);
#pragma unroll
                for (int i = 0; i < 4; ++i) buf[k][i] = s[i * 64 + lane]; }
#pragma unroll
            for (int k = 0; k < 4; ++k) { const int p = wt * 64 + q0 + k; u32x4* d = (u32x4*)(xs + (size_t)rows[k] * DM);
#pragma unroll
                for (int i = 0; i < 4; ++i) d[i * 64 + lane] = buf[k][i];
                if (lane == 0) { roww[rows[k]] = tw[p]; trow[p] = rows[k]; } }
        }
    }
}
struct MoeSched {
    LAS const int* te; int ntiles, ncol, G, c;
    __device__ __forceinline__ bool next(int i, pg8::Unit& u) const {
        const int L = i * G + c; if (L >= ntiles * ncol) return false;
        const int pm = L / ncol, pl = L % ncol; u.pm = pm; u.pn = te[pm] * ncol + pl; return true;
    }
    __device__ __forceinline__ void a_ready(const pg8::Unit&) const {}
    __device__ __forceinline__ void done(const pg8::Unit&) const {}
};
__device__ __forceinline__ int moe_tile_table(const Args& a, int l, LAS int* off, LAS int* te) {
    const int nt = moe_offsets(a, l, off);
    const int tid_ = LTID;
    if (tid_ < 128) { const int pm = tid_; if (pm < nt) { int e = 0; for (int k = 1; k < NEXP; ++k) if ((off[k] >> 8) <= pm) e = k; te[pm] = e; } }
    __syncthreads();
    return nt;
}
struct EpiGateUp {
    static constexpr bool PERM = true, AFTER_DRAIN = false;
    unsigned char* ws;
    __device__ __forceinline__ void operator()(const f32x4 (&acc)[2][2][4][2], const pg8::Unit& u, int wr, int wc, int fr, int fq) const {
        bf16_t* hm = (bf16_t*)(ws + WS_HM); const float* roww = (const float*)(ws + WS_ROWW);
        const int row0 = u.pm * 256 + wr * 64 + fr, col0 = (u.pn & 3) * 128 + wc * 32 + 8 * fq;
#pragma unroll
        for (int ai = 0; ai < 2; ++ai)
#pragma unroll
            for (int m = 0; m < 4; ++m) { const int row = row0 + ai * 128 + m * 16; const float rw = roww[row];
                float o[8];
#pragma unroll
                for (int n = 0; n < 2; ++n)
#pragma unroll
                    for (int e = 0; e < 4; ++e) { const float gt = acc[ai][0][m][n][e], up = acc[ai][1][m][n][e]; o[n * 4 + e] = gt * fast_sigmoid(gt) * up * rw; }
                u32x4 w = {cvtpk(o[0], o[1]), cvtpk(o[2], o[3]), cvtpk(o[4], o[5]), cvtpk(o[6], o[7])};
                *(u32x4*)(hm + (size_t)row * DEXP + col0) = w; }
    }
};
struct EpiDown {
    static constexpr bool PERM = true, AFTER_DRAIN = false;
    unsigned char* ws;
    __device__ __forceinline__ void operator()(const f32x4 (&acc)[2][2][4][2], const pg8::Unit& u, int wr, int wc, int fr, int fq) const {
        bf16_t* y = (bf16_t*)(ws + WS_Y);
        const int row0 = u.pm * 256 + wr * 64 + fr, col0 = (u.pn & 7) * 256 + wc * 32 + 8 * fq;
#pragma unroll
        for (int ai = 0; ai < 2; ++ai)
#pragma unroll
            for (int m = 0; m < 4; ++m) { bf16_t* rowp = y + (size_t)(row0 + ai * 128 + m * 16) * DM + col0;
#pragma unroll
                for (int bj = 0; bj < 2; ++bj) { const f32x4 v0 = acc[ai][bj][m][0], v1 = acc[ai][bj][m][1];
                    u32x4 w = {cvtpk(v0[0], v0[1]), cvtpk(v0[2], v0[3]), cvtpk(v1[0], v1[1]), cvtpk(v1[2], v1[3])};
                    *(u32x4*)(rowp + bj * 128) = w; } }
    }
};
__device__ __forceinline__ void p10_ln2(const Args& a, int l) {
    unsigned char* ws = launder_s(a.ws); const int tid = LTID, wid = tid >> 6, lane = tid & 63;
    const float* x1f = (const float*)(ws + WS_X1F); const bf16_t* y = (const bf16_t*)(ws + WS_Y); const int* trow = (const int*)(ws + WS_TOK) + 6 * NTOK;
    float* xo = (l == NL - 1) ? a.out : (float*)(ws + WS_XF); bf16_t* xb = (bf16_t*)(ws + WS_XB);
    const float* g = a.in[23] + (size_t)l * DM; const float* bta = a.in[24] + (size_t)l * DM;
    for (int row = LBID * 8 + wid; row < NTOK; row += gridDim.x * 8) {
        const bf16_t* y0 = y + (size_t)trow[row * 2] * DM; const bf16_t* y1 = y + (size_t)trow[row * 2 + 1] * DM;
        f32x4 v[8];
#pragma unroll
        for (int i = 0; i < 8; ++i) { const int cidx = i * 256 + lane * 4; const f32x4 xv = *(const f32x4*)(x1f + (size_t)row * DM + cidx);
            const u32x2 a0 = *(const u32x2*)(y0 + cidx), a1 = *(const u32x2*)(y1 + cidx);
            const f32x4 f0 = {__uint_as_float(a0.x << 16), __uint_as_float(a0.x & 0xffff0000u), __uint_as_float(a0.y << 16), __uint_as_float(a0.y & 0xffff0000u)};
            const f32x4 f1 = {__uint_as_float(a1.x << 16), __uint_as_float(a1.x & 0xffff0000u), __uint_as_float(a1.y << 16), __uint_as_float(a1.y & 0xffff0000u)};
            v[i] = xv * ALPHA + (f0 + f1); }
        ln_row(v, g, bta, lane);
#pragma unroll
        for (int i = 0; i < 8; ++i) { const int cidx = i * 256 + lane * 4; *(f32x4*)(xo + (size_t)row * DM + cidx) = v[i];
            u32x2 w; w.x = cvtpk(v[i][0], v[i][1]); w.y = cvtpk(v[i][2], v[i][3]); *(u32x2*)(xb + (size_t)row * DM + cidx) = w; }
    }
}

#if defined(DBG_STAGE)
__device__ __forceinline__ void dbg_accum(unsigned* ctl, int k, float err, float ref) {
    err = wave_sum(err); ref = wave_sum(ref);
    if ((threadIdx.x & 63) == 0) { atomicAdd((float*)(ctl + CW_DBG) + 2 * k, err); atomicAdd((float*)(ctl + CW_DBG) + 2 * k + 1, ref); }
}
__device__ __forceinline__ float ldbf(const bf16_t* p) { return bf2f(*p); }
__device__ __forceinline__ float gelu_ref(float x) { return 0.5f * x * (1.0f + tanhf(0.7978845608028654f * (x + 0.044715f * x * x * x))); }
__device__ __forceinline__ float sigm_ref(float x) { return 1.0f / (1.0f + expf(-x)); }

__device__ void dbg_inproj(const Args& a, unsigned* ctl) {
    unsigned char* ws = a.ws; const int tid = threadIdx.x; const int r = (blockIdx.x * 32 + 5) % NTOK;
    const float* x = a.in[0] + (size_t)r * DM; const float* w = a.in[1];
    float err = 0.f, ref = 0.f;
    for (int c = tid; c < IN_COLS; c += 512) {
        float s = 0.f; for (int k = 0; k < DM; ++k) s += x[k] * w[(size_t)k * IN_COLS + c];
        float rv, gv; bool skip = false;
        if (c < 1024) { rv = s; gv = ldbf((const bf16_t*)(ws + WS_QA) + (size_t)r * 1024 + c); }
        else if (c < 2560) { rv = s; gv = ldbf((const bf16_t*)(ws + WS_KV) + (size_t)r * 1536 + (c - 1024)); }
        else if (c < 2584) { rv = sigm_ref(s); gv = ((const float*)(ws + WS_SKF))[(size_t)r * 32 + (c - 2560)]; }
        else if (c < 3608) { rv = s; gv = ldbf((const bf16_t*)(ws + WS_QB) + (size_t)r * 1024 + (c - 2584)); }
        else if (c < 3864) { rv = s; gv = ldbf((const bf16_t*)(ws + WS_HC) + (size_t)r * 256 + (c - 3608)); }
        else if (c < 4120) { rv = s; gv = ldbf((const bf16_t*)(ws + WS_QI) + (size_t)r * 256 + (c - 3864)); }
        else if (c < 4184) { rv = s; gv = ldbf((const bf16_t*)(ws + WS_KI) + (size_t)r * 64 + (c - 4120)); }
        else if (c < 4188) { rv = s; gv = ((const float*)(ws + WS_SKF))[(size_t)r * 32 + 24 + (c - 4184)]; }
        else if (c < 5212) { rv = gelu_ref(s); gv = ldbf((const bf16_t*)(ws + WS_HU) + (size_t)r * 1024 + (c - 4188)); }
        else if (c < 6236) { skip = true; rv = gv = 0.f; }
        else { rv = sigm_ref(s); gv = ldbf((const bf16_t*)(ws + WS_HG) + (size_t)r * 6144 + (c - 6236)); }
        if (!skip) { err += (gv - rv) * (gv - rv); ref += rv * rv; }
    }
    dbg_accum(ctl, 5, err, ref);
}
__device__ void dbg_compress(const Args& a, unsigned* ctl, LAS unsigned char* lds) {
    unsigned char* ws = a.ws; const int tid = threadIdx.x; LAS float* sh = (LAS float*)lds;
    const int kv = blockIdx.x & 1; int R = ((blockIdx.x >> 1) * 8 + 3) % 1024; if ((R & 127) == 127) R -= 1;
    const int bh = R >> 7, i = R & 127, b = bh >> 1, hkv = bh & 1;
    const float* pe = a.in[4] + (size_t)kv * 4096; const float* w1 = a.in[2] + (size_t)kv * 4096 * 128; const float* w2 = a.in[3] + (size_t)kv * 128 * 128;
    const int n = tid & 127, q = tid >> 7; float s = 0.f;
    for (int k = q * 1024; k < (q + 1) * 1024; ++k) { const int l = k >> 7, d = k & 127;
        const float xv = ldbf((const bf16_t*)(ws + WS_KV) + ((size_t)b * SEQ + 16 * i + l) * 1536 + kv * 256 + hkv * 128 + d) + pe[k]; s += xv * w1[(size_t)k * 128 + n]; }
    sh[q * 128 + n] = s; __syncthreads();
    if (tid < 128) sh[512 + tid] = gelu_ref((sh[tid] + sh[128 + tid]) + (sh[256 + tid] + sh[384 + tid]));
    __syncthreads();
    float err = 0.f, ref = 0.f;
    if (tid < 128) { float o = 0.f; for (int j = 0; j < 128; ++j) o += sh[512 + j] * w2[j * 128 + tid];
        const float gv = ldbf((const bf16_t*)(ws + WS_KC) + ((size_t)kv * 1024 + R) * 128 + tid); err = (gv - o) * (gv - o); ref = o * o; }
    dbg_accum(ctl, 2, err, ref); __syncthreads();
}
__device__ void dbg_nsa(const Args& a, unsigned* ctl, LAS unsigned char* lds) {
    unsigned char* ws = a.ws; const int tid = threadIdx.x;
    const int b = blockIdx.x & 3, hkv = (blockIdx.x >> 2) & 1, t = (blockIdx.x * 131 + 77) % SEQ, cur = t >> 6;
    LAS float* P = (LAS float*)lds;
    LAS float* O = P + 4 * 2048;
    LAS float* IMPv = O + 512;
    LAS unsigned* SEL = (LAS unsigned*)(IMPv + 32);
    LAS float* Q = IMPv + 64;
    const size_t tok = (size_t)b * SEQ + t;
    { const int g = tid >> 7, d = tid & 127; Q[tid] = ldbf((const bf16_t*)(ws + WS_QA) + tok * 1024 + (hkv * 4 + g) * 128 + d); O[tid] = 0.f; }
    __syncthreads();
    const float scale = 0.08838834764831845f;
    const bf16_t* KC = (const bf16_t*)(ws + WS_KC) + (size_t)(b * 2 + hkv) * 128 * 128; const bf16_t* VC = KC + (size_t)8 * 128 * 128;
    const bf16_t* KVb = (const bf16_t*)(ws + WS_KV) + (size_t)b * SEQ * 1536 + hkv * 128;
    { const int g = tid >> 7, i = tid & 127; const float slope = exp2f(-(float)(hkv * 4 + g + 1)); float s = -INFINITY;
      if (i < 127 && t - (16 * i + 31) >= 0) { float d = 0.f; for (int k = 0; k < 128; ++k) d += Q[g * 128 + k] * ldbf(KC + i * 128 + k); s = d * scale - slope * (float)(t - (16 * i + 31)); }
      P[g * 2048 + i] = s; }
    __syncthreads();
    if (tid < 4) { float m = -INFINITY; for (int i = 0; i < 127; ++i) m = fmaxf(m, P[tid * 2048 + i]); float l = 0.f;
        for (int i = 0; i < 128; ++i) { const float e = (i < 127 && P[tid * 2048 + i] > -INFINITY) ? expf(P[tid * 2048 + i] - m) : 0.f; P[tid * 2048 + i] = e; l += e; }
        const float inv = l > 0.f ? 1.f / l : 0.f; for (int i = 0; i < 128; ++i) P[tid * 2048 + i] *= inv; }
    __syncthreads();
    { const int g = tid >> 7, d = tid & 127; float o = 0.f; for (int i = 0; i < 127; ++i) o += P[g * 2048 + i] * ldbf(VC + i * 128 + d);
      O[tid] += ((const float*)(ws + WS_SKF))[tok * 32 + (hkv * 4 + g) * 3 + 0] * o; }
    if (tid < 32) { float v = 0.f; for (int g = 0; g < 4; ++g) for (int i = 4 * tid - 1; i <= 4 * tid + 3; ++i) if (i >= 0 && i < 127) v += P[g * 2048 + i]; IMPv[tid] = v; }
    __syncthreads();
    if (tid < 32) { const int j = tid; const bool forced = (j == 0) || (j == cur) || (j == cur - 1); IMPv[j] = (j <= cur) ? IMPv[j] + (forced ? 1e4f : 0.f) : -1e30f; }
    __syncthreads();
    if (tid == 0) {
        unsigned sel = 0; for (int n = 0; n < 16; ++n) { int bj = -1; float bv = 0.f; for (int j = 0; j < 32; ++j) { const float vj = IMPv[j]; if (!((sel >> j) & 1u) && (bj < 0 || vj > bv)) { bj = j; bv = vj; } } sel |= 1u << bj; }
        SEL[0] = sel; }
    __syncthreads();
    const unsigned sel = SEL[0];
    for (int br = 1; br <= 2; ++br) {
        const bf16_t* Kp = KVb + (br == 1 ? 512 : 1024); const bf16_t* Vp = KVb + (br == 1 ? 768 : 1280);
        for (int idx = tid; idx < 4 * 2048; idx += 512) { const int g = idx >> 11, s = idx & 2047; const float slope = exp2f(-(float)(hkv * 4 + g + 1));
            const bool ok = (s <= t) && (br == 1 ? ((sel >> (s >> 6)) & 1u) : (t - s < 512)); float sc = -INFINITY;
            if (ok) { float d = 0.f; for (int k = 0; k < 128; ++k) d += Q[g * 128 + k] * ldbf(Kp + (size_t)s * 1536 + k); sc = d * scale - slope * (float)(t - s); }
            P[idx] = sc; }
        __syncthreads();
        if (tid < 4) { float m = -INFINITY; for (int s = 0; s < 2048; ++s) m = fmaxf(m, P[tid * 2048 + s]); float l = 0.f;
            for (int s = 0; s < 2048; ++s) { const float e = P[tid * 2048 + s] > -INFINITY ? expf(P[tid * 2048 + s] - m) : 0.f; P[tid * 2048 + s] = e; l += e; }
            const float inv = l > 0.f ? 1.f / l : 0.f; for (int s = 0; s < 2048; ++s) P[tid * 2048 + s] *= inv; }
        __syncthreads();
        { const int g = tid >> 7, d = tid & 127; float o = 0.f; for (int s = 0; s <= t; ++s) { const float p = P[g * 2048 + s]; if (p != 0.f) o += p * ldbf(Vp + (size_t)s * 1536 + d); }
          O[tid] += ((const float*)(ws + WS_SKF))[tok * 32 + (hkv * 4 + g) * 3 + br] * o; }
        __syncthreads();
    }
    { const int g = tid >> 7, d = tid & 127; const float rv = O[tid], gv = ldbf((const bf16_t*)(ws + WS_BR) + tok * 1024 + (hkv * 4 + g) * 128 + d);
      dbg_accum(ctl, 1, (gv - rv) * (gv - rv), rv * rv); }
    __syncthreads();
}
__device__ void dbg_dsa(const Args& a, unsigned* ctl, LAS unsigned char* lds) {
    unsigned char* ws = a.ws; const int tid = threadIdx.x;
    const int b = blockIdx.x & 3, t = (blockIdx.x * 197 + 301) % SEQ; const size_t tok = (size_t)b * SEQ + t;
    LAS float* LG = (LAS float*)lds;
    LAS float* SC = LG + 8 * 2048;
    LAS float* QL = SC + 2048;
    LAS float* OL = QL + 2048;
    LAS unsigned char* SL = (LAS unsigned char*)(OL + 2048);
    const bf16_t* HC = (const bf16_t*)(ws + WS_HC) + (size_t)b * SEQ * 256; const float* PSQ = (const float*)(ws + WS_PSQ) + (size_t)b * SEQ * 4;
    const float* gk = a.in[7];
    for (int s = tid; s < 2048; s += 512) { float sc = -INFINITY;
        if (s <= t) { sc = 0.f; for (int h = 0; h < 4; ++h) { float d = 0.f; for (int k = 0; k < 64; ++k) d += ldbf((const bf16_t*)(ws + WS_QI) + tok * 256 + h * 64 + k) * ldbf((const bf16_t*)(ws + WS_KI) + ((size_t)b * SEQ + s) * 64 + k);
            sc += fmaxf(d, 0.f) * ((const float*)(ws + WS_SKF))[tok * 32 + 24 + h]; } }
        SC[s] = sc; }
    for (int idx = tid; idx < 2048; idx += 512) { const int h = idx >> 8, c = idx & 255; float s = 0.f;
        for (int d = 0; d < 128; ++d) s += ldbf((const bf16_t*)(ws + WS_QB) + tok * 1024 + h * 128 + d) * a.in[5][((size_t)h * 256 + c) * 128 + d];
        QL[idx] = s * 0.08838834764831845f; }
    __syncthreads();
    for (int s = tid; s < 2048; s += 512) { bool selv = false;
        if (s <= t) { if (t + 1 <= 256) selv = true; else { int rank = 0; const float v = SC[s]; for (int s2 = 0; s2 <= t; ++s2) { const float v2 = SC[s2]; rank += (v2 > v || (v2 == v && s2 < s)) ? 1 : 0; } selv = rank < 256; } }
        SL[s] = selv ? 1 : 0; }
    __syncthreads();
    for (int idx = tid; idx < 8 * 2048; idx += 512) { const int h = idx >> 11, s = idx & 2047; float lg = -INFINITY;
        if (SL[s]) { const f32x4 q4 = *(const f32x4*)(PSQ + (size_t)s * 4); const float rs = 1.0f / sqrtf(((q4[0] + q4[1]) + (q4[2] + q4[3])) / 256.f + LN_EPS);
            float d = 0.f; for (int c = 0; c < 256; ++c) d += QL[h * 256 + c] * (ldbf(HC + (size_t)s * 256 + c) * rs * gk[c]); lg = d - exp2f(-(float)(h + 1)) * (float)(t - s); }
        LG[idx] = lg; }
    __syncthreads();
    if (tid < 8) { float m = -INFINITY; for (int s = 0; s < 2048; ++s) m = fmaxf(m, LG[tid * 2048 + s]); float l = 0.f;
        for (int s = 0; s < 2048; ++s) { const float e = LG[tid * 2048 + s] > -INFINITY ? expf(LG[tid * 2048 + s] - m) : 0.f; LG[tid * 2048 + s] = e; l += e; }
        const float inv = l > 0.f ? 1.f / l : 0.f; for (int s = 0; s < 2048; ++s) LG[tid * 2048 + s] *= inv; }
    __syncthreads();
    for (int idx = tid; idx < 2048; idx += 512) { const int h = idx >> 8, c = idx & 255; float o = 0.f;
        for (int s = 0; s <= t; ++s) { const float p = LG[h * 2048 + s]; if (p != 0.f) { const f32x4 q4 = *(const f32x4*)(PSQ + (size_t)s * 4); const float rs = 1.0f / sqrtf(((q4[0] + q4[1]) + (q4[2] + q4[3])) / 256.f + LN_EPS);
            o += p * ldbf(HC + (size_t)s * 256 + c) * rs * gk[c]; } }
        OL[idx] = o; }
    __syncthreads();
    float err = 0.f, ref = 0.f;
    for (int idx = tid; idx < 1024; idx += 512) { const int h = idx >> 7, d = idx & 127; float o = 0.f; for (int c = 0; c < 256; ++c) o += OL[h * 256 + c] * a.in[6][((size_t)h * 256 + c) * 128 + d];
        const float gv = ldbf((const bf16_t*)(ws + WS_BR) + (size_t)NTOK * 1024 + tok * 1024 + idx); err += (gv - o) * (gv - o); ref += o * o; }
    dbg_accum(ctl, 3, err, ref); __syncthreads();
}
__device__ void dbg_gmlp(const Args& a, unsigned* ctl) {
    unsigned char* ws = a.ws; const int tid = threadIdx.x;
    const int b = blockIdx.x & 3, t = (blockIdx.x * 89 + 40) % SEQ, ch = t >> 7, tl = t & 127; const size_t tok = (size_t)b * SEQ + t;
    float err = 0.f, ref = 0.f;
    for (int c = tid; c < 1024; c += 512) { const int g = c >> 7; float m = a.in[11][g * 128 + tl];
        for (int s = 0; s <= tl; ++s) m += a.in[10][((size_t)g * 128 + tl) * 128 + s] * ldbf((const bf16_t*)(ws + WS_HV) + ((size_t)b * SEQ + ch * 128 + s) * 1024 + c);
        const float rv = m * ldbf((const bf16_t*)(ws + WS_HU) + tok * 1024 + c), gv = ldbf((const bf16_t*)(ws + WS_BR) + (size_t)2 * NTOK * 1024 + tok * 1024 + c);
        err += (gv - rv) * (gv - rv); ref += rv * rv; }
    dbg_accum(ctl, 4, err, ref);
}
__device__ void dbg_merge(const Args& a, unsigned* ctl, LAS unsigned char* lds) {
    unsigned char* ws = a.ws; const int tid = threadIdx.x; const int r = (blockIdx.x * 32 + 9) % NTOK; LAS float* MP = (LAS float*)lds;
    for (int d = tid; d < DM; d += 512) { float acc = 0.f;
        for (int n = 0; n < 3; ++n) { float y = 0.f; const bf16_t* br = (const bf16_t*)(ws + WS_BR) + (size_t)n * NTOK * 1024 + (size_t)r * 1024; const float* wb = a.in[12] + (size_t)n * 1024 * 2048;
            for (int w = 0; w < 1024; ++w) y += ldbf(br + w) * wb[(size_t)w * 2048 + d];
            acc += ldbf((const bf16_t*)(ws + WS_HG) + (size_t)r * 6144 + n * 2048 + d) * y; }
        MP[d] = acc; }
    __syncthreads();
    float err = 0.f, ref = 0.f;
    for (int d = tid; d < DM; d += 512) { float s = 0.f; for (int k = 0; k < DM; ++k) s += MP[k] * a.in[13][(size_t)k * 2048 + d];
        const float rv = ALPHA * a.in[0][(size_t)r * DM + d] + s, gv = ((const float*)(ws + WS_MIXT))[(size_t)r * DM + d]; err += (gv - rv) * (gv - rv); ref += rv * rv; }
    dbg_accum(ctl, 6, err, ref); __syncthreads();
}
__device__ void dbg_moe(const Args& a, unsigned* ctl, LAS unsigned char* lds) {
    unsigned char* ws = a.ws; const int tid = threadIdx.x; const int r = (blockIdx.x * 32 + 17) % NTOK;
    LAS float* X1 = (LAS float*)lds; LAS float* RED = X1 + 2048; LAS float* HH = RED + 1024; LAS float* YY = HH + 1024; LAS float* LOG = YY + 2048;
    const float* pre = (const float*)(ws + WS_MIXT) + (size_t)r * DM;
    float s = 0.f; for (int d = tid; d < DM; d += 512) s += pre[d]; RED[tid] = s; __syncthreads();
    if (tid == 0) { float m = 0.f; for (int i = 0; i < 512; ++i) m += RED[i]; RED[512] = m / DM; } __syncthreads();
    const float mean = RED[512]; __syncthreads();
    s = 0.f; for (int d = tid; d < DM; d += 512) s += (pre[d] - mean) * (pre[d] - mean); RED[tid] = s; __syncthreads();
    if (tid == 0) { float m = 0.f; for (int i = 0; i < 512; ++i) m += RED[i]; RED[513] = 1.0f / sqrtf(m / DM + LN_EPS); } __syncthreads();
    const float rstd = RED[513];
    for (int d = tid; d < DM; d += 512) X1[d] = (pre[d] - mean) * rstd * a.in[14][d] + a.in[15][d];
    __syncthreads();
    if (tid < 20) { float lg = 0.f; if (tid < 4) { for (int k = 0; k < DM; ++k) lg += X1[k] * a.in[16][(size_t)k * 4 + tid]; lg += a.in[17][tid]; } else { for (int k = 0; k < DM; ++k) lg += X1[k] * a.in[18][(size_t)k * 16 + (tid - 4)]; lg += a.in[19][tid - 4]; } LOG[tid] = lg; }
    __syncthreads();
    int gi = 0; for (int j = 1; j < 4; ++j) if (LOG[j] > LOG[gi]) gi = j;
    float den = 0.f; for (int j = 0; j < 4; ++j) den += expf(LOG[j] - LOG[gi]); const float gp = 1.f / den;
    int e1 = 0; for (int j = 1; j < 4; ++j) if (LOG[4 + gi * 4 + j] > LOG[4 + gi * 4 + e1]) e1 = j;
    int e2 = -1; for (int j = 0; j < 4; ++j) if (j != e1 && (e2 < 0 || LOG[4 + gi * 4 + j] > LOG[4 + gi * 4 + e2])) e2 = j;
    const float ex = expf(LOG[4 + gi * 4 + e2] - LOG[4 + gi * 4 + e1]); const float wv0 = gp / (1.f + ex), wv1 = gp * ex / (1.f + ex); const int ev0 = gi * 4 + e1, ev1 = gi * 4 + e2;
    for (int q = 0; q < 2; ++q) { const int e = q ? ev1 : ev0; const float* wg = a.in[20] + (size_t)e * 2048 * 512; const float* wu = a.in[21] + (size_t)e * 2048 * 512;
        float g = 0.f, u = 0.f; for (int k = 0; k < DM; ++k) { g += X1[k] * wg[(size_t)k * 512 + tid]; u += X1[k] * wu[(size_t)k * 512 + tid]; }
        HH[q * 512 + tid] = g / (1.f + expf(-g)) * u * (q ? wv1 : wv0); }
    __syncthreads();
    for (int d = tid; d < DM; d += 512) { float y = 0.f; for (int q = 0; q < 2; ++q) { const float* wd = a.in[22] + (size_t)(q ? ev1 : ev0) * 512 * 2048; for (int f = 0; f < 512; ++f) y += HH[q * 512 + f] * wd[(size_t)f * 2048 + d]; } YY[d] = ALPHA * X1[d] + y; }
    __syncthreads();
    s = 0.f; for (int d = tid; d < DM; d += 512) s += YY[d]; RED[tid] = s; __syncthreads();
    if (tid == 0) { float m = 0.f; for (int i = 0; i < 512; ++i) m += RED[i]; RED[514] = m / DM; } __syncthreads();
    const float mean2 = RED[514]; __syncthreads();
    s = 0.f; for (int d = tid; d < DM; d += 512) s += (YY[d] - mean2) * (YY[d] - mean2); RED[tid] = s; __syncthreads();
    if (tid == 0) { float m = 0.f; for (int i = 0; i < 512; ++i) m += RED[i]; RED[515] = 1.0f / sqrtf(m / DM + LN_EPS); } __syncthreads();
    const float rstd2 = RED[515];
    float err = 0.f, ref = 0.f;
    const int* trow = (const int*)(ws + WS_TOK) + 6 * NTOK; const bf16_t* Y = (const bf16_t*)(ws + WS_Y);
    for (int d = tid; d < DM; d += 512) {
#if DBG_STAGE == 8
        const float rv = (YY[d] - mean2) * rstd2 * a.in[23][d] + a.in[24][d], gv = ((const float*)(ws + WS_XF))[(size_t)r * DM + d];
#else
        const float rv = YY[d] - ALPHA * X1[d], gv = ldbf(Y + (size_t)trow[r * 2] * DM + d) + ldbf(Y + (size_t)trow[r * 2 + 1] * DM + d);
#endif
        err += (gv - rv) * (gv - rv); ref += rv * rv; }
    dbg_accum(ctl, 7, err, ref); __syncthreads();
}
__device__ void dbg_checks(const Args& a, unsigned* ctl, LAS unsigned char* lds) {
#if DBG_STAGE == 5
    dbg_inproj(a, ctl);
#elif DBG_STAGE == 2
    dbg_compress(a, ctl, lds);
#elif DBG_STAGE == 1
    dbg_nsa(a, ctl, lds);
#elif DBG_STAGE == 3
    dbg_dsa(a, ctl, lds);
#elif DBG_STAGE == 4
    dbg_gmlp(a, ctl);
#elif DBG_STAGE == 6
    dbg_merge(a, ctl, lds);
#else
    dbg_moe(a, ctl, lds);
#endif
}
__device__ void dbg_scale_output(const Args& a, unsigned* ctl) {
    const int k = (DBG_STAGE == 8) ? 7 : DBG_STAGE;
    const float err = __hip_atomic_load((float*)(ctl + CW_DBG) + 2 * k, __ATOMIC_RELAXED, __HIP_MEMORY_SCOPE_AGENT), ref = __hip_atomic_load((float*)(ctl + CW_DBG) + 2 * k + 1, __ATOMIC_RELAXED, __HIP_MEMORY_SCOPE_AGENT);
    const float E = ref > 0.f ? sqrtf(err / ref) : 1.0f; const float f = 1.0f + 3.0f * fminf(E, 1.0f);
    for (size_t i = (size_t)blockIdx.x * 512 + threadIdx.x; i < (size_t)NTOK * DM; i += (size_t)gridDim.x * 512) a.out[i] *= f;
}
#endif

struct ItemTable { unsigned short v[768]; };
constexpr int item_cost(int type, int idx) {
    if (type == 0) { const int qb = idx & 31; return 4 + qb + ((qb + 1) < 9 ? (qb + 1) : 9); }
    if (type == 1) { const int qb = idx & 7; return 4 * (qb + 1) + 1; }
    return 1;
}
constexpr ItemTable make_items() {
    ItemTable t{}; int pos = 0;
    for (int cst = 64; cst >= 0; --cst) for (int id = 0; id < 768; ++id) { const int type = id >> 8, idx = id & 255; if (item_cost(type, idx) == cst) t.v[pos++] = (unsigned short)((type << 12) | idx); }
    return t;
}
__device__ const ItemTable g_items = make_items();

constexpr int N_PHASES = 1 + NL * 10;
#ifndef PH_MASK
#define PH_MASK 0x7ff
#endif
#define PH_ON(k) (((PH_MASK) >> (k)) & 1)
#if defined(PROBE_DOUBLE) && MK_SINGLE
#define PH_REPS(k) ((((PROBE_DOUBLE) >> (k)) & 1) ? 2 : 1)
#else
#define PH_REPS(k) 1
#endif
#ifndef PROBE_SUB
#define PROBE_SUB 0xff
#endif
__global__ void __launch_bounds__(512, 2) mk_fwd(Args a_unused) {
    extern __shared__ __attribute__((aligned(16))) unsigned char lds_raw[];
    LAS unsigned char* lds = (LAS unsigned char*)lds_raw;
    typedef const __attribute__((address_space(4))) Args KArgs;
    KArgs* const ka0 = (KArgs*)__builtin_amdgcn_kernarg_segment_ptr();
#define KA() (*(const Args*)(KArgs*)((unsigned long long)ka0 + opaque_zero()))
    const Args& a = KA();
    unsigned char* ws0 = a.ws;
    unsigned* ctl = (unsigned*)(ws0 + WS_CTL);
    const int tid = threadIdx.x, G = gridDim.x, wg = blockIdx.x;
#if MK_SINGLE
    if (tid < 4) ((LAS unsigned*)(lds + LDS_BYTES - 16))[tid] = 0u;
    __syncthreads();
    XcdBarrier bar = xcd_barrier_post(ctl + CW_BAR, (volatile LAS unsigned*)(lds + LDS_BYTES - 16));
#define GRID_BAR() do { XcdBarrier bb_ = bar; bb_.bar = launder_s(bb_.bar); bb_.x = bar.x + opaque_zero(); xcd_barrier(bb_); } while (0)
#else
#define GRID_BAR() do { } while (0)
#endif
#if MK_SINGLE
#define IN(k) true
#else
    const int lo = a.ph_lo, hi = a.ph_hi;
#define IN(k) (lo <= (k) && (k) < hi)
#endif
#if defined(PROBE_BAR2)
#define SEAM(k) do { if (IN(k) && IN((k) + 1)) { GRID_BAR(); GRID_BAR(); } } while (0)
#else
#define SEAM(k) do { if (IN(k) && IN((k) + 1)) GRID_BAR(); } while (0)
#endif

    if (PH_ON(10) && IN(0)) for (int rep = 0; rep < PH_REPS(10); ++rep) { if (rep) GRID_BAR();
#if defined(PROBE_P0_NOSTORE)
        p0_prologue(a, lds, rep != 0);
#else
        p0_prologue(a, lds);
#endif
    }
    SEAM(0);
    for (int l = 0; l < NL; ++l) {
        const int p = 1 + l * 10;
        unsigned char* ws = launder_s(ws0);
        if (PH_ON(0) && IN(p + 0)) for (int rep = 0; rep < PH_REPS(0); ++rep) { if (rep) GRID_BAR(); ws = launder_s(ws); const Args& a = KA();
            skinny_item(a, l, lds);
            pg8::Gemm g{(const bf16_t*)(ws + WS_XB), (const bf16_t*)(ws + WS_WIN) + (size_t)l * NMAIN * DM, NTOK, NMAIN, DM};
            pg8::StaticOrder S; S.init(NTOK, NMAIN, G, wg); EpiInProj E{ws};
            pg8::gemm_phase<EpiInProj, pg8::StaticOrder, false>(lds, g, S, E, nullptr);
        }
        SEAM(p + 0);
        if (PH_ON(1) && IN(p + 1)) for (int rep = 0; rep < PH_REPS(1); ++rep) { if (rep) GRID_BAR(); ws = launder_s(ws); const Args& a = KA();
            const int subm = rep ? (PROBE_SUB) : 0xff;
            if (subm & 1) { pg8::Gemm g{(const bf16_t*)(ws + WS_HC), (const bf16_t*)(ws + WS_WKVUP) + (size_t)l * 2048 * 256, NTOK, 2048, 256};
              pg8::StaticOrder S; S.init(NTOK, 2048, G, wg); EpiKvUp E{ws};
              pg8::gemm_phase<EpiKvUp, pg8::StaticOrder, false>(lds, g, S, E, nullptr); }
            if (subm & 2) gmlp_ln_rows(a, l);
            if (subm & 4) for (int it = wg; it < 64; it += G) compress_item(a, l, lds, it);
            if (subm & 8) for (int it = wg; it < 256; it += G) { indexer_item(a, lds, it); indexer_item(a, lds, 511 - it); }
        }
        SEAM(p + 1);
        if (PH_ON(2) && IN(p + 2)) for (int rep = 0; rep < PH_REPS(2); ++rep) { if (rep) GRID_BAR(); ws = launder_s(ws); const Args& a = KA();
            LAS unsigned* slot = (LAS unsigned*)(lds + att::L_MISC); const int tq = LTID;
            unsigned qi = (unsigned)wg;
            for (;;) {
                if (qi >= 768u) break;
                unsigned nxt = 0u;
                if (tq == 0) nxt = (unsigned)G + __hip_atomic_fetch_add(ctl + CW_Q + (l * 2 + rep) * 64, 1u, __ATOMIC_RELAXED, __HIP_MEMORY_SCOPE_AGENT);
                const unsigned it = g_items.v[qi]; const int type = it >> 12, idx = it & 255;
                if (type == 0) att::nsa_item(a, lds, idx >> 6, (idx >> 5) & 1, idx & 31);
                else if (type == 1) att::dsa_item(a, lds, idx >> 6, (idx >> 3) & 7, idx & 7);
                else att::gmlp_item(a, lds, l, idx >> 6, (idx >> 2) & 15, idx & 3);
                if (tq == 0) slot[0] = nxt;
                __syncthreads();
                qi = slot[0];
                __syncthreads();
            }
        }
        SEAM(p + 2);
        if (PH_ON(3) && IN(p + 3)) for (int rep = 0; rep < PH_REPS(3); ++rep) { if (rep) GRID_BAR(); ws = launder_s(ws); const Args& a = KA();
            pg8::Gemm g{(const bf16_t*)(ws + WS_BR), (const bf16_t*)(ws + WS_WB) + (size_t)l * 3 * 2048 * 1024, 0, 0, 1024};
            BranchSched S{G, wg}; EpiBranch E{ws};
            pg8::gemm_phase<EpiBranch, BranchSched, false>(lds, g, S, E, nullptr);
        }
        SEAM(p + 3);
        if (PH_ON(4) && IN(p + 4)) for (int rep = 0; rep < PH_REPS(4); ++rep) { if (rep) GRID_BAR(); ws = launder_s(ws); const Args& a = KA();
            pg8::Gemm g{(const bf16_t*)(ws + WS_MIXB), (const bf16_t*)(ws + WS_WO) + (size_t)l * DM * DM, NTOK, DM, DM};
            pg8::StaticOrder S; S.init(NTOK, DM, G, wg); EpiOut E{l == 0 ? a.in[0] : (const float*)(ws + WS_XF), (float*)(ws + WS_MIXT)};
            pg8::gemm_phase<EpiOut, pg8::StaticOrder, false>(lds, g, S, E, nullptr);
        }
        SEAM(p + 4);
        if (PH_ON(5) && IN(p + 5)) { const Args& a = KA(); p6_ln1_route(a, l, lds); }
        SEAM(p + 5);
        if (PH_ON(6) && IN(p + 6)) for (int rep = 0; rep < PH_REPS(6); ++rep) { if (rep) GRID_BAR(); const Args& a = KA(); p7_gather(a, l, lds); }
        SEAM(p + 6);
        if (PH_ON(7) && IN(p + 7)) for (int rep = 0; rep < PH_REPS(7); ++rep) { if (rep) GRID_BAR(); ws = launder_s(ws); const Args& a = KA();
            LAS int* off = (LAS int*)(lds + 131072); LAS int* te = off + 32;
            const int nt = moe_tile_table(a, l, off, te);
            pg8::Gemm g{(const bf16_t*)(ws + WS_XS), (const bf16_t*)(ws + WS_WGU) + (size_t)l * 16 * 1024 * 2048, 0, 0, DM};
            MoeSched S{te, nt, 4, G, wg}; EpiGateUp E{ws};
            pg8::gemm_phase<EpiGateUp, MoeSched, false>(lds, g, S, E, nullptr);
        }
        SEAM(p + 7);
        if (PH_ON(8) && IN(p + 8)) for (int rep = 0; rep < PH_REPS(8); ++rep) { if (rep) GRID_BAR(); ws = launder_s(ws); const Args& a = KA();
            LAS int* off = (LAS int*)(lds + 131072); LAS int* te = off + 32;
            const int nt = moe_tile_table(a, l, off, te);
            pg8::Gemm g{(const bf16_t*)(ws + WS_HM), (const bf16_t*)(ws + WS_WD) + (size_t)l * 16 * 2048 * 512, 0, 0, DEXP};
            MoeSched S{te, nt, 8, G, wg}; EpiDown E{ws};
            pg8::gemm_phase<EpiDown, MoeSched, false>(lds, g, S, E, nullptr);
        }
        SEAM(p + 8);
        if (PH_ON(9) && IN(p + 9)) for (int rep = 0; rep < PH_REPS(9); ++rep) { if (rep) GRID_BAR(); const Args& a = KA(); p10_ln2(a, l); }
        SEAM(p + 9);
    }
#undef IN
#undef SEAM
}

#if defined(DBG_STAGE)
__global__ void __launch_bounds__(512, 2) dbg_k(Args a, int what) {
    extern __shared__ __attribute__((aligned(16))) unsigned char lds_raw[];
    LAS unsigned char* lds = (LAS unsigned char*)lds_raw; unsigned* ctl = (unsigned*)(a.ws + WS_CTL);
    if (what == 0) dbg_checks(a, ctl, lds); else dbg_scale_output(a, ctl);
}
#endif
extern "C" void kernel_launch(void* const* d_in, const int* in_sizes, int n_in, void* d_out, int out_size, void* d_ws, size_t ws_size, hipStream_t stream) {
    static int grid = 0;
    if (grid == 0) {
        if (n_in != 25 || out_size != NTOK * DM || ws_size < WS_END) { fprintf(stderr, "kernel_launch: expected 25 inputs, out %d, ws >= %zu; got n_in %d out %d ws %zu\n", NTOK * DM, (size_t)WS_END, n_in, out_size, ws_size); grid = -1; return; }
        int dev = 0, cus = 0, per_cu = 0;
        if (hipGetDevice(&dev) != hipSuccess || hipDeviceGetAttribute(&cus, hipDeviceAttributeMultiprocessorCount, dev) != hipSuccess) { fprintf(stderr, "kernel_launch: device query failed\n"); grid = -1; return; }
#if defined(DBG_STAGE)
        (void)hipFuncSetAttribute((const void*)dbg_k, hipFuncAttributeMaxDynamicSharedMemorySize, LDS_BYTES);
#endif
        if (hipFuncSetAttribute((const void*)mk_fwd, hipFuncAttributeMaxDynamicSharedMemorySize, LDS_BYTES) != hipSuccess) { fprintf(stderr, "kernel_launch: hipFuncSetAttribute failed\n"); grid = -1; return; }
        if (hipOccupancyMaxActiveBlocksPerMultiprocessor(&per_cu, (const void*)mk_fwd, 512, LDS_BYTES) != hipSuccess || per_cu < 1) fprintf(stderr, "kernel_launch: occupancy query reports %d blocks per CU\n", per_cu);
        (void)hipGetLastError();
        grid = cus;
    }
    if (grid < 0) return;
    (void)hipMemsetAsync((char*)d_ws + WS_CTL, 0, CTL_BYTES, stream);
    Args a{};
    for (int i = 0; i < 25; ++i) a.in[i] = (const float*)d_in[i];
    a.out = (float*)d_out; a.ws = (unsigned char*)d_ws; a.rep = 0; a.sub = 0xff;
#if MK_SINGLE
    a.ph_lo = 0; a.ph_hi = N_PHASES;
    hipLaunchKernelGGL(mk_fwd, dim3(grid), dim3(512), LDS_BYTES, stream, a);
#else
    for (int p = 0; p < N_PHASES; ++p) { a.ph_lo = p; a.ph_hi = p + 1; hipLaunchKernelGGL(mk_fwd, dim3(grid), dim3(512), LDS_BYTES, stream, a);
#if defined(PROBE_DOUBLE)
        { const int k = p == 0 ? 10 : (p - 1) % 10; if ((PROBE_DOUBLE >> k) & 1) { a.rep = 1;
#if defined(PROBE_SUB)
            a.sub = PROBE_SUB;
#endif
            hipLaunchKernelGGL(mk_fwd, dim3(grid), dim3(512), LDS_BYTES, stream, a); a.rep = 0; a.sub = 0xff; } }
#endif
#if defined(DBG_STAGE)
        if (p == 10) hipLaunchKernelGGL(dbg_k, dim3(grid), dim3(512), LDS_BYTES, stream, a, 0);
        if (p == N_PHASES - 1) hipLaunchKernelGGL(dbg_k, dim3(grid), dim3(512), LDS_BYTES, stream, a, 1);
#endif
    }
#endif
    const hipError_t le = hipPeekAtLastError();
    if (le != hipSuccess) fprintf(stderr, "kernel_launch: launch failed: %s\n", hipGetErrorName(le));
}
```

```cpp
#include <hip/hip_runtime.h>
#include <cstdio>
#include <cstdint>

#ifndef MK_SINGLE
#define MK_SINGLE 1
#endif

constexpr int NB = 4, SEQ = 2048, DM = 2048, NL = 4, NTOK = NB * SEQ;
constexpr int IN_COLS = 12380, NMAIN = 12288, NSK = 128;
constexpr int NEXP = 16, DEXP = 512, MOE_ROWS = 2 * NTOK + NEXP * 256;
constexpr float LN_EPS = 1e-5f;
constexpr float ALPHA = 1.681792830507429f;
constexpr float LOG2E = 1.4426950408889634f;
constexpr float ATT_C2 = 0.08838834764831845f * LOG2E;
constexpr int LDS_BYTES = 147456;

typedef unsigned short bf16_t;
typedef short bf16x8 __attribute__((ext_vector_type(8)));
typedef short s16x4 __attribute__((ext_vector_type(4)));
typedef float f32x16 __attribute__((ext_vector_type(16)));
typedef float f32x4 __attribute__((ext_vector_type(4)));
typedef float f32x2 __attribute__((ext_vector_type(2)));
typedef unsigned u32x4 __attribute__((ext_vector_type(4)));
typedef unsigned u32x2 __attribute__((ext_vector_type(2)));

constexpr size_t al256(size_t x) { return (x + 255) & ~(size_t)255; }
constexpr size_t WS_CTL    = 0;
constexpr size_t CTL_BYTES = 65536;
constexpr size_t WS_WIN    = WS_CTL + CTL_BYTES;
constexpr size_t WS_WSK    = WS_WIN  + (size_t)NL * NMAIN * DM * 2;
constexpr size_t WS_W1     = WS_WSK  + (size_t)NL * NSK * DM * 2;
constexpr size_t WS_W2     = WS_W1   + (size_t)NL * 2 * 128 * 4096 * 2;
constexpr size_t WS_C1     = WS_W2   + (size_t)NL * 2 * 128 * 128 * 2;
constexpr size_t WS_WKVUP  = WS_C1   + (size_t)NL * 2 * 16 * 128 * 4;
constexpr size_t WS_WSTRIL = WS_WKVUP + (size_t)NL * 2048 * 256 * 2;
constexpr size_t WS_WB     = WS_WSTRIL + (size_t)NL * 8 * 128 * 128 * 2;
constexpr size_t WS_WO     = WS_WB   + (size_t)NL * 3 * 2048 * 1024 * 2;
constexpr size_t WS_WR     = WS_WO   + (size_t)NL * 2048 * 2048 * 2;
constexpr size_t WS_WGU    = WS_WR   + (size_t)NL * 2 * 32 * 2048 * 2;
constexpr size_t WS_WD     = WS_WGU  + (size_t)NL * 16 * 1024 * 2048 * 2;
constexpr size_t WS_XF     = WS_WD   + (size_t)NL * 16 * 2048 * 512 * 2;
constexpr size_t WS_XB     = WS_XF   + (size_t)NTOK * DM * 4;
constexpr size_t WS_SKF    = WS_XB   + (size_t)NTOK * DM * 2;
constexpr size_t WS_KI     = WS_SKF  + (size_t)NTOK * 32 * 4;
constexpr size_t WS_QA     = WS_KI   + (size_t)NTOK * 64 * 2;
constexpr size_t WS_KV     = WS_QA   + (size_t)NTOK * 1024 * 2;
constexpr size_t WS_QB     = WS_KV   + (size_t)NTOK * 1536 * 2;
constexpr size_t WS_HC     = WS_QB   + (size_t)NTOK * 1024 * 2;
constexpr size_t WS_PSQ    = WS_HC   + (size_t)NTOK * 256 * 2;
constexpr size_t WS_QI     = WS_PSQ  + (size_t)NTOK * 4 * 4;
constexpr size_t WS_HU     = WS_QI   + (size_t)NTOK * 256 * 2;
constexpr size_t WS_HV     = WS_HU   + (size_t)NTOK * 1024 * 2;
constexpr size_t WS_HG     = WS_HV   + (size_t)NTOK * 1024 * 2;
constexpr size_t WS_KVUP   = WS_HG   + (size_t)NTOK * 6144 * 2;
constexpr size_t WS_KC     = WS_KVUP + (size_t)NTOK * 2048 * 2;
constexpr size_t WS_MASK   = WS_KC   + (size_t)2 * 8 * 128 * 128 * 2;
constexpr size_t WS_BR     = WS_MASK + (size_t)NTOK * 32 * 8;
constexpr size_t WS_TT     = WS_BR   + (size_t)3 * NTOK * 1024 * 2;
constexpr size_t WS_MIXT   = WS_TT   + (size_t)256 * 64 * 512 * 4;
constexpr size_t WS_MIXB   = WS_MIXT + (size_t)NTOK * DM * 4;
constexpr size_t WS_X1F    = WS_MIXB + (size_t)NTOK * DM * 2;
constexpr size_t WS_X1B    = WS_X1F  + (size_t)NTOK * DM * 4;
constexpr size_t WS_TOK    = WS_X1B  + (size_t)NTOK * DM * 2;
constexpr size_t WS_ROWW   = WS_TOK  + (size_t)NTOK * 2 * 4 * 4;
constexpr size_t WS_XS     = WS_ROWW + (size_t)MOE_ROWS * 4;
constexpr size_t WS_HM     = WS_XS   + (size_t)MOE_ROWS * DM * 2;
constexpr size_t WS_Y      = WS_HM   + (size_t)MOE_ROWS * DEXP * 2;
constexpr size_t WS_END    = WS_Y    + (size_t)MOE_ROWS * DM * 2;

constexpr int CW_BAR  = 0;
constexpr int CW_Q    = 4096;
constexpr int CW_CNT  = 4096 + 64 * 8;
constexpr int CW_CNTW = 8704;
constexpr int CW_DBG  = 13312;

__device__ __forceinline__ bf16_t f2bf(float f) { unsigned u = __float_as_uint(f); u += 0x7FFFu + ((u >> 16) & 1u); return (bf16_t)(u >> 16); }
__device__ __forceinline__ float bf2f(bf16_t b) { return __uint_as_float(((unsigned)b) << 16); }
__device__ __forceinline__ unsigned cvtpk(float lo, float hi) { unsigned r; asm volatile("v_cvt_pk_bf16_f32 %0, %1, %2" : "=v"(r) : "v"(lo), "v"(hi)); return r; }
__device__ __forceinline__ bf16x8 pack8(f32x4 a, f32x4 b) { u32x4 w = {cvtpk(a[0], a[1]), cvtpk(a[2], a[3]), cvtpk(b[0], b[1]), cvtpk(b[2], b[3])}; return *reinterpret_cast<bf16x8*>(&w); }
__device__ __forceinline__ float fast_sigmoid(float x) { return __builtin_amdgcn_rcpf(1.0f + __builtin_amdgcn_exp2f(-x * LOG2E)); }
__device__ __forceinline__ float gelu_tanh(float x) {
    const float z = 0.7978845608028654f * (x + 0.044715f * x * x * x);
    return x * __builtin_amdgcn_rcpf(1.0f + __builtin_amdgcn_exp2f(-2.0f * LOG2E * z));
}
__device__ __forceinline__ float wave_sum(float v) {
#pragma unroll
    for (int o = 32; o >= 1; o >>= 1) v += __shfl_xor(v, o);
    return v;
}

__device__ __forceinline__ int launder_v(int x) { asm volatile("" : "+v"(x)); return x; }
__device__ __forceinline__ unsigned opaque_zero() { unsigned z; asm volatile("s_mov_b32 %0, 0" : "=s"(z)); return z; }
template <class T> __device__ __forceinline__ T* launder_s(T* p) { typedef __attribute__((address_space(1))) T GT; GT* g = (GT*)((unsigned long long)p + opaque_zero()); return (T*)g; }
#define LTID launder_v((int)threadIdx.x)
#define LBID ((int)(blockIdx.x + opaque_zero()))
namespace pg8 {
#define PG8_LAS __attribute__((address_space(3)))
typedef unsigned short bf16_t;
typedef short bf16x8 __attribute__((ext_vector_type(8)));
typedef float f32x4 __attribute__((ext_vector_type(4)));
typedef unsigned u32x4 __attribute__((ext_vector_type(4)));
constexpr int BM = 256, BK = 64, HALF = 128, HTB = HALF * BK * 2  , STAGE_BYTES = 8 * HTB, NXCD = 8, WGM = 8;

__host__ __device__ __forceinline__ int lds_byte(int r, int c) { const int st = (r >> 4) * 2 + (c >> 5), rr = r & 15, cc = c & 31, ob = rr * 64 + cc * 2; return st * 1024 + (ob ^ (((ob >> 9) & 1) << 5)); }
__host__ __device__ __forceinline__ void stage_rc(int b, int& R, int& C) { const int st = b / 1024, sb = b % 1024, swz = sb ^ (((sb >> 9) & 1) << 5); R = (st >> 1) * 16 + swz / 64; C = (st & 1) * 32 + (swz % 64) / 2; }
__host__ __device__ __forceinline__ int perm32(int rho) { const int n = rho >> 4, i = rho & 15; return 8 * (i >> 2) + 4 * n + (i & 3); }

struct Unit { int pm, pn; };
template <class E, class = void> struct has_keep { static constexpr bool v = false; };
template <class E> struct has_keep<E, decltype((void)&E::keep)> { static constexpr bool v = true; };
struct Gemm { const bf16_t* A; const bf16_t* Bt; int M, N, K; };

struct StaticOrder {
    int nM, nN, nwg, G, c;
    __host__ __device__ void init(int M, int N, int G_, int c_) { nM = M / BM; nN = N / BM; nwg = nM * nN; G = G_; c = c_; }
    __host__ __device__ bool next(int i, Unit& u) const {
        const long L = (long)i * G + c; if (L >= nwg) return false;
        int wgid = (int)L; { const int q = nwg / NXCD, r = nwg % NXCD, xcd = wgid % NXCD, off = wgid / NXCD; wgid = (xcd < r ? xcd * (q + 1) : r * (q + 1) + (xcd - r) * q) + off; }
        const int nig = WGM * nN, gid = wgid / nig, fm = gid * WGM, gsz = (nM - fm) < WGM ? (nM - fm) : WGM;
        u.pm = fm + ((wgid % nig) % gsz); u.pn = (wgid % nig) / gsz; return true;
    }
    __device__ __forceinline__ void a_ready(const Unit&) const {}
    __device__ __forceinline__ void done(const Unit&) const {}
};
struct CountedOrder : StaticOrder {
    const unsigned* ready; unsigned need; unsigned* tmo;
    __device__ __forceinline__ void a_ready(const Unit& u) const {
        if (threadIdx.x < 64) {
            const unsigned long long t0 = __builtin_amdgcn_s_memrealtime(); unsigned polls = 0;
            while ((unsigned)__builtin_amdgcn_readfirstlane(__hip_atomic_load(ready + 64 * u.pm, __ATOMIC_RELAXED, __HIP_MEMORY_SCOPE_AGENT)) < need) {
                if ((++polls & 255u) == 0u && __builtin_amdgcn_readfirstlane(__hip_atomic_load(tmo, __ATOMIC_RELAXED, __HIP_MEMORY_SCOPE_AGENT)) != 0u) break;
                if (__builtin_amdgcn_s_memrealtime() - t0 > 2000000ull) {
                    if (threadIdx.x == 0) { unsigned expect = 0u; __hip_atomic_compare_exchange_strong(tmo + 1, &expect, 0x600u | (unsigned)(u.pm & 0xff), __ATOMIC_RELAXED, __ATOMIC_RELAXED, __HIP_MEMORY_SCOPE_AGENT); __hip_atomic_store(tmo, 1u, __ATOMIC_RELAXED, __HIP_MEMORY_SCOPE_AGENT); }
                    break; }
                __builtin_amdgcn_s_sleep(2); }
            __builtin_amdgcn_fence(__ATOMIC_ACQUIRE, "agent");
            asm volatile("s_waitcnt vmcnt(0)" ::: "memory");
        }
#if !defined(BROKEN_HOOK_NO_BARRIER)
        asm volatile("" ::: "memory"); __builtin_amdgcn_s_barrier(); asm volatile("" ::: "memory");
#endif
    }
};

__device__ __forceinline__ unsigned cvt_pk_bf16(float lo, float hi) { unsigned r; asm volatile("v_cvt_pk_bf16_f32 %0, %1, %2" : "=v"(r) : "v"(lo), "v"(hi)); return r; }
typedef float f32x2 __attribute__((ext_vector_type(2)));
__device__ __forceinline__ f32x2 gelu_pk(f32x2 v) {
    const f32x2 av = __builtin_elementwise_abs(v), d = av * 0.2316418882f + 1.0f;
    f32x2 t; t.x = __builtin_amdgcn_rcpf(d.x); t.y = __builtin_amdgcn_rcpf(d.y);
    f32x2 q = t * 0.5307027145f + (-0.7265760135f); q = q * t + 0.7107068705f; q = q * t + (-0.142248368f); q = q * t + 0.127414796f; q = q * t;
    const f32x2 s = (v * v) * (-0.72134752044f);
    f32x2 e; e.x = __builtin_amdgcn_exp2f(s.x); e.y = __builtin_amdgcn_exp2f(s.y);
    const f32x2 m = v * (q * e), r = v - m;
    f32x2 o; o.x = v.x < 0.f ? m.x : r.x; o.y = v.y < 0.f ? m.y : r.y; return o;
}

struct EpiF32 {
    static constexpr bool PERM = false, AFTER_DRAIN = false;
    float* C; int ldc; const float* bias;
    __device__ __forceinline__ void operator()(const f32x4 (&acc)[2][2][4][2], const Unit& u, int wr, int wc, int fr, int fq) const {
        const int row0 = u.pm * BM + wr * 64 + fr, col0 = u.pn * BM + wc * 32 + 4 * fq;
        f32x4 bv[2][2];
#pragma unroll
        for (int bj = 0; bj < 2; ++bj)
#pragma unroll
            for (int n = 0; n < 2; ++n) bv[bj][n] = bias ? *(const f32x4*)(bias + col0 + bj * HALF + n * 16) : (f32x4){0.f, 0.f, 0.f, 0.f};
#pragma unroll
        for (int ai = 0; ai < 2; ++ai)
#pragma unroll
            for (int m = 0; m < 4; ++m) { float* rowp = C + (size_t)(row0 + ai * HALF + m * 16) * ldc + col0;
#pragma unroll
                for (int bj = 0; bj < 2; ++bj)
#pragma unroll
                    for (int n = 0; n < 2; ++n) *(f32x4*)(rowp + bj * HALF + n * 16) = acc[ai][bj][m][n] + bv[bj][n]; }
    }
};
template <int ACT  > struct EpiBf16 {
    static constexpr bool PERM = true, AFTER_DRAIN = false;
    bf16_t* O; int ldc; const float* bias; int split_cols; size_t split_stride;
    __device__ __forceinline__ void operator()(const f32x4 (&acc)[2][2][4][2], const Unit& u, int wr, int wc, int fr, int fq) const {
        const int row0 = u.pm * BM + wr * 64 + fr; int colt = u.pn * BM; bf16_t* base = O;
        if (split_cols) { const int t = colt / split_cols; base += (size_t)t * split_stride; colt -= t * split_cols; }
        const int col0 = colt + wc * 32 + 8 * fq, bcol0 = u.pn * BM + wc * 32 + 8 * fq;
        f32x4 bv[2][2];
#pragma unroll
        for (int bj = 0; bj < 2; ++bj)
#pragma unroll
            for (int n = 0; n < 2; ++n) bv[bj][n] = bias ? *(const f32x4*)(bias + bcol0 + bj * HALF + 4 * n) : (f32x4){0.f, 0.f, 0.f, 0.f};
#pragma unroll
        for (int ai = 0; ai < 2; ++ai)
#pragma unroll
            for (int m = 0; m < 4; ++m) { bf16_t* rowp = base + (size_t)(row0 + ai * HALF + m * 16) * ldc + col0;
#pragma unroll
                for (int bj = 0; bj < 2; ++bj) { f32x4 v0 = acc[ai][bj][m][0] + bv[bj][0], v1 = acc[ai][bj][m][1] + bv[bj][1];
                    if (ACT == 1) { f32x2 a = gelu_pk((f32x2){v0[0], v0[1]}), b = gelu_pk((f32x2){v0[2], v0[3]}), c = gelu_pk((f32x2){v1[0], v1[1]}), d = gelu_pk((f32x2){v1[2], v1[3]});
                        v0 = (f32x4){a.x, a.y, b.x, b.y}; v1 = (f32x4){c.x, c.y, d.x, d.y}; }
                    if (ACT == 2) {
#pragma unroll
                        for (int j = 0; j < 4; ++j) { v0[j] = 0.5f * v0[j] * (1.0f + erff(v0[j] * 0.70710678f)); v1[j] = 0.5f * v1[j] * (1.0f + erff(v1[j] * 0.70710678f)); } }
                    u32x4 w; w.x = cvt_pk_bf16(v0[0], v0[1]); w.y = cvt_pk_bf16(v0[2], v0[3]); w.z = cvt_pk_bf16(v1[0], v1[1]); w.w = cvt_pk_bf16(v1[2], v1[3]);
                    *(u32x4*)(rowp + bj * HALF) = w; } }
    }
};

struct PanelStats {
    unsigned* xbuf;
    unsigned* cnt;
    unsigned* tmo;
    int ntn; float eps;
    unsigned code;
    __device__ __forceinline__ bool run(const f32x4 (&v)[2][2][4][2], const Unit& u, int wr, int wc, int fr, int fq, PG8_LAS unsigned char* lds, int wid, int lane) const {
        typedef float f32x2v __attribute__((ext_vector_type(2)));
        PG8_LAS f32x2v* P = (PG8_LAS f32x2v*)lds;
        PG8_LAS f32x2v* S = (PG8_LAS f32x2v*)(lds + 8192);
        PG8_LAS unsigned* flag = (PG8_LAS unsigned*)(lds + 8192 + 2048);
#pragma unroll
        for (int ai = 0; ai < 2; ++ai)
#pragma unroll
            for (int m = 0; m < 4; ++m) {
                float s = 0.f;
#pragma unroll
                for (int bj = 0; bj < 2; ++bj)
#pragma unroll
                    for (int n = 0; n < 2; ++n) { const f32x4 x = v[ai][bj][m][n]; s += (x[0] + x[1]) + (x[2] + x[3]); }
                s += __shfl_xor(s, 16); s += __shfl_xor(s, 32);
                const float mw = s * (1.0f / 64.0f); float q = 0.f;
#pragma unroll
                for (int bj = 0; bj < 2; ++bj)
#pragma unroll
                    for (int n = 0; n < 2; ++n) { const f32x4 d = v[ai][bj][m][n] - mw; q += (d[0] * d[0] + d[1] * d[1]) + (d[2] * d[2] + d[3] * d[3]); }
                q += __shfl_xor(q, 16); q += __shfl_xor(q, 32);
                if (fq == 0) P[(ai * HALF + wr * 64 + m * 16 + fr) * 4 + wc] = (f32x2v){mw, q};
            }
        asm volatile("s_waitcnt lgkmcnt(0)" ::: "memory"); __builtin_amdgcn_s_barrier(); asm volatile("" ::: "memory");
#if defined(BROKEN_NO_WAIT)
        if (blockIdx.x >= 64) { const long long t0 = clock64(); while (clock64() - t0 < 60000) __builtin_amdgcn_s_sleep(8); }
#endif
        const int row = wid * 32 + (lane & 31);
        if (lane < 32) {
            const f32x2v a = P[row * 4 + 0], b = P[row * 4 + 1], c = P[row * 4 + 2], d = P[row * 4 + 3];
            const float mt = (a.x + b.x + c.x + d.x) * 0.25f;
            const float da = a.x - mt, db = b.x - mt, dc = c.x - mt, dd = d.x - mt;
            const float m2 = (a.y + b.y) + (c.y + d.y) + 64.0f * ((da * da + db * db) + (dc * dc + dd * dd));
            unsigned long long* slot = (unsigned long long*)xbuf + ((size_t)(u.pm * BM + row) * 4 + u.pn);
            __hip_atomic_store(slot, ((unsigned long long)__float_as_uint(m2) << 32) | __float_as_uint(mt), __ATOMIC_RELAXED, __HIP_MEMORY_SCOPE_AGENT);
        }
        asm volatile("s_waitcnt vmcnt(0)" ::: "memory");
        if (lane == 0) __hip_atomic_fetch_add(cnt + 64 * u.pm, 1u, __ATOMIC_RELAXED, __HIP_MEMORY_SCOPE_AGENT);
        if (wid == 0) {
            bool dead = false; const unsigned long long t0 = __builtin_amdgcn_s_memrealtime(); const unsigned want = 8u * (unsigned)ntn;
            for (;;) {
#if defined(BROKEN_NO_WAIT)
                break;
#endif
                if ((unsigned)__builtin_amdgcn_readfirstlane(__hip_atomic_load(cnt + 64 * u.pm, __ATOMIC_RELAXED, __HIP_MEMORY_SCOPE_AGENT)) >= want) break;
                if (__builtin_amdgcn_s_memrealtime() - t0 > 2000000ull) {
                    if (lane == 0) { unsigned expect = 0u; __hip_atomic_compare_exchange_strong(tmo + 1, &expect, code | (unsigned)(u.pm & 0xff), __ATOMIC_RELAXED, __ATOMIC_RELAXED, __HIP_MEMORY_SCOPE_AGENT);
                                     __hip_atomic_store(tmo, 1u, __ATOMIC_RELAXED, __HIP_MEMORY_SCOPE_AGENT); }
                    dead = true; break; }
                __builtin_amdgcn_s_sleep(2);
            }
            __builtin_amdgcn_fence(__ATOMIC_ACQUIRE, "agent");
            if (lane == 0) flag[0] = dead ? 1u : 0u;
        }
        asm volatile("s_waitcnt vmcnt(0) lgkmcnt(0)" ::: "memory"); __builtin_amdgcn_s_barrier(); asm volatile("" ::: "memory");
        const bool bad = flag[0] != 0u;
        if (lane < 32) {
            const unsigned long long* slot = (const unsigned long long*)xbuf + (size_t)(u.pm * BM + row) * 4; float mt[4], m2[4]; float ms = 0.f;
#pragma unroll
            for (int t = 0; t < 4; ++t) { if (t < ntn) { const unsigned long long w = __hip_atomic_load(slot + t, __ATOMIC_RELAXED, __HIP_MEMORY_SCOPE_AGENT); mt[t] = __uint_as_float((unsigned)w); m2[t] = __uint_as_float((unsigned)(w >> 32)); } else { mt[t] = 0.f; m2[t] = 0.f; } ms += mt[t]; }
            const float mean = ms / (float)ntn; float q = 0.f;
#pragma unroll
            for (int t = 0; t < 4; ++t) if (t < ntn) { const float dm = mt[t] - mean; q += m2[t] + 256.0f * dm * dm; }
            S[row] = (f32x2v){mean, 1.0f / sqrtf(q / (256.0f * (float)ntn) + eps)};
        }
        asm volatile("s_waitcnt lgkmcnt(0)" ::: "memory"); __builtin_amdgcn_s_barrier(); asm volatile("" ::: "memory");
        return bad;
    }
};
struct EpiLnRes {
    static constexpr bool PERM = false, AFTER_DRAIN = true;
    const float* base; float* out; int ldc; const float* bias; PanelStats st; unsigned poison;
    __device__ __forceinline__ void refuse(size_t i0, size_t stride, int M, int N) const { const float q = __builtin_nanf(""); for (size_t i = i0; i < (size_t)M * N; i += stride) out[(i / N) * ldc + i % N] = q;
        if (i0 == 0) { unsigned expect = 0u; __hip_atomic_compare_exchange_strong(st.tmo + 1, &expect, 0x7f0u, __ATOMIC_RELAXED, __ATOMIC_RELAXED, __HIP_MEMORY_SCOPE_AGENT); __hip_atomic_store(st.tmo, 1u, __ATOMIC_RELAXED, __HIP_MEMORY_SCOPE_AGENT); } }
    __device__ __forceinline__ void fused(f32x4 (&acc)[2][2][4][2], const Unit& u, int wr, int wc, int fr, int fq, PG8_LAS unsigned char* lds, int wid, int lane) const {
        typedef float f32x2v __attribute__((ext_vector_type(2)));
        const PG8_LAS f32x2v* S = (const PG8_LAS f32x2v*)(lds + 8192);
        const int col0 = u.pn * BM + wc * 32 + 4 * fq;
#pragma unroll
        for (int bj = 0; bj < 2; ++bj)
#pragma unroll
            for (int n = 0; n < 2; ++n) { const f32x4 bv = bias ? *(const f32x4*)(bias + col0 + bj * HALF + n * 16) : (f32x4){0.f, 0.f, 0.f, 0.f};
#pragma unroll
                for (int ai = 0; ai < 2; ++ai)
#pragma unroll
                    for (int m = 0; m < 4; ++m) acc[ai][bj][m][n] += bv; }
        const bool bad = st.run(acc, u, wr, wc, fr, fq, lds, wid, lane) || poison != 0u;
        const float qnan = __builtin_nanf("");
#pragma unroll
        for (int ai = 0; ai < 2; ++ai)
#pragma unroll
            for (int m = 0; m < 4; ++m) { const int r = ai * HALF + wr * 64 + m * 16 + fr; const f32x2v sr = S[r]; const size_t off = (size_t)(u.pm * BM + r) * ldc + col0;
#pragma unroll
                for (int bj = 0; bj < 2; ++bj)
#pragma unroll
                    for (int n = 0; n < 2; ++n) { const f32x4 bs = *(const f32x4*)(base + off + bj * HALF + n * 16); f32x4 o = bs + (acc[ai][bj][m][n] - sr.x) * sr.y;
                        if (bad) o = (f32x4){qnan, qnan, qnan, qnan}; *(f32x4*)(out + off + bj * HALF + n * 16) = o; }
                asm volatile("" ::: "memory"); }
    }
};
struct EpiLnResLn {
    static constexpr bool PERM = false, AFTER_DRAIN = true;
    const float* base; float* out; bf16_t* xn; int ldc; const float* bias; PanelStats st1, st2; unsigned poison;
    __device__ __forceinline__ void refuse(size_t i0, size_t stride, int M, int N) const { const float q = __builtin_nanf(""); for (size_t i = i0; i < (size_t)M * N; i += stride) { const size_t o = (i / N) * ldc + i % N; out[o] = q; xn[o] = (bf16_t)0x7fc0u; }
        if (i0 == 0) { unsigned expect = 0u; __hip_atomic_compare_exchange_strong(st1.tmo + 1, &expect, 0x7f0u, __ATOMIC_RELAXED, __ATOMIC_RELAXED, __HIP_MEMORY_SCOPE_AGENT); __hip_atomic_store(st1.tmo, 1u, __ATOMIC_RELAXED, __HIP_MEMORY_SCOPE_AGENT); } }
    __device__ __forceinline__ void fused(f32x4 (&acc)[2][2][4][2], const Unit& u, int wr, int wc, int fr, int fq, PG8_LAS unsigned char* lds, int wid, int lane) const {
        typedef float f32x2v __attribute__((ext_vector_type(2))); typedef unsigned u32x2v __attribute__((ext_vector_type(2)));
        const PG8_LAS f32x2v* S = (const PG8_LAS f32x2v*)(lds + 8192);
        const int col0 = u.pn * BM + wc * 32 + 4 * fq;
#pragma unroll
        for (int bj = 0; bj < 2; ++bj)
#pragma unroll
            for (int n = 0; n < 2; ++n) { const f32x4 bv = bias ? *(const f32x4*)(bias + col0 + bj * HALF + n * 16) : (f32x4){0.f, 0.f, 0.f, 0.f};
#pragma unroll
                for (int ai = 0; ai < 2; ++ai)
#pragma unroll
                    for (int m = 0; m < 4; ++m) acc[ai][bj][m][n] += bv; }
        bool bad = st1.run(acc, u, wr, wc, fr, fq, lds, wid, lane) || poison != 0u;
        const float qnan = __builtin_nanf("");
#pragma unroll
        for (int ai = 0; ai < 2; ++ai)
#pragma unroll
            for (int m = 0; m < 4; ++m) { const int r = ai * HALF + wr * 64 + m * 16 + fr; const f32x2v sr = S[r]; const size_t off = (size_t)(u.pm * BM + r) * ldc + col0;
#pragma unroll
                for (int bj = 0; bj < 2; ++bj)
#pragma unroll
                    for (int n = 0; n < 2; ++n) { const f32x4 bs = *(const f32x4*)(base + off + bj * HALF + n * 16); acc[ai][bj][m][n] = bs + (acc[ai][bj][m][n] - sr.x) * sr.y; }
                asm volatile("" : "+v"(acc[ai][0][m][0]), "+v"(acc[ai][0][m][1]), "+v"(acc[ai][1][m][0]), "+v"(acc[ai][1][m][1]));
                if (m & 1) asm volatile("" ::: "memory"); }
        const bool bad1 = bad;
        bad = st2.run(acc, u, wr, wc, fr, fq, lds, wid, lane) || bad;
#pragma unroll
        for (int ai = 0; ai < 2; ++ai)
#pragma unroll
            for (int m = 0; m < 4; ++m) { const int r = ai * HALF + wr * 64 + m * 16 + fr; const f32x2v sr = S[r]; const size_t off = (size_t)(u.pm * BM + r) * ldc + col0;
#pragma unroll
                for (int bj = 0; bj < 2; ++bj)
#pragma unroll
                    for (int n = 0; n < 2; ++n) { const f32x4 x1 = acc[ai][bj][m][n]; *(f32x4*)(out + off + bj * HALF + n * 16) = bad1 ? (f32x4){qnan, qnan, qnan, qnan} : x1;
                        const f32x4 o = (x1 - sr.x) * sr.y; u32x2v w; w.x = cvt_pk_bf16(o[0], o[1]); w.y = cvt_pk_bf16(o[2], o[3]);
                        if (bad) { w.x = 0x7fc07fc0u; w.y = 0x7fc07fc0u; } *(u32x2v*)(xn + off + bj * HALF + n * 16) = w; }
                asm volatile("" ::: "memory"); }
    }
};

template <class Epi, class Sched, bool STAMP = false>
__device__ __forceinline__ void gemm_phase(PG8_LAS unsigned char* lds, const Gemm g, const Sched& S, const Epi& E, unsigned long long* stamps) {
    const int tid = launder_v((int)threadIdx.x), wid = __builtin_amdgcn_readfirstlane(tid >> 6), lane = tid & 63, wr = wid >> 2, wc = wid & 3, fr = lane & 15, fq = lane >> 4;
    const int K = g.K, nt = K / BK;
    int ts_lo = 0, ts_hi = 0, nts = 0; const unsigned long long rt_entry = STAMP ? (unsigned long long)wall_clock64() : 0ull;
#define PG8_STAMP() do { if (STAMP && wid == 0 && nts < 64) { const unsigned long long _c = (unsigned long long)clock64(); \
        ts_lo = (lane == nts) ? (int)(unsigned)_c : ts_lo; ts_hi = (lane == nts) ? (int)(unsigned)(_c >> 32) : ts_hi; ++nts; } } while (0)
    PG8_STAMP();
    unsigned voffA[2], voffB[2];
#pragma unroll
    for (int i = 0; i < 2; ++i) { int R, C; stage_rc(tid * 16 + i * 8192, R, C); const int Rb = Epi::PERM ? ((R & ~31) + perm32(R & 31)) : R;
        voffA[i] = (unsigned)(R * K + C) * 2u; voffB[i] = (unsigned)(Rb * K + C) * 2u; }
    const size_t kstep = (size_t)(BK * 2);
    const size_t hstep = (size_t)HALF * K * 2;
    const size_t tstep = 2 * hstep;
    const unsigned ldsw = (unsigned)wid * 1024u;
    const int aoff = lds_byte(wr * 64 + fr, fq * 8), boff = lds_byte(wc * 32 + fr, fq * 8);
#define PG8_SA(b, h) (((b) * 2 + (h)) * HTB)
#define PG8_SB(b, h) ((4 + (b) * 2 + (h)) * HTB)
#define PG8_STAGE(bufoff, gbase, voff) do { _Pragma("unroll") for (int _i = 0; _i < 2; ++_i) \
        __builtin_amdgcn_global_load_lds((const unsigned*)((const char*)(gbase) + (voff)[_i]), (PG8_LAS unsigned*)(lds + (bufoff) + ldsw + _i * 8192), 16, 0, 0); } while (0)
#define PG8_LDA(dst, b, h) do { _Pragma("unroll") for (int m = 0; m < 4; ++m) _Pragma("unroll") for (int k = 0; k < 2; ++k) dst[m][k] = *(const PG8_LAS bf16x8*)(lds + PG8_SA(b, h) + aoff + m * 2048 + k * 1024); } while (0)
#define PG8_LDB(dst, b, h) do { _Pragma("unroll") for (int n = 0; n < 2; ++n) _Pragma("unroll") for (int k = 0; k < 2; ++k) dst[n][k] = *(const PG8_LAS bf16x8*)(lds + PG8_SB(b, h) + boff + n * 2048 + k * 1024); } while (0)
#define PG8_MMA(ai, bj, At, Bt) do { __builtin_amdgcn_s_setprio(1); _Pragma("unroll") for (int m = 0; m < 4; ++m) _Pragma("unroll") for (int n = 0; n < 2; ++n) _Pragma("unroll") for (int k = 0; k < 2; ++k) \
        acc[ai][bj][m][n] = __builtin_amdgcn_mfma_f32_16x16x32_bf16(Bt[n][k], At[m][k], acc[ai][bj][m][n], 0, 0, 0); __builtin_amdgcn_s_setprio(0); } while (0)
#define PG8_WAIT_V(n) asm volatile("s_waitcnt vmcnt(" #n ")" ::: "memory")
#define PG8_WAIT_L(n) asm volatile("s_waitcnt lgkmcnt(" #n ")" ::: "memory")
#define PG8_BAR __builtin_amdgcn_s_barrier()
#define PG8_SCHED __builtin_amdgcn_sched_barrier(0)
    Unit cur, nxt; int ui = 0;
    if (!S.next(0, cur)) return;
    f32x4 acc[2][2][4][2];
#pragma unroll
    for (int a = 0; a < 2; ++a)
#pragma unroll
        for (int b = 0; b < 2; ++b)
#pragma unroll
            for (int m = 0; m < 4; ++m)
#pragma unroll
                for (int n = 0; n < 2; ++n) acc[a][b][m][n] = (f32x4){0.f, 0.f, 0.f, 0.f};
    bf16x8 At[4][2], B0[2][2], B1[2][2];
    const char* cA = (const char*)g.A + (size_t)cur.pm * tstep; const char* cB = (const char*)g.Bt + (size_t)cur.pn * tstep;
    S.a_ready(cur);
    PG8_STAGE(PG8_SB(0, 0), cB, voffB); PG8_STAGE(PG8_SA(0, 0), cA, voffA); PG8_STAGE(PG8_SB(0, 1), cB + hstep, voffB); PG8_STAGE(PG8_SA(0, 1), cA + hstep, voffA);
    if (wr == 1) PG8_BAR;
    PG8_WAIT_V(4); PG8_BAR;
    PG8_STAGE(PG8_SB(1, 0), cB + kstep, voffB); PG8_STAGE(PG8_SA(1, 0), cA + kstep, voffA); PG8_STAGE(PG8_SB(1, 1), cB + hstep + kstep, voffB);
    PG8_WAIT_V(6); PG8_BAR;
    PG8_STAMP();
    for (;;) {
        const bool has_next = S.next(ui + 1, nxt);
        const char* nA = has_next ? (const char*)g.A + (size_t)nxt.pm * tstep : cA; const char* nB = has_next ? (const char*)g.Bt + (size_t)nxt.pn * tstep : cB;
        for (int t = 0; t < nt; t += 2) {
            const bool last = (t == nt - 2);
            const char* a1 = cA + (size_t)(t + 1) * kstep;
            const char* a2 = last ? nA : cA + (size_t)(t + 2) * kstep; const char* b2 = last ? nB : cB + (size_t)(t + 2) * kstep;
            const char* a3 = a2 + kstep; const char* b3 = b2 + kstep;
            if (last && has_next) S.a_ready(nxt);
            PG8_LDB(B0, 0, 0); PG8_SCHED; PG8_LDA(At, 0, 0); PG8_STAGE(PG8_SA(1, 1), a1 + hstep, voffA);
            PG8_WAIT_L(8); PG8_BAR; PG8_WAIT_L(0); PG8_MMA(0, 0, At, B0); PG8_BAR; PG8_SCHED;
            PG8_LDB(B1, 0, 1); PG8_STAGE(PG8_SB(0, 0), b2, voffB);
            PG8_BAR; PG8_WAIT_L(0); PG8_MMA(0, 1, At, B1); PG8_BAR;
            PG8_LDA(At, 0, 1); PG8_STAGE(PG8_SA(0, 0), a2, voffA);
            PG8_BAR; PG8_WAIT_L(0); PG8_MMA(1, 0, At, B0); PG8_BAR; PG8_SCHED;
            PG8_STAGE(PG8_SB(0, 1), b2 + hstep, voffB);
            PG8_WAIT_V(6); PG8_BAR; PG8_MMA(1, 1, At, B1); PG8_BAR;
            PG8_LDB(B0, 1, 0); PG8_SCHED; PG8_LDA(At, 1, 0); PG8_STAGE(PG8_SA(0, 1), a2 + hstep, voffA);
            PG8_WAIT_L(8); PG8_BAR; PG8_WAIT_L(0); PG8_MMA(0, 0, At, B0); PG8_BAR; PG8_SCHED;
            PG8_LDB(B1, 1, 1); PG8_STAGE(PG8_SB(1, 0), b3, voffB);
            PG8_BAR; PG8_WAIT_L(0); PG8_MMA(0, 1, At, B1); PG8_BAR;
            PG8_LDA(At, 1, 1); PG8_STAGE(PG8_SA(1, 0), a3, voffA);
            PG8_BAR; PG8_WAIT_L(0); PG8_MMA(1, 0, At, B0); PG8_BAR; PG8_SCHED;
            PG8_STAGE(PG8_SB(1, 1), b3 + hstep, voffB);
            PG8_WAIT_V(6); PG8_BAR; PG8_MMA(1, 1, At, B1); PG8_BAR;
        }
        PG8_STAMP();
        if constexpr (!Epi::AFTER_DRAIN) { E(acc, cur, wr, wc, fr, fq); S.done(cur); }
        PG8_STAMP();
        if (!has_next) break;
        bool keep_acc = false;
        if constexpr (has_keep<Epi>::v) keep_acc = E.keep(cur);
        if (!keep_acc)
#pragma unroll
        for (int a = 0; a < 2; ++a)
#pragma unroll
            for (int b = 0; b < 2; ++b)
#pragma unroll
                for (int m = 0; m < 4; ++m)
#pragma unroll
                    for (int n = 0; n < 2; ++n) acc[a][b][m][n] = (f32x4){0.f, 0.f, 0.f, 0.f};
        cur = nxt; cA = nA; cB = nB; ++ui;
    }
    PG8_WAIT_V(0);
    if (wr == 0) PG8_BAR;
    PG8_BAR;
    if constexpr (Epi::AFTER_DRAIN) { E.fused(acc, cur, wr, wc, fr, fq, lds, wid, lane); S.done(cur); }
    PG8_STAMP();
    if (STAMP && wid == 0) { stamps[lane] = lane < nts ? (((unsigned long long)(unsigned)ts_hi << 32) | (unsigned)ts_lo) : 0ull;
        if (lane == 62) stamps[62] = rt_entry; if (lane == 63) stamps[63] = (unsigned long long)wall_clock64(); }
#undef PG8_STAMP
#undef PG8_SA
#undef PG8_SB
#undef PG8_STAGE
#undef PG8_LDA
#undef PG8_LDB
#undef PG8_MMA
#undef PG8_WAIT_V
#undef PG8_WAIT_L
#undef PG8_BAR
#undef PG8_SCHED
}
}
#define XB_TMO      128
#define XB_XCNT(j)  (256  + 64 * (j))
#define XB_XSUB(j)  (1280 + 64 * (j))
#define XB_XGEN(j)  (2304 + 64 * (j))
#define XB_TOP      3328
#define XB_TOPGEN   3392
#define XCD_BAR_WORDS 3456
#define XB_SPIN_CAP (1u << 18)
#define LAS __attribute__((address_space(3)))

__device__ __forceinline__ unsigned xb_ld(unsigned* p)              { return __hip_atomic_load(p, __ATOMIC_RELAXED, __HIP_MEMORY_SCOPE_AGENT); }
__device__ __forceinline__ unsigned xb_add(unsigned* p, unsigned v) { return __hip_atomic_fetch_add(p, v, __ATOMIC_RELAXED, __HIP_MEMORY_SCOPE_AGENT); }
__device__ __forceinline__ unsigned xb_xcc_id() { return (unsigned)__builtin_amdgcn_s_getreg((3 << 11) | 20) & 0xFu; }
#define XB_SPIN(cond, bar) do { unsigned _sp = 0; while (cond) { __builtin_amdgcn_s_sleep(1); \
    if ((++_sp & 255u) == 0u) { if (xb_ld(&(bar)[XB_TMO])) break; if (_sp > XB_SPIN_CAP) { atomicAdd(&(bar)[XB_TMO], 1u); break; } } } } while (0)

struct XcdBarrier {
    unsigned* bar; unsigned x;
    volatile LAS unsigned* st;
};

__device__ __forceinline__ XcdBarrier xcd_barrier_post(unsigned* bar, volatile LAS unsigned* st) {
    XcdBarrier b; b.bar = bar; b.x = xb_xcc_id(); b.st = st;
    if (threadIdx.x == 0) (void)xb_add(&bar[XB_XCNT(b.x)], 1u);
    return b;
}
__device__ __forceinline__ void xcd_barrier_complete(unsigned* bar, unsigned x, unsigned& nloc, unsigned& nx) {
    const unsigned G = gridDim.x * gridDim.y * gridDim.z;
    unsigned sum, cnt, mine, sp = 0u;
    for (;;) {
        sum = 0u; cnt = 0u; mine = 0u;
#pragma unroll
        for (unsigned j = 0; j < 16; ++j) { const unsigned c = xb_ld(&bar[XB_XCNT(j)]); sum += c; cnt += (c > 0u) ? 1u : 0u; mine = (j == x) ? c : mine; }
        if (sum == G) break;
        __builtin_amdgcn_s_sleep(1);
        if ((++sp & 255u) == 0u) { if (xb_ld(&bar[XB_TMO])) break; if (sp > XB_SPIN_CAP) { atomicAdd(&bar[XB_TMO], 1u); break; } }
    }
    nloc = mine > 0u ? mine : 1u; nx = cnt > 0u ? cnt : 1u;
}

__device__ __forceinline__ void xcd_barrier(const XcdBarrier& b) {
    asm volatile("s_waitcnt vmcnt(0)" ::: "memory");
    __syncthreads();
    if (threadIdx.x == 0) {
        unsigned* bar = b.bar;
        __builtin_amdgcn_s_waitcnt(0);
        unsigned nloc = b.st[0], nx = b.st[1];
        if (nloc == 0u) { xcd_barrier_complete(bar, b.x, nloc, nx); b.st[0] = nloc; b.st[1] = nx; }
        const unsigned old = xb_add(&bar[XB_XSUB(b.x)], 1u);
        const unsigned gen = old / nloc;
        if (old + 1u == (gen + 1u) * nloc) {
            __builtin_amdgcn_fence(__ATOMIC_RELEASE, "agent");
            asm volatile("s_waitcnt vmcnt(0)" ::: "memory");
            const unsigned og = xb_add(&bar[XB_TOP], 1u);
            const unsigned tg = og / nx;
            if (og + 1u == (tg + 1u) * nx) xb_add(&bar[XB_TOPGEN], 1u);
            else XB_SPIN(xb_ld(&bar[XB_TOPGEN]) == tg, bar);
            __builtin_amdgcn_fence(__ATOMIC_ACQUIRE, "agent");
            xb_add(&bar[XB_XGEN(b.x)], 1u);
            asm volatile("s_waitcnt vmcnt(0)" ::: "memory");
        } else {
            XB_SPIN(xb_ld(&bar[XB_XGEN(b.x)]) == gen, bar);
            __builtin_amdgcn_fence(__ATOMIC_ACQUIRE, "agent");
            asm volatile("s_waitcnt vmcnt(0)" ::: "memory");
        }
    }
    __syncthreads();
}

struct Args { const float* in[25]; float* out; unsigned char* ws; int ph_lo, ph_hi, rep, sub; };
#define LAS __attribute__((address_space(3)))

struct CvtJob { const float* src; int ld; int ncols; int K; const float* kscale; int kind; bf16_t* dst; bf16_t* dst2; };
__device__ __forceinline__ bf16_t* cvt_dst_row(const CvtJob& j, int c) {
    switch (j.kind) {
    case 0: return j.dst + (size_t)c * j.K;
    case 1: {
        if (c < 2560) return j.dst + (size_t)c * DM;
        if (c < 2584) return j.dst2 + (size_t)(c - 2560) * DM;
        if (c < 4120) return j.dst + (size_t)(c - 24) * DM;
        if (c < 4184) return j.dst2 + (size_t)(24 + c - 4120) * DM;
        if (c < 4188) return j.dst2 + (size_t)(88 + c - 4184) * DM;
        return j.dst + (size_t)(c - 92) * DM; }
    case 2: return j.dst + ((size_t)(c >> 7) * 256 + (c & 127)) * j.K;
    default: return j.dst + ((size_t)(c >> 7) * 256 + 128 + (c & 127)) * j.K;
    }
}
struct CvtTile { CvtJob j; int k0, c0; };
__device__ __forceinline__ bool cvt_decode(const Args& a, unsigned char* ws, int ti, CvtTile& t) {
    if (ti >= NL * (32 * 194 + 2 * 64 * 2 + 2 * 2 * 2 + 2 * 8 * 4 * 2 + 3 * 16 * 32 + 32 * 32 + 2 * 16 * 32 * 8 + 16 * 8 * 32)) return false;
    constexpr int PT_WIN = 32 * 194, PT_W1 = 2 * 64 * 2, PT_W2 = 2 * 2 * 2, PT_WUK = 8 * 4 * 2, PT_WB = 3 * 16 * 32, PT_WO = 32 * 32, PT_EX = 16 * 32 * 8, PT_DN = 16 * 8 * 32;
    constexpr int PT_LAYER = PT_WIN + PT_W1 + PT_W2 + 2 * PT_WUK + PT_WB + PT_WO + 2 * PT_EX + PT_DN;
    const int l = ti / PT_LAYER; int r = ti % PT_LAYER; CvtJob& j = t.j; j.kscale = nullptr; j.dst2 = nullptr; int kt, ct;
    if (r < PT_WIN) { j.src = a.in[1] + (size_t)l * DM * IN_COLS; j.ld = IN_COLS; j.ncols = IN_COLS; j.K = DM; j.kind = 1;
        j.dst = (bf16_t*)(ws + WS_WIN) + (size_t)l * NMAIN * DM; j.dst2 = (bf16_t*)(ws + WS_WSK) + (size_t)l * NSK * DM; kt = r % 32; ct = r / 32; }
    else if ((r -= PT_WIN) < PT_W1) { const int kv = r / 128; r %= 128; j.src = a.in[2] + ((size_t)l * 2 + kv) * 4096 * 128; j.ld = 128; j.ncols = 128; j.K = 4096; j.kind = 0;
        j.dst = (bf16_t*)(ws + WS_W1) + ((size_t)l * 2 + kv) * 128 * 4096; kt = r % 64; ct = r / 64; }
    else if ((r -= PT_W1) < PT_W2) { const int kv = r / 4; r %= 4; j.src = a.in[3] + ((size_t)l * 2 + kv) * 128 * 128; j.ld = 128; j.ncols = 128; j.K = 128; j.kind = 0;
        j.dst = (bf16_t*)(ws + WS_W2) + ((size_t)l * 2 + kv) * 128 * 128; kt = r / 2; ct = r % 2; }
    else if ((r -= PT_W2) < 2 * PT_WUK) { const int which = r / PT_WUK; r %= PT_WUK; const int h = r / 8; r %= 8;
        j.src = a.in[which ? 6 : 5] + ((size_t)l * 8 + h) * 256 * 128; j.ld = 128; j.ncols = 128; j.K = 256; j.kind = 0; j.kscale = a.in[7] + (size_t)l * 256;
        j.dst = (bf16_t*)(ws + WS_WKVUP) + ((size_t)l * 2048 + which * 1024 + h * 128) * 256; kt = r / 2; ct = r % 2; }
    else if ((r -= 2 * PT_WUK) < PT_WB) { const int n = r / 512; r %= 512; j.src = a.in[12] + ((size_t)l * 3 + n) * 1024 * 2048; j.ld = 2048; j.ncols = 2048; j.K = 1024; j.kind = 0;
        j.dst = (bf16_t*)(ws + WS_WB) + ((size_t)l * 3 + n) * 2048 * 1024; kt = r % 16; ct = r / 16; }
    else if ((r -= PT_WB) < PT_WO) { j.src = a.in[13] + (size_t)l * 2048 * 2048; j.ld = 2048; j.ncols = 2048; j.K = 2048; j.kind = 0;
        j.dst = (bf16_t*)(ws + WS_WO) + (size_t)l * 2048 * 2048; kt = r % 32; ct = r / 32; }
    else if ((r -= PT_WO) < 2 * PT_EX) { const int which = r / PT_EX; r %= PT_EX; const int e = r / 256; r %= 256;
        j.src = a.in[which ? 21 : 20] + ((size_t)l * 16 + e) * 2048 * 512; j.ld = 512; j.ncols = 512; j.K = 2048; j.kind = which ? 3 : 2;
        j.dst = (bf16_t*)(ws + WS_WGU) + ((size_t)l * 16 + e) * 1024 * 2048; kt = r % 32; ct = r / 32; }
    else { r -= 2 * PT_EX; const int e = r / 256; r %= 256;
        j.src = a.in[22] + ((size_t)l * 16 + e) * 512 * 2048; j.ld = 2048; j.ncols = 2048; j.K = 512; j.kind = 0;
        j.dst = (bf16_t*)(ws + WS_WD) + ((size_t)l * 16 + e) * 2048 * 512; kt = r % 8; ct = r / 8; }
    t.k0 = kt * 64; t.c0 = ct * 64; return true;
}
__device__ __forceinline__ void cvt_load(const CvtTile& t, f32x4 (&v)[16], int lane) {
    const int c = t.c0 + 4 * (lane & 15); const bool ok = c < t.j.ncols;
    const float* sp = t.j.src + (size_t)(t.k0 + (lane >> 4)) * t.j.ld + c;
#pragma unroll
    for (int i = 0; i < 16; ++i) v[i] = ok ? *(const f32x4*)(sp + (size_t)(4 * i) * t.j.ld) : (f32x4){0.f, 0.f, 0.f, 0.f};
}
__device__ __forceinline__ void cvt_store(const CvtTile& t, const f32x4 (&v)[16], LAS float* T, int lane, bool nostore = false) {
#if defined(PROBE_P0_NOLDS)
    if (nostore) { f32x4 s = v[0];
#pragma unroll
        for (int i = 1; i < 16; ++i) s += v[i];
        if (s[0] + s[1] + s[2] + s[3] == 1.2345e30f) T[lane] = s[0];
        return; }
#endif
#pragma unroll
    for (int i = 0; i < 16; ++i) { LAS float* p = T + (4 * i + (lane >> 4)) * 65 + 4 * (lane & 15); p[0] = v[i][0]; p[1] = v[i][1]; p[2] = v[i][2]; p[3] = v[i][3]; }
    asm volatile("s_waitcnt lgkmcnt(0)" ::: "memory");
    const int q = lane & 7;
#pragma unroll
    for (int i2 = 0; i2 < 8; ++i2) { const int cl = i2 * 8 + (lane >> 3), c = t.c0 + cl;
        float x[8];
#pragma unroll
        for (int e = 0; e < 8; ++e) x[e] = T[(8 * q + e) * 65 + cl];
        if (c < t.j.ncols) { bf16_t* d = cvt_dst_row(t.j, c);
            if (t.j.kscale) {
#pragma unroll
                for (int e = 0; e < 8; ++e) x[e] *= t.j.kscale[t.k0 + 8 * q + e]; }
            u32x4 w = {cvtpk(x[0], x[1]), cvtpk(x[2], x[3]), cvtpk(x[4], x[5]), cvtpk(x[6], x[7])};
            if (!nostore || w.x == 0x12345678u) *(u32x4*)(d + t.k0 + 8 * q) = w; } }
    asm volatile("s_waitcnt lgkmcnt(0)" ::: "memory");
}

__device__ __forceinline__ void p0_prologue(const Args& a, LAS unsigned char* lds, bool nostore = false) {
    LAS float* tl = (LAS float*)lds;
    unsigned char* ws = launder_s(a.ws);
    const int G = gridDim.x, wg = LBID, tid = LTID, wid = tid >> 6, lane = tid & 63;
    {
        LAS float* T = tl + wid * (64 * 65);
        const int step = G * 8; int ti = wg * 8 + wid;
        CvtTile ta, tb; f32x4 va[16], vb[16];
        bool ha = cvt_decode(a, ws, ti, ta); if (ha) cvt_load(ta, va, lane);
        while (ha) {
            const bool hb = cvt_decode(a, ws, ti + step, tb); if (hb) cvt_load(tb, vb, lane);
            cvt_store(ta, va, T, lane, nostore);
            if (!hb) break;
            ti += 2 * step;
            ha = cvt_decode(a, ws, ti, ta); if (ha) cvt_load(ta, va, lane);
            cvt_store(tb, vb, T, lane, nostore);
        }
        __syncthreads();
    }
    const size_t gtid = (size_t)wg * 512 + tid, gn = (size_t)G * 512;
    for (size_t i = gtid; i < (size_t)NL * 36 * DM; i += gn) { const size_t l = i / (36 * DM), r = i % (36 * DM); ((bf16_t*)(ws + WS_WSK))[(l * NSK + 92) * DM + r] = 0; }
    for (size_t i = gtid; i < (size_t)NL * 8 * 128 * 128; i += gn) { const int s = (int)(i & 127), t = (int)((i >> 7) & 127); ((bf16_t*)(ws + WS_WSTRIL))[i] = (s <= t) ? f2bf(a.in[10][i]) : (bf16_t)0; }
    for (size_t i = gtid; i < (size_t)NL * 32 * DM; i += gn) { const int k = (int)(i % DM), n = (int)((i / DM) % 32), l = (int)(i / ((size_t)32 * DM));
        float v = 0.f; if (n < 4) v = a.in[16][((size_t)l * DM + k) * 4 + n]; else if (n < 20) v = a.in[18][((size_t)l * DM + k) * 16 + (n - 4)];
        const bf16_t h = f2bf(v); const bf16_t lo = f2bf(v - bf2f(h));
        bf16_t* d = (bf16_t*)(ws + WS_WR) + (size_t)l * 2 * 32 * DM; d[(size_t)n * DM + k] = h; d[(size_t)(32 + n) * DM + k] = lo; }
    for (int js = wg; js < NL * 2 * 16; js += G) {
        const int job = js >> 4, sl = js & 15;
        const float* pe = a.in[4] + (size_t)job * 4096 + sl * 256; const float* w1 = a.in[2] + (size_t)job * 4096 * 128 + (size_t)sl * 256 * 128;
        const int n = tid & 127, q = tid >> 7; float acc4[4] = {0.f, 0.f, 0.f, 0.f};
#pragma unroll 4
        for (int k = q * 64; k < (q + 1) * 64; k += 4) {
#pragma unroll
            for (int u = 0; u < 4; ++u) acc4[u] += pe[k + u] * w1[(size_t)(k + u) * 128 + n]; }
        tl[q * 128 + n] = (acc4[0] + acc4[1]) + (acc4[2] + acc4[3]); __syncthreads();
        if (tid < 128) ((float*)(ws + WS_C1))[(size_t)js * 128 + tid] = (tl[tid] + tl[128 + tid]) + (tl[256 + tid] + tl[384 + tid]);
        __syncthreads();
    }
    for (size_t i = gtid; i < (size_t)NTOK * DM / 8; i += gn) { const f32x4 v0 = *(const f32x4*)(a.in[0] + i * 8), v1 = *(const f32x4*)(a.in[0] + i * 8 + 4);
        *(bf16x8*)((bf16_t*)(ws + WS_XB) + i * 8) = pack8(v0, v1); }
}

#define MFMA32(a, b, c) __builtin_amdgcn_mfma_f32_32x32x16_bf16((a), (b), (c), 0, 0, 0)
__device__ __forceinline__ int crow(int r, int hi) { return (r & 3) + 8 * (r >> 2) + 4 * hi; }

__device__ __forceinline__ void skinny_item(const Args& a, int l, LAS unsigned char* lds) {
    unsigned char* ws = launder_s(a.ws);
    const int tid = LTID, wid = __builtin_amdgcn_readfirstlane(tid >> 6), lane = tid & 63, r32 = lane & 31, hi = lane >> 5;
    const bf16_t* xb = (const bf16_t*)(ws + WS_XB); const bf16_t* wsk = (const bf16_t*)(ws + WS_WSK) + (size_t)l * NSK * DM;
    for (int it = LBID; it < NTOK / 32; it += gridDim.x) {
        const int row0 = it * 32;
        f32x16 acc[3] = {};
        const bf16_t* ap = xb + (size_t)(row0 + r32) * DM + 256 * wid + 8 * hi;
        const bf16_t* bp = wsk + (size_t)r32 * DM + 256 * wid + 8 * hi;
#pragma unroll 4
        for (int ks = 0; ks < 16; ++ks) {
            const bf16x8 af = *(const bf16x8*)(ap + 16 * ks);
#pragma unroll
            for (int nb = 0; nb < 3; ++nb) { const bf16x8 bfr = *(const bf16x8*)(bp + (size_t)nb * 32 * DM + 16 * ks); acc[nb] = MFMA32(af, bfr, acc[nb]); }
        }
        LAS float* red = (LAS float*)lds;
#pragma unroll
        for (int nb = 0; nb < 3; ++nb)
#pragma unroll
            for (int r = 0; r < 16; ++r) red[((wid * 3 + nb) * 16 + r) * 64 + lane] = acc[nb][r];
        __syncthreads();
        for (int i = tid; i < 3 * 16 * 64; i += 512) {
            float s = 0.f;
#pragma unroll
            for (int w = 0; w < 8; ++w) s += red[w * 3072 + i];
            const int ln = i & 63, r = (i >> 6) & 15, nb = i >> 10;
            const int row = row0 + crow(r, ln >> 5), n = nb * 32 + (ln & 31);
            if (n < 24) ((float*)(ws + WS_SKF))[(size_t)row * 32 + n] = fast_sigmoid(s);
            else if (n < 88) ((bf16_t*)(ws + WS_KI))[(size_t)row * 64 + (n - 24)] = f2bf(s);
            else if (n < 92) ((float*)(ws + WS_SKF))[(size_t)row * 32 + 24 + (n - 88)] = s;
        }
        __syncthreads();
    }
}

struct EpiInProj {
    static constexpr bool PERM = true, AFTER_DRAIN = false;
    unsigned char* ws;
    __device__ __forceinline__ void operator()(const f32x4 (&acc)[2][2][4][2], const pg8::Unit& u, int wr, int wc, int fr, int fq) const {
        const int pn = u.pn; size_t off; int ld, ct, act = 0;
        if (pn < 4)       { off = WS_QA; ld = 1024; ct = pn; }
        else if (pn < 10) { off = WS_KV; ld = 1536; ct = pn - 4; }
        else if (pn < 14) { off = WS_QB; ld = 1024; ct = pn - 10; }
        else if (pn < 15) { off = WS_HC; ld = 256;  ct = 0; }
        else if (pn < 16) { off = WS_QI; ld = 256;  ct = 0; }
        else if (pn < 20) { off = WS_HU; ld = 1024; ct = pn - 16; act = 1; }
        else if (pn < 24) { off = WS_HV; ld = 1024; ct = pn - 20; act = 1; }
        else              { off = WS_HG; ld = 6144; ct = pn - 24; act = 2; }
        bf16_t* base = (bf16_t*)(ws + off);
        const int row0 = u.pm * 256 + wr * 64 + fr, col0 = ct * 256 + wc * 32 + 8 * fq;
#pragma unroll
        for (int ai = 0; ai < 2; ++ai)
#pragma unroll
            for (int m = 0; m < 4; ++m) {
                const int row = row0 + ai * 128 + m * 16; bf16_t* rowp = base + (size_t)row * ld + col0;
                float sq = 0.f;
#pragma unroll
                for (int bj = 0; bj < 2; ++bj) {
                    f32x4 v0 = acc[ai][bj][m][0], v1 = acc[ai][bj][m][1];
                    if (act == 1) {
#pragma unroll
                        for (int e = 0; e < 4; ++e) { v0[e] = gelu_tanh(v0[e]); v1[e] = gelu_tanh(v1[e]); } }
                    else if (act == 2) {
#pragma unroll
                        for (int e = 0; e < 4; ++e) { v0[e] = fast_sigmoid(v0[e]); v1[e] = fast_sigmoid(v1[e]); } }
                    if (pn == 14) {
#pragma unroll
                        for (int e = 0; e < 4; ++e) sq += v0[e] * v0[e] + v1[e] * v1[e]; }
                    u32x4 w; w.x = cvtpk(v0[0], v0[1]); w.y = cvtpk(v0[2], v0[3]); w.z = cvtpk(v1[0], v1[1]); w.w = cvtpk(v1[2], v1[3]);
                    *(u32x4*)(rowp + bj * 128) = w;
                }
                if (pn == 14) { sq += __shfl_xor(sq, 16); sq += __shfl_xor(sq, 32); if (fq == 0) ((float*)(ws + WS_PSQ))[(size_t)row * 4 + wc] = sq; }
            }
    }
};

namespace att {
constexpr int SHM = 16384;
constexpr int L_V = 0, L_K = 2 * SHM, L_WS = 4 * SHM;
constexpr int L_IMP = 69632;
constexpr int L_SELM = L_IMP + 4 * 64 * 33 * 4;
constexpr int L_MISC = L_SELM + 512;
#define KSWZ(row, colB) ((row) * 256 + ((colB) ^ (((row) & 7) << 4)))
__device__ __forceinline__ int v_st(int k, int c) { const int kk = (k & ~0xC) | ((k & 4) << 1) | ((k & 8) >> 1); return ((kk >> 3) * 4 + (c >> 5)) * 512 + ((kk & 7) * 32 + (c & 31)) * 2; }
__device__ __forceinline__ int v_rd_base(int lane) { return ((lane & 3) << 3) | (((lane >> 2) & 3) << 6) | (((lane >> 4) & 1) << 5) | (((lane >> 5) & 1) << 8); }

struct Ctx { int tid, wid, lane, r32, hi, sr, sc, kws, vst0, vst1, vb0; LAS char* lds; LAS float* li_l; LAS float* al_l; };
__device__ __forceinline__ Ctx make_ctx(LAS unsigned char* lds) {
    Ctx c; c.tid = LTID; c.wid = __builtin_amdgcn_readfirstlane(c.tid >> 6); c.lane = c.tid & 63; c.r32 = c.lane & 31; c.hi = c.lane >> 5;
    c.sr = c.tid >> 4; c.sc = (c.tid & 15) * 8; c.kws = KSWZ(c.sr, c.sc * 2); c.vst0 = v_st(c.sr, c.sc); c.vst1 = v_st(32 + c.sr, c.sc);
    c.lds = (LAS char*)lds; c.vb0 = (int)(unsigned)(uintptr_t)(c.lds + L_V) + v_rd_base(c.lane);
    c.li_l = (LAS float*)(c.lds + L_WS + c.wid * 256); c.al_l = c.li_l + 32; return c;
}
struct Stage { bf16x8 k0, k1, v0, v1; };
__device__ __forceinline__ void stage_load(Stage& s, const Ctx& c, const bf16_t* K, int ldk, const bf16_t* V, int ldv, int key0) {
    s.v0 = *(const bf16x8*)(V + (size_t)(key0 + c.sr) * ldv + c.sc); s.v1 = *(const bf16x8*)(V + (size_t)(key0 + 32 + c.sr) * ldv + c.sc);
    s.k0 = *(const bf16x8*)(K + (size_t)(key0 + c.sr) * ldk + c.sc); s.k1 = *(const bf16x8*)(K + (size_t)(key0 + 32 + c.sr) * ldk + c.sc);
}
template <int BUF> __device__ __forceinline__ void stage_write(const Stage& s, const Ctx& c) {
    *(LAS bf16x8*)(c.lds + L_K + BUF * SHM + c.kws) = s.k0; *(LAS bf16x8*)(c.lds + L_K + BUF * SHM + c.kws + 32 * 256) = s.k1;
    *(LAS bf16x8*)(c.lds + L_V + BUF * SHM + c.vst0) = s.v0; *(LAS bf16x8*)(c.lds + L_V + BUF * SHM + c.vst1) = s.v1;
}
template <int KB> __device__ __forceinline__ void qkt(f32x16& p0, f32x16& p1, const Ctx& c, const bf16x8 (&qr)[8]) {
    p0 = f32x16{}; p1 = f32x16{};
    LAS const char* kb[4];
#pragma unroll
    for (int dd = 0; dd < 4; ++dd) kb[dd] = c.lds + L_K + KB * SHM + KSWZ(c.r32, (dd * 16 + c.hi * 8) * 2);
#pragma unroll
    for (int d0 = 0; d0 < 8; ++d0) { LAS const char* a = kb[d0 & 3] + (d0 >> 2) * 128;
        const bf16x8 b0 = *(LAS const bf16x8*)a; const bf16x8 b1 = *(LAS const bf16x8*)(a + 32 * 256);
        p0 = MFMA32(b0, qr[d0], p0); p1 = MFMA32(b1, qr[d0], p1); }
}
template <int VB> __device__ __forceinline__ void pv_tile(f32x16 (&o)[4], int vb0, bf16x8 pa0, bf16x8 pa1, bf16x8 pa2, bf16x8 pa3) {
#define TRRD(dst, off) asm volatile("ds_read_b64_tr_b16 %0, %1 offset:%2" : "=&v"(dst) : "v"(vb0), "i"(off) : "memory")
#define PV_RD(L_, H_, ks) do { constexpr int b_ = VB * SHM + (ks) * 4096; TRRD(L_[0], b_); TRRD(H_[0], b_ + 2048); TRRD(L_[1], b_ + 512); TRRD(H_[1], b_ + 512 + 2048); \
        TRRD(L_[2], b_ + 1024); TRRD(H_[2], b_ + 1024 + 2048); TRRD(L_[3], b_ + 1536); TRRD(H_[3], b_ + 1536 + 2048); } while (0)
#define PV_MM(L_, H_, pa) do { _Pragma("unroll") for (int d0 = 0; d0 < 4; ++d0) \
        o[d0] = MFMA32(pa, ((bf16x8){L_[d0][0], L_[d0][1], L_[d0][2], L_[d0][3], H_[d0][0], H_[d0][1], H_[d0][2], H_[d0][3]}), o[d0]); } while (0)
    s16x4 la[4], ha[4], lb[4], hb[4];
    PV_RD(la, ha, 0);
    PV_RD(lb, hb, 1); asm volatile("s_waitcnt lgkmcnt(8)" ::: "memory"); __builtin_amdgcn_sched_barrier(0); PV_MM(la, ha, pa0); __builtin_amdgcn_sched_barrier(0);
    PV_RD(la, ha, 2); asm volatile("s_waitcnt lgkmcnt(8)" ::: "memory"); __builtin_amdgcn_sched_barrier(0); PV_MM(lb, hb, pa1); __builtin_amdgcn_sched_barrier(0);
    PV_RD(lb, hb, 3); asm volatile("s_waitcnt lgkmcnt(8)" ::: "memory"); __builtin_amdgcn_sched_barrier(0); PV_MM(la, ha, pa2); __builtin_amdgcn_sched_barrier(0);
    asm volatile("s_waitcnt lgkmcnt(0)" ::: "memory"); __builtin_amdgcn_sched_barrier(0); PV_MM(lb, hb, pa3);
#undef PV_RD
#undef PV_MM
#undef TRRD
}
__device__ __forceinline__ float pair_max(float v) { auto rr = __builtin_amdgcn_permlane32_swap(__float_as_uint(v), __float_as_uint(v), false, false); return fmaxf(__uint_as_float(rr[0]), __uint_as_float(rr[1])); }
__device__ __forceinline__ float pair_sum(float v) { auto rr = __builtin_amdgcn_permlane32_swap(__float_as_uint(v), __float_as_uint(v), false, false); return __uint_as_float(rr[0]) + __uint_as_float(rr[1]); }
#define PK4(P, B_, OUT) do { unsigned xa0_ = cvtpk(P[B_+0], P[B_+1]), xa1_ = cvtpk(P[B_+2], P[B_+3]); \
        unsigned xb0_ = cvtpk(P[B_+4], P[B_+5]), xb1_ = cvtpk(P[B_+6], P[B_+7]); \
        auto xr0_ = __builtin_amdgcn_permlane32_swap(xa0_, xb0_, false, false); auto xr1_ = __builtin_amdgcn_permlane32_swap(xa1_, xb1_, false, false); \
        u32x4 xw_ = {xr0_[0], xr1_[0], xr0_[1], xr1_[1]}; OUT = *reinterpret_cast<bf16x8*>(&xw_); } while (0)

enum { MODE_WIN = 0, MODE_SEL = 1, MODE_BITS = 2, MODE_CMP = 3 };
template <int MODE> __device__ __forceinline__ void bias_mask(f32x16& p0, f32x16& p1, float bias0, float slope2k, int dq, unsigned W, bool rowsel, unsigned wlo, unsigned whi, int lim) {
    const float NEG = -__builtin_inff();
#pragma unroll
    for (int r = 0; r < 16; ++r) {
        const int cc = (r & 3) + 8 * (r >> 2);
        const float y0 = fmaf(p0[r], ATT_C2, fmaf(slope2k, (float)cc, bias0)), y1 = fmaf(p1[r], ATT_C2, fmaf(slope2k, (float)(cc + 32), bias0));
        bool ok0, ok1;
        if (MODE == MODE_WIN)       { ok0 = (unsigned)(dq - cc) < W; ok1 = (unsigned)(dq - cc - 32) < W; }
        else if (MODE == MODE_SEL)  { ok0 = rowsel && (dq - cc >= 0); ok1 = rowsel && (dq - cc - 32 >= 0); }
        else if (MODE == MODE_BITS) { ok0 = (wlo >> cc) & 1u; ok1 = (whi >> cc) & 1u; }
        else                        { ok0 = cc <= lim; ok1 = cc + 32 <= lim; }
        p0[r] = ok0 ? y0 : NEG; p1[r] = ok1 ? y1 : NEG;
    }
}
__device__ __forceinline__ void softmax_step(f32x16& p0, f32x16& p1, float& m, float& l, f32x16 (&o)[4], const Ctx& c, bf16x8& pa0, bf16x8& pa1, bf16x8& pa2, bf16x8& pa3) {
    float pmax = p0[0];
#pragma unroll
    for (int r = 1; r < 16; ++r) pmax = fmaxf(pmax, p0[r]);
#pragma unroll
    for (int r = 0; r < 16; ++r) pmax = fmaxf(pmax, p1[r]);
    pmax = pair_max(pmax);
    const float mn = fmaxf(m, pmax), alpha = __builtin_amdgcn_exp2f(m - mn); m = mn;
#pragma unroll
    for (int r = 0; r < 16; ++r) { p0[r] = __builtin_amdgcn_exp2f(p0[r] - mn); p1[r] = __builtin_amdgcn_exp2f(p1[r] - mn); }
    float ps = 0.f;
#pragma unroll
    for (int r = 0; r < 16; ++r) ps += p0[r] + p1[r];
    ps = pair_sum(ps); l = l * alpha + ps;
    PK4(p0, 0, pa0); PK4(p0, 8, pa1); PK4(p1, 0, pa2); PK4(p1, 8, pa3);
    if (__any(alpha < 1.f)) {
        if (c.hi == 0) c.al_l[c.r32] = alpha;
        asm volatile("s_waitcnt lgkmcnt(0)" ::: "memory");
#pragma unroll
        for (int r = 0; r < 16; ++r) { const float al = c.al_l[crow(r, c.hi)];
#pragma unroll
            for (int d = 0; d < 4; ++d) o[d][r] *= al; }
    }
}
struct BranchArgs {
    const bf16_t* K; const bf16_t* V; int ldk, ldv;
    unsigned tilemask;
    int t; float slope2;
    unsigned rowsel;
    const unsigned long long* mrow;
    unsigned W;
    int tw0;
};
template <int MODE> __device__ __forceinline__ void softmax_tile(f32x16& p0, f32x16& p1, float slope2k, float s32, float bias0, bool emask, int dq, unsigned W, unsigned wlo, unsigned whi, int lim,
                                                                 float& m, float& l, f32x16 (&o)[4], const Ctx& c, bf16x8& pa0, bf16x8& pa1, bf16x8& pa2, bf16x8& pa3) {
    const float NEG = -__builtin_inff();
#pragma unroll
    for (int r = 0; r < 16; ++r) { const float cf_ = (float)((r & 3) + 8 * (r >> 2)); p0[r] = fmaf(slope2k, cf_, p0[r] * ATT_C2); p1[r] = fmaf(slope2k, cf_, p1[r] * ATT_C2); }
    if (emask) {
#pragma unroll
        for (int r = 0; r < 16; ++r) { const int cc = (r & 3) + 8 * (r >> 2); bool ok0, ok1;
            if (MODE == MODE_WIN)       { ok0 = (unsigned)(dq - cc) < W; ok1 = (unsigned)(dq - cc - 32) < W; }
            else if (MODE == MODE_SEL)  { ok0 = (dq - cc >= 0); ok1 = (dq - cc - 32 >= 0); }
            else if (MODE == MODE_BITS) { ok0 = (wlo >> cc) & 1u; ok1 = (whi >> cc) & 1u; }
            else                        { ok0 = cc <= lim; ok1 = cc + 32 <= lim; }
            p0[r] = ok0 ? p0[r] : NEG; p1[r] = ok1 ? p1[r] : NEG; }
    }
    float z0 = p0[0], z1 = p1[0];
#pragma unroll
    for (int r = 1; r < 16; ++r) { z0 = fmaxf(z0, p0[r]); z1 = fmaxf(z1, p1[r]); }
    const float pmax = pair_max(fmaxf(z0, z1 + s32) + bias0);
    const float mn = fmaxf(m, pmax), alpha = __builtin_amdgcn_exp2f(m - mn); m = mn;
    const float d0 = bias0 - mn, d1 = d0 + s32;
#pragma unroll
    for (int r = 0; r < 16; ++r) { p0[r] = __builtin_amdgcn_exp2f(p0[r] + d0); p1[r] = __builtin_amdgcn_exp2f(p1[r] + d1); }
    float ps = 0.f;
#pragma unroll
    for (int r = 0; r < 16; ++r) ps += p0[r] + p1[r];
    ps = pair_sum(ps); l = l * alpha + ps;
    PK4(p0, 0, pa0); PK4(p0, 8, pa1); PK4(p1, 0, pa2); PK4(p1, 8, pa3);
    if (__any(alpha < 1.f)) {
        if (c.hi == 0) c.al_l[c.r32] = alpha;
        asm volatile("s_waitcnt lgkmcnt(0)" ::: "memory");
#pragma unroll
        for (int r = 0; r < 16; ++r) { const float al = c.al_l[crow(r, c.hi)];
#pragma unroll
            for (int d = 0; d < 4; ++d) o[d][r] *= al; }
    }
}
template <int MODE, int BUF> __device__ __forceinline__ void branch_step(const Ctx& c, const bf16x8 (&qr)[8], const BranchArgs& A, float slope2k, float s32, int j, unsigned long long mw, f32x16 (&o)[4], float& m, float& l) {
    f32x16 p0, p1; bf16x8 pa0, pa1, pa2, pa3;
    qkt<BUF>(p0, p1, c, qr);
    const int kb = j * 64, dq = A.t - kb - 4 * c.hi;
    if (MODE == MODE_CMP) {
        softmax_tile<MODE>(p0, p1, slope2k, s32, -A.slope2 * (float)(A.t - 31 - 16 * (kb + 4 * c.hi)), true, 0, 0u, 0u, 0u, (int)A.W - kb - 4 * c.hi, m, l, o, c, pa0, pa1, pa2, pa3);
    } else {
        float bias0 = -A.slope2 * (float)dq; bool emask;
        if (MODE == MODE_WIN) emask = (kb + 63 > A.tw0) || (kb <= A.tw0 + 31 - (int)A.W);
        else if (MODE == MODE_SEL) { emask = (kb + 63 > A.tw0); if (!((A.rowsel >> j) & 1u)) bias0 = -__builtin_inff(); }
        else emask = !__all(mw == ~0ull);
        softmax_tile<MODE>(p0, p1, slope2k, s32, bias0, emask, dq, A.W, (unsigned)(mw >> (4 * c.hi)), (unsigned)(mw >> (32 + 4 * c.hi)), 0, m, l, o, c, pa0, pa1, pa2, pa3);
    }
    pv_tile<BUF>(o, c.vb0, pa0, pa1, pa2, pa3);
}
template <int MODE> __device__ __forceinline__ void attn_branch(const Ctx& c, const bf16x8 (&qr)[8], const BranchArgs& A, f32x16 (&o)[4], float& l, float& m) {
    m = -1e30f; l = 0.f;
#pragma unroll
    for (int d = 0; d < 4; ++d) o[d] = f32x16{};
    const float slope2k = (MODE == MODE_CMP) ? A.slope2 * 16.f : A.slope2, s32 = 32.f * slope2k;
    unsigned rest = A.tilemask; int j0 = __builtin_ctz(rest); rest &= rest - 1;
    bool h1 = rest != 0u; int j1 = h1 ? __builtin_ctz(rest) : j0; rest &= rest - 1;
    Stage sA, sB; unsigned long long mwA = 0, mwB = 0, mwC = 0, mwD = 0;
    stage_load(sA, c, A.K, A.ldk, A.V, A.ldv, j0 * 64); if (MODE == MODE_BITS) mwA = A.mrow[j0];
    if (h1) { stage_load(sB, c, A.K, A.ldk, A.V, A.ldv, j1 * 64); if (MODE == MODE_BITS) mwB = A.mrow[j1]; }
    stage_write<0>(sA, c);
    __syncthreads();
    for (;;) {
        const bool h2 = rest != 0u; const int j2 = h2 ? __builtin_ctz(rest) : j1; rest &= rest - 1;
        if (h2) { stage_load(sA, c, A.K, A.ldk, A.V, A.ldv, j2 * 64); if (MODE == MODE_BITS) mwC = A.mrow[j2]; }
        branch_step<MODE, 0>(c, qr, A, slope2k, s32, j0, mwA, o, m, l);
        if (h1) stage_write<1>(sB, c);
        __syncthreads();
        if (!h1) break;
        const bool h3 = rest != 0u; const int j3 = h3 ? __builtin_ctz(rest) : j2; rest &= rest - 1;
        if (h3) { stage_load(sB, c, A.K, A.ldk, A.V, A.ldv, j3 * 64); if (MODE == MODE_BITS) mwD = A.mrow[j3]; }
        branch_step<MODE, 1>(c, qr, A, slope2k, s32, j1, mwB, o, m, l);
        if (h2) stage_write<0>(sA, c);
        __syncthreads();
        if (!h2) break;
        j0 = j2; mwA = mwC; h1 = h3; j1 = j3; mwB = mwD;
    }
}
__device__ __forceinline__ void row_coef(const Ctx& c, float coef, float (&cf)[16]) {
    if (c.hi == 0) c.li_l[c.r32] = coef;
    asm volatile("s_waitcnt lgkmcnt(0)" ::: "memory");
#pragma unroll
    for (int r = 0; r < 16; ++r) cf[r] = c.li_l[crow(r, c.hi)];
    asm volatile("s_waitcnt lgkmcnt(0)" ::: "memory");
}
__device__ __forceinline__ void store_rows_bf16(const Ctx& c, const f32x16 (&v)[4], bf16_t* base, size_t rowstride) {
#pragma unroll
    for (int r = 0; r < 16; ++r) { bf16_t* rp = base + (size_t)crow(r, c.hi) * rowstride;
#pragma unroll
        for (int d0 = 0; d0 < 4; ++d0) { const float x = v[d0][r]; const float xn = __shfl_xor(x, 1);
            if ((c.r32 & 1) == 0) *(unsigned*)(rp + d0 * 32 + c.r32) = cvtpk(x, xn); } }
}

__device__ __forceinline__ void nsa_item(const Args& a, LAS unsigned char* ldsu, int b, int hkv, int qb) {
    unsigned char* ws = launder_s(a.ws); Ctx c = make_ctx(ldsu);
    const int g = c.wid >> 1, half = c.wid & 1, head = hkv * 4 + g;
    const int tl = half * 32 + c.r32, t = qb * 64 + tl;
    const size_t tok = (size_t)b * SEQ + t;
    const float slope2 = __builtin_amdgcn_exp2f(-(float)(head + 1)) * LOG2E;
    bf16x8 qr[8];
    { const bf16_t* qp = (const bf16_t*)(ws + WS_QA) + tok * 1024 + head * 128 + c.hi * 8;
#pragma unroll
      for (int d0 = 0; d0 < 8; ++d0) qr[d0] = *(const bf16x8*)(qp + d0 * 16); }
    const float* gate = (const float*)(ws + WS_SKF) + tok * 32 + head * 3;
    float* TT = (float*)(ws + WS_TT) + ((size_t)LBID * 512 + c.tid) * 64;
    f32x16 o[4]; float cf[16];
    BranchArgs A; A.t = t; A.slope2 = slope2; A.mrow = nullptr; A.rowsel = 0; A.tw0 = qb * 64 + half * 32;
#ifndef NSA_NO_CMP
    {
        const bf16_t* KC = (const bf16_t*)(ws + WS_KC) + (size_t)(b * 2 + hkv) * 128 * 128;
        const bool two = qb >= 16;
        int lim = (t - 31) >> 4; lim = lim > 126 ? 126 : lim;
        A.K = KC; A.V = KC + (size_t)8 * 128 * 128; A.ldk = 128; A.ldv = 128; A.tilemask = two ? 3u : 1u; A.W = (unsigned)lim;
        float l, m; attn_branch<MODE_CMP>(c, qr, A, o, l, m);
        const float inv = l > 0.f ? 1.0f / l : 0.f;
        if (two) {
            LAS float* IMP = (LAS float*)(c.lds + L_IMP) + (g * 64 + tl) * 33;
            float prev = 0.f;
#define IMP_TILE(BUF) do { f32x16 p0, p1; qkt<BUF>(p0, p1, c, qr); \
                bias_mask<MODE_CMP>(p0, p1, -slope2 * (float)(t - 31 - 16 * (BUF * 64 + 4 * c.hi)), slope2 * 16.f, 0, 0u, false, 0u, 0u, lim - BUF * 64 - 4 * c.hi); \
                _Pragma("unroll") for (int r = 0; r < 16; ++r) { p0[r] = __builtin_amdgcn_exp2f(p0[r] - m) * inv; p1[r] = __builtin_amdgcn_exp2f(p1[r] - m) * inv; } \
                _Pragma("unroll") for (int k = 0; k < 8; ++k) { const int mm = k & 3; \
                    const float s4 = (k < 4) ? (p0[4 * mm] + p0[4 * mm + 1]) + (p0[4 * mm + 2] + p0[4 * mm + 3]) : (p1[4 * mm] + p1[4 * mm + 1]) + (p1[4 * mm + 2] + p1[4 * mm + 3]); \
                    const float lst = (k < 4) ? p0[4 * mm + 3] : p1[4 * mm + 3]; \
                    auto rr = __builtin_amdgcn_permlane32_swap(__float_as_uint(lst), __float_as_uint(lst), false, false); \
                    const float from_lo = __uint_as_float(rr[0]), from_hi = __uint_as_float(rr[1]); \
                    IMP[2 * (BUF * 8 + k) + c.hi] = s4 + (c.hi ? from_lo : prev);     \
                    prev = from_hi; } } while (0)
            IMP_TILE(0); IMP_TILE(1);
#undef IMP_TILE
        }
        row_coef(c, gate[0] * inv, cf);
#pragma unroll
        for (int d0 = 0; d0 < 4; ++d0)
#pragma unroll
            for (int r4 = 0; r4 < 4; ++r4) { f32x4 v = {o[d0][4 * r4] * cf[4 * r4], o[d0][4 * r4 + 1] * cf[4 * r4 + 1], o[d0][4 * r4 + 2] * cf[4 * r4 + 2], o[d0][4 * r4 + 3] * cf[4 * r4 + 3]}; *(f32x4*)(TT + d0 * 16 + r4 * 4) = v; }
        __syncthreads();
    }
#endif
#ifndef NSA_NO_SELECT
    {
        LAS unsigned* SELM = (LAS unsigned*)(c.lds + L_SELM);
        if (qb <= 15) { if (c.tid <= 64) SELM[c.tid] = (2u << qb) - 1u; }
        else {
            LAS float* VS = (LAS float*)(c.lds + L_MISC + 256);
            const int tq = c.tid & 63, jg = c.tid >> 6;
            { LAS const float* I0 = (LAS const float*)(c.lds + L_IMP) + tq * 33;
#pragma unroll
              for (int e = 0; e < 4; ++e) { const int j = 4 * jg + e; VS[tq * 33 + j] = (I0[j] + I0[64 * 33 + j]) + (I0[2 * 64 * 33 + j] + I0[3 * 64 * 33 + j]); } }
            if (c.tid < 64) SELM[c.tid] = 1u | (1u << qb) | (1u << (qb - 1));
            __syncthreads();
            float vj[4]; int rank[4] = {0, 0, 0, 0};
#pragma unroll
            for (int e = 0; e < 4; ++e) vj[e] = VS[tq * 33 + 4 * jg + e];
#pragma unroll 4
            for (int j2 = 1; j2 <= qb - 2; ++j2) { const float v2 = VS[tq * 33 + j2];
#pragma unroll
                for (int e = 0; e < 4; ++e) rank[e] += ((v2 > vj[e]) || (v2 == vj[e] && j2 < 4 * jg + e)) ? 1 : 0; }
            unsigned bits = 0u;
#pragma unroll
            for (int e = 0; e < 4; ++e) { const int j = 4 * jg + e; if (j >= 1 && j <= qb - 2 && rank[e] < 13) bits |= 1u << j; }
            if (bits) __hip_atomic_fetch_or(SELM + tq, bits, __ATOMIC_RELAXED, __HIP_MEMORY_SCOPE_WORKGROUP);
            __syncthreads();
            if (c.wid == 0) { unsigned any = SELM[c.lane];
#pragma unroll
                for (int ofs = 32; ofs >= 1; ofs >>= 1) any |= (unsigned)__shfl_xor((int)any, ofs);
                if (c.lane == 0) SELM[64] = any; }
        }
        __syncthreads();
    }
#endif
    A.ldk = 1536; A.ldv = 1536; A.W = 0x7fffffffu;
    const bf16_t* KVb = (const bf16_t*)(ws + WS_KV) + (size_t)b * SEQ * 1536 + hkv * 128;
#ifndef NSA_NO_SEL
    {
        c = make_ctx(ldsu); ws = launder_s(ws);
        LAS const unsigned* SELM = (LAS const unsigned*)(c.lds + L_SELM);
        A.K = KVb + 512; A.V = KVb + 768; A.rowsel = SELM[tl];
        A.tilemask = (unsigned)__builtin_amdgcn_readfirstlane((int)SELM[64]) & ((2u << qb) - 1u);
        float l, m; attn_branch<MODE_SEL>(c, qr, A, o, l, m);
        row_coef(c, gate[1] * (l > 0.f ? 1.0f / l : 0.f), cf);
#pragma unroll
        for (int d0 = 0; d0 < 4; ++d0) {
#pragma unroll
            for (int r4 = 0; r4 < 4; ++r4) { f32x4 v = *(const f32x4*)(TT + d0 * 16 + r4 * 4);
                v[0] += o[d0][4 * r4] * cf[4 * r4]; v[1] += o[d0][4 * r4 + 1] * cf[4 * r4 + 1]; v[2] += o[d0][4 * r4 + 2] * cf[4 * r4 + 2]; v[3] += o[d0][4 * r4 + 3] * cf[4 * r4 + 3]; *(f32x4*)(TT + d0 * 16 + r4 * 4) = v; }
            asm volatile("" ::: "memory"); }
    }
#endif
#ifndef NSA_NO_WIN
    {
        c = make_ctx(ldsu); ws = launder_s(ws);
        A.K = KVb + 1024; A.V = KVb + 1280; A.W = 512u;
        const int jlo = qb >= 8 ? qb - 8 : 0;
        A.tilemask = ((2u << qb) - 1u) & ~((1u << jlo) - 1u);
        float l, m; attn_branch<MODE_WIN>(c, qr, A, o, l, m);
        row_coef(c, gate[2] * (l > 0.f ? 1.0f / l : 0.f), cf);
#pragma unroll
        for (int d0 = 0; d0 < 4; ++d0) {
#pragma unroll
            for (int r4 = 0; r4 < 4; ++r4) { const f32x4 v = *(const f32x4*)(TT + d0 * 16 + r4 * 4);
                o[d0][4 * r4] = v[0] + o[d0][4 * r4] * cf[4 * r4]; o[d0][4 * r4 + 1] = v[1] + o[d0][4 * r4 + 1] * cf[4 * r4 + 1]; o[d0][4 * r4 + 2] = v[2] + o[d0][4 * r4 + 2] * cf[4 * r4 + 2]; o[d0][4 * r4 + 3] = v[3] + o[d0][4 * r4 + 3] * cf[4 * r4 + 3]; }
            asm volatile("" ::: "memory"); }
        store_rows_bf16(c, o, (bf16_t*)(ws + WS_BR) + ((size_t)b * SEQ + qb * 64 + half * 32) * 1024 + head * 128, 1024);
    }
#endif
}

__device__ __forceinline__ void dsa_item(const Args& a, LAS unsigned char* ldsu, int b, int h, int qb) {
    unsigned char* ws = launder_s(a.ws); const Ctx c = make_ctx(ldsu);
    const int t = qb * 256 + c.wid * 32 + c.r32; const size_t tok = (size_t)b * SEQ + t;
    bf16x8 qr[8];
    { const bf16_t* qp = (const bf16_t*)(ws + WS_QB) + tok * 1024 + h * 128 + c.hi * 8;
#pragma unroll
      for (int d0 = 0; d0 < 8; ++d0) qr[d0] = *(const bf16x8*)(qp + d0 * 16); }
    BranchArgs A; A.tw0 = qb * 256 + c.wid * 32; A.ldk = 2048; A.ldv = 2048; A.t = t; A.slope2 = __builtin_amdgcn_exp2f(-(float)(h + 1)) * LOG2E; A.W = 0; A.rowsel = 0;
    const bf16_t* kv = (const bf16_t*)(ws + WS_KVUP) + (size_t)b * SEQ * 2048 + h * 128;
    A.K = kv; A.V = kv + 1024; A.mrow = (const unsigned long long*)(ws + WS_MASK) + tok * 32;
    const int nt = 4 * qb + 4; A.tilemask = nt >= 32 ? 0xffffffffu : ((1u << nt) - 1u);
    f32x16 o[4]; float l, m, cf[16];
    attn_branch<MODE_BITS>(c, qr, A, o, l, m);
    row_coef(c, l > 0.f ? 1.0f / l : 0.f, cf);
#pragma unroll
    for (int d0 = 0; d0 < 4; ++d0)
#pragma unroll
        for (int r = 0; r < 16; ++r) o[d0][r] *= cf[r];
    store_rows_bf16(c, o, (bf16_t*)(ws + WS_BR) + (size_t)NTOK * 1024 + ((size_t)b * SEQ + qb * 256 + c.wid * 32) * 1024 + h * 128, 1024);
}

__device__ __forceinline__ void gmlp_item(const Args& a, LAS unsigned char* ldsu, int l, int b, int ch, int gp) {
    unsigned char* ws = launder_s(a.ws); const Ctx c = make_ctx(ldsu);
    const size_t tok0 = (size_t)b * SEQ + ch * 128;
    const bf16_t* HV = (const bf16_t*)(ws + WS_HV);
#pragma unroll
    for (int gs = 0; gs < 2; ++gs)
#pragma unroll
        for (int st = 0; st < 2; ++st) {
            const bf16_t* vp = HV + (tok0 + st * 64) * 1024 + (2 * gp + gs) * 128 + c.sc;
            const bf16x8 x0 = *(const bf16x8*)(vp + (size_t)c.sr * 1024), x1 = *(const bf16x8*)(vp + (size_t)(32 + c.sr) * 1024);
            *(LAS bf16x8*)(c.lds + L_V + (2 * gs + st) * SHM + c.vst0) = x0; *(LAS bf16x8*)(c.lds + L_V + (2 * gs + st) * SHM + c.vst1) = x1;
        }
    __syncthreads();
    const int gs = c.wid >> 2, wq = c.wid & 3, g = 2 * gp + gs;
    const bf16_t* Wp = (const bf16_t*)(ws + WS_WSTRIL) + (((size_t)l * 8 + g) * 128 + wq * 32 + c.r32) * 128 + c.hi * 8;
    f32x16 o[4] = {};
    bf16x8 pa0 = *(const bf16x8*)(Wp), pa1 = *(const bf16x8*)(Wp + 16), pa2 = *(const bf16x8*)(Wp + 32), pa3 = *(const bf16x8*)(Wp + 48);
    if (gs == 0) pv_tile<0>(o, c.vb0, pa0, pa1, pa2, pa3); else pv_tile<2>(o, c.vb0, pa0, pa1, pa2, pa3);
    if (wq >= 2) {
        pa0 = *(const bf16x8*)(Wp + 64); pa1 = *(const bf16x8*)(Wp + 80); pa2 = *(const bf16x8*)(Wp + 96); pa3 = *(const bf16x8*)(Wp + 112);
        if (gs == 0) pv_tile<1>(o, c.vb0, pa0, pa1, pa2, pa3); else pv_tile<3>(o, c.vb0, pa0, pa1, pa2, pa3);
    }
    const float* bs = a.in[11] + ((size_t)l * 8 + g) * 128 + wq * 32;
    const bf16_t* HU = (const bf16_t*)(ws + WS_HU) + (tok0 + wq * 32) * 1024 + g * 128;
#pragma unroll
    for (int r = 0; r < 16; ++r) { const int rr = crow(r, c.hi); const float bias = bs[rr];
#pragma unroll
        for (int d0 = 0; d0 < 4; ++d0) o[d0][r] = (o[d0][r] + bias) * bf2f(HU[(size_t)rr * 1024 + d0 * 32 + c.r32]); }
    store_rows_bf16(c, o, (bf16_t*)(ws + WS_BR) + (size_t)2 * NTOK * 1024 + (tok0 + wq * 32) * 1024 + g * 128, 1024);
    __syncthreads();
}
}

struct EpiKvUp {
    static constexpr bool PERM = true, AFTER_DRAIN = false;
    unsigned char* ws;
    __device__ __forceinline__ void operator()(const f32x4 (&acc)[2][2][4][2], const pg8::Unit& u, int wr, int wc, int fr, int fq) const {
        bf16_t* base = (bf16_t*)(ws + WS_KVUP); const float* psq = (const float*)(ws + WS_PSQ);
        const int row0 = u.pm * 256 + wr * 64 + fr, col0 = u.pn * 256 + wc * 32 + 8 * fq;
        f32x4 qn = *(const f32x4*)(psq + (size_t)row0 * 4);
#pragma unroll
        for (int ai = 0; ai < 2; ++ai)
#pragma unroll
            for (int m = 0; m < 4; ++m) {
                const int row = row0 + ai * 128 + m * 16; const f32x4 q = qn;
                if (ai * 4 + m < 7) { const int i1_ = ai * 4 + m + 1; qn = *(const f32x4*)(psq + (size_t)(row0 + (i1_ >> 2) * 128 + (i1_ & 3) * 16) * 4); }
                const float rs = __builtin_amdgcn_rsqf(((q[0] + q[1]) + (q[2] + q[3])) * (1.0f / 256.0f) + LN_EPS);
                bf16_t* rowp = base + (size_t)row * 2048 + col0;
#pragma unroll
                for (int bj = 0; bj < 2; ++bj) { const f32x4 v0 = acc[ai][bj][m][0] * rs, v1 = acc[ai][bj][m][1] * rs;
                    u32x4 w; w.x = cvtpk(v0[0], v0[1]); w.y = cvtpk(v0[2], v0[3]); w.z = cvtpk(v1[0], v1[1]); w.w = cvtpk(v1[2], v1[3]);
                    *(u32x4*)(rowp + bj * 128) = w; }
            }
    }
};

__device__ __forceinline__ void gmlp_ln_rows(const Args& a, int l) {
    unsigned char* ws = launder_s(a.ws); const int tid = LTID, wid = tid >> 6, lane = tid & 63;
    const float* g = a.in[8] + (size_t)l * 1024; const float* bta = a.in[9] + (size_t)l * 1024;
    for (int rowb = LBID * 8 + wid; rowb < NTOK; rowb += gridDim.x * 8 * 4) {
        bf16x8 xa[4], xb4[4];
#pragma unroll
        for (int k = 0; k < 4; ++k) { const int row = rowb + k * gridDim.x * 8; if (row < NTOK) { const bf16_t* p = (const bf16_t*)(ws + WS_HV) + (size_t)row * 1024 + lane * 8; xa[k] = *(const bf16x8*)p; xb4[k] = *(const bf16x8*)(p + 512); } }
#pragma unroll
        for (int k = 0; k < 4; ++k) { const int row = rowb + k * gridDim.x * 8; if (row >= NTOK) break;
            bf16_t* p = (bf16_t*)(ws + WS_HV) + (size_t)row * 1024 + lane * 8;
            float v[16];
#pragma unroll
            for (int e = 0; e < 8; ++e) { v[e] = bf2f((bf16_t)xa[k][e]); v[8 + e] = bf2f((bf16_t)xb4[k][e]); }
            float s = 0.f;
#pragma unroll
            for (int e = 0; e < 16; ++e) s += v[e];
            const float mean = wave_sum(s) * (1.0f / 1024.0f);
            float q = 0.f;
#pragma unroll
            for (int e = 0; e < 16; ++e) { const float d = v[e] - mean; q += d * d; }
            const float rstd = 1.0f / sqrtf(wave_sum(q) * (1.0f / 1024.0f) + LN_EPS);
            float o[16];
#pragma unroll
            for (int e = 0; e < 8; ++e) { o[e] = (v[e] - mean) * rstd * g[lane * 8 + e] + bta[lane * 8 + e]; o[8 + e] = (v[8 + e] - mean) * rstd * g[512 + lane * 8 + e] + bta[512 + lane * 8 + e]; }
            u32x4 w0 = {cvtpk(o[0], o[1]), cvtpk(o[2], o[3]), cvtpk(o[4], o[5]), cvtpk(o[6], o[7])}, w1 = {cvtpk(o[8], o[9]), cvtpk(o[10], o[11]), cvtpk(o[12], o[13]), cvtpk(o[14], o[15])};
            *(u32x4*)p = w0; *(u32x4*)(p + 512) = w1; }
    }
}

__device__ __forceinline__ void compress_item(const Args& a, int l, LAS unsigned char* lds, int item) {
    unsigned char* ws = launder_s(a.ws);
    const int tid = LTID, wid = __builtin_amdgcn_readfirstlane(tid >> 6), lane = tid & 63, r32 = lane & 31, hi = lane >> 5;
    const int kv = item >> 5, rt = item & 31;
    const int R = rt * 32 + r32, bh = R >> 7; int i = R & 127; if (i > 126) i = 126;
    const int b = bh >> 1, hkv = bh & 1;
    const bf16_t* src = (const bf16_t*)(ws + WS_KV) + ((size_t)b * SEQ + 16 * i + 4 * wid) * 1536 + kv * 256 + hkv * 128 + hi * 8;
    const bf16_t* w1 = (const bf16_t*)(ws + WS_W1) + ((size_t)l * 2 + kv) * 128 * 4096 + (size_t)r32 * 4096 + wid * 512 + hi * 8;
    f32x16 acc[4] = {};
    bf16x8 A0[4], B0[4][4], A1[4], B1[4][4];
#define CMP_LOAD(A_, B_, c_) do { _Pragma("unroll") for (int jj = 0; jj < 4; ++jj) { const int s_ = (c_) * 4 + jj, tk_ = s_ >> 3, dk_ = s_ & 7; \
        A_[jj] = *(const bf16x8*)(src + (size_t)tk_ * 1536 + dk_ * 16); \
        _Pragma("unroll") for (int nb = 0; nb < 4; ++nb) B_[jj][nb] = *(const bf16x8*)(w1 + (size_t)nb * 32 * 4096 + tk_ * 128 + dk_ * 16); } } while (0)
#define CMP_MMA(A_, B_) do { _Pragma("unroll") for (int jj = 0; jj < 4; ++jj) _Pragma("unroll") for (int nb = 0; nb < 4; ++nb) acc[nb] = MFMA32(A_[jj], B_[jj][nb], acc[nb]); } while (0)
    CMP_LOAD(A0, B0, 0);
#pragma unroll 1
    for (int c = 0; c < 8; c += 2) {
        CMP_LOAD(A1, B1, c + 1); CMP_MMA(A0, B0);
        if (c + 2 < 8) CMP_LOAD(A0, B0, c + 2);
        CMP_MMA(A1, B1);
    }
#undef CMP_LOAD
#undef CMP_MMA
    LAS float* red = (LAS float*)lds;
#pragma unroll
    for (int nb = 0; nb < 4; ++nb)
#pragma unroll
        for (int r = 0; r < 16; ++r) red[((wid * 4 + nb) * 16 + r) * 64 + lane] = acc[nb][r];
    __syncthreads();
    LAS bf16_t* G = (LAS bf16_t*)(lds + 131072);
    const float* c1 = (const float*)(ws + WS_C1) + ((size_t)l * 2 + kv) * 16 * 128;
    for (int idx = tid; idx < 4096; idx += 512) {
        float s = 0.f;
#pragma unroll
        for (int w = 0; w < 8; ++w) s += red[w * 4096 + idx];
        const int ln = idx & 63, r = (idx >> 6) & 15, nb = idx >> 10;
        const int row = crow(r, ln >> 5), n = nb * 32 + (ln & 31);
        float cb = 0.f;
#pragma unroll
        for (int sl = 0; sl < 16; ++sl) cb += c1[sl * 128 + n];
        G[row * 136 + n] = f2bf(gelu_tanh(s + cb));
    }
    __syncthreads();
    if (wid < 4) {
        const bf16_t* w2 = (const bf16_t*)(ws + WS_W2) + ((size_t)l * 2 + kv) * 128 * 128 + (size_t)(wid * 32 + r32) * 128 + hi * 8;
        f32x16 o = {};
#pragma unroll
        for (int ks = 0; ks < 8; ++ks) { const bf16x8 af = *(LAS const bf16x8*)(G + r32 * 136 + ks * 16 + hi * 8); const bf16x8 bfr = *(const bf16x8*)(w2 + ks * 16); o = MFMA32(af, bfr, o); }
        bf16_t* dst = (bf16_t*)(ws + WS_KC) + (size_t)kv * 8 * 128 * 128;
#pragma unroll
        for (int r = 0; r < 16; ++r) { const int RR = rt * 32 + crow(r, hi); dst[(size_t)RR * 128 + wid * 32 + r32] = f2bf(o[r]); }
    }
    __syncthreads();
}

__device__ __forceinline__ unsigned sortable(float f) { unsigned u = __float_as_uint(f); if ((u << 1) == 0u) u = 0u; return (u & 0x80000000u) ? ~u : (u | 0x80000000u); }
__device__ __forceinline__ void indexer_item(const Args& a, LAS unsigned char* lds, int item) {
    unsigned char* ws = launder_s(a.ws);
    const int tid = LTID, wid = __builtin_amdgcn_readfirstlane(tid >> 6), lane = tid & 63, r32 = lane & 31, hi = lane >> 5;
    const int b = item >> 7, t0 = (item & 127) * 16;
    unsigned long long* MASK = (unsigned long long*)(ws + WS_MASK);
    if (t0 + 16 <= 256) {
        for (int q = wid * 2; q < wid * 2 + 2; ++q) { const int t = t0 + q;
            if (lane < 32) { const int lo = lane * 64; unsigned long long w = 0ull; if (t >= lo + 63) w = ~0ull; else if (t >= lo) w = (2ull << (t - lo)) - 1ull;
                MASK[((size_t)b * SEQ + t) * 32 + lane] = w; } }
        return;
    }
    LAS unsigned* SC = (LAS unsigned*)lds;
    LAS float* WI = (LAS float*)(lds + 131072);
    if (tid < 64) WI[tid] = ((const float*)(ws + WS_SKF))[((size_t)b * SEQ + t0 + (tid >> 2)) * 32 + 24 + (tid & 3)];
    bf16x8 aq[2][4];
#pragma unroll
    for (int rb = 0; rb < 2; ++rb) { const bf16_t* qp = (const bf16_t*)(ws + WS_QI) + ((size_t)b * SEQ + t0 + rb * 8 + (r32 >> 2)) * 256 + (r32 & 3) * 64 + hi * 8;
#pragma unroll
        for (int ks = 0; ks < 4; ++ks) aq[rb][ks] = *(const bf16x8*)(qp + ks * 16); }
    __syncthreads();
    const int nch = (t0 + 16 + 31) >> 5;
    const bf16_t* KI = (const bf16_t*)(ws + WS_KI) + (size_t)b * SEQ * 64;
    bf16x8 bkA[4], bkB[4];
#define IDX_LOAD(bk_, ch_) do { const bf16_t* kp_ = KI + (size_t)((ch_) * 32 + r32) * 64 + hi * 8; _Pragma("unroll") for (int ks = 0; ks < 4; ++ks) bk_[ks] = *(const bf16x8*)(kp_ + ks * 16); } while (0)
#define IDX_COMPUTE(bk_, ch_) do { _Pragma("unroll") for (int rb = 0; rb < 2; ++rb) { f32x16 s = {}; \
            _Pragma("unroll") for (int ks = 0; ks < 4; ++ks) s = MFMA32(aq[rb][ks], bk_[ks], s); \
              \
            _Pragma("unroll") for (int mq = 0; mq < 4; ++mq) { const int q = rb * 8 + 2 * mq + hi; float sc = 0.f; \
                _Pragma("unroll") for (int h = 0; h < 4; ++h) sc += fmaxf(s[mq * 4 + h], 0.f) * WI[q * 4 + h]; \
                const int key = (ch_) * 32 + r32; SC[q * 2048 + key] = (key <= t0 + q) ? sortable(sc) : 0u; } } } while (0)
    if (wid < nch) IDX_LOAD(bkA, wid);
#pragma unroll 1
    for (int ch = wid; ch < nch; ch += 16) {
        if (ch + 8 < nch) IDX_LOAD(bkB, ch + 8);
        IDX_COMPUTE(bkA, ch);
        if (ch + 8 < nch) { if (ch + 16 < nch) IDX_LOAD(bkA, ch + 16); IDX_COMPUTE(bkB, ch + 8); }
    }
#undef IDX_LOAD
#undef IDX_COMPUTE
    __syncthreads();
    for (int q = wid * 2; q < wid * 2 + 2; ++q) {
        const int t = t0 + q; const int nw = (t >> 6) + 1;
        unsigned kk[32];
#pragma unroll
        for (int i = 0; i < 32; ++i) kk[i] = (i < nw && (i * 64 + lane) < nch * 32) ? SC[q * 2048 + i * 64 + lane] : 0u;
        unsigned T = 0u; bool exact = false;
        for (int bit = 31; bit >= 0; --bit) {
            const unsigned cand = T | (1u << bit); int cnt = 0;
#pragma unroll
            for (int i = 0; i < 32; ++i) cnt += __popcll(__ballot(kk[i] >= cand));
            if (cnt >= 256) { T = cand; if (cnt == 256) { exact = true; break; } }
        }
        int need = 0;
        if (!exact) { int ngt = 0;
#pragma unroll
            for (int i = 0; i < 32; ++i) ngt += __popcll(__ballot(kk[i] > T));
            need = 256 - ngt; }
        unsigned long long mine = 0ull;
#pragma unroll
        for (int i = 0; i < 32; ++i) {
            unsigned long long w;
            if (exact) w = __ballot(kk[i] >= T);
            else { w = __ballot(kk[i] > T); unsigned long long eq = __ballot(kk[i] == T);
                   const int ne = __popcll(eq);
                   if (ne <= need) { w |= eq; need -= ne; }
                   else { while (need > 0) { const unsigned long long low = eq & (0ull - eq); w |= low; eq ^= low; --need; } } }
            if (lane == i) mine = w;
        }
        if (lane < 32) MASK[((size_t)b * SEQ + t) * 32 + lane] = mine;
    }
    __syncthreads();
}

struct BranchSched {
    int G, c;
    __device__ __forceinline__ bool next(int i, pg8::Unit& u) const {
        const int n = i % 3, idx = (i / 3) * G + c; if (idx >= 256) return false;
        pg8::StaticOrder so; so.init(NTOK, DM, 256, idx); so.next(0, u); u.pm += n * 32; u.pn += n * 8; return true;
    }
    __device__ __forceinline__ void a_ready(const pg8::Unit&) const {}
    __device__ __forceinline__ void done(const pg8::Unit&) const {}
};
struct EpiBranch {
    static constexpr bool PERM = true, AFTER_DRAIN = false;
    unsigned char* ws;
    __device__ __forceinline__ bool keep(const pg8::Unit& u) const { return (u.pm >> 5) < 2; }
    __device__ __forceinline__ void operator()(f32x4 (&acc)[2][2][4][2], const pg8::Unit& u, int wr, int wc, int fr, int fq) const {
        const int n = u.pm >> 5, pm = u.pm & 31, pn = u.pn & 7;
        bf16_t* O = (bf16_t*)(ws + WS_MIXB); const bf16_t* Gt = (const bf16_t*)(ws + WS_HG) + n * 2048;
        const int row0 = pm * 256 + wr * 64 + fr, col0 = pn * 256 + wc * 32 + 8 * fq;
        u32x4 gcur[2], hcur[2], gnxt[2], hnxt[2];
#define LOADG(G_, H_, ai_, m_) do { const size_t row_ = (size_t)(row0 + (ai_) * 128 + (m_) * 16); \
            G_[0] = *(const u32x4*)(Gt + row_ * 6144 + col0); G_[1] = *(const u32x4*)(Gt + row_ * 6144 + col0 + 128); \
            if (n < 2) { H_[0] = *(const u32x4*)(Gt + 2048 + row_ * 6144 + col0); H_[1] = *(const u32x4*)(Gt + 2048 + row_ * 6144 + col0 + 128); } } while (0)
        LOADG(gcur, hcur, 0, 0);
#pragma unroll
        for (int ai = 0; ai < 2; ++ai)
#pragma unroll
            for (int m = 0; m < 4; ++m) { const size_t row = (size_t)(row0 + ai * 128 + m * 16);
                if (ai * 4 + m < 7) LOADG(gnxt, hnxt, (ai * 4 + m + 1) >> 2, (ai * 4 + m + 1) & 3);
#pragma unroll
                for (int bj = 0; bj < 2; ++bj) { const int col = col0 + bj * 128;
                    const u32x4 gw = gcur[bj];
                    float gv[8] = {__uint_as_float(gw.x << 16), __uint_as_float(gw.x & 0xffff0000u), __uint_as_float(gw.y << 16), __uint_as_float(gw.y & 0xffff0000u),
                                   __uint_as_float(gw.z << 16), __uint_as_float(gw.z & 0xffff0000u), __uint_as_float(gw.w << 16), __uint_as_float(gw.w & 0xffff0000u)};
                    if (n < 2) {
                        const u32x4 hw = hcur[bj];
                        const float hv[8] = {__uint_as_float(hw.x << 16), __uint_as_float(hw.x & 0xffff0000u), __uint_as_float(hw.y << 16), __uint_as_float(hw.y & 0xffff0000u),
                                             __uint_as_float(hw.z << 16), __uint_as_float(hw.z & 0xffff0000u), __uint_as_float(hw.w << 16), __uint_as_float(hw.w & 0xffff0000u)};
#pragma unroll
                        for (int e = 0; e < 8; ++e) gv[e] *= __builtin_amdgcn_rcpf(fmaxf(hv[e], 1e-30f));
#pragma unroll
                        for (int e = 0; e < 4; ++e) { acc[ai][bj][m][0][e] *= gv[e]; acc[ai][bj][m][1][e] *= gv[4 + e]; }
                    } else {
                        const f32x4 v0 = acc[ai][bj][m][0], v1 = acc[ai][bj][m][1];
                        u32x4 w; w.x = cvtpk(v0[0] * gv[0], v0[1] * gv[1]); w.y = cvtpk(v0[2] * gv[2], v0[3] * gv[3]); w.z = cvtpk(v1[0] * gv[4], v1[1] * gv[5]); w.w = cvtpk(v1[2] * gv[6], v1[3] * gv[7]);
                        *(u32x4*)(O + row * 2048 + col) = w; } }
                gcur[0] = gnxt[0]; gcur[1] = gnxt[1]; hcur[0] = hnxt[0]; hcur[1] = hnxt[1];
            }
#undef LOADG
    }
};
struct EpiOut {
    static constexpr bool PERM = false, AFTER_DRAIN = false;
    const float* x; float* pre;
    __device__ __forceinline__ void operator()(const f32x4 (&acc)[2][2][4][2], const pg8::Unit& u, int wr, int wc, int fr, int fq) const {
        const int row0 = u.pm * 256 + wr * 64 + fr, col0 = u.pn * 256 + wc * 32 + 4 * fq;
        f32x4 xc[4], xn[4];
#define LOADX(X_, ai_, m_) do { const size_t off_ = (size_t)(row0 + (ai_) * 128 + (m_) * 16) * 2048 + col0; \
            X_[0] = *(const f32x4*)(x + off_); X_[1] = *(const f32x4*)(x + off_ + 16); X_[2] = *(const f32x4*)(x + off_ + 128); X_[3] = *(const f32x4*)(x + off_ + 144); } while (0)
        LOADX(xc, 0, 0);
#pragma unroll
        for (int ai = 0; ai < 2; ++ai)
#pragma unroll
            for (int m = 0; m < 4; ++m) { const size_t off = (size_t)(row0 + ai * 128 + m * 16) * 2048 + col0;
                if (ai * 4 + m < 7) LOADX(xn, (ai * 4 + m + 1) >> 2, (ai * 4 + m + 1) & 3);
#pragma unroll
                for (int bj = 0; bj < 2; ++bj)
#pragma unroll
                    for (int n = 0; n < 2; ++n) *(f32x4*)(pre + off + bj * 128 + n * 16) = xc[bj * 2 + n] * ALPHA + acc[ai][bj][m][n];
#pragma unroll
                for (int k = 0; k < 4; ++k) xc[k] = xn[k];
            }
#undef LOADX
    }
};

__device__ __forceinline__ void ln_row(f32x4 (&v)[8], const float* g, const float* bta, int lane) {
    float s = 0.f;
#pragma unroll
    for (int i = 0; i < 8; ++i) s += (v[i][0] + v[i][1]) + (v[i][2] + v[i][3]);
    const float mean = wave_sum(s) * (1.0f / 2048.0f);
    float q = 0.f;
#pragma unroll
    for (int i = 0; i < 8; ++i) { const f32x4 d = v[i] - mean; q += (d[0] * d[0] + d[1] * d[1]) + (d[2] * d[2] + d[3] * d[3]); }
    const float rstd = 1.0f / sqrtf(wave_sum(q) * (1.0f / 2048.0f) + LN_EPS);
#pragma unroll
    for (int i = 0; i < 8; ++i) { const f32x4 gg = *(const f32x4*)(g + i * 256 + lane * 4), bb = *(const f32x4*)(bta + i * 256 + lane * 4); v[i] = (v[i] - mean) * rstd * gg + bb; }
}

__device__ __forceinline__ void p6_ln1_route(const Args& a, int l, LAS unsigned char* lds) {
    unsigned char* ws = launder_s(a.ws);
    const int tid = LTID, wid = __builtin_amdgcn_readfirstlane(tid >> 6), lane = tid & 63, r32 = lane & 31, hi = lane >> 5;
    const float* pre = (const float*)(ws + WS_MIXT); float* x1f = (float*)(ws + WS_X1F); bf16_t* x1b = (bf16_t*)(ws + WS_X1B);
    const float* g = a.in[14] + (size_t)l * DM; const float* bta = a.in[15] + (size_t)l * DM;
    unsigned* cnt = (unsigned*)(ws + WS_CTL) + CW_CNT + l * 1024;
    for (int it = LBID; it < NTOK / 32; it += gridDim.x) {
        const int row0 = it * 32;
        { f32x4 v[4][8];
#pragma unroll
          for (int rr = 0; rr < 4; ++rr)
#pragma unroll
              for (int i = 0; i < 8; ++i) v[rr][i] = *(const f32x4*)(pre + (size_t)(row0 + wid * 4 + rr) * DM + i * 256 + lane * 4);
#pragma unroll
          for (int rr = 0; rr < 4; ++rr) { const size_t row = (size_t)(row0 + wid * 4 + rr);
              ln_row(v[rr], g, bta, lane);
#pragma unroll
              for (int i = 0; i < 8; ++i) { *(f32x4*)(x1f + row * DM + i * 256 + lane * 4) = v[rr][i]; u32x2 w; w.x = cvtpk(v[rr][i][0], v[rr][i][1]); w.y = cvtpk(v[rr][i][2], v[rr][i][3]); *(u32x2*)(x1b + row * DM + i * 256 + lane * 4) = w; } } }
        asm volatile("s_waitcnt vmcnt(0)" ::: "memory");
        __syncthreads();
        f32x16 acc = {};
        { const float* xp = x1f + (size_t)(row0 + r32) * DM + 256 * wid + 8 * hi;
          const bf16_t* wh = (const bf16_t*)(ws + WS_WR) + (size_t)l * 2 * 32 * DM + (size_t)r32 * DM + 256 * wid + 8 * hi; const bf16_t* wl = wh + 32 * DM;
#pragma unroll 4
          for (int ks = 0; ks < 16; ++ks) {
              const f32x4 x0 = *(const f32x4*)(xp + ks * 16), x1 = *(const f32x4*)(xp + ks * 16 + 4);
              const bf16x8 xh = pack8(x0, x1);
              f32x4 r0, r1;
#pragma unroll
              for (int e = 0; e < 4; ++e) { r0[e] = x0[e] - bf2f((bf16_t)xh[e]); r1[e] = x1[e] - bf2f((bf16_t)xh[4 + e]); }
              const bf16x8 xl = pack8(r0, r1);
              const bf16x8 bh = *(const bf16x8*)(wh + ks * 16), bl = *(const bf16x8*)(wl + ks * 16);
              acc = MFMA32(xh, bh, acc); acc = MFMA32(xl, bh, acc); acc = MFMA32(xh, bl, acc);
          } }
        LAS float* red = (LAS float*)lds;
#pragma unroll
        for (int r = 0; r < 16; ++r) red[(wid * 16 + r) * 64 + lane] = acc[r];
        __syncthreads();
        LAS float* LG = (LAS float*)(lds + 32768);
        if (tid < 32) ((LAS unsigned*)(lds + 40960))[tid] = 0u;
        for (int idx = tid; idx < 1024; idx += 512) { float s = 0.f;
#pragma unroll
            for (int w = 0; w < 8; ++w) s += red[w * 1024 + idx];
            const int ln = idx & 63, r = idx >> 6; LG[crow(r, ln >> 5) * 33 + (ln & 31)] = s; }
        __syncthreads();
        if (tid < 32) {
            const int row = row0 + tid; LAS const float* lg = LG + tid * 33;
            float gl[4];
#pragma unroll
            for (int j = 0; j < 4; ++j) gl[j] = lg[j] + a.in[17][l * 4 + j];
            int gi = 0; float gm = gl[0];
#pragma unroll
            for (int j = 1; j < 4; ++j) if (gl[j] > gm) { gm = gl[j]; gi = j; }
            float den = 0.f;
#pragma unroll
            for (int j = 0; j < 4; ++j) den += expf(gl[j] - gm);
            const float gp = 1.0f / den;
            float el[4];
#pragma unroll
            for (int j = 0; j < 4; ++j) el[j] = lg[4 + gi * 4 + j] + a.in[19][l * 16 + gi * 4 + j];
            int e1 = 0; float m1 = el[0];
#pragma unroll
            for (int j = 1; j < 4; ++j) if (el[j] > m1) { m1 = el[j]; e1 = j; }
            int e2 = -1; float m2 = 0.f;
#pragma unroll
            for (int j = 0; j < 4; ++j) if (j != e1 && (e2 < 0 || el[j] > m2)) { m2 = el[j]; e2 = j; }
            const float ex = expf(m2 - m1), w1 = 1.0f / (1.0f + ex), w2 = ex / (1.0f + ex);
            const int E1 = gi * 4 + e1, E2 = gi * 4 + e2;
            LAS unsigned* lc = (LAS unsigned*)(lds + 40960);
            const unsigned p1 = __hip_atomic_fetch_add(lc + E1, 1u, __ATOMIC_RELAXED, __HIP_MEMORY_SCOPE_WORKGROUP);
            const unsigned p2 = __hip_atomic_fetch_add(lc + E2, 1u, __ATOMIC_RELAXED, __HIP_MEMORY_SCOPE_WORKGROUP);
            asm volatile("s_waitcnt lgkmcnt(0)" ::: "memory");
            if (tid < 16) ((unsigned*)(ws + WS_CTL) + CW_CNTW)[it * 16 + tid] = lc[tid];
            int* tk = (int*)(ws + WS_TOK); float* tw = (float*)(ws + WS_TOK) + 4 * NTOK;
            tk[row * 2] = E1; tk[row * 2 + 1] = E2; tk[2 * NTOK + row * 2] = (int)p1; tk[2 * NTOK + row * 2 + 1] = (int)p2;
            tw[row * 2] = gp * w1; tw[row * 2 + 1] = gp * w2;
        }
        __syncthreads();
    }
}

__device__ __forceinline__ int moe_offsets(const Args& a, int l, LAS int* off) {
    const unsigned* cnt = (const unsigned*)(a.ws + WS_CTL) + CW_CNT + l * 1024;
    const int tid_ = LTID;
    if (tid_ < 16) off[32 + tid_] = ((int)__hip_atomic_load(cnt + 64 * tid_, __ATOMIC_RELAXED, __HIP_MEMORY_SCOPE_AGENT) + 255) & ~255;
    __syncthreads();
    if (tid_ == 0) { int o = 0; for (int e = 0; e < NEXP; ++e) { off[e] = o; o += off[32 + e]; } off[NEXP] = o; }
    __syncthreads();
    return off[NEXP] >> 8;
}
__device__ __forceinline__ void p7_gather(const Args& a, int l, LAS unsigned char* lds) {
    unsigned char* ws = launder_s(a.ws);
    const int tid = LTID, wid = tid >> 6, lane = tid & 63;
    LAS int* off = (LAS int*)lds; LAS int* PS = off + 32; LAS int* PP = PS + 512; LAS int* BASE = PP + 512;
    const unsigned* cntw = (const unsigned*)(ws + WS_CTL) + CW_CNTW;
    { const int e = tid & 15, part = tid >> 4; int s = 0;
#pragma unroll
      for (int k = 0; k < 8; ++k) s += (int)cntw[(part * 8 + k) * 16 + e];
      PS[part * 16 + e] = s; }
    __syncthreads();
    if (tid < 16) { int run = 0; for (int part = 0; part < 32; ++part) { PP[part * 16 + tid] = run; run += PS[part * 16 + tid]; } PS[tid] = run;
        if (LBID == 0) __hip_atomic_store((unsigned*)(ws + WS_CTL) + CW_CNT + l * 1024 + 64 * tid, (unsigned)run, __ATOMIC_RELAXED, __HIP_MEMORY_SCOPE_AGENT); }
    __syncthreads();
    if (tid == 0) { int o = 0; for (int e = 0; e < NEXP; ++e) { off[e] = o; o += (PS[e] + 255) & ~255; } off[NEXP] = o; }
    const int* tk = (const int*)(ws + WS_TOK); const float* tw = (const float*)(ws + WS_TOK) + 4 * NTOK; int* trow = (int*)(ws + WS_TOK) + 6 * NTOK;
    const bf16_t* x1b = (const bf16_t*)(ws + WS_X1B); bf16_t* xs = (bf16_t*)(ws + WS_XS); float* roww = (float*)(ws + WS_ROWW);
    for (int wt = LBID; wt < NTOK / 32; wt += gridDim.x) {
        __syncthreads();
        if (tid < 16) { int b = PP[(wt >> 3) * 16 + tid]; int cv[7];
#pragma unroll
            for (int k = 0; k < 7; ++k) cv[k] = ((wt & ~7) + k < wt) ? (int)cntw[((wt & ~7) + k) * 16 + tid] : 0;
#pragma unroll
            for (int k = 0; k < 7; ++k) b += cv[k];
            BASE[tid] = b; }
        __syncthreads();
        for (int q0 = wid * 8; q0 < wid * 8 + 8; q0 += 4) {
            u32x4 buf[4][4]; int rows[4];
#pragma unroll
            for (int k = 0; k < 4; ++k) { const int p = wt * 64 + q0 + k; const int e = tk[p]; rows[k] = off[e] + BASE[e] + tk[2 * NTOK + p];
                const u32x4* s = (const u32x4*)(x1b + (size_t)(p >> 1) * DM);
#pragma unroll
                for (int i = 0; i < 4; ++i) buf[k][i] = s[i * 64 + lane]; }
#pragma unroll
            for (int k = 0; k < 4; ++k) { const int p = wt * 64 + q0 + k; u32x4* d = (u32x4*)(xs + (size_t)rows[k] * DM);
#pragma unroll
                for (int i = 0; i < 4; ++i) d[i * 64 + lane] = buf[k][i];
                if (lane == 0) { roww[rows[k]] = tw[p]; trow[p] = rows[k]; } }
        }
    }
}
struct MoeSched {
    LAS const int* te; int ntiles, ncol, G, c;
    __device__ __forceinline__ bool next(int i, pg8::Unit& u) const {
        const int L = i * G + c; if (L >= ntiles * ncol) return false;
        const int pm = L / ncol, pl = L % ncol; u.pm = pm; u.pn = te[pm] * ncol + pl; return true;
    }
    __device__ __forceinline__ void a_ready(const pg8::Unit&) const {}
    __device__ __forceinline__ void done(const pg8::Unit&) const {}
};
__device__ __forceinline__ int moe_tile_table(const Args& a, int l, LAS int* off, LAS int* te) {
    const int nt = moe_offsets(a, l, off);
    const int tid_ = LTID;
    if (tid_ < 128) { const int pm = tid_; if (pm < nt) { int e = 0; for (int k = 1; k < NEXP; ++k) if ((off[k] >> 8) <= pm) e = k; te[pm] = e; } }
    __syncthreads();
    return nt;
}
struct EpiGateUp {
    static constexpr bool PERM = true, AFTER_DRAIN = false;
    unsigned char* ws;
    __device__ __forceinline__ void operator()(const f32x4 (&acc)[2][2][4][2], const pg8::Unit& u, int wr, int wc, int fr, int fq) const {
        bf16_t* hm = (bf16_t*)(ws + WS_HM); const float* roww = (const float*)(ws + WS_ROWW);
        const int row0 = u.pm * 256 + wr * 64 + fr, col0 = (u.pn & 3) * 128 + wc * 32 + 8 * fq;
        float rwv[8];
#pragma unroll
        for (int k = 0; k < 8; ++k) rwv[k] = roww[row0 + (k >> 2) * 128 + (k & 3) * 16];
#pragma unroll
        for (int ai = 0; ai < 2; ++ai)
#pragma unroll
            for (int m = 0; m < 4; ++m) { const int row = row0 + ai * 128 + m * 16; const float rw = rwv[ai * 4 + m];
                float o[8];
#pragma unroll
                for (int n = 0; n < 2; ++n)
#pragma unroll
                    for (int e = 0; e < 4; ++e) { const float gt = acc[ai][0][m][n][e], up = acc[ai][1][m][n][e]; o[n * 4 + e] = gt * fast_sigmoid(gt) * up * rw; }
                u32x4 w = {cvtpk(o[0], o[1]), cvtpk(o[2], o[3]), cvtpk(o[4], o[5]), cvtpk(o[6], o[7])};
                *(u32x4*)(hm + (size_t)row * DEXP + col0) = w; }
    }
};
struct EpiDown {
    static constexpr bool PERM = true, AFTER_DRAIN = false;
    unsigned char* ws;
    __device__ __forceinline__ void operator()(const f32x4 (&acc)[2][2][4][2], const pg8::Unit& u, int wr, int wc, int fr, int fq) const {
        bf16_t* y = (bf16_t*)(ws + WS_Y);
        const int row0 = u.pm * 256 + wr * 64 + fr, col0 = (u.pn & 7) * 256 + wc * 32 + 8 * fq;
#pragma unroll
        for (int ai = 0; ai < 2; ++ai)
#pragma unroll
            for (int m = 0; m < 4; ++m) { bf16_t* rowp = y + (size_t)(row0 + ai * 128 + m * 16) * DM + col0;
#pragma unroll
                for (int bj = 0; bj < 2; ++bj) { const f32x4 v0 = acc[ai][bj][m][0], v1 = acc[ai][bj][m][1];
                    u32x4 w = {cvtpk(v0[0], v0[1]), cvtpk(v0[2], v0[3]), cvtpk(v1[0], v1[1]), cvtpk(v1[2], v1[3])};
                    *(u32x4*)(rowp + bj * 128) = w; } }
    }
};
__device__ __forceinline__ void p10_ln2(const Args& a, int l) {
    unsigned char* ws = launder_s(a.ws); const int tid = LTID, wid = tid >> 6, lane = tid & 63;
    const float* x1f = (const float*)(ws + WS_X1F); const bf16_t* y = (const bf16_t*)(ws + WS_Y); const int* trow = (const int*)(ws + WS_TOK) + 6 * NTOK;
    float* xo = (l == NL - 1) ? a.out : (float*)(ws + WS_XF); bf16_t* xb = (bf16_t*)(ws + WS_XB);
    const float* g = a.in[23] + (size_t)l * DM; const float* bta = a.in[24] + (size_t)l * DM;
    const int rstep = gridDim.x * 8; int row = LBID * 8 + wid;
    int tr0 = row < NTOK ? trow[row * 2] : 0, tr1 = row < NTOK ? trow[row * 2 + 1] : 0;
    for (; row < NTOK; row += rstep) {
        const bf16_t* y0 = y + (size_t)tr0 * DM; const bf16_t* y1 = y + (size_t)tr1 * DM;
        if (row + rstep < NTOK) { tr0 = trow[(row + rstep) * 2]; tr1 = trow[(row + rstep) * 2 + 1]; }
        f32x4 v[8];
#pragma unroll
        for (int i = 0; i < 8; ++i) { const int cidx = i * 256 + lane * 4; const f32x4 xv = *(const f32x4*)(x1f + (size_t)row * DM + cidx);
            const u32x2 a0 = *(const u32x2*)(y0 + cidx), a1 = *(const u32x2*)(y1 + cidx);
            const f32x4 f0 = {__uint_as_float(a0.x << 16), __uint_as_float(a0.x & 0xffff0000u), __uint_as_float(a0.y << 16), __uint_as_float(a0.y & 0xffff0000u)};
            const f32x4 f1 = {__uint_as_float(a1.x << 16), __uint_as_float(a1.x & 0xffff0000u), __uint_as_float(a1.y << 16), __uint_as_float(a1.y & 0xffff0000u)};
            v[i] = xv * ALPHA + (f0 + f1); }
        ln_row(v, g, bta, lane);
#pragma unroll
        for (int i = 0; i < 8; ++i) { const int cidx = i * 256 + lane * 4; *(f32x4*)(xo + (size_t)row * DM + cidx) = v[i];
            u32x2 w; w.x = cvtpk(v[i][0], v[i][1]); w.y = cvtpk(v[i][2], v[i][3]); *(u32x2*)(xb + (size_t)row * DM + cidx) = w; }
    }
}

#if defined(DBG_STAGE)
__device__ __forceinline__ void dbg_accum(unsigned* ctl, int k, float err, float ref) {
    err = wave_sum(err); ref = wave_sum(ref);
    if ((threadIdx.x & 63) == 0) { atomicAdd((float*)(ctl + CW_DBG) + 2 * k, err); atomicAdd((float*)(ctl + CW_DBG) + 2 * k + 1, ref); }
}
__device__ __forceinline__ float ldbf(const bf16_t* p) { return bf2f(*p); }
__device__ __forceinline__ float gelu_ref(float x) { return 0.5f * x * (1.0f + tanhf(0.7978845608028654f * (x + 0.044715f * x * x * x))); }
__device__ __forceinline__ float sigm_ref(float x) { return 1.0f / (1.0f + expf(-x)); }

__device__ void dbg_inproj(const Args& a, unsigned* ctl) {
    unsigned char* ws = a.ws; const int tid = threadIdx.x; const int r = (blockIdx.x * 32 + 5) % NTOK;
    const float* x = a.in[0] + (size_t)r * DM; const float* w = a.in[1];
    float err = 0.f, ref = 0.f;
    for (int c = tid; c < IN_COLS; c += 512) {
        float s = 0.f; for (int k = 0; k < DM; ++k) s += x[k] * w[(size_t)k * IN_COLS + c];
        float rv, gv; bool skip = false;
        if (c < 1024) { rv = s; gv = ldbf((const bf16_t*)(ws + WS_QA) + (size_t)r * 1024 + c); }
        else if (c < 2560) { rv = s; gv = ldbf((const bf16_t*)(ws + WS_KV) + (size_t)r * 1536 + (c - 1024)); }
        else if (c < 2584) { rv = sigm_ref(s); gv = ((const float*)(ws + WS_SKF))[(size_t)r * 32 + (c - 2560)]; }
        else if (c < 3608) { rv = s; gv = ldbf((const bf16_t*)(ws + WS_QB) + (size_t)r * 1024 + (c - 2584)); }
        else if (c < 3864) { rv = s; gv = ldbf((const bf16_t*)(ws + WS_HC) + (size_t)r * 256 + (c - 3608)); }
        else if (c < 4120) { rv = s; gv = ldbf((const bf16_t*)(ws + WS_QI) + (size_t)r * 256 + (c - 3864)); }
        else if (c < 4184) { rv = s; gv = ldbf((const bf16_t*)(ws + WS_KI) + (size_t)r * 64 + (c - 4120)); }
        else if (c < 4188) { rv = s; gv = ((const float*)(ws + WS_SKF))[(size_t)r * 32 + 24 + (c - 4184)]; }
        else if (c < 5212) { rv = gelu_ref(s); gv = ldbf((const bf16_t*)(ws + WS_HU) + (size_t)r * 1024 + (c - 4188)); }
        else if (c < 6236) { skip = true; rv = gv = 0.f; }
        else { rv = sigm_ref(s); gv = ldbf((const bf16_t*)(ws + WS_HG) + (size_t)r * 6144 + (c - 6236)); }
        if (!skip) { err += (gv - rv) * (gv - rv); ref += rv * rv; }
    }
    dbg_accum(ctl, 5, err, ref);
}
__device__ void dbg_compress(const Args& a, unsigned* ctl, LAS unsigned char* lds) {
    unsigned char* ws = a.ws; const int tid = threadIdx.x; LAS float* sh = (LAS float*)lds;
    const int kv = blockIdx.x & 1; int R = ((blockIdx.x >> 1) * 8 + 3) % 1024; if ((R & 127) == 127) R -= 1;
    const int bh = R >> 7, i = R & 127, b = bh >> 1, hkv = bh & 1;
    const float* pe = a.in[4] + (size_t)kv * 4096; const float* w1 = a.in[2] + (size_t)kv * 4096 * 128; const float* w2 = a.in[3] + (size_t)kv * 128 * 128;
    const int n = tid & 127, q = tid >> 7; float s = 0.f;
    for (int k = q * 1024; k < (q + 1) * 1024; ++k) { const int l = k >> 7, d = k & 127;
        const float xv = ldbf((const bf16_t*)(ws + WS_KV) + ((size_t)b * SEQ + 16 * i + l) * 1536 + kv * 256 + hkv * 128 + d) + pe[k]; s += xv * w1[(size_t)k * 128 + n]; }
    sh[q * 128 + n] = s; __syncthreads();
    if (tid < 128) sh[512 + tid] = gelu_ref((sh[tid] + sh[128 + tid]) + (sh[256 + tid] + sh[384 + tid]));
    __syncthreads();
    float err = 0.f, ref = 0.f;
    if (tid < 128) { float o = 0.f; for (int j = 0; j < 128; ++j) o += sh[512 + j] * w2[j * 128 + tid];
        const float gv = ldbf((const bf16_t*)(ws + WS_KC) + ((size_t)kv * 1024 + R) * 128 + tid); err = (gv - o) * (gv - o); ref = o * o; }
    dbg_accum(ctl, 2, err, ref); __syncthreads();
}
__device__ void dbg_nsa(const Args& a, unsigned* ctl, LAS unsigned char* lds) {
    unsigned char* ws = a.ws; const int tid = threadIdx.x;
    const int b = blockIdx.x & 3, hkv = (blockIdx.x >> 2) & 1, t = (blockIdx.x * 131 + 77) % SEQ, cur = t >> 6;
    LAS float* P = (LAS float*)lds;
    LAS float* O = P + 4 * 2048;
    LAS float* IMPv = O + 512;
    LAS unsigned* SEL = (LAS unsigned*)(IMPv + 32);
    LAS float* Q = IMPv + 64;
    const size_t tok = (size_t)b * SEQ + t;
    { const int g = tid >> 7, d = tid & 127; Q[tid] = ldbf((const bf16_t*)(ws + WS_QA) + tok * 1024 + (hkv * 4 + g) * 128 + d); O[tid] = 0.f; }
    __syncthreads();
    const float scale = 0.08838834764831845f;
    const bf16_t* KC = (const bf16_t*)(ws + WS_KC) + (size_t)(b * 2 + hkv) * 128 * 128; const bf16_t* VC = KC + (size_t)8 * 128 * 128;
    const bf16_t* KVb = (const bf16_t*)(ws + WS_KV) + (size_t)b * SEQ * 1536 + hkv * 128;
    { const int g = tid >> 7, i = tid & 127; const float slope = exp2f(-(float)(hkv * 4 + g + 1)); float s = -INFINITY;
      if (i < 127 && t - (16 * i + 31) >= 0) { float d = 0.f; for (int k = 0; k < 128; ++k) d += Q[g * 128 + k] * ldbf(KC + i * 128 + k); s = d * scale - slope * (float)(t - (16 * i + 31)); }
      P[g * 2048 + i] = s; }
    __syncthreads();
    if (tid < 4) { float m = -INFINITY; for (int i = 0; i < 127; ++i) m = fmaxf(m, P[tid * 2048 + i]); float l = 0.f;
        for (int i = 0; i < 128; ++i) { const float e = (i < 127 && P[tid * 2048 + i] > -INFINITY) ? expf(P[tid * 2048 + i] - m) : 0.f; P[tid * 2048 + i] = e; l += e; }
        const float inv = l > 0.f ? 1.f / l : 0.f; for (int i = 0; i < 128; ++i) P[tid * 2048 + i] *= inv; }
    __syncthreads();
    { const int g = tid >> 7, d = tid & 127; float o = 0.f; for (int i = 0; i < 127; ++i) o += P[g * 2048 + i] * ldbf(VC + i * 128 + d);
      O[tid] += ((const float*)(ws + WS_SKF))[tok * 32 + (hkv * 4 + g) * 3 + 0] * o; }
    if (tid < 32) { float v = 0.f; for (int g = 0; g < 4; ++g) for (int i = 4 * tid - 1; i <= 4 * tid + 3; ++i) if (i >= 0 && i < 127) v += P[g * 2048 + i]; IMPv[tid] = v; }
    __syncthreads();
    if (tid < 32) { const int j = tid; const bool forced = (j == 0) || (j == cur) || (j == cur - 1); IMPv[j] = (j <= cur) ? IMPv[j] + (forced ? 1e4f : 0.f) : -1e30f; }
    __syncthreads();
    if (tid == 0) {
        unsigned sel = 0; for (int n = 0; n < 16; ++n) { int bj = -1; float bv = 0.f; for (int j = 0; j < 32; ++j) { const float vj = IMPv[j]; if (!((sel >> j) & 1u) && (bj < 0 || vj > bv)) { bj = j; bv = vj; } } sel |= 1u << bj; }
        SEL[0] = sel; }
    __syncthreads();
    const unsigned sel = SEL[0];
    for (int br = 1; br <= 2; ++br) {
        const bf16_t* Kp = KVb + (br == 1 ? 512 : 1024); const bf16_t* Vp = KVb + (br == 1 ? 768 : 1280);
        for (int idx = tid; idx < 4 * 2048; idx += 512) { const int g = idx >> 11, s = idx & 2047; const float slope = exp2f(-(float)(hkv * 4 + g + 1));
            const bool ok = (s <= t) && (br == 1 ? ((sel >> (s >> 6)) & 1u) : (t - s < 512)); float sc = -INFINITY;
            if (ok) { float d = 0.f; for (int k = 0; k < 128; ++k) d += Q[g * 128 + k] * ldbf(Kp + (size_t)s * 1536 + k); sc = d * scale - slope * (float)(t - s); }
            P[idx] = sc; }
        __syncthreads();
        if (tid < 4) { float m = -INFINITY; for (int s = 0; s < 2048; ++s) m = fmaxf(m, P[tid * 2048 + s]); float l = 0.f;
            for (int s = 0; s < 2048; ++s) { const float e = P[tid * 2048 + s] > -INFINITY ? expf(P[tid * 2048 + s] - m) : 0.f; P[tid * 2048 + s] = e; l += e; }
            const float inv = l > 0.f ? 1.f / l : 0.f; for (int s = 0; s < 2048; ++s) P[tid * 2048 + s] *= inv; }
        __syncthreads();
        { const int g = tid >> 7, d = tid & 127; float o = 0.f; for (int s = 0; s <= t; ++s) { const float p = P[g * 2048 + s]; if (p != 0.f) o += p * ldbf(Vp + (size_t)s * 1536 + d); }
          O[tid] += ((const float*)(ws + WS_SKF))[tok * 32 + (hkv * 4 + g) * 3 + br] * o; }
        __syncthreads();
    }
    { const int g = tid >> 7, d = tid & 127; const float rv = O[tid], gv = ldbf((const bf16_t*)(ws + WS_BR) + tok * 1024 + (hkv * 4 + g) * 128 + d);
      dbg_accum(ctl, 1, (gv - rv) * (gv - rv), rv * rv); }
    __syncthreads();
}
__device__ void dbg_dsa(const Args& a, unsigned* ctl, LAS unsigned char* lds) {
    unsigned char* ws = a.ws; const int tid = threadIdx.x;
    const int b = blockIdx.x & 3, t = (blockIdx.x * 197 + 301) % SEQ; const size_t tok = (size_t)b * SEQ + t;
    LAS float* LG = (LAS float*)lds;
    LAS float* SC = LG + 8 * 2048;
    LAS float* QL = SC + 2048;
    LAS float* OL = QL + 2048;
    LAS unsigned char* SL = (LAS unsigned char*)(OL + 2048);
    const bf16_t* HC = (const bf16_t*)(ws + WS_HC) + (size_t)b * SEQ * 256; const float* PSQ = (const float*)(ws + WS_PSQ) + (size_t)b * SEQ * 4;
    const float* gk = a.in[7];
    for (int s = tid; s < 2048; s += 512) { float sc = -INFINITY;
        if (s <= t) { sc = 0.f; for (int h = 0; h < 4; ++h) { float d = 0.f; for (int k = 0; k < 64; ++k) d += ldbf((const bf16_t*)(ws + WS_QI) + tok * 256 + h * 64 + k) * ldbf((const bf16_t*)(ws + WS_KI) + ((size_t)b * SEQ + s) * 64 + k);
            sc += fmaxf(d, 0.f) * ((const float*)(ws + WS_SKF))[tok * 32 + 24 + h]; } }
        SC[s] = sc; }
    for (int idx = tid; idx < 2048; idx += 512) { const int h = idx >> 8, c = idx & 255; float s = 0.f;
        for (int d = 0; d < 128; ++d) s += ldbf((const bf16_t*)(ws + WS_QB) + tok * 1024 + h * 128 + d) * a.in[5][((size_t)h * 256 + c) * 128 + d];
        QL[idx] = s * 0.08838834764831845f; }
    __syncthreads();
    for (int s = tid; s < 2048; s += 512) { bool selv = false;
        if (s <= t) { if (t + 1 <= 256) selv = true; else { int rank = 0; const float v = SC[s]; for (int s2 = 0; s2 <= t; ++s2) { const float v2 = SC[s2]; rank += (v2 > v || (v2 == v && s2 < s)) ? 1 : 0; } selv = rank < 256; } }
        SL[s] = selv ? 1 : 0; }
    __syncthreads();
    for (int idx = tid; idx < 8 * 2048; idx += 512) { const int h = idx >> 11, s = idx & 2047; float lg = -INFINITY;
        if (SL[s]) { const f32x4 q4 = *(const f32x4*)(PSQ + (size_t)s * 4); const float rs = 1.0f / sqrtf(((q4[0] + q4[1]) + (q4[2] + q4[3])) / 256.f + LN_EPS);
            float d = 0.f; for (int c = 0; c < 256; ++c) d += QL[h * 256 + c] * (ldbf(HC + (size_t)s * 256 + c) * rs * gk[c]); lg = d - exp2f(-(float)(h + 1)) * (float)(t - s); }
        LG[idx] = lg; }
    __syncthreads();
    if (tid < 8) { float m = -INFINITY; for (int s = 0; s < 2048; ++s) m = fmaxf(m, LG[tid * 2048 + s]); float l = 0.f;
        for (int s = 0; s < 2048; ++s) { const float e = LG[tid * 2048 + s] > -INFINITY ? expf(LG[tid * 2048 + s] - m) : 0.f; LG[tid * 2048 + s] = e; l += e; }
        const float inv = l > 0.f ? 1.f / l : 0.f; for (int s = 0; s < 2048; ++s) LG[tid * 2048 + s] *= inv; }
    __syncthreads();
    for (int idx = tid; idx < 2048; idx += 512) { const int h = idx >> 8, c = idx & 255; float o = 0.f;
        for (int s = 0; s <= t; ++s) { const float p = LG[h * 2048 + s]; if (p != 0.f) { const f32x4 q4 = *(const f32x4*)(PSQ + (size_t)s * 4); const float rs = 1.0f / sqrtf(((q4[0] + q4[1]) + (q4[2] + q4[3])) / 256.f + LN_EPS);
            o += p * ldbf(HC + (size_t)s * 256 + c) * rs * gk[c]; } }
        OL[idx] = o; }
    __syncthreads();
    float err = 0.f, ref = 0.f;
    for (int idx = tid; idx < 1024; idx += 512) { const int h = idx >> 7, d = idx & 127; float o = 0.f; for (int c = 0; c < 256; ++c) o += OL[h * 256 + c] * a.in[6][((size_t)h * 256 + c) * 128 + d];
        const float gv = ldbf((const bf16_t*)(ws + WS_BR) + (size_t)NTOK * 1024 + tok * 1024 + idx); err += (gv - o) * (gv - o); ref += o * o; }
    dbg_accum(ctl, 3, err, ref); __syncthreads();
}
__device__ void dbg_gmlp(const Args& a, unsigned* ctl) {
    unsigned char* ws = a.ws; const int tid = threadIdx.x;
    const int b = blockIdx.x & 3, t = (blockIdx.x * 89 + 40) % SEQ, ch = t >> 7, tl = t & 127; const size_t tok = (size_t)b * SEQ + t;
    float err = 0.f, ref = 0.f;
    for (int c = tid; c < 1024; c += 512) { const int g = c >> 7; float m = a.in[11][g * 128 + tl];
        for (int s = 0; s <= tl; ++s) m += a.in[10][((size_t)g * 128 + tl) * 128 + s] * ldbf((const bf16_t*)(ws + WS_HV) + ((size_t)b * SEQ + ch * 128 + s) * 1024 + c);
        const float rv = m * ldbf((const bf16_t*)(ws + WS_HU) + tok * 1024 + c), gv = ldbf((const bf16_t*)(ws + WS_BR) + (size_t)2 * NTOK * 1024 + tok * 1024 + c);
        err += (gv - rv) * (gv - rv); ref += rv * rv; }
    dbg_accum(ctl, 4, err, ref);
}
__device__ void dbg_merge(const Args& a, unsigned* ctl, LAS unsigned char* lds) {
    unsigned char* ws = a.ws; const int tid = threadIdx.x; const int r = (blockIdx.x * 32 + 9) % NTOK; LAS float* MP = (LAS float*)lds;
    for (int d = tid; d < DM; d += 512) { float acc = 0.f;
        for (int n = 0; n < 3; ++n) { float y = 0.f; const bf16_t* br = (const bf16_t*)(ws + WS_BR) + (size_t)n * NTOK * 1024 + (size_t)r * 1024; const float* wb = a.in[12] + (size_t)n * 1024 * 2048;
            for (int w = 0; w < 1024; ++w) y += ldbf(br + w) * wb[(size_t)w * 2048 + d];
            acc += ldbf((const bf16_t*)(ws + WS_HG) + (size_t)r * 6144 + n * 2048 + d) * y; }
        MP[d] = acc; }
    __syncthreads();
    float err = 0.f, ref = 0.f;
    for (int d = tid; d < DM; d += 512) { float s = 0.f; for (int k = 0; k < DM; ++k) s += MP[k] * a.in[13][(size_t)k * 2048 + d];
        const float rv = ALPHA * a.in[0][(size_t)r * DM + d] + s, gv = ((const float*)(ws + WS_MIXT))[(size_t)r * DM + d]; err += (gv - rv) * (gv - rv); ref += rv * rv; }
    dbg_accum(ctl, 6, err, ref); __syncthreads();
}
__device__ void dbg_moe(const Args& a, unsigned* ctl, LAS unsigned char* lds) {
    unsigned char* ws = a.ws; const int tid = threadIdx.x; const int r = (blockIdx.x * 32 + 17) % NTOK;
    LAS float* X1 = (LAS float*)lds; LAS float* RED = X1 + 2048; LAS float* HH = RED + 1024; LAS float* YY = HH + 1024; LAS float* LOG = YY + 2048;
    const float* pre = (const float*)(ws + WS_MIXT) + (size_t)r * DM;
    float s = 0.f; for (int d = tid; d < DM; d += 512) s += pre[d]; RED[tid] = s; __syncthreads();
    if (tid == 0) { float m = 0.f; for (int i = 0; i < 512; ++i) m += RED[i]; RED[512] = m / DM; } __syncthreads();
    const float mean = RED[512]; __syncthreads();
    s = 0.f; for (int d = tid; d < DM; d += 512) s += (pre[d] - mean) * (pre[d] - mean); RED[tid] = s; __syncthreads();
    if (tid == 0) { float m = 0.f; for (int i = 0; i < 512; ++i) m += RED[i]; RED[513] = 1.0f / sqrtf(m / DM + LN_EPS); } __syncthreads();
    const float rstd = RED[513];
    for (int d = tid; d < DM; d += 512) X1[d] = (pre[d] - mean) * rstd * a.in[14][d] + a.in[15][d];
    __syncthreads();
    if (tid < 20) { float lg = 0.f; if (tid < 4) { for (int k = 0; k < DM; ++k) lg += X1[k] * a.in[16][(size_t)k * 4 + tid]; lg += a.in[17][tid]; } else { for (int k = 0; k < DM; ++k) lg += X1[k] * a.in[18][(size_t)k * 16 + (tid - 4)]; lg += a.in[19][tid - 4]; } LOG[tid] = lg; }
    __syncthreads();
    int gi = 0; for (int j = 1; j < 4; ++j) if (LOG[j] > LOG[gi]) gi = j;
    float den = 0.f; for (int j = 0; j < 4; ++j) den += expf(LOG[j] - LOG[gi]); const float gp = 1.f / den;
    int e1 = 0; for (int j = 1; j < 4; ++j) if (LOG[4 + gi * 4 + j] > LOG[4 + gi * 4 + e1]) e1 = j;
    int e2 = -1; for (int j = 0; j < 4; ++j) if (j != e1 && (e2 < 0 || LOG[4 + gi * 4 + j] > LOG[4 + gi * 4 + e2])) e2 = j;
    const float ex = expf(LOG[4 + gi * 4 + e2] - LOG[4 + gi * 4 + e1]); const float wv0 = gp / (1.f + ex), wv1 = gp * ex / (1.f + ex); const int ev0 = gi * 4 + e1, ev1 = gi * 4 + e2;
    for (int q = 0; q < 2; ++q) { const int e = q ? ev1 : ev0; const float* wg = a.in[20] + (size_t)e * 2048 * 512; const float* wu = a.in[21] + (size_t)e * 2048 * 512;
        float g = 0.f, u = 0.f; for (int k = 0; k < DM; ++k) { g += X1[k] * wg[(size_t)k * 512 + tid]; u += X1[k] * wu[(size_t)k * 512 + tid]; }
        HH[q * 512 + tid] = g / (1.f + expf(-g)) * u * (q ? wv1 : wv0); }
    __syncthreads();
    for (int d = tid; d < DM; d += 512) { float y = 0.f; for (int q = 0; q < 2; ++q) { const float* wd = a.in[22] + (size_t)(q ? ev1 : ev0) * 512 * 2048; for (int f = 0; f < 512; ++f) y += HH[q * 512 + f] * wd[(size_t)f * 2048 + d]; } YY[d] = ALPHA * X1[d] + y; }
    __syncthreads();
    s = 0.f; for (int d = tid; d < DM; d += 512) s += YY[d]; RED[tid] = s; __syncthreads();
    if (tid == 0) { float m = 0.f; for (int i = 0; i < 512; ++i) m += RED[i]; RED[514] = m / DM; } __syncthreads();
    const float mean2 = RED[514]; __syncthreads();
    s = 0.f; for (int d = tid; d < DM; d += 512) s += (YY[d] - mean2) * (YY[d] - mean2); RED[tid] = s; __syncthreads();
    if (tid == 0) { float m = 0.f; for (int i = 0; i < 512; ++i) m += RED[i]; RED[515] = 1.0f / sqrtf(m / DM + LN_EPS); } __syncthreads();
    const float rstd2 = RED[515];
    float err = 0.f, ref = 0.f;
    const int* trow = (const int*)(ws + WS_TOK) + 6 * NTOK; const bf16_t* Y = (const bf16_t*)(ws + WS_Y);
    for (int d = tid; d < DM; d += 512) {
#if DBG_STAGE == 8
        const float rv = (YY[d] - mean2) * rstd2 * a.in[23][d] + a.in[24][d], gv = ((const float*)(ws + WS_XF))[(size_t)r * DM + d];
#else
        const float rv = YY[d] - ALPHA * X1[d], gv = ldbf(Y + (size_t)trow[r * 2] * DM + d) + ldbf(Y + (size_t)trow[r * 2 + 1] * DM + d);
#endif
        err += (gv - rv) * (gv - rv); ref += rv * rv; }
    dbg_accum(ctl, 7, err, ref); __syncthreads();
}
__device__ void dbg_checks(const Args& a, unsigned* ctl, LAS unsigned char* lds) {
#if DBG_STAGE == 5
    dbg_inproj(a, ctl);
#elif DBG_STAGE == 2
    dbg_compress(a, ctl, lds);
#elif DBG_STAGE == 1
    dbg_nsa(a, ctl, lds);
#elif DBG_STAGE == 3
    dbg_dsa(a, ctl, lds);
#elif DBG_STAGE == 4
    dbg_gmlp(a, ctl);
#elif DBG_STAGE == 6
    dbg_merge(a, ctl, lds);
#else
    dbg_moe(a, ctl, lds);
#endif
}
__device__ void dbg_scale_output(const Args& a, unsigned* ctl) {
    const int k = (DBG_STAGE == 8) ? 7 : DBG_STAGE;
    const float err = __hip_atomic_load((float*)(ctl + CW_DBG) + 2 * k, __ATOMIC_RELAXED, __HIP_MEMORY_SCOPE_AGENT), ref = __hip_atomic_load((float*)(ctl + CW_DBG) + 2 * k + 1, __ATOMIC_RELAXED, __HIP_MEMORY_SCOPE_AGENT);
    const float E = ref > 0.f ? sqrtf(err / ref) : 1.0f; const float f = 1.0f + 3.0f * fminf(E, 1.0f);
    for (size_t i = (size_t)blockIdx.x * 512 + threadIdx.x; i < (size_t)NTOK * DM; i += (size_t)gridDim.x * 512) a.out[i] *= f;
}
#endif

struct ItemTable { unsigned short v[768]; };
constexpr int item_cost(int type, int idx) {
    if (type == 0) { const int qb = idx & 31; return 4 + qb + ((qb + 1) < 9 ? (qb + 1) : 9); }
    if (type == 1) { const int qb = idx & 7; return 4 * (qb + 1) + 1; }
    return 1;
}
constexpr ItemTable make_items() {
    ItemTable t{}; int pos = 0;
    for (int cst = 64; cst >= 0; --cst) for (int id = 0; id < 768; ++id) { const int type = id >> 8, idx = id & 255; if (item_cost(type, idx) == cst) t.v[pos++] = (unsigned short)((type << 12) | idx); }
    return t;
}
__device__ const ItemTable g_items = make_items();

constexpr int N_PHASES = 1 + NL * 10;
#ifndef PH_MASK
#define PH_MASK 0x7ff
#endif
#define PH_ON(k) (((PH_MASK) >> (k)) & 1)
#if defined(PROBE_DOUBLE) && MK_SINGLE
#define PH_REPS(k) ((((PROBE_DOUBLE) >> (k)) & 1) ? 2 : 1)
#else
#define PH_REPS(k) 1
#endif
#ifndef PROBE_SUB
#define PROBE_SUB 0xff
#endif
__global__ void __launch_bounds__(512, 2) mk_fwd(Args a_unused) {
    extern __shared__ __attribute__((aligned(16))) unsigned char lds_raw[];
    LAS unsigned char* lds = (LAS unsigned char*)lds_raw;
    typedef const __attribute__((address_space(4))) Args KArgs;
    KArgs* const ka0 = (KArgs*)__builtin_amdgcn_kernarg_segment_ptr();
#define KA() (*(const Args*)(KArgs*)((unsigned long long)ka0 + opaque_zero()))
    const Args& a = KA();
    unsigned char* ws0 = a.ws;
    unsigned* ctl = (unsigned*)(ws0 + WS_CTL);
    const int tid = threadIdx.x, G = gridDim.x, wg = blockIdx.x;
#if MK_SINGLE
    if (tid < 4) ((LAS unsigned*)(lds + LDS_BYTES - 16))[tid] = 0u;
    __syncthreads();
    XcdBarrier bar = xcd_barrier_post(ctl + CW_BAR, (volatile LAS unsigned*)(lds + LDS_BYTES - 16));
#define GRID_BAR() do { XcdBarrier bb_ = bar; bb_.bar = launder_s(bb_.bar); bb_.x = bar.x + opaque_zero(); xcd_barrier(bb_); } while (0)
#else
#define GRID_BAR() do { } while (0)
#endif
#if MK_SINGLE
#define IN(k) true
#else
    const int lo = a.ph_lo, hi = a.ph_hi;
#define IN(k) (lo <= (k) && (k) < hi)
#endif
#if defined(PROBE_BAR2)
#define SEAM(k) do { if (IN(k) && IN((k) + 1)) { GRID_BAR(); GRID_BAR(); } } while (0)
#else
#define SEAM(k) do { if (IN(k) && IN((k) + 1)) GRID_BAR(); } while (0)
#endif

    if (PH_ON(10) && IN(0)) for (int rep = 0; rep < PH_REPS(10); ++rep) { if (rep) GRID_BAR();
#if defined(PROBE_P0_NOSTORE)
        p0_prologue(a, lds, rep != 0);
#else
        p0_prologue(a, lds);
#endif
    }
    SEAM(0);
    for (int l = 0; l < NL; ++l) {
        const int p = 1 + l * 10;
        unsigned char* ws = launder_s(ws0);
        if (PH_ON(0) && IN(p + 0)) for (int rep = 0; rep < PH_REPS(0); ++rep) { if (rep) GRID_BAR(); ws = launder_s(ws); const Args& a = KA();
            skinny_item(a, l, lds);
            pg8::Gemm g{(const bf16_t*)(ws + WS_XB), (const bf16_t*)(ws + WS_WIN) + (size_t)l * NMAIN * DM, NTOK, NMAIN, DM};
            pg8::StaticOrder S; S.init(NTOK, NMAIN, G, wg); EpiInProj E{ws};
            pg8::gemm_phase<EpiInProj, pg8::StaticOrder, false>(lds, g, S, E, nullptr);
        }
        SEAM(p + 0);
        if (PH_ON(1) && IN(p + 1)) for (int rep = 0; rep < PH_REPS(1); ++rep) { if (rep) GRID_BAR(); ws = launder_s(ws); const Args& a = KA();
            const int subm = rep ? (PROBE_SUB) : 0xff;
            if (subm & 1) { pg8::Gemm g{(const bf16_t*)(ws + WS_HC), (const bf16_t*)(ws + WS_WKVUP) + (size_t)l * 2048 * 256, NTOK, 2048, 256};
              pg8::StaticOrder S; S.init(NTOK, 2048, G, wg);
              EpiKvUp E{ws};
              pg8::gemm_phase<EpiKvUp, pg8::StaticOrder, false>(lds, g, S, E, nullptr); }
            if (subm & 2) gmlp_ln_rows(a, l);
            if (subm & 4) for (int it = wg; it < 64; it += G) compress_item(a, l, lds, it);
            if (subm & 8) for (int it = wg; it < 256; it += G) { indexer_item(a, lds, it); indexer_item(a, lds, 511 - it); }
        }
        SEAM(p + 1);
        if (PH_ON(2) && IN(p + 2)) for (int rep = 0; rep < PH_REPS(2); ++rep) { if (rep) GRID_BAR(); ws = launder_s(ws); const Args& a = KA();
            LAS unsigned* slot = (LAS unsigned*)(lds + att::L_MISC); const int tq = LTID;
            unsigned qi = (unsigned)wg;
            for (;;) {
                if (qi >= 768u) break;
                unsigned nxt = 0u;
                if (tq == 0) nxt = (unsigned)G + __hip_atomic_fetch_add(ctl + CW_Q + (l * 2 + rep) * 64, 1u, __ATOMIC_RELAXED, __HIP_MEMORY_SCOPE_AGENT);
                const unsigned it = g_items.v[qi]; const int type = it >> 12, idx = it & 255;
                if (type == 0) att::nsa_item(a, lds, idx >> 6, (idx >> 5) & 1, idx & 31);
                else if (type == 1) att::dsa_item(a, lds, idx >> 6, (idx >> 3) & 7, idx & 7);
                else att::gmlp_item(a, lds, l, idx >> 6, (idx >> 2) & 15, idx & 3);
                if (tq == 0) slot[0] = nxt;
                __syncthreads();
                qi = slot[0];
                __syncthreads();
            }
        }
        SEAM(p + 2);
        if (PH_ON(3) && IN(p + 3)) for (int rep = 0; rep < PH_REPS(3); ++rep) { if (rep) GRID_BAR(); ws = launder_s(ws); const Args& a = KA();
            pg8::Gemm g{(const bf16_t*)(ws + WS_BR), (const bf16_t*)(ws + WS_WB) + (size_t)l * 3 * 2048 * 1024, 0, 0, 1024};
            BranchSched S{G, wg}; EpiBranch E{ws};
            pg8::gemm_phase<EpiBranch, BranchSched, false>(lds, g, S, E, nullptr);
        }
        SEAM(p + 3);
        if (PH_ON(4) && IN(p + 4)) for (int rep = 0; rep < PH_REPS(4); ++rep) { if (rep) GRID_BAR(); ws = launder_s(ws); const Args& a = KA();
            pg8::Gemm g{(const bf16_t*)(ws + WS_MIXB), (const bf16_t*)(ws + WS_WO) + (size_t)l * DM * DM, NTOK, DM, DM};
            pg8::StaticOrder S; S.init(NTOK, DM, G, wg); EpiOut E{l == 0 ? a.in[0] : (const float*)(ws + WS_XF), (float*)(ws + WS_MIXT)};
            pg8::gemm_phase<EpiOut, pg8::StaticOrder, false>(lds, g, S, E, nullptr);
        }
        SEAM(p + 4);
        if (PH_ON(5) && IN(p + 5)) { const Args& a = KA(); p6_ln1_route(a, l, lds); }
        SEAM(p + 5);
        if (PH_ON(6) && IN(p + 6)) for (int rep = 0; rep < PH_REPS(6); ++rep) { if (rep) GRID_BAR(); const Args& a = KA(); p7_gather(a, l, lds); }
        SEAM(p + 6);
        if (PH_ON(7) && IN(p + 7)) for (int rep = 0; rep < PH_REPS(7); ++rep) { if (rep) GRID_BAR(); ws = launder_s(ws); const Args& a = KA();
            LAS int* off = (LAS int*)(lds + 131072); LAS int* te = off + 64;
            const int nt = moe_tile_table(a, l, off, te);
            pg8::Gemm g{(const bf16_t*)(ws + WS_XS), (const bf16_t*)(ws + WS_WGU) + (size_t)l * 16 * 1024 * 2048, 0, 0, DM};
            MoeSched S{te, nt, 4, G, wg}; EpiGateUp E{ws};
            pg8::gemm_phase<EpiGateUp, MoeSched, false>(lds, g, S, E, nullptr);
        }
        SEAM(p + 7);
        if (PH_ON(8) && IN(p + 8)) for (int rep = 0; rep < PH_REPS(8); ++rep) { if (rep) GRID_BAR(); ws = launder_s(ws); const Args& a = KA();
            LAS int* off = (LAS int*)(lds + 131072); LAS int* te = off + 64;
            const int nt = moe_tile_table(a, l, off, te);
            pg8::Gemm g{(const bf16_t*)(ws + WS_HM), (const bf16_t*)(ws + WS_WD) + (size_t)l * 16 * 2048 * 512, 0, 0, DEXP};
            MoeSched S{te, nt, 8, G, wg}; EpiDown E{ws};
            pg8::gemm_phase<EpiDown, MoeSched, false>(lds, g, S, E, nullptr);
        }
        SEAM(p + 8);
        if (PH_ON(9) && IN(p + 9)) for (int rep = 0; rep < PH_REPS(9); ++rep) { if (rep) GRID_BAR(); const Args& a = KA(); p10_ln2(a, l); }
        SEAM(p + 9);
    }
#undef IN
#undef SEAM
}

#if defined(DBG_STAGE)
__global__ void __launch_bounds__(512, 2) dbg_k(Args a, int what) {
    extern __shared__ __attribute__((aligned(16))) unsigned char lds_raw[];
    LAS unsigned char* lds = (LAS unsigned char*)lds_raw; unsigned* ctl = (unsigned*)(a.ws + WS_CTL);
    if (what == 0) dbg_checks(a, ctl, lds); else dbg_scale_output(a, ctl);
}
#endif
extern "C" void kernel_launch(void* const* d_in, const int* in_sizes, int n_in, void* d_out, int out_size, void* d_ws, size_t ws_size, hipStream_t stream) {
    static int grid = 0;
    if (grid == 0) {
        if (n_in != 25 || out_size != NTOK * DM || ws_size < WS_END) { fprintf(stderr, "kernel_launch: expected 25 inputs, out %d, ws >= %zu; got n_in %d out %d ws %zu\n", NTOK * DM, (size_t)WS_END, n_in, out_size, ws_size); grid = -1; return; }
        int dev = 0, cus = 0, per_cu = 0;
        if (hipGetDevice(&dev) != hipSuccess || hipDeviceGetAttribute(&cus, hipDeviceAttributeMultiprocessorCount, dev) != hipSuccess) { fprintf(stderr, "kernel_launch: device query failed\n"); grid = -1; return; }
#if defined(DBG_STAGE)
        (void)hipFuncSetAttribute((const void*)dbg_k, hipFuncAttributeMaxDynamicSharedMemorySize, LDS_BYTES);
#endif
        if (hipFuncSetAttribute((const void*)mk_fwd, hipFuncAttributeMaxDynamicSharedMemorySize, LDS_BYTES) != hipSuccess) { fprintf(stderr, "kernel_launch: hipFuncSetAttribute failed\n"); grid = -1; return; }
        if (hipOccupancyMaxActiveBlocksPerMultiprocessor(&per_cu, (const void*)mk_fwd, 512, LDS_BYTES) != hipSuccess || per_cu < 1) fprintf(stderr, "kernel_launch: occupancy query reports %d blocks per CU\n", per_cu);
        (void)hipGetLastError();
        grid = cus;
    }
    if (grid < 0) return;
    (void)hipMemsetAsync((char*)d_ws + WS_CTL, 0, CTL_BYTES, stream);
    Args a{};
    for (int i = 0; i < 25; ++i) a.in[i] = (const float*)d_in[i];
    a.out = (float*)d_out; a.ws = (unsigned char*)d_ws; a.rep = 0; a.sub = 0xff;
#if MK_SINGLE
    a.ph_lo = 0; a.ph_hi = N_PHASES;
    hipLaunchKernelGGL(mk_fwd, dim3(grid), dim3(512), LDS_BYTES, stream, a);
#else
    for (int p = 0; p < N_PHASES; ++p) { a.ph_lo = p; a.ph_hi = p + 1; hipLaunchKernelGGL(mk_fwd, dim3(grid), dim3(512), LDS_BYTES, stream, a);
#if defined(PROBE_DOUBLE)
        { const int k = p == 0 ? 10 : (p - 1) % 10; if ((PROBE_DOUBLE >> k) & 1) { a.rep = 1;
#if defined(PROBE_SUB)
            a.sub = PROBE_SUB;
#endif
            hipLaunchKernelGGL(mk_fwd, dim3(grid), dim3(512), LDS_BYTES, stream, a); a.rep = 0; a.sub = 0xff; } }
#endif
#if defined(DBG_STAGE)
        if (p == 10) hipLaunchKernelGGL(dbg_k, dim3(grid), dim3(512), LDS_BYTES, stream, a, 0);
        if (p == N_PHASES - 1) hipLaunchKernelGGL(dbg_k, dim3(grid), dim3(512), LDS_BYTES, stream, a, 1);
#endif
    }
#endif
    const hipError_t le = hipPeekAtLastError();
    if (le != hipSuccess) fprintf(stderr, "kernel_launch: launch failed: %s\n", hipGetErrorName(le));
}
```

```cpp
#include <hip/hip_runtime.h>
#include <cstdio>
#include <cstdint>

#ifndef MK_SINGLE
#define MK_SINGLE 1
#endif

constexpr int NB = 4, SEQ = 2048, DM = 2048, NL = 4, NTOK = NB * SEQ;
constexpr int IN_COLS = 12380, NMAIN = 12288, NSK = 128;
constexpr int NEXP = 16, DEXP = 512, MOE_ROWS = 2 * NTOK + NEXP * 256;
constexpr float LN_EPS = 1e-5f;
constexpr float ALPHA = 1.681792830507429f;
constexpr float LOG2E = 1.4426950408889634f;
constexpr float ATT_C2 = 0.08838834764831845f * LOG2E;
constexpr int LDS_BYTES = 147456;

typedef unsigned short bf16_t;
typedef short bf16x8 __attribute__((ext_vector_type(8)));
typedef short s16x4 __attribute__((ext_vector_type(4)));
typedef float f32x16 __attribute__((ext_vector_type(16)));
typedef float f32x4 __attribute__((ext_vector_type(4)));
typedef float f32x2 __attribute__((ext_vector_type(2)));
typedef unsigned u32x4 __attribute__((ext_vector_type(4)));
typedef unsigned u32x2 __attribute__((ext_vector_type(2)));

constexpr size_t al256(size_t x) { return (x + 255) & ~(size_t)255; }
constexpr size_t WS_CTL    = 0;
constexpr size_t CTL_BYTES = 65536;
constexpr size_t WS_WIN    = WS_CTL + CTL_BYTES;
constexpr size_t WS_WSK    = WS_WIN  + (size_t)NL * NMAIN * DM * 2;
constexpr size_t WS_W1     = WS_WSK  + (size_t)NL * NSK * DM * 2;
constexpr size_t WS_W2     = WS_W1   + (size_t)NL * 2 * 128 * 4096 * 2;
constexpr size_t WS_C1     = WS_W2   + (size_t)NL * 2 * 128 * 128 * 2;
constexpr size_t WS_WKVUP  = WS_C1   + (size_t)NL * 2 * 16 * 128 * 4;
constexpr size_t WS_WSTRIL = WS_WKVUP + (size_t)NL * 2048 * 256 * 2;
constexpr size_t WS_WB     = WS_WSTRIL + (size_t)NL * 8 * 128 * 128 * 2;
constexpr size_t WS_WO     = WS_WB   + (size_t)NL * 3 * 2048 * 1024 * 2;
constexpr size_t WS_WR     = WS_WO   + (size_t)NL * 2048 * 2048 * 2;
constexpr size_t WS_WGU    = WS_WR   + (size_t)NL * 2 * 32 * 2048 * 2;
constexpr size_t WS_WD     = WS_WGU  + (size_t)NL * 16 * 1024 * 2048 * 2;
constexpr size_t WS_XF     = WS_WD   + (size_t)NL * 16 * 2048 * 512 * 2;
constexpr size_t WS_XB     = WS_XF   + (size_t)NTOK * DM * 4;
constexpr size_t WS_SKF    = WS_XB   + (size_t)NTOK * DM * 2;
constexpr size_t WS_KI     = WS_SKF  + (size_t)NTOK * 32 * 4;
constexpr size_t WS_QA     = WS_KI   + (size_t)NTOK * 64 * 2;
constexpr size_t WS_KV     = WS_QA   + (size_t)NTOK * 1024 * 2;
constexpr size_t WS_QB     = WS_KV   + (size_t)NTOK * 1536 * 2;
constexpr size_t WS_HC     = WS_QB   + (size_t)NTOK * 1024 * 2;
constexpr size_t WS_PSQ    = WS_HC   + (size_t)NTOK * 256 * 2;
constexpr size_t WS_QI     = WS_PSQ  + (size_t)NTOK * 4 * 4;
constexpr size_t WS_HU     = WS_QI   + (size_t)NTOK * 256 * 2;
constexpr size_t WS_HV     = WS_HU   + (size_t)NTOK * 1024 * 2;
constexpr size_t WS_HG     = WS_HV   + (size_t)NTOK * 1024 * 2;
constexpr size_t WS_KVUP   = WS_HG   + (size_t)NTOK * 6144 * 2;
constexpr size_t WS_KC     = WS_KVUP + (size_t)NTOK * 2048 * 2;
constexpr size_t WS_MASK   = WS_KC   + (size_t)2 * 8 * 128 * 128 * 2;
constexpr size_t WS_BR     = WS_MASK + (size_t)NTOK * 32 * 8;
constexpr size_t WS_TT     = WS_BR   + (size_t)3 * NTOK * 1024 * 2;
constexpr size_t WS_MIXT   = WS_TT   + (size_t)256 * 64 * 512 * 4;
constexpr size_t WS_MIXB   = WS_MIXT + (size_t)NTOK * DM * 4;
constexpr size_t WS_X1F    = WS_MIXB + (size_t)NTOK * DM * 2;
constexpr size_t WS_X1B    = WS_X1F  + (size_t)NTOK * DM * 4;
constexpr size_t WS_TOK    = WS_X1B  + (size_t)NTOK * DM * 2;
constexpr size_t WS_ROWW   = WS_TOK  + (size_t)NTOK * 2 * 4 * 4;
constexpr size_t WS_XS     = WS_ROWW + (size_t)MOE_ROWS * 4;
constexpr size_t WS_HM     = WS_XS   + (size_t)MOE_ROWS * DM * 2;
constexpr size_t WS_Y      = WS_HM   + (size_t)MOE_ROWS * DEXP * 2;
constexpr size_t WS_END    = WS_Y    + (size_t)MOE_ROWS * DM * 2;

constexpr int CW_BAR  = 0;
constexpr int CW_Q    = 4096;
constexpr int CW_CNT  = 5120;
constexpr int CW_CNTW = 9216;
constexpr int CW_DBG  = 13312;

__device__ __forceinline__ bf16_t f2bf(float f) { unsigned u = __float_as_uint(f); u += 0x7FFFu + ((u >> 16) & 1u); return (bf16_t)(u >> 16); }
__device__ __forceinline__ float bf2f(bf16_t b) { return __uint_as_float(((unsigned)b) << 16); }
__device__ __forceinline__ unsigned cvtpk(float lo, float hi) { unsigned r; asm volatile("v_cvt_pk_bf16_f32 %0, %1, %2" : "=v"(r) : "v"(lo), "v"(hi)); return r; }
__device__ __forceinline__ bf16x8 pack8(f32x4 a, f32x4 b) { u32x4 w = {cvtpk(a[0], a[1]), cvtpk(a[2], a[3]), cvtpk(b[0], b[1]), cvtpk(b[2], b[3])}; return *reinterpret_cast<bf16x8*>(&w); }
__device__ __forceinline__ float fast_sigmoid(float x) { return __builtin_amdgcn_rcpf(1.0f + __builtin_amdgcn_exp2f(-x * LOG2E)); }
__device__ __forceinline__ float gelu_tanh(float x) {
    const float z = 0.7978845608028654f * (x + 0.044715f * x * x * x);
    return x * __builtin_amdgcn_rcpf(1.0f + __builtin_amdgcn_exp2f(-2.0f * LOG2E * z));
}
__device__ __forceinline__ float wave_sum(float v) {
#pragma unroll
    for (int o = 32; o >= 1; o >>= 1) v += __shfl_xor(v, o);
    return v;
}

__device__ __forceinline__ int launder_v(int x) { asm volatile("" : "+v"(x)); return x; }
__device__ __forceinline__ unsigned opaque_zero() { unsigned z; asm volatile("s_mov_b32 %0, 0" : "=s"(z)); return z; }
template <class T> __device__ __forceinline__ T* launder_s(T* p) { typedef __attribute__((address_space(1))) T GT; GT* g = (GT*)((unsigned long long)p + opaque_zero()); return (T*)g; }
#define LTID launder_v((int)threadIdx.x)
#define LBID ((int)(blockIdx.x + opaque_zero()))
namespace pg8 {
#define PG8_LAS __attribute__((address_space(3)))
typedef unsigned short bf16_t;
typedef short bf16x8 __attribute__((ext_vector_type(8)));
typedef float f32x4 __attribute__((ext_vector_type(4)));
typedef unsigned u32x4 __attribute__((ext_vector_type(4)));
constexpr int BM = 256, BK = 64, HALF = 128, HTB = HALF * BK * 2  , STAGE_BYTES = 8 * HTB, NXCD = 8, WGM = 8;

__host__ __device__ __forceinline__ int lds_byte(int r, int c) { const int st = (r >> 4) * 2 + (c >> 5), rr = r & 15, cc = c & 31, ob = rr * 64 + cc * 2; return st * 1024 + (ob ^ (((ob >> 9) & 1) << 5)); }
__host__ __device__ __forceinline__ void stage_rc(int b, int& R, int& C) { const int st = b / 1024, sb = b % 1024, swz = sb ^ (((sb >> 9) & 1) << 5); R = (st >> 1) * 16 + swz / 64; C = (st & 1) * 32 + (swz % 64) / 2; }
__host__ __device__ __forceinline__ int perm32(int rho) { const int n = rho >> 4, i = rho & 15; return 8 * (i >> 2) + 4 * n + (i & 3); }

struct Unit { int pm, pn; };
template <class E, class = void> struct has_keep { static constexpr bool v = false; };
template <class E> struct has_keep<E, decltype((void)&E::keep)> { static constexpr bool v = true; };
struct Gemm { const bf16_t* A; const bf16_t* Bt; int M, N, K; };

struct StaticOrder {
    int nM, nN, nwg, G, c;
    __host__ __device__ void init(int M, int N, int G_, int c_) { nM = M / BM; nN = N / BM; nwg = nM * nN; G = G_; c = c_; }
    __host__ __device__ bool next(int i, Unit& u) const {
        const long L = (long)i * G + c; if (L >= nwg) return false;
        int wgid = (int)L; { const int q = nwg / NXCD, r = nwg % NXCD, xcd = wgid % NXCD, off = wgid / NXCD; wgid = (xcd < r ? xcd * (q + 1) : r * (q + 1) + (xcd - r) * q) + off; }
        const int nig = WGM * nN, gid = wgid / nig, fm = gid * WGM, gsz = (nM - fm) < WGM ? (nM - fm) : WGM;
        u.pm = fm + ((wgid % nig) % gsz); u.pn = (wgid % nig) / gsz; return true;
    }
    __device__ __forceinline__ void a_ready(const Unit&) const {}
    __device__ __forceinline__ void done(const Unit&) const {}
};
struct CountedOrder : StaticOrder {
    const unsigned* ready; unsigned need; unsigned* tmo;
    __device__ __forceinline__ void a_ready(const Unit& u) const {
        if (threadIdx.x < 64) {
            const unsigned long long t0 = __builtin_amdgcn_s_memrealtime(); unsigned polls = 0;
            while ((unsigned)__builtin_amdgcn_readfirstlane(__hip_atomic_load(ready + 64 * u.pm, __ATOMIC_RELAXED, __HIP_MEMORY_SCOPE_AGENT)) < need) {
                if ((++polls & 255u) == 0u && __builtin_amdgcn_readfirstlane(__hip_atomic_load(tmo, __ATOMIC_RELAXED, __HIP_MEMORY_SCOPE_AGENT)) != 0u) break;
                if (__builtin_amdgcn_s_memrealtime() - t0 > 2000000ull) {
                    if (threadIdx.x == 0) { unsigned expect = 0u; __hip_atomic_compare_exchange_strong(tmo + 1, &expect, 0x600u | (unsigned)(u.pm & 0xff), __ATOMIC_RELAXED, __ATOMIC_RELAXED, __HIP_MEMORY_SCOPE_AGENT); __hip_atomic_store(tmo, 1u, __ATOMIC_RELAXED, __HIP_MEMORY_SCOPE_AGENT); }
                    break; }
                __builtin_amdgcn_s_sleep(2); }
            __builtin_amdgcn_fence(__ATOMIC_ACQUIRE, "agent");
            asm volatile("s_waitcnt vmcnt(0)" ::: "memory");
        }
#if !defined(BROKEN_HOOK_NO_BARRIER)
        asm volatile("" ::: "memory"); __builtin_amdgcn_s_barrier(); asm volatile("" ::: "memory");
#endif
    }
};

__device__ __forceinline__ unsigned cvt_pk_bf16(float lo, float hi) { unsigned r; asm volatile("v_cvt_pk_bf16_f32 %0, %1, %2" : "=v"(r) : "v"(lo), "v"(hi)); return r; }
typedef float f32x2 __attribute__((ext_vector_type(2)));
__device__ __forceinline__ f32x2 gelu_pk(f32x2 v) {
    const f32x2 av = __builtin_elementwise_abs(v), d = av * 0.2316418882f + 1.0f;
    f32x2 t; t.x = __builtin_amdgcn_rcpf(d.x); t.y = __builtin_amdgcn_rcpf(d.y);
    f32x2 q = t * 0.5307027145f + (-0.7265760135f); q = q * t + 0.7107068705f; q = q * t + (-0.142248368f); q = q * t + 0.127414796f; q = q * t;
    const f32x2 s = (v * v) * (-0.72134752044f);
    f32x2 e; e.x = __builtin_amdgcn_exp2f(s.x); e.y = __builtin_amdgcn_exp2f(s.y);
    const f32x2 m = v * (q * e), r = v - m;
    f32x2 o; o.x = v.x < 0.f ? m.x : r.x; o.y = v.y < 0.f ? m.y : r.y; return o;
}

struct EpiF32 {
    static constexpr bool PERM = false, AFTER_DRAIN = false;
    float* C; int ldc; const float* bias;
    __device__ __forceinline__ void operator()(const f32x4 (&acc)[2][2][4][2], const Unit& u, int wr, int wc, int fr, int fq) const {
        const int row0 = u.pm * BM + wr * 64 + fr, col0 = u.pn * BM + wc * 32 + 4 * fq;
        f32x4 bv[2][2];
#pragma unroll
        for (int bj = 0; bj < 2; ++bj)
#pragma unroll
            for (int n = 0; n < 2; ++n) bv[bj][n] = bias ? *(const f32x4*)(bias + col0 + bj * HALF + n * 16) : (f32x4){0.f, 0.f, 0.f, 0.f};
#pragma unroll
        for (int ai = 0; ai < 2; ++ai)
#pragma unroll
            for (int m = 0; m < 4; ++m) { float* rowp = C + (size_t)(row0 + ai * HALF + m * 16) * ldc + col0;
#pragma unroll
                for (int bj = 0; bj < 2; ++bj)
#pragma unroll
                    for (int n = 0; n < 2; ++n) *(f32x4*)(rowp + bj * HALF + n * 16) = acc[ai][bj][m][n] + bv[bj][n]; }
    }
};
template <int ACT  > struct EpiBf16 {
    static constexpr bool PERM = true, AFTER_DRAIN = false;
    bf16_t* O; int ldc; const float* bias; int split_cols; size_t split_stride;
    __device__ __forceinline__ void operator()(const f32x4 (&acc)[2][2][4][2], const Unit& u, int wr, int wc, int fr, int fq) const {
        const int row0 = u.pm * BM + wr * 64 + fr; int colt = u.pn * BM; bf16_t* base = O;
        if (split_cols) { const int t = colt / split_cols; base += (size_t)t * split_stride; colt -= t * split_cols; }
        const int col0 = colt + wc * 32 + 8 * fq, bcol0 = u.pn * BM + wc * 32 + 8 * fq;
        f32x4 bv[2][2];
#pragma unroll
        for (int bj = 0; bj < 2; ++bj)
#pragma unroll
            for (int n = 0; n < 2; ++n) bv[bj][n] = bias ? *(const f32x4*)(bias + bcol0 + bj * HALF + 4 * n) : (f32x4){0.f, 0.f, 0.f, 0.f};
#pragma unroll
        for (int ai = 0; ai < 2; ++ai)
#pragma unroll
            for (int m = 0; m < 4; ++m) { bf16_t* rowp = base + (size_t)(row0 + ai * HALF + m * 16) * ldc + col0;
#pragma unroll
                for (int bj = 0; bj < 2; ++bj) { f32x4 v0 = acc[ai][bj][m][0] + bv[bj][0], v1 = acc[ai][bj][m][1] + bv[bj][1];
                    if (ACT == 1) { f32x2 a = gelu_pk((f32x2){v0[0], v0[1]}), b = gelu_pk((f32x2){v0[2], v0[3]}), c = gelu_pk((f32x2){v1[0], v1[1]}), d = gelu_pk((f32x2){v1[2], v1[3]});
                        v0 = (f32x4){a.x, a.y, b.x, b.y}; v1 = (f32x4){c.x, c.y, d.x, d.y}; }
                    if (ACT == 2) {
#pragma unroll
                        for (int j = 0; j < 4; ++j) { v0[j] = 0.5f * v0[j] * (1.0f + erff(v0[j] * 0.70710678f)); v1[j] = 0.5f * v1[j] * (1.0f + erff(v1[j] * 0.70710678f)); } }
                    u32x4 w; w.x = cvt_pk_bf16(v0[0], v0[1]); w.y = cvt_pk_bf16(v0[2], v0[3]); w.z = cvt_pk_bf16(v1[0], v1[1]); w.w = cvt_pk_bf16(v1[2], v1[3]);
                    *(u32x4*)(rowp + bj * HALF) = w; } }
    }
};

struct PanelStats {
    unsigned* xbuf;
    unsigned* cnt;
    unsigned* tmo;
    int ntn; float eps;
    unsigned code;
    __device__ __forceinline__ bool run(const f32x4 (&v)[2][2][4][2], const Unit& u, int wr, int wc, int fr, int fq, PG8_LAS unsigned char* lds, int wid, int lane) const {
        typedef float f32x2v __attribute__((ext_vector_type(2)));
        PG8_LAS f32x2v* P = (PG8_LAS f32x2v*)lds;
        PG8_LAS f32x2v* S = (PG8_LAS f32x2v*)(lds + 8192);
        PG8_LAS unsigned* flag = (PG8_LAS unsigned*)(lds + 8192 + 2048);
#pragma unroll
        for (int ai = 0; ai < 2; ++ai)
#pragma unroll
            for (int m = 0; m < 4; ++m) {
                float s = 0.f;
#pragma unroll
                for (int bj = 0; bj < 2; ++bj)
#pragma unroll
                    for (int n = 0; n < 2; ++n) { const f32x4 x = v[ai][bj][m][n]; s += (x[0] + x[1]) + (x[2] + x[3]); }
                s += __shfl_xor(s, 16); s += __shfl_xor(s, 32);
                const float mw = s * (1.0f / 64.0f); float q = 0.f;
#pragma unroll
                for (int bj = 0; bj < 2; ++bj)
#pragma unroll
                    for (int n = 0; n < 2; ++n) { const f32x4 d = v[ai][bj][m][n] - mw; q += (d[0] * d[0] + d[1] * d[1]) + (d[2] * d[2] + d[3] * d[3]); }
                q += __shfl_xor(q, 16); q += __shfl_xor(q, 32);
                if (fq == 0) P[(ai * HALF + wr * 64 + m * 16 + fr) * 4 + wc] = (f32x2v){mw, q};
            }
        asm volatile("s_waitcnt lgkmcnt(0)" ::: "memory"); __builtin_amdgcn_s_barrier(); asm volatile("" ::: "memory");
#if defined(BROKEN_NO_WAIT)
        if (blockIdx.x >= 64) { const long long t0 = clock64(); while (clock64() - t0 < 60000) __builtin_amdgcn_s_sleep(8); }
#endif
        const int row = wid * 32 + (lane & 31);
        if (lane < 32) {
            const f32x2v a = P[row * 4 + 0], b = P[row * 4 + 1], c = P[row * 4 + 2], d = P[row * 4 + 3];
            const float mt = (a.x + b.x + c.x + d.x) * 0.25f;
            const float da = a.x - mt, db = b.x - mt, dc = c.x - mt, dd = d.x - mt;
            const float m2 = (a.y + b.y) + (c.y + d.y) + 64.0f * ((da * da + db * db) + (dc * dc + dd * dd));
            unsigned long long* slot = (unsigned long long*)xbuf + ((size_t)(u.pm * BM + row) * 4 + u.pn);
            __hip_atomic_store(slot, ((unsigned long long)__float_as_uint(m2) << 32) | __float_as_uint(mt), __ATOMIC_RELAXED, __HIP_MEMORY_SCOPE_AGENT);
        }
        asm volatile("s_waitcnt vmcnt(0)" ::: "memory");
        if (lane == 0) __hip_atomic_fetch_add(cnt + 64 * u.pm, 1u, __ATOMIC_RELAXED, __HIP_MEMORY_SCOPE_AGENT);
        if (wid == 0) {
            bool dead = false; const unsigned long long t0 = __builtin_amdgcn_s_memrealtime(); const unsigned want = 8u * (unsigned)ntn;
            for (;;) {
#if defined(BROKEN_NO_WAIT)
                break;
#endif
                if ((unsigned)__builtin_amdgcn_readfirstlane(__hip_atomic_load(cnt + 64 * u.pm, __ATOMIC_RELAXED, __HIP_MEMORY_SCOPE_AGENT)) >= want) break;
                if (__builtin_amdgcn_s_memrealtime() - t0 > 2000000ull) {
                    if (lane == 0) { unsigned expect = 0u; __hip_atomic_compare_exchange_strong(tmo + 1, &expect, code | (unsigned)(u.pm & 0xff), __ATOMIC_RELAXED, __ATOMIC_RELAXED, __HIP_MEMORY_SCOPE_AGENT);
                                     __hip_atomic_store(tmo, 1u, __ATOMIC_RELAXED, __HIP_MEMORY_SCOPE_AGENT); }
                    dead = true; break; }
                __builtin_amdgcn_s_sleep(2);
            }
            __builtin_amdgcn_fence(__ATOMIC_ACQUIRE, "agent");
            if (lane == 0) flag[0] = dead ? 1u : 0u;
        }
        asm volatile("s_waitcnt vmcnt(0) lgkmcnt(0)" ::: "memory"); __builtin_amdgcn_s_barrier(); asm volatile("" ::: "memory");
        const bool bad = flag[0] != 0u;
        if (lane < 32) {
            const unsigned long long* slot = (const unsigned long long*)xbuf + (size_t)(u.pm * BM + row) * 4; float mt[4], m2[4]; float ms = 0.f;
#pragma unroll
            for (int t = 0; t < 4; ++t) { if (t < ntn) { const unsigned long long w = __hip_atomic_load(slot + t, __ATOMIC_RELAXED, __HIP_MEMORY_SCOPE_AGENT); mt[t] = __uint_as_float((unsigned)w); m2[t] = __uint_as_float((unsigned)(w >> 32)); } else { mt[t] = 0.f; m2[t] = 0.f; } ms += mt[t]; }
            const float mean = ms / (float)ntn; float q = 0.f;
#pragma unroll
            for (int t = 0; t < 4; ++t) if (t < ntn) { const float dm = mt[t] - mean; q += m2[t] + 256.0f * dm * dm; }
            S[row] = (f32x2v){mean, 1.0f / sqrtf(q / (256.0f * (float)ntn) + eps)};
        }
        asm volatile("s_waitcnt lgkmcnt(0)" ::: "memory"); __builtin_amdgcn_s_barrier(); asm volatile("" ::: "memory");
        return bad;
    }
};
struct EpiLnRes {
    static constexpr bool PERM = false, AFTER_DRAIN = true;
    const float* base; float* out; int ldc; const float* bias; PanelStats st; unsigned poison;
    __device__ __forceinline__ void refuse(size_t i0, size_t stride, int M, int N) const { const float q = __builtin_nanf(""); for (size_t i = i0; i < (size_t)M * N; i += stride) out[(i / N) * ldc + i % N] = q;
        if (i0 == 0) { unsigned expect = 0u; __hip_atomic_compare_exchange_strong(st.tmo + 1, &expect, 0x7f0u, __ATOMIC_RELAXED, __ATOMIC_RELAXED, __HIP_MEMORY_SCOPE_AGENT); __hip_atomic_store(st.tmo, 1u, __ATOMIC_RELAXED, __HIP_MEMORY_SCOPE_AGENT); } }
    __device__ __forceinline__ void fused(f32x4 (&acc)[2][2][4][2], const Unit& u, int wr, int wc, int fr, int fq, PG8_LAS unsigned char* lds, int wid, int lane) const {
        typedef float f32x2v __attribute__((ext_vector_type(2)));
        const PG8_LAS f32x2v* S = (const PG8_LAS f32x2v*)(lds + 8192);
        const int col0 = u.pn * BM + wc * 32 + 4 * fq;
#pragma unroll
        for (int bj = 0; bj < 2; ++bj)
#pragma unroll
            for (int n = 0; n < 2; ++n) { const f32x4 bv = bias ? *(const f32x4*)(bias + col0 + bj * HALF + n * 16) : (f32x4){0.f, 0.f, 0.f, 0.f};
#pragma unroll
                for (int ai = 0; ai < 2; ++ai)
#pragma unroll
                    for (int m = 0; m < 4; ++m) acc[ai][bj][m][n] += bv; }
        const bool bad = st.run(acc, u, wr, wc, fr, fq, lds, wid, lane) || poison != 0u;
        const float qnan = __builtin_nanf("");
#pragma unroll
        for (int ai = 0; ai < 2; ++ai)
#pragma unroll
            for (int m = 0; m < 4; ++m) { const int r = ai * HALF + wr * 64 + m * 16 + fr; const f32x2v sr = S[r]; const size_t off = (size_t)(u.pm * BM + r) * ldc + col0;
#pragma unroll
                for (int bj = 0; bj < 2; ++bj)
#pragma unroll
                    for (int n = 0; n < 2; ++n) { const f32x4 bs = *(const f32x4*)(base + off + bj * HALF + n * 16); f32x4 o = bs + (acc[ai][bj][m][n] - sr.x) * sr.y;
                        if (bad) o = (f32x4){qnan, qnan, qnan, qnan}; *(f32x4*)(out + off + bj * HALF + n * 16) = o; }
                asm volatile("" ::: "memory"); }
    }
};
struct EpiLnResLn {
    static constexpr bool PERM = false, AFTER_DRAIN = true;
    const float* base; float* out; bf16_t* xn; int ldc; const float* bias; PanelStats st1, st2; unsigned poison;
    __device__ __forceinline__ void refuse(size_t i0, size_t stride, int M, int N) const { const float q = __builtin_nanf(""); for (size_t i = i0; i < (size_t)M * N; i += stride) { const size_t o = (i / N) * ldc + i % N; out[o] = q; xn[o] = (bf16_t)0x7fc0u; }
        if (i0 == 0) { unsigned expect = 0u; __hip_atomic_compare_exchange_strong(st1.tmo + 1, &expect, 0x7f0u, __ATOMIC_RELAXED, __ATOMIC_RELAXED, __HIP_MEMORY_SCOPE_AGENT); __hip_atomic_store(st1.tmo, 1u, __ATOMIC_RELAXED, __HIP_MEMORY_SCOPE_AGENT); } }
    __device__ __forceinline__ void fused(f32x4 (&acc)[2][2][4][2], const Unit& u, int wr, int wc, int fr, int fq, PG8_LAS unsigned char* lds, int wid, int lane) const {
        typedef float f32x2v __attribute__((ext_vector_type(2))); typedef unsigned u32x2v __attribute__((ext_vector_type(2)));
        const PG8_LAS f32x2v* S = (const PG8_LAS f32x2v*)(lds + 8192);
        const int col0 = u.pn * BM + wc * 32 + 4 * fq;
#pragma unroll
        for (int bj = 0; bj < 2; ++bj)
#pragma unroll
            for (int n = 0; n < 2; ++n) { const f32x4 bv = bias ? *(const f32x4*)(bias + col0 + bj * HALF + n * 16) : (f32x4){0.f, 0.f, 0.f, 0.f};
#pragma unroll
                for (int ai = 0; ai < 2; ++ai)
#pragma unroll
                    for (int m = 0; m < 4; ++m) acc[ai][bj][m][n] += bv; }
        bool bad = st1.run(acc, u, wr, wc, fr, fq, lds, wid, lane) || poison != 0u;
        const float qnan = __builtin_nanf("");
#pragma unroll
        for (int ai = 0; ai < 2; ++ai)
#pragma unroll
            for (int m = 0; m < 4; ++m) { const int r = ai * HALF + wr * 64 + m * 16 + fr; const f32x2v sr = S[r]; const size_t off = (size_t)(u.pm * BM + r) * ldc + col0;
#pragma unroll
                for (int bj = 0; bj < 2; ++bj)
#pragma unroll
                    for (int n = 0; n < 2; ++n) { const f32x4 bs = *(const f32x4*)(base + off + bj * HALF + n * 16); acc[ai][bj][m][n] = bs + (acc[ai][bj][m][n] - sr.x) * sr.y; }
                asm volatile("" : "+v"(acc[ai][0][m][0]), "+v"(acc[ai][0][m][1]), "+v"(acc[ai][1][m][0]), "+v"(acc[ai][1][m][1]));
                if (m & 1) asm volatile("" ::: "memory"); }
        const bool bad1 = bad;
        bad = st2.run(acc, u, wr, wc, fr, fq, lds, wid, lane) || bad;
#pragma unroll
        for (int ai = 0; ai < 2; ++ai)
#pragma unroll
            for (int m = 0; m < 4; ++m) { const int r = ai * HALF + wr * 64 + m * 16 + fr; const f32x2v sr = S[r]; const size_t off = (size_t)(u.pm * BM + r) * ldc + col0;
#pragma unroll
                for (int bj = 0; bj < 2; ++bj)
#pragma unroll
                    for (int n = 0; n < 2; ++n) { const f32x4 x1 = acc[ai][bj][m][n]; *(f32x4*)(out + off + bj * HALF + n * 16) = bad1 ? (f32x4){qnan, qnan, qnan, qnan} : x1;
                        const f32x4 o = (x1 - sr.x) * sr.y; u32x2v w; w.x = cvt_pk_bf16(o[0], o[1]); w.y = cvt_pk_bf16(o[2], o[3]);
                        if (bad) { w.x = 0x7fc07fc0u; w.y = 0x7fc07fc0u; } *(u32x2v*)(xn + off + bj * HALF + n * 16) = w; }
                asm volatile("" ::: "memory"); }
    }
};

template <class Epi, class Sched, bool STAMP = false>
__device__ __forceinline__ void gemm_phase(PG8_LAS unsigned char* lds, const Gemm g, const Sched& S, const Epi& E, unsigned long long* stamps) {
    const int tid = launder_v((int)threadIdx.x), wid = __builtin_amdgcn_readfirstlane(tid >> 6), lane = tid & 63, wr = wid >> 2, wc = wid & 3, fr = lane & 15, fq = lane >> 4;
    const int K = g.K, nt = K / BK;
    int ts_lo = 0, ts_hi = 0, nts = 0; const unsigned long long rt_entry = STAMP ? (unsigned long long)wall_clock64() : 0ull;
#define PG8_STAMP() do { if (STAMP && wid == 0 && nts < 64) { const unsigned long long _c = (unsigned long long)clock64(); \
        ts_lo = (lane == nts) ? (int)(unsigned)_c : ts_lo; ts_hi = (lane == nts) ? (int)(unsigned)(_c >> 32) : ts_hi; ++nts; } } while (0)
    PG8_STAMP();
    unsigned voffA[2], voffB[2];
#pragma unroll
    for (int i = 0; i < 2; ++i) { int R, C; stage_rc(tid * 16 + i * 8192, R, C); const int Rb = Epi::PERM ? ((R & ~31) + perm32(R & 31)) : R;
        voffA[i] = (unsigned)(R * K + C) * 2u; voffB[i] = (unsigned)(Rb * K + C) * 2u; }
    const size_t kstep = (size_t)(BK * 2);
    const size_t hstep = (size_t)HALF * K * 2;
    const size_t tstep = 2 * hstep;
    const unsigned ldsw = (unsigned)wid * 1024u;
    const int aoff = lds_byte(wr * 64 + fr, fq * 8), boff = lds_byte(wc * 32 + fr, fq * 8);
#define PG8_SA(b, h) (((b) * 2 + (h)) * HTB)
#define PG8_SB(b, h) ((4 + (b) * 2 + (h)) * HTB)
#define PG8_STAGE(bufoff, gbase, voff) do { _Pragma("unroll") for (int _i = 0; _i < 2; ++_i) \
        __builtin_amdgcn_global_load_lds((const unsigned*)((const char*)(gbase) + (voff)[_i]), (PG8_LAS unsigned*)(lds + (bufoff) + ldsw + _i * 8192), 16, 0, 0); } while (0)
#define PG8_LDA(dst, b, h) do { _Pragma("unroll") for (int m = 0; m < 4; ++m) _Pragma("unroll") for (int k = 0; k < 2; ++k) dst[m][k] = *(const PG8_LAS bf16x8*)(lds + PG8_SA(b, h) + aoff + m * 2048 + k * 1024); } while (0)
#define PG8_LDB(dst, b, h) do { _Pragma("unroll") for (int n = 0; n < 2; ++n) _Pragma("unroll") for (int k = 0; k < 2; ++k) dst[n][k] = *(const PG8_LAS bf16x8*)(lds + PG8_SB(b, h) + boff + n * 2048 + k * 1024); } while (0)
#define PG8_MMA(ai, bj, At, Bt) do { __builtin_amdgcn_s_setprio(1); _Pragma("unroll") for (int m = 0; m < 4; ++m) _Pragma("unroll") for (int n = 0; n < 2; ++n) _Pragma("unroll") for (int k = 0; k < 2; ++k) \
        acc[ai][bj][m][n] = __builtin_amdgcn_mfma_f32_16x16x32_bf16(Bt[n][k], At[m][k], acc[ai][bj][m][n], 0, 0, 0); __builtin_amdgcn_s_setprio(0); } while (0)
#define PG8_WAIT_V(n) asm volatile("s_waitcnt vmcnt(" #n ")" ::: "memory")
#define PG8_WAIT_L(n) asm volatile("s_waitcnt lgkmcnt(" #n ")" ::: "memory")
#define PG8_BAR __builtin_amdgcn_s_barrier()
#define PG8_SCHED __builtin_amdgcn_sched_barrier(0)
    Unit cur, nxt; int ui = 0;
    if (!S.next(0, cur)) return;
    f32x4 acc[2][2][4][2];
#pragma unroll
    for (int a = 0; a < 2; ++a)
#pragma unroll
        for (int b = 0; b < 2; ++b)
#pragma unroll
            for (int m = 0; m < 4; ++m)
#pragma unroll
                for (int n = 0; n < 2; ++n) acc[a][b][m][n] = (f32x4){0.f, 0.f, 0.f, 0.f};
    bf16x8 At[4][2], B0[2][2], B1[2][2];
    const char* cA = (const char*)g.A + (size_t)cur.pm * tstep; const char* cB = (const char*)g.Bt + (size_t)cur.pn * tstep;
    S.a_ready(cur);
    PG8_STAGE(PG8_SB(0, 0), cB, voffB); PG8_STAGE(PG8_SA(0, 0), cA, voffA); PG8_STAGE(PG8_SB(0, 1), cB + hstep, voffB); PG8_STAGE(PG8_SA(0, 1), cA + hstep, voffA);
    if (wr == 1) PG8_BAR;
    PG8_WAIT_V(4); PG8_BAR;
    PG8_STAGE(PG8_SB(1, 0), cB + kstep, voffB); PG8_STAGE(PG8_SA(1, 0), cA + kstep, voffA); PG8_STAGE(PG8_SB(1, 1), cB + hstep + kstep, voffB);
    PG8_WAIT_V(6); PG8_BAR;
    PG8_STAMP();
    for (;;) {
        const bool has_next = S.next(ui + 1, nxt);
        const char* nA = has_next ? (const char*)g.A + (size_t)nxt.pm * tstep : cA; const char* nB = has_next ? (const char*)g.Bt + (size_t)nxt.pn * tstep : cB;
        for (int t = 0; t < nt; t += 2) {
            const bool last = (t == nt - 2);
            const char* a1 = cA + (size_t)(t + 1) * kstep;
            const char* a2 = last ? nA : cA + (size_t)(t + 2) * kstep; const char* b2 = last ? nB : cB + (size_t)(t + 2) * kstep;
            const char* a3 = a2 + kstep; const char* b3 = b2 + kstep;
            if (last && has_next) S.a_ready(nxt);
            PG8_LDB(B0, 0, 0); PG8_SCHED; PG8_LDA(At, 0, 0); PG8_STAGE(PG8_SA(1, 1), a1 + hstep, voffA);
            PG8_WAIT_L(8); PG8_BAR; PG8_WAIT_L(0); PG8_MMA(0, 0, At, B0); PG8_BAR; PG8_SCHED;
            PG8_LDB(B1, 0, 1); PG8_STAGE(PG8_SB(0, 0), b2, voffB);
            PG8_BAR; PG8_WAIT_L(0); PG8_MMA(0, 1, At, B1); PG8_BAR;
            PG8_LDA(At, 0, 1); PG8_STAGE(PG8_SA(0, 0), a2, voffA);
            PG8_BAR; PG8_WAIT_L(0); PG8_MMA(1, 0, At, B0); PG8_BAR; PG8_SCHED;
            PG8_STAGE(PG8_SB(0, 1), b2 + hstep, voffB);
            PG8_WAIT_V(6); PG8_BAR; PG8_MMA(1, 1, At, B1); PG8_BAR;
            PG8_LDB(B0, 1, 0); PG8_SCHED; PG8_LDA(At, 1, 0); PG8_STAGE(PG8_SA(0, 1), a2 + hstep, voffA);
            PG8_WAIT_L(8); PG8_BAR; PG8_WAIT_L(0); PG8_MMA(0, 0, At, B0); PG8_BAR; PG8_SCHED;
            PG8_LDB(B1, 1, 1); PG8_STAGE(PG8_SB(1, 0), b3, voffB);
            PG8_BAR; PG8_WAIT_L(0); PG8_MMA(0, 1, At, B1); PG8_BAR;
            PG8_LDA(At, 1, 1); PG8_STAGE(PG8_SA(1, 0), a3, voffA);
            PG8_BAR; PG8_WAIT_L(0); PG8_MMA(1, 0, At, B0); PG8_BAR; PG8_SCHED;
            PG8_STAGE(PG8_SB(1, 1), b3 + hstep, voffB);
            PG8_WAIT_V(6); PG8_BAR; PG8_MMA(1, 1, At, B1); PG8_BAR;
        }
        PG8_STAMP();
        if constexpr (!Epi::AFTER_DRAIN) { E(acc, cur, wr, wc, fr, fq); S.done(cur); }
        PG8_STAMP();
        if (!has_next) break;
        bool keep_acc = false;
        if constexpr (has_keep<Epi>::v) keep_acc = E.keep(cur);
        if (!keep_acc)
#pragma unroll
        for (int a = 0; a < 2; ++a)
#pragma unroll
            for (int b = 0; b < 2; ++b)
#pragma unroll
                for (int m = 0; m < 4; ++m)
#pragma unroll
                    for (int n = 0; n < 2; ++n) acc[a][b][m][n] = (f32x4){0.f, 0.f, 0.f, 0.f};
        cur = nxt; cA = nA; cB = nB; ++ui;
    }
    PG8_WAIT_V(0);
    if (wr == 0) PG8_BAR;
    PG8_BAR;
    if constexpr (Epi::AFTER_DRAIN) { E.fused(acc, cur, wr, wc, fr, fq, lds, wid, lane); S.done(cur); }
    PG8_STAMP();
    if (STAMP && wid == 0) { stamps[lane] = lane < nts ? (((unsigned long long)(unsigned)ts_hi << 32) | (unsigned)ts_lo) : 0ull;
        if (lane == 62) stamps[62] = rt_entry; if (lane == 63) stamps[63] = (unsigned long long)wall_clock64(); }
#undef PG8_STAMP
#undef PG8_SA
#undef PG8_SB
#undef PG8_STAGE
#undef PG8_LDA
#undef PG8_LDB
#undef PG8_MMA
#undef PG8_WAIT_V
#undef PG8_WAIT_L
#undef PG8_BAR
#undef PG8_SCHED
}
}
#define XB_TMO      128
#define XB_XCNT(j)  (256  + 64 * (j))
#define XB_XSUB(j)  (1280 + 64 * (j))
#define XB_XGEN(j)  (2304 + 64 * (j))
#define XB_TOP      3328
#define XB_TOPGEN   3392
#define XCD_BAR_WORDS 3456
#define XB_SPIN_CAP (1u << 18)
#define LAS __attribute__((address_space(3)))

__device__ __forceinline__ unsigned xb_ld(unsigned* p)              { return __hip_atomic_load(p, __ATOMIC_RELAXED, __HIP_MEMORY_SCOPE_AGENT); }
__device__ __forceinline__ unsigned xb_add(unsigned* p, unsigned v) { return __hip_atomic_fetch_add(p, v, __ATOMIC_RELAXED, __HIP_MEMORY_SCOPE_AGENT); }
__device__ __forceinline__ unsigned xb_xcc_id() { return (unsigned)__builtin_amdgcn_s_getreg((3 << 11) | 20) & 0xFu; }
#define XB_SPIN(cond, bar) do { unsigned _sp = 0; while (cond) { __builtin_amdgcn_s_sleep(1); \
    if ((++_sp & 255u) == 0u) { if (xb_ld(&(bar)[XB_TMO])) break; if (_sp > XB_SPIN_CAP) { atomicAdd(&(bar)[XB_TMO], 1u); break; } } } } while (0)

struct XcdBarrier {
    unsigned* bar; unsigned x;
    volatile LAS unsigned* st;
};

__device__ __forceinline__ XcdBarrier xcd_barrier_post(unsigned* bar, volatile LAS unsigned* st) {
    XcdBarrier b; b.bar = bar; b.x = xb_xcc_id(); b.st = st;
    if (threadIdx.x == 0) (void)xb_add(&bar[XB_XCNT(b.x)], 1u);
    return b;
}
__device__ __forceinline__ void xcd_barrier_complete(unsigned* bar, unsigned x, unsigned& nloc, unsigned& nx) {
    const unsigned G = gridDim.x * gridDim.y * gridDim.z;
    unsigned sum, cnt, mine, sp = 0u;
    for (;;) {
        sum = 0u; cnt = 0u; mine = 0u;
#pragma unroll
        for (unsigned j = 0; j < 16; ++j) { const unsigned c = xb_ld(&bar[XB_XCNT(j)]); sum += c; cnt += (c > 0u) ? 1u : 0u; mine = (j == x) ? c : mine; }
        if (sum == G) break;
        __builtin_amdgcn_s_sleep(1);
        if ((++sp & 255u) == 0u) { if (xb_ld(&bar[XB_TMO])) break; if (sp > XB_SPIN_CAP) { atomicAdd(&bar[XB_TMO], 1u); break; } }
    }
    nloc = mine > 0u ? mine : 1u; nx = cnt > 0u ? cnt : 1u;
}

__device__ __forceinline__ void xcd_barrier(const XcdBarrier& b) {
    asm volatile("s_waitcnt vmcnt(0)" ::: "memory");
    __syncthreads();
    if (threadIdx.x == 0) {
        unsigned* bar = b.bar;
        __builtin_amdgcn_s_waitcnt(0);
        unsigned nloc = b.st[0], nx = b.st[1];
        if (nloc == 0u) { xcd_barrier_complete(bar, b.x, nloc, nx); b.st[0] = nloc; b.st[1] = nx; }
        const unsigned old = xb_add(&bar[XB_XSUB(b.x)], 1u);
        const unsigned gen = old / nloc;
        if (old + 1u == (gen + 1u) * nloc) {
            __builtin_amdgcn_fence(__ATOMIC_RELEASE, "agent");
            asm volatile("s_waitcnt vmcnt(0)" ::: "memory");
            const unsigned og = xb_add(&bar[XB_TOP], 1u);
            const unsigned tg = og / nx;
            if (og + 1u == (tg + 1u) * nx) xb_add(&bar[XB_TOPGEN], 1u);
            else XB_SPIN(xb_ld(&bar[XB_TOPGEN]) == tg, bar);
            __builtin_amdgcn_fence(__ATOMIC_ACQUIRE, "agent");
            xb_add(&bar[XB_XGEN(b.x)], 1u);
            asm volatile("s_waitcnt vmcnt(0)" ::: "memory");
        } else {
            XB_SPIN(xb_ld(&bar[XB_XGEN(b.x)]) == gen, bar);
            __builtin_amdgcn_fence(__ATOMIC_ACQUIRE, "agent");
            asm volatile("s_waitcnt vmcnt(0)" ::: "memory");
        }
    }
    __syncthreads();
}

struct Args { const float* in[25]; float* out; unsigned char* ws; int ph_lo, ph_hi, rep, sub; };
#define LAS __attribute__((address_space(3)))

struct CvtJob { const float* src; int ld; int ncols; int K; const float* kscale; int kind; bf16_t* dst; bf16_t* dst2; };
__device__ __forceinline__ bf16_t* cvt_dst_row(const CvtJob& j, int c) {
    switch (j.kind) {
    case 0: return j.dst + (size_t)c * j.K;
    case 1: {
        if (c < 2560) return j.dst + (size_t)c * DM;
        if (c < 2584) return j.dst2 + (size_t)(c - 2560) * DM;
        if (c < 4120) return j.dst + (size_t)(c - 24) * DM;
        if (c < 4184) return j.dst2 + (size_t)(24 + c - 4120) * DM;
        if (c < 4188) return j.dst2 + (size_t)(88 + c - 4184) * DM;
        return j.dst + (size_t)(c - 92) * DM; }
    case 2: return j.dst + ((size_t)(c >> 7) * 256 + (c & 127)) * j.K;
    default: return j.dst + ((size_t)(c >> 7) * 256 + 128 + (c & 127)) * j.K;
    }
}
struct CvtTile { CvtJob j; int k0, c0; };
__device__ __forceinline__ bool cvt_decode(const Args& a, unsigned char* ws, int ti, CvtTile& t) {
    if (ti >= NL * (32 * 194 + 2 * 64 * 2 + 2 * 2 * 2 + 2 * 8 * 4 * 2 + 3 * 16 * 32 + 32 * 32 + 2 * 16 * 32 * 8 + 16 * 8 * 32)) return false;
    constexpr int PT_WIN = 32 * 194, PT_W1 = 2 * 64 * 2, PT_W2 = 2 * 2 * 2, PT_WUK = 8 * 4 * 2, PT_WB = 3 * 16 * 32, PT_WO = 32 * 32, PT_EX = 16 * 32 * 8, PT_DN = 16 * 8 * 32;
    constexpr int PT_LAYER = PT_WIN + PT_W1 + PT_W2 + 2 * PT_WUK + PT_WB + PT_WO + 2 * PT_EX + PT_DN;
    const int l = ti / PT_LAYER; int r = ti % PT_LAYER; CvtJob& j = t.j; j.kscale = nullptr; j.dst2 = nullptr; int kt, ct;
    if (r < PT_WIN) { j.src = a.in[1] + (size_t)l * DM * IN_COLS; j.ld = IN_COLS; j.ncols = IN_COLS; j.K = DM; j.kind = 1;
        j.dst = (bf16_t*)(ws + WS_WIN) + (size_t)l * NMAIN * DM; j.dst2 = (bf16_t*)(ws + WS_WSK) + (size_t)l * NSK * DM; kt = r % 32; ct = r / 32; }
    else if ((r -= PT_WIN) < PT_W1) { const int kv = r / 128; r %= 128; j.src = a.in[2] + ((size_t)l * 2 + kv) * 4096 * 128; j.ld = 128; j.ncols = 128; j.K = 4096; j.kind = 0;
        j.dst = (bf16_t*)(ws + WS_W1) + ((size_t)l * 2 + kv) * 128 * 4096; kt = r % 64; ct = r / 64; }
    else if ((r -= PT_W1) < PT_W2) { const int kv = r / 4; r %= 4; j.src = a.in[3] + ((size_t)l * 2 + kv) * 128 * 128; j.ld = 128; j.ncols = 128; j.K = 128; j.kind = 0;
        j.dst = (bf16_t*)(ws + WS_W2) + ((size_t)l * 2 + kv) * 128 * 128; kt = r / 2; ct = r % 2; }
    else if ((r -= PT_W2) < 2 * PT_WUK) { const int which = r / PT_WUK; r %= PT_WUK; const int h = r / 8; r %= 8;
        j.src = a.in[which ? 6 : 5] + ((size_t)l * 8 + h) * 256 * 128; j.ld = 128; j.ncols = 128; j.K = 256; j.kind = 0; j.kscale = a.in[7] + (size_t)l * 256;
        j.dst = (bf16_t*)(ws + WS_WKVUP) + ((size_t)l * 2048 + which * 1024 + h * 128) * 256; kt = r / 2; ct = r % 2; }
    else if ((r -= 2 * PT_WUK) < PT_WB) { const int n = r / 512; r %= 512; j.src = a.in[12] + ((size_t)l * 3 + n) * 1024 * 2048; j.ld = 2048; j.ncols = 2048; j.K = 1024; j.kind = 0;
        j.dst = (bf16_t*)(ws + WS_WB) + ((size_t)l * 3 + n) * 2048 * 1024; kt = r % 16; ct = r / 16; }
    else if ((r -= PT_WB) < PT_WO) { j.src = a.in[13] + (size_t)l * 2048 * 2048; j.ld = 2048; j.ncols = 2048; j.K = 2048; j.kind = 0;
        j.dst = (bf16_t*)(ws + WS_WO) + (size_t)l * 2048 * 2048; kt = r % 32; ct = r / 32; }
    else if ((r -= PT_WO) < 2 * PT_EX) { const int which = r / PT_EX; r %= PT_EX; const int e = r / 256; r %= 256;
        j.src = a.in[which ? 21 : 20] + ((size_t)l * 16 + e) * 2048 * 512; j.ld = 512; j.ncols = 512; j.K = 2048; j.kind = which ? 3 : 2;
        j.dst = (bf16_t*)(ws + WS_WGU) + ((size_t)l * 16 + e) * 1024 * 2048; kt = r % 32; ct = r / 32; }
    else { r -= 2 * PT_EX; const int e = r / 256; r %= 256;
        j.src = a.in[22] + ((size_t)l * 16 + e) * 512 * 2048; j.ld = 2048; j.ncols = 2048; j.K = 512; j.kind = 0;
        j.dst = (bf16_t*)(ws + WS_WD) + ((size_t)l * 16 + e) * 2048 * 512; kt = r % 8; ct = r / 8; }
    t.k0 = kt * 64; t.c0 = ct * 64; return true;
}
__device__ __forceinline__ void cvt_load(const CvtTile& t, f32x4 (&v)[16], int lane) {
    const int c = t.c0 + 4 * (lane & 15); const bool ok = c < t.j.ncols;
    const float* sp = t.j.src + (size_t)(t.k0 + (lane >> 4)) * t.j.ld + c;
#pragma unroll
    for (int i = 0; i < 16; ++i) v[i] = ok ? *(const f32x4*)(sp + (size_t)(4 * i) * t.j.ld) : (f32x4){0.f, 0.f, 0.f, 0.f};
}
__device__ __forceinline__ void cvt_store(const CvtTile& t, const f32x4 (&v)[16], LAS float* T, int lane, bool nostore = false) {
#if defined(PROBE_P0_NOLDS)
    if (nostore) { f32x4 s = v[0];
#pragma unroll
        for (int i = 1; i < 16; ++i) s += v[i];
        if (s[0] + s[1] + s[2] + s[3] == 1.2345e30f) T[lane] = s[0];
        return; }
#endif
#pragma unroll
    for (int i = 0; i < 16; ++i) { LAS float* p = T + (4 * i + (lane >> 4)) * 65 + 4 * (lane & 15); p[0] = v[i][0]; p[1] = v[i][1]; p[2] = v[i][2]; p[3] = v[i][3]; }
    asm volatile("s_waitcnt lgkmcnt(0)" ::: "memory");
    const int q = lane & 7;
#pragma unroll
    for (int i2 = 0; i2 < 8; ++i2) { const int cl = i2 * 8 + (lane >> 3), c = t.c0 + cl;
        float x[8];
#pragma unroll
        for (int e = 0; e < 8; ++e) x[e] = T[(8 * q + e) * 65 + cl];
        if (c < t.j.ncols) { bf16_t* d = cvt_dst_row(t.j, c);
            if (t.j.kscale) {
#pragma unroll
                for (int e = 0; e < 8; ++e) x[e] *= t.j.kscale[t.k0 + 8 * q + e]; }
            u32x4 w = {cvtpk(x[0], x[1]), cvtpk(x[2], x[3]), cvtpk(x[4], x[5]), cvtpk(x[6], x[7])};
            if (!nostore || w.x == 0x12345678u) *(u32x4*)(d + t.k0 + 8 * q) = w; } }
    asm volatile("s_waitcnt lgkmcnt(0)" ::: "memory");
}

__device__ __forceinline__ void p0_prologue(const Args& a, LAS unsigned char* lds, bool nostore = false) {
    LAS float* tl = (LAS float*)lds;
    unsigned char* ws = launder_s(a.ws);
    const int G = gridDim.x, wg = LBID, tid = LTID, wid = tid >> 6, lane = tid & 63;
    {
        LAS float* T = tl + wid * (64 * 65);
        const int step = G * 8; int ti = wg * 8 + wid;
        CvtTile ta, tb; f32x4 va[16], vb[16];
        bool ha = cvt_decode(a, ws, ti, ta); if (ha) cvt_load(ta, va, lane);
        while (ha) {
            const bool hb = cvt_decode(a, ws, ti + step, tb); if (hb) cvt_load(tb, vb, lane);
            cvt_store(ta, va, T, lane, nostore);
            if (!hb) break;
            ti += 2 * step;
            ha = cvt_decode(a, ws, ti, ta); if (ha) cvt_load(ta, va, lane);
            cvt_store(tb, vb, T, lane, nostore);
        }
        __syncthreads();
    }
    const size_t gtid = (size_t)wg * 512 + tid, gn = (size_t)G * 512;
    for (size_t i = gtid; i < (size_t)NL * 36 * DM; i += gn) { const size_t l = i / (36 * DM), r = i % (36 * DM); ((bf16_t*)(ws + WS_WSK))[(l * NSK + 92) * DM + r] = 0; }
    for (size_t i = gtid; i < (size_t)NL * 8 * 128 * 128; i += gn) { const int s = (int)(i & 127), t = (int)((i >> 7) & 127); ((bf16_t*)(ws + WS_WSTRIL))[i] = (s <= t) ? f2bf(a.in[10][i]) : (bf16_t)0; }
    for (size_t i = gtid; i < (size_t)NL * 32 * DM; i += gn) { const int k = (int)(i % DM), n = (int)((i / DM) % 32), l = (int)(i / ((size_t)32 * DM));
        float v = 0.f; if (n < 4) v = a.in[16][((size_t)l * DM + k) * 4 + n]; else if (n < 20) v = a.in[18][((size_t)l * DM + k) * 16 + (n - 4)];
        const bf16_t h = f2bf(v); const bf16_t lo = f2bf(v - bf2f(h));
        bf16_t* d = (bf16_t*)(ws + WS_WR) + (size_t)l * 2 * 32 * DM; d[(size_t)n * DM + k] = h; d[(size_t)(32 + n) * DM + k] = lo; }
    for (int js = wg; js < NL * 2 * 16; js += G) {
        const int job = js >> 4, sl = js & 15;
        const float* pe = a.in[4] + (size_t)job * 4096 + sl * 256; const float* w1 = a.in[2] + (size_t)job * 4096 * 128 + (size_t)sl * 256 * 128;
        const int n = tid & 127, q = tid >> 7; float acc4[4] = {0.f, 0.f, 0.f, 0.f};
#pragma unroll 4
        for (int k = q * 64; k < (q + 1) * 64; k += 4) {
#pragma unroll
            for (int u = 0; u < 4; ++u) acc4[u] += pe[k + u] * w1[(size_t)(k + u) * 128 + n]; }
        tl[q * 128 + n] = (acc4[0] + acc4[1]) + (acc4[2] + acc4[3]); __syncthreads();
        if (tid < 128) ((float*)(ws + WS_C1))[(size_t)js * 128 + tid] = (tl[tid] + tl[128 + tid]) + (tl[256 + tid] + tl[384 + tid]);
        __syncthreads();
    }
    for (size_t i = gtid; i < (size_t)NTOK * DM / 8; i += gn) { const f32x4 v0 = *(const f32x4*)(a.in[0] + i * 8), v1 = *(const f32x4*)(a.in[0] + i * 8 + 4);
        *(bf16x8*)((bf16_t*)(ws + WS_XB) + i * 8) = pack8(v0, v1); }
}

#define MFMA32(a, b, c) __builtin_amdgcn_mfma_f32_32x32x16_bf16((a), (b), (c), 0, 0, 0)
__device__ __forceinline__ int crow(int r, int hi) { return (r & 3) + 8 * (r >> 2) + 4 * hi; }

__device__ __forceinline__ void skinny_item(const Args& a, int l, LAS unsigned char* lds) {
    unsigned char* ws = launder_s(a.ws);
    const int tid = LTID, wid = __builtin_amdgcn_readfirstlane(tid >> 6), lane = tid & 63, r32 = lane & 31, hi = lane >> 5;
    const bf16_t* xb = (const bf16_t*)(ws + WS_XB); const bf16_t* wsk = (const bf16_t*)(ws + WS_WSK) + (size_t)l * NSK * DM;
    for (int it = LBID; it < NTOK / 32; it += gridDim.x) {
        const int row0 = it * 32;
        f32x16 acc[3] = {};
        const bf16_t* ap = xb + (size_t)(row0 + r32) * DM + 256 * wid + 8 * hi;
        const bf16_t* bp = wsk + (size_t)r32 * DM + 256 * wid + 8 * hi;
#pragma unroll 8
        for (int ks = 0; ks < 16; ++ks) {
            const bf16x8 af = *(const bf16x8*)(ap + 16 * ks);
#pragma unroll
            for (int nb = 0; nb < 3; ++nb) { const bf16x8 bfr = *(const bf16x8*)(bp + (size_t)nb * 32 * DM + 16 * ks); acc[nb] = MFMA32(af, bfr, acc[nb]); }
        }
        LAS float* red = (LAS float*)lds;
#pragma unroll
        for (int nb = 0; nb < 3; ++nb)
#pragma unroll
            for (int r = 0; r < 16; ++r) red[((wid * 3 + nb) * 16 + r) * 64 + lane] = acc[nb][r];
        __syncthreads();
        for (int i = tid; i < 3 * 16 * 64; i += 512) {
            float s = 0.f;
#pragma unroll
            for (int w = 0; w < 8; ++w) s += red[w * 3072 + i];
            const int ln = i & 63, r = (i >> 6) & 15, nb = i >> 10;
            const int row = row0 + crow(r, ln >> 5), n = nb * 32 + (ln & 31);
            if (n < 24) ((float*)(ws + WS_SKF))[(size_t)row * 32 + n] = fast_sigmoid(s);
            else if (n < 88) ((bf16_t*)(ws + WS_KI))[(size_t)row * 64 + (n - 24)] = f2bf(s);
            else if (n < 92) ((float*)(ws + WS_SKF))[(size_t)row * 32 + 24 + (n - 88)] = s;
        }
        __syncthreads();
    }
}

struct EpiInProj {
    static constexpr bool PERM = true, AFTER_DRAIN = false;
    unsigned char* ws;
    __device__ __forceinline__ void operator()(const f32x4 (&acc)[2][2][4][2], const pg8::Unit& u, int wr, int wc, int fr, int fq) const {
        const int pn = u.pn; size_t off; int ld, ct, act = 0;
        if (pn < 4)       { off = WS_QA; ld = 1024; ct = pn; }
        else if (pn < 10) { off = WS_KV; ld = 1536; ct = pn - 4; }
        else if (pn < 14) { off = WS_QB; ld = 1024; ct = pn - 10; }
        else if (pn < 15) { off = WS_HC; ld = 256;  ct = 0; }
        else if (pn < 16) { off = WS_QI; ld = 256;  ct = 0; }
        else if (pn < 20) { off = WS_HU; ld = 1024; ct = pn - 16; act = 1; }
        else if (pn < 24) { off = WS_HV; ld = 1024; ct = pn - 20; act = 1; }
        else              { off = WS_HG; ld = 6144; ct = pn - 24; act = 2; }
        bf16_t* base = (bf16_t*)(ws + off);
        const int row0 = u.pm * 256 + wr * 64 + fr, col0 = ct * 256 + wc * 32 + 8 * fq;
#pragma unroll
        for (int ai = 0; ai < 2; ++ai)
#pragma unroll
            for (int m = 0; m < 4; ++m) {
                const int row = row0 + ai * 128 + m * 16; bf16_t* rowp = base + (size_t)row * ld + col0;
                float sq = 0.f;
#pragma unroll
                for (int bj = 0; bj < 2; ++bj) {
                    f32x4 v0 = acc[ai][bj][m][0], v1 = acc[ai][bj][m][1];
                    if (act == 1) {
#pragma unroll
                        for (int e = 0; e < 4; ++e) { v0[e] = gelu_tanh(v0[e]); v1[e] = gelu_tanh(v1[e]); } }
                    else if (act == 2) {
#pragma unroll
                        for (int e = 0; e < 4; ++e) { v0[e] = fast_sigmoid(v0[e]); v1[e] = fast_sigmoid(v1[e]); } }
                    if (pn == 14) {
#pragma unroll
                        for (int e = 0; e < 4; ++e) sq += v0[e] * v0[e] + v1[e] * v1[e]; }
                    u32x4 w; w.x = cvtpk(v0[0], v0[1]); w.y = cvtpk(v0[2], v0[3]); w.z = cvtpk(v1[0], v1[1]); w.w = cvtpk(v1[2], v1[3]);
                    *(u32x4*)(rowp + bj * 128) = w;
                }
                if (pn == 14) { sq += __shfl_xor(sq, 16); sq += __shfl_xor(sq, 32); if (fq == 0) ((float*)(ws + WS_PSQ))[(size_t)row * 4 + wc] = sq; }
            }
    }
};

namespace att {
constexpr int SHM = 16384;
constexpr int L_V = 0, L_K = 2 * SHM, L_WS = 4 * SHM;
constexpr int L_SELM = L_WS + 2048;
constexpr int L_MISC = L_SELM + 512;
constexpr int L_IMP = L_MISC + 512;
constexpr int L_VS = L_IMP + 4 * 64 * 33 * 4;
constexpr int L_T = L_IMP;
#define KSWZ(row, colB) ((row) * 256 + ((colB) ^ (((row) & 7) << 4)))
__device__ __forceinline__ int v_st(int k, int c) { const int kk = (k & ~0xC) | ((k & 4) << 1) | ((k & 8) >> 1); return ((kk >> 3) * 4 + (c >> 5)) * 512 + ((kk & 7) * 32 + (c & 31)) * 2; }
__device__ __forceinline__ int v_rd_base(int lane) { return ((lane & 3) << 3) | (((lane >> 2) & 3) << 6) | (((lane >> 4) & 1) << 5) | (((lane >> 5) & 1) << 8); }

struct Ctx { int tid, wid, lane, r32, hi, sr, sc, kws, vst0, vst1, vb0; LAS char* lds; LAS float* li_l; LAS float* al_l; };
__device__ __forceinline__ Ctx make_ctx(LAS unsigned char* lds) {
    Ctx c; c.tid = LTID; c.wid = __builtin_amdgcn_readfirstlane(c.tid >> 6); c.lane = c.tid & 63; c.r32 = c.lane & 31; c.hi = c.lane >> 5;
    c.sr = c.tid >> 4; c.sc = (c.tid & 15) * 8; c.kws = KSWZ(c.sr, c.sc * 2); c.vst0 = v_st(c.sr, c.sc); c.vst1 = v_st(32 + c.sr, c.sc);
    c.lds = (LAS char*)lds; c.vb0 = (int)(unsigned)(uintptr_t)(c.lds + L_V) + v_rd_base(c.lane);
    c.li_l = (LAS float*)(c.lds + L_WS + c.wid * 256); c.al_l = c.li_l + 32; return c;
}
struct Stage { bf16x8 k0, k1, v0, v1; };
__device__ __forceinline__ void stage_load(Stage& s, const Ctx& c, const bf16_t* K, int ldk, const bf16_t* V, int ldv, int key0) {
    s.v0 = *(const bf16x8*)(V + (size_t)(key0 + c.sr) * ldv + c.sc); s.v1 = *(const bf16x8*)(V + (size_t)(key0 + 32 + c.sr) * ldv + c.sc);
    s.k0 = *(const bf16x8*)(K + (size_t)(key0 + c.sr) * ldk + c.sc); s.k1 = *(const bf16x8*)(K + (size_t)(key0 + 32 + c.sr) * ldk + c.sc);
}
template <int BUF> __device__ __forceinline__ void stage_write(const Stage& s, const Ctx& c) {
    *(LAS bf16x8*)(c.lds + L_K + BUF * SHM + c.kws) = s.k0; *(LAS bf16x8*)(c.lds + L_K + BUF * SHM + c.kws + 32 * 256) = s.k1;
    *(LAS bf16x8*)(c.lds + L_V + BUF * SHM + c.vst0) = s.v0; *(LAS bf16x8*)(c.lds + L_V + BUF * SHM + c.vst1) = s.v1;
}
template <int KB> __device__ __forceinline__ void qkt(f32x16& p0, f32x16& p1, const Ctx& c, const bf16x8 (&qr)[8]) {
    p0 = f32x16{}; p1 = f32x16{};
    LAS const char* kb[4];
#pragma unroll
    for (int dd = 0; dd < 4; ++dd) kb[dd] = c.lds + L_K + KB * SHM + KSWZ(c.r32, (dd * 16 + c.hi * 8) * 2);
#pragma unroll
    for (int d0 = 0; d0 < 8; ++d0) { LAS const char* a = kb[d0 & 3] + (d0 >> 2) * 128;
        const bf16x8 b0 = *(LAS const bf16x8*)a; const bf16x8 b1 = *(LAS const bf16x8*)(a + 32 * 256);
        p0 = MFMA32(b0, qr[d0], p0); p1 = MFMA32(b1, qr[d0], p1); }
}
template <int VB> __device__ __forceinline__ void pv_tile(f32x16 (&o)[4], int vb0, bf16x8 pa0, bf16x8 pa1, bf16x8 pa2, bf16x8 pa3) {
#define TRRD(dst, off) asm volatile("ds_read_b64_tr_b16 %0, %1 offset:%2" : "=&v"(dst) : "v"(vb0), "i"(off) : "memory")
#define PV_RD(L_, H_, ks) do { constexpr int b_ = VB * SHM + (ks) * 4096; TRRD(L_[0], b_); TRRD(H_[0], b_ + 2048); TRRD(L_[1], b_ + 512); TRRD(H_[1], b_ + 512 + 2048); \
        TRRD(L_[2], b_ + 1024); TRRD(H_[2], b_ + 1024 + 2048); TRRD(L_[3], b_ + 1536); TRRD(H_[3], b_ + 1536 + 2048); } while (0)
#define PV_MM(L_, H_, pa) do { _Pragma("unroll") for (int d0 = 0; d0 < 4; ++d0) \
        o[d0] = MFMA32(pa, ((bf16x8){L_[d0][0], L_[d0][1], L_[d0][2], L_[d0][3], H_[d0][0], H_[d0][1], H_[d0][2], H_[d0][3]}), o[d0]); } while (0)
    s16x4 la[4], ha[4], lb[4], hb[4];
    PV_RD(la, ha, 0);
    PV_RD(lb, hb, 1); asm volatile("s_waitcnt lgkmcnt(8)" ::: "memory"); __builtin_amdgcn_sched_barrier(0); PV_MM(la, ha, pa0); __builtin_amdgcn_sched_barrier(0);
    PV_RD(la, ha, 2); asm volatile("s_waitcnt lgkmcnt(8)" ::: "memory"); __builtin_amdgcn_sched_barrier(0); PV_MM(lb, hb, pa1); __builtin_amdgcn_sched_barrier(0);
    PV_RD(lb, hb, 3); asm volatile("s_waitcnt lgkmcnt(8)" ::: "memory"); __builtin_amdgcn_sched_barrier(0); PV_MM(la, ha, pa2); __builtin_amdgcn_sched_barrier(0);
    asm volatile("s_waitcnt lgkmcnt(0)" ::: "memory"); __builtin_amdgcn_sched_barrier(0); PV_MM(lb, hb, pa3);
#undef PV_RD
#undef PV_MM
#undef TRRD
}
__device__ __forceinline__ float pair_max(float v) { auto rr = __builtin_amdgcn_permlane32_swap(__float_as_uint(v), __float_as_uint(v), false, false); return fmaxf(__uint_as_float(rr[0]), __uint_as_float(rr[1])); }
__device__ __forceinline__ float pair_sum(float v) { auto rr = __builtin_amdgcn_permlane32_swap(__float_as_uint(v), __float_as_uint(v), false, false); return __uint_as_float(rr[0]) + __uint_as_float(rr[1]); }
#define PK4(P, B_, OUT) do { unsigned xa0_ = cvtpk(P[B_+0], P[B_+1]), xa1_ = cvtpk(P[B_+2], P[B_+3]); \
        unsigned xb0_ = cvtpk(P[B_+4], P[B_+5]), xb1_ = cvtpk(P[B_+6], P[B_+7]); \
        auto xr0_ = __builtin_amdgcn_permlane32_swap(xa0_, xb0_, false, false); auto xr1_ = __builtin_amdgcn_permlane32_swap(xa1_, xb1_, false, false); \
        u32x4 xw_ = {xr0_[0], xr1_[0], xr0_[1], xr1_[1]}; OUT = *reinterpret_cast<bf16x8*>(&xw_); } while (0)

enum { MODE_WIN = 0, MODE_SEL = 1, MODE_BITS = 2, MODE_CMP = 3 };
template <int MODE> __device__ __forceinline__ void bias_mask(f32x16& p0, f32x16& p1, float bias0, float slope2k, int dq, unsigned W, bool rowsel, unsigned wlo, unsigned whi, int lim) {
    const float NEG = -__builtin_inff();
#pragma unroll
    for (int r = 0; r < 16; ++r) {
        const int cc = (r & 3) + 8 * (r >> 2);
        const float y0 = fmaf(p0[r], ATT_C2, fmaf(slope2k, (float)cc, bias0)), y1 = fmaf(p1[r], ATT_C2, fmaf(slope2k, (float)(cc + 32), bias0));
        bool ok0, ok1;
        if (MODE == MODE_WIN)       { ok0 = (unsigned)(dq - cc) < W; ok1 = (unsigned)(dq - cc - 32) < W; }
        else if (MODE == MODE_SEL)  { ok0 = rowsel && (dq - cc >= 0); ok1 = rowsel && (dq - cc - 32 >= 0); }
        else if (MODE == MODE_BITS) { ok0 = (wlo >> cc) & 1u; ok1 = (whi >> cc) & 1u; }
        else                        { ok0 = cc <= lim; ok1 = cc + 32 <= lim; }
        p0[r] = ok0 ? y0 : NEG; p1[r] = ok1 ? y1 : NEG;
    }
}
__device__ __forceinline__ void softmax_step(f32x16& p0, f32x16& p1, float& m, float& l, f32x16 (&o)[4], const Ctx& c, bf16x8& pa0, bf16x8& pa1, bf16x8& pa2, bf16x8& pa3) {
    float pmax = p0[0];
#pragma unroll
    for (int r = 1; r < 16; ++r) pmax = fmaxf(pmax, p0[r]);
#pragma unroll
    for (int r = 0; r < 16; ++r) pmax = fmaxf(pmax, p1[r]);
    pmax = pair_max(pmax);
    const float mn = fmaxf(m, pmax), alpha = __builtin_amdgcn_exp2f(m - mn); m = mn;
#pragma unroll
    for (int r = 0; r < 16; ++r) { p0[r] = __builtin_amdgcn_exp2f(p0[r] - mn); p1[r] = __builtin_amdgcn_exp2f(p1[r] - mn); }
    float ps = 0.f;
#pragma unroll
    for (int r = 0; r < 16; ++r) ps += p0[r] + p1[r];
    ps = pair_sum(ps); l = l * alpha + ps;
    PK4(p0, 0, pa0); PK4(p0, 8, pa1); PK4(p1, 0, pa2); PK4(p1, 8, pa3);
    if (__any(alpha < 1.f)) {
        if (c.hi == 0) c.al_l[c.r32] = alpha;
        asm volatile("s_waitcnt lgkmcnt(0)" ::: "memory");
#pragma unroll
        for (int r = 0; r < 16; ++r) { const float al = c.al_l[crow(r, c.hi)];
#pragma unroll
            for (int d = 0; d < 4; ++d) o[d][r] *= al; }
    }
}
struct BranchArgs {
    const bf16_t* K; const bf16_t* V; int ldk, ldv;
    unsigned tilemask;
    int t; float slope2;
    unsigned rowsel;
    const unsigned long long* mrow;
    unsigned W;
    int tw0;
};
template <int MODE> __device__ __forceinline__ void softmax_tile(f32x16& p0, f32x16& p1, float slope2k, float s32, float bias0, bool emask, int dq, unsigned W, unsigned wlo, unsigned whi, int lim,
                                                                 float& m, float& l, f32x16 (&o)[4], const Ctx& c, bf16x8& pa0, bf16x8& pa1, bf16x8& pa2, bf16x8& pa3) {
    const float NEG = -__builtin_inff();
#pragma unroll
    for (int r = 0; r < 16; ++r) { const float cf_ = (float)((r & 3) + 8 * (r >> 2)); p0[r] = fmaf(slope2k, cf_, p0[r] * ATT_C2); p1[r] = fmaf(slope2k, cf_, p1[r] * ATT_C2); }
    if (emask) {
#pragma unroll
        for (int r = 0; r < 16; ++r) { const int cc = (r & 3) + 8 * (r >> 2); bool ok0, ok1;
            if (MODE == MODE_WIN)       { ok0 = (unsigned)(dq - cc) < W; ok1 = (unsigned)(dq - cc - 32) < W; }
            else if (MODE == MODE_SEL)  { ok0 = (dq - cc >= 0); ok1 = (dq - cc - 32 >= 0); }
            else if (MODE == MODE_BITS) { ok0 = (wlo >> cc) & 1u; ok1 = (whi >> cc) & 1u; }
            else                        { ok0 = cc <= lim; ok1 = cc + 32 <= lim; }
            p0[r] = ok0 ? p0[r] : NEG; p1[r] = ok1 ? p1[r] : NEG; }
    }
    float z0 = p0[0], z1 = p1[0];
#pragma unroll
    for (int r = 1; r < 16; ++r) { z0 = fmaxf(z0, p0[r]); z1 = fmaxf(z1, p1[r]); }
    const float pmax = pair_max(fmaxf(z0, z1 + s32) + bias0);
    const float mn = fmaxf(m, pmax), alpha = __builtin_amdgcn_exp2f(m - mn); m = mn;
    const float d0 = bias0 - mn, d1 = d0 + s32;
#pragma unroll
    for (int r = 0; r < 16; ++r) { p0[r] = __builtin_amdgcn_exp2f(p0[r] + d0); p1[r] = __builtin_amdgcn_exp2f(p1[r] + d1); }
    float ps = 0.f;
#pragma unroll
    for (int r = 0; r < 16; ++r) ps += p0[r] + p1[r];
    ps = pair_sum(ps); l = l * alpha + ps;
    PK4(p0, 0, pa0); PK4(p0, 8, pa1); PK4(p1, 0, pa2); PK4(p1, 8, pa3);
    if (__any(alpha < 1.f)) {
        if (c.hi == 0) c.al_l[c.r32] = alpha;
        asm volatile("s_waitcnt lgkmcnt(0)" ::: "memory");
#pragma unroll
        for (int r = 0; r < 16; ++r) { const float al = c.al_l[crow(r, c.hi)];
#pragma unroll
            for (int d = 0; d < 4; ++d) o[d][r] *= al; }
    }
}
template <int MODE, int BUF> __device__ __forceinline__ void branch_step(const Ctx& c, const bf16x8 (&qr)[8], const BranchArgs& A, float slope2k, float s32, int j, unsigned long long mw, f32x16 (&o)[4], float& m, float& l) {
    f32x16 p0, p1; bf16x8 pa0, pa1, pa2, pa3;
    qkt<BUF>(p0, p1, c, qr);
    const int kb = j * 64, dq = A.t - kb - 4 * c.hi;
    if (MODE == MODE_CMP) {
        softmax_tile<MODE>(p0, p1, slope2k, s32, -A.slope2 * (float)(A.t - 31 - 16 * (kb + 4 * c.hi)), true, 0, 0u, 0u, 0u, (int)A.W - kb - 4 * c.hi, m, l, o, c, pa0, pa1, pa2, pa3);
    } else {
        float bias0 = -A.slope2 * (float)dq; bool emask;
        if (MODE == MODE_WIN) emask = (kb + 63 > A.tw0) || (kb <= A.tw0 + 31 - (int)A.W);
        else if (MODE == MODE_SEL) { emask = (kb + 63 > A.tw0); if (!((A.rowsel >> j) & 1u)) bias0 = -__builtin_inff(); }
        else emask = !__all(mw == ~0ull);
        softmax_tile<MODE>(p0, p1, slope2k, s32, bias0, emask, dq, A.W, (unsigned)(mw >> (4 * c.hi)), (unsigned)(mw >> (32 + 4 * c.hi)), 0, m, l, o, c, pa0, pa1, pa2, pa3);
    }
    pv_tile<BUF>(o, c.vb0, pa0, pa1, pa2, pa3);
}
template <int MODE> __device__ __forceinline__ void attn_branch(const Ctx& c, const bf16x8 (&qr)[8], const BranchArgs& A, f32x16 (&o)[4], float& l, float& m) {
    m = -1e30f; l = 0.f;
#pragma unroll
    for (int d = 0; d < 4; ++d) o[d] = f32x16{};
    const float slope2k = (MODE == MODE_CMP) ? A.slope2 * 16.f : A.slope2, s32 = 32.f * slope2k;
    unsigned rest = A.tilemask; int j0 = __builtin_ctz(rest); rest &= rest - 1;
    bool h1 = rest != 0u; int j1 = h1 ? __builtin_ctz(rest) : j0; rest &= rest - 1;
    Stage sA, sB; unsigned long long mwA = 0, mwB = 0, mwC = 0, mwD = 0;
    stage_load(sA, c, A.K, A.ldk, A.V, A.ldv, j0 * 64); if (MODE == MODE_BITS) mwA = A.mrow[j0];
    if (h1) { stage_load(sB, c, A.K, A.ldk, A.V, A.ldv, j1 * 64); if (MODE == MODE_BITS) mwB = A.mrow[j1]; }
    stage_write<0>(sA, c);
    __syncthreads();
    for (;;) {
        const bool h2 = rest != 0u; const int j2 = h2 ? __builtin_ctz(rest) : j1; rest &= rest - 1;
        if (h2) { stage_load(sA, c, A.K, A.ldk, A.V, A.ldv, j2 * 64); if (MODE == MODE_BITS) mwC = A.mrow[j2]; }
        branch_step<MODE, 0>(c, qr, A, slope2k, s32, j0, mwA, o, m, l);
        if (h1) stage_write<1>(sB, c);
        __syncthreads();
        if (!h1) break;
        const bool h3 = rest != 0u; const int j3 = h3 ? __builtin_ctz(rest) : j2; rest &= rest - 1;
        if (h3) { stage_load(sB, c, A.K, A.ldk, A.V, A.ldv, j3 * 64); if (MODE == MODE_BITS) mwD = A.mrow[j3]; }
        branch_step<MODE, 1>(c, qr, A, slope2k, s32, j1, mwB, o, m, l);
        if (h2) stage_write<0>(sA, c);
        __syncthreads();
        if (!h2) break;
        j0 = j2; mwA = mwC; h1 = h3; j1 = j3; mwB = mwD;
    }
}
__device__ __forceinline__ void row_coef(const Ctx& c, float coef, float (&cf)[16]) {
    if (c.hi == 0) c.li_l[c.r32] = coef;
    asm volatile("s_waitcnt lgkmcnt(0)" ::: "memory");
#pragma unroll
    for (int r = 0; r < 16; ++r) cf[r] = c.li_l[crow(r, c.hi)];
    asm volatile("s_waitcnt lgkmcnt(0)" ::: "memory");
}
__device__ __forceinline__ void store_rows_bf16(const Ctx& c, const f32x16 (&v)[4], bf16_t* base, size_t rowstride) {
#pragma unroll
    for (int r = 0; r < 16; ++r) { bf16_t* rp = base + (size_t)crow(r, c.hi) * rowstride;
#pragma unroll
        for (int d0 = 0; d0 < 4; ++d0) { const float x = v[d0][r]; const float xn = __shfl_xor(x, 1);
            if ((c.r32 & 1) == 0) *(unsigned*)(rp + d0 * 32 + c.r32) = cvtpk(x, xn); } }
}

__device__ __forceinline__ void nsa_item(const Args& a, LAS unsigned char* ldsu, int b, int hkv, int qb) {
    unsigned char* ws = launder_s(a.ws); Ctx c = make_ctx(ldsu);
    const int g = c.wid >> 1, half = c.wid & 1, head = hkv * 4 + g;
    const int tl = half * 32 + c.r32, t = qb * 64 + tl;
    const size_t tok = (size_t)b * SEQ + t;
    const float slope2 = __builtin_amdgcn_exp2f(-(float)(head + 1)) * LOG2E;
    bf16x8 qr[8];
    { const bf16_t* qp = (const bf16_t*)(ws + WS_QA) + tok * 1024 + head * 128 + c.hi * 8;
#pragma unroll
      for (int d0 = 0; d0 < 8; ++d0) qr[d0] = *(const bf16x8*)(qp + d0 * 16); }
    const float* gate = (const float*)(ws + WS_SKF) + tok * 32 + head * 3;
    const float gate0 = gate[0], gate1 = gate[1], gate2 = gate[2];
    f32x16 o[4]; float cf[16];
    BranchArgs A; A.t = t; A.slope2 = slope2; A.mrow = nullptr; A.rowsel = 0; A.tw0 = qb * 64 + half * 32;
#ifndef NSA_NO_CMP
    {
        const bf16_t* KC = (const bf16_t*)(ws + WS_KC) + (size_t)(b * 2 + hkv) * 128 * 128;
        const bool two = qb >= 16;
        int lim = (t - 31) >> 4; lim = lim > 126 ? 126 : lim;
        A.K = KC; A.V = KC + (size_t)8 * 128 * 128; A.ldk = 128; A.ldv = 128; A.tilemask = two ? 3u : 1u; A.W = (unsigned)lim;
        float l, m; attn_branch<MODE_CMP>(c, qr, A, o, l, m);
        const float inv = l > 0.f ? 1.0f / l : 0.f;
        if (two) {
            LAS float* IMP = (LAS float*)(c.lds + L_IMP) + (g * 64 + tl) * 33;
            float prev = 0.f;
#define IMP_TILE(BUF) do { f32x16 p0, p1; qkt<BUF>(p0, p1, c, qr); \
                bias_mask<MODE_CMP>(p0, p1, -slope2 * (float)(t - 31 - 16 * (BUF * 64 + 4 * c.hi)), slope2 * 16.f, 0, 0u, false, 0u, 0u, lim - BUF * 64 - 4 * c.hi); \
                _Pragma("unroll") for (int r = 0; r < 16; ++r) { p0[r] = __builtin_amdgcn_exp2f(p0[r] - m) * inv; p1[r] = __builtin_amdgcn_exp2f(p1[r] - m) * inv; } \
                _Pragma("unroll") for (int k = 0; k < 8; ++k) { const int mm = k & 3; \
                    const float s4 = (k < 4) ? (p0[4 * mm] + p0[4 * mm + 1]) + (p0[4 * mm + 2] + p0[4 * mm + 3]) : (p1[4 * mm] + p1[4 * mm + 1]) + (p1[4 * mm + 2] + p1[4 * mm + 3]); \
                    const float lst = (k < 4) ? p0[4 * mm + 3] : p1[4 * mm + 3]; \
                    auto rr = __builtin_amdgcn_permlane32_swap(__float_as_uint(lst), __float_as_uint(lst), false, false); \
                    const float from_lo = __uint_as_float(rr[0]), from_hi = __uint_as_float(rr[1]); \
                    IMP[2 * (BUF * 8 + k) + c.hi] = s4 + (c.hi ? from_lo : prev);     \
                    prev = from_hi; } } while (0)
            IMP_TILE(0); IMP_TILE(1);
#undef IMP_TILE
        }
        row_coef(c, gate0 * inv, cf);
#pragma unroll
        for (int d0 = 0; d0 < 4; ++d0)
#pragma unroll
            for (int r = 0; r < 16; ++r) o[d0][r] *= cf[r];
        __syncthreads();
    }
#endif
#ifndef NSA_NO_SELECT
    {
        LAS unsigned* SELM = (LAS unsigned*)(c.lds + L_SELM);
        if (qb <= 15) { if (c.tid <= 64) SELM[c.tid] = (2u << qb) - 1u; }
        else {
            LAS float* VS = (LAS float*)(c.lds + L_VS);
            const int tq = c.tid & 63, jg = c.tid >> 6;
            { LAS const float* I0 = (LAS const float*)(c.lds + L_IMP) + tq * 33;
#pragma unroll
              for (int e = 0; e < 4; ++e) { const int j = 4 * jg + e; VS[tq * 33 + j] = (I0[j] + I0[64 * 33 + j]) + (I0[2 * 64 * 33 + j] + I0[3 * 64 * 33 + j]); } }
            if (c.tid < 64) SELM[c.tid] = 1u | (1u << qb) | (1u << (qb - 1));
            __syncthreads();
            float vj[4]; int rank[4] = {0, 0, 0, 0};
#pragma unroll
            for (int e = 0; e < 4; ++e) vj[e] = VS[tq * 33 + 4 * jg + e];
#pragma unroll 4
            for (int j2 = 1; j2 <= qb - 2; ++j2) { const float v2 = VS[tq * 33 + j2];
#pragma unroll
                for (int e = 0; e < 4; ++e) rank[e] += ((v2 > vj[e]) || (v2 == vj[e] && j2 < 4 * jg + e)) ? 1 : 0; }
            unsigned bits = 0u;
#pragma unroll
            for (int e = 0; e < 4; ++e) { const int j = 4 * jg + e; if (j >= 1 && j <= qb - 2 && rank[e] < 13) bits |= 1u << j; }
            if (bits) __hip_atomic_fetch_or(SELM + tq, bits, __ATOMIC_RELAXED, __HIP_MEMORY_SCOPE_WORKGROUP);
            __syncthreads();
            if (c.wid == 0) { unsigned any = SELM[c.lane];
#pragma unroll
                for (int ofs = 32; ofs >= 1; ofs >>= 1) any |= (unsigned)__shfl_xor((int)any, ofs);
                if (c.lane == 0) SELM[64] = any; }
        }
        __syncthreads();
    }
#endif
    LAS u32x4* TL = (LAS u32x4*)(c.lds + L_T) + c.tid;
    LAS const unsigned* SELMr = (LAS const unsigned*)(c.lds + L_SELM);
    const unsigned my_sel = SELMr[tl], any_sel = (unsigned)__builtin_amdgcn_readfirstlane((int)SELMr[64]);
#pragma unroll
    for (int k = 0; k < 8; ++k) { const int d0 = k >> 1, rb = (k & 1) * 8;
        u32x4 w = {cvtpk(o[d0][rb], o[d0][rb + 1]), cvtpk(o[d0][rb + 2], o[d0][rb + 3]), cvtpk(o[d0][rb + 4], o[d0][rb + 5]), cvtpk(o[d0][rb + 6], o[d0][rb + 7])}; TL[k * 512] = w; }
    A.ldk = 1536; A.ldv = 1536; A.W = 0x7fffffffu;
    const bf16_t* KVb = (const bf16_t*)(ws + WS_KV) + (size_t)b * SEQ * 1536 + hkv * 128;
#ifndef NSA_NO_SEL
    {
        c = make_ctx(ldsu); ws = launder_s(ws);
        A.K = KVb + 512; A.V = KVb + 768; A.rowsel = my_sel;
        A.tilemask = any_sel & ((2u << qb) - 1u);
        float l, m; attn_branch<MODE_SEL>(c, qr, A, o, l, m);
        row_coef(c, gate1 * (l > 0.f ? 1.0f / l : 0.f), cf);
#pragma unroll
        for (int k = 0; k < 8; ++k) { const int d0 = k >> 1, rb = (k & 1) * 8; const u32x4 w = TL[k * 512];
            const float t0 = __uint_as_float(w.x << 16) + o[d0][rb] * cf[rb], t1 = __uint_as_float(w.x & 0xffff0000u) + o[d0][rb + 1] * cf[rb + 1];
            const float t2 = __uint_as_float(w.y << 16) + o[d0][rb + 2] * cf[rb + 2], t3 = __uint_as_float(w.y & 0xffff0000u) + o[d0][rb + 3] * cf[rb + 3];
            const float t4 = __uint_as_float(w.z << 16) + o[d0][rb + 4] * cf[rb + 4], t5 = __uint_as_float(w.z & 0xffff0000u) + o[d0][rb + 5] * cf[rb + 5];
            const float t6 = __uint_as_float(w.w << 16) + o[d0][rb + 6] * cf[rb + 6], t7 = __uint_as_float(w.w & 0xffff0000u) + o[d0][rb + 7] * cf[rb + 7];
            u32x4 w2 = {cvtpk(t0, t1), cvtpk(t2, t3), cvtpk(t4, t5), cvtpk(t6, t7)}; TL[k * 512] = w2; }
    }
#endif
#ifndef NSA_NO_WIN
    {
        c = make_ctx(ldsu); ws = launder_s(ws);
        A.K = KVb + 1024; A.V = KVb + 1280; A.W = 512u;
        const int jlo = qb >= 8 ? qb - 8 : 0;
        A.tilemask = ((2u << qb) - 1u) & ~((1u << jlo) - 1u);
        float l, m; attn_branch<MODE_WIN>(c, qr, A, o, l, m);
        row_coef(c, gate2 * (l > 0.f ? 1.0f / l : 0.f), cf);
#pragma unroll
        for (int k = 0; k < 8; ++k) { const int d0 = k >> 1, rb = (k & 1) * 8; const u32x4 w = TL[k * 512];
            o[d0][rb]     = __uint_as_float(w.x << 16) + o[d0][rb] * cf[rb];         o[d0][rb + 1] = __uint_as_float(w.x & 0xffff0000u) + o[d0][rb + 1] * cf[rb + 1];
            o[d0][rb + 2] = __uint_as_float(w.y << 16) + o[d0][rb + 2] * cf[rb + 2]; o[d0][rb + 3] = __uint_as_float(w.y & 0xffff0000u) + o[d0][rb + 3] * cf[rb + 3];
            o[d0][rb + 4] = __uint_as_float(w.z << 16) + o[d0][rb + 4] * cf[rb + 4]; o[d0][rb + 5] = __uint_as_float(w.z & 0xffff0000u) + o[d0][rb + 5] * cf[rb + 5];
            o[d0][rb + 6] = __uint_as_float(w.w << 16) + o[d0][rb + 6] * cf[rb + 6]; o[d0][rb + 7] = __uint_as_float(w.w & 0xffff0000u) + o[d0][rb + 7] * cf[rb + 7]; }
        store_rows_bf16(c, o, (bf16_t*)(ws + WS_BR) + ((size_t)b * SEQ + qb * 64 + half * 32) * 1024 + head * 128, 1024);
    }
#endif
}

__device__ __forceinline__ void dsa_item(const Args& a, LAS unsigned char* ldsu, int b, int h, int qb) {
    unsigned char* ws = launder_s(a.ws); const Ctx c = make_ctx(ldsu);
    const int t = qb * 256 + c.wid * 32 + c.r32; const size_t tok = (size_t)b * SEQ + t;
    bf16x8 qr[8];
    { const bf16_t* qp = (const bf16_t*)(ws + WS_QB) + tok * 1024 + h * 128 + c.hi * 8;
#pragma unroll
      for (int d0 = 0; d0 < 8; ++d0) qr[d0] = *(const bf16x8*)(qp + d0 * 16); }
    BranchArgs A; A.tw0 = qb * 256 + c.wid * 32; A.ldk = 2048; A.ldv = 2048; A.t = t; A.slope2 = __builtin_amdgcn_exp2f(-(float)(h + 1)) * LOG2E; A.W = 0; A.rowsel = 0;
    const bf16_t* kv = (const bf16_t*)(ws + WS_KVUP) + (size_t)b * SEQ * 2048 + h * 128;
    A.K = kv; A.V = kv + 1024; A.mrow = (const unsigned long long*)(ws + WS_MASK) + tok * 32;
    const int nt = 4 * qb + 4; A.tilemask = nt >= 32 ? 0xffffffffu : ((1u << nt) - 1u);
    f32x16 o[4]; float l, m, cf[16];
    attn_branch<MODE_BITS>(c, qr, A, o, l, m);
    row_coef(c, l > 0.f ? 1.0f / l : 0.f, cf);
#pragma unroll
    for (int d0 = 0; d0 < 4; ++d0)
#pragma unroll
        for (int r = 0; r < 16; ++r) o[d0][r] *= cf[r];
    store_rows_bf16(c, o, (bf16_t*)(ws + WS_BR) + (size_t)NTOK * 1024 + ((size_t)b * SEQ + qb * 256 + c.wid * 32) * 1024 + h * 128, 1024);
}

__device__ __forceinline__ void gmlp_item(const Args& a, LAS unsigned char* ldsu, int l, int b, int ch, int gp) {
    unsigned char* ws = launder_s(a.ws); const Ctx c = make_ctx(ldsu);
    const size_t tok0 = (size_t)b * SEQ + ch * 128;
    const bf16_t* HV = (const bf16_t*)(ws + WS_HV);
#pragma unroll
    for (int gs = 0; gs < 2; ++gs)
#pragma unroll
        for (int st = 0; st < 2; ++st) {
            const bf16_t* vp = HV + (tok0 + st * 64) * 1024 + (2 * gp + gs) * 128 + c.sc;
            const bf16x8 x0 = *(const bf16x8*)(vp + (size_t)c.sr * 1024), x1 = *(const bf16x8*)(vp + (size_t)(32 + c.sr) * 1024);
            *(LAS bf16x8*)(c.lds + L_V + (2 * gs + st) * SHM + c.vst0) = x0; *(LAS bf16x8*)(c.lds + L_V + (2 * gs + st) * SHM + c.vst1) = x1;
        }
    __syncthreads();
    const int gs = c.wid >> 2, wq = c.wid & 3, g = 2 * gp + gs;
    const bf16_t* Wp = (const bf16_t*)(ws + WS_WSTRIL) + (((size_t)l * 8 + g) * 128 + wq * 32 + c.r32) * 128 + c.hi * 8;
    f32x16 o[4] = {};
    bf16x8 pa0 = *(const bf16x8*)(Wp), pa1 = *(const bf16x8*)(Wp + 16), pa2 = *(const bf16x8*)(Wp + 32), pa3 = *(const bf16x8*)(Wp + 48);
    if (gs == 0) pv_tile<0>(o, c.vb0, pa0, pa1, pa2, pa3); else pv_tile<2>(o, c.vb0, pa0, pa1, pa2, pa3);
    if (wq >= 2) {
        pa0 = *(const bf16x8*)(Wp + 64); pa1 = *(const bf16x8*)(Wp + 80); pa2 = *(const bf16x8*)(Wp + 96); pa3 = *(const bf16x8*)(Wp + 112);
        if (gs == 0) pv_tile<1>(o, c.vb0, pa0, pa1, pa2, pa3); else pv_tile<3>(o, c.vb0, pa0, pa1, pa2, pa3);
    }
    const float* bs = a.in[11] + ((size_t)l * 8 + g) * 128 + wq * 32;
    const bf16_t* HU = (const bf16_t*)(ws + WS_HU) + (tok0 + wq * 32) * 1024 + g * 128;
#pragma unroll
    for (int r = 0; r < 16; ++r) { const int rr = crow(r, c.hi); const float bias = bs[rr];
#pragma unroll
        for (int d0 = 0; d0 < 4; ++d0) o[d0][r] = (o[d0][r] + bias) * bf2f(HU[(size_t)rr * 1024 + d0 * 32 + c.r32]); }
    store_rows_bf16(c, o, (bf16_t*)(ws + WS_BR) + (size_t)2 * NTOK * 1024 + (tok0 + wq * 32) * 1024 + g * 128, 1024);
    __syncthreads();
}
}

struct EpiKvUp {
    static constexpr bool PERM = true, AFTER_DRAIN = false;
    unsigned char* ws;
    __device__ __forceinline__ void operator()(const f32x4 (&acc)[2][2][4][2], const pg8::Unit& u, int wr, int wc, int fr, int fq) const {
        bf16_t* base = (bf16_t*)(ws + WS_KVUP); const float* psq = (const float*)(ws + WS_PSQ);
        const int row0 = u.pm * 256 + wr * 64 + fr, col0 = u.pn * 256 + wc * 32 + 8 * fq;
        f32x4 qn = *(const f32x4*)(psq + (size_t)row0 * 4);
#pragma unroll
        for (int ai = 0; ai < 2; ++ai)
#pragma unroll
            for (int m = 0; m < 4; ++m) {
                const int row = row0 + ai * 128 + m * 16; const f32x4 q = qn;
                if (ai * 4 + m < 7) { const int i1_ = ai * 4 + m + 1; qn = *(const f32x4*)(psq + (size_t)(row0 + (i1_ >> 2) * 128 + (i1_ & 3) * 16) * 4); }
                const float rs = __builtin_amdgcn_rsqf(((q[0] + q[1]) + (q[2] + q[3])) * (1.0f / 256.0f) + LN_EPS);
                bf16_t* rowp = base + (size_t)row * 2048 + col0;
#pragma unroll
                for (int bj = 0; bj < 2; ++bj) { const f32x4 v0 = acc[ai][bj][m][0] * rs, v1 = acc[ai][bj][m][1] * rs;
                    u32x4 w; w.x = cvtpk(v0[0], v0[1]); w.y = cvtpk(v0[2], v0[3]); w.z = cvtpk(v1[0], v1[1]); w.w = cvtpk(v1[2], v1[3]);
                    *(u32x4*)(rowp + bj * 128) = w; }
            }
    }
};

__device__ __forceinline__ void gmlp_ln_rows(const Args& a, int l) {
    unsigned char* ws = launder_s(a.ws); const int tid = LTID, wid = tid >> 6, lane = tid & 63;
    const float* g = a.in[8] + (size_t)l * 1024; const float* bta = a.in[9] + (size_t)l * 1024;
    for (int rowb = LBID * 8 + wid; rowb < NTOK; rowb += gridDim.x * 8 * 4) {
        bf16x8 xa[4], xb4[4];
#pragma unroll
        for (int k = 0; k < 4; ++k) { const int row = rowb + k * gridDim.x * 8; if (row < NTOK) { const bf16_t* p = (const bf16_t*)(ws + WS_HV) + (size_t)row * 1024 + lane * 8; xa[k] = *(const bf16x8*)p; xb4[k] = *(const bf16x8*)(p + 512); } }
#pragma unroll
        for (int k = 0; k < 4; ++k) { const int row = rowb + k * gridDim.x * 8; if (row >= NTOK) break;
            bf16_t* p = (bf16_t*)(ws + WS_HV) + (size_t)row * 1024 + lane * 8;
            float v[16];
#pragma unroll
            for (int e = 0; e < 8; ++e) { v[e] = bf2f((bf16_t)xa[k][e]); v[8 + e] = bf2f((bf16_t)xb4[k][e]); }
            float s = 0.f;
#pragma unroll
            for (int e = 0; e < 16; ++e) s += v[e];
            const float mean = wave_sum(s) * (1.0f / 1024.0f);
            float q = 0.f;
#pragma unroll
            for (int e = 0; e < 16; ++e) { const float d = v[e] - mean; q += d * d; }
            const float rstd = 1.0f / sqrtf(wave_sum(q) * (1.0f / 1024.0f) + LN_EPS);
            float o[16];
#pragma unroll
            for (int e = 0; e < 8; ++e) { o[e] = (v[e] - mean) * rstd * g[lane * 8 + e] + bta[lane * 8 + e]; o[8 + e] = (v[8 + e] - mean) * rstd * g[512 + lane * 8 + e] + bta[512 + lane * 8 + e]; }
            u32x4 w0 = {cvtpk(o[0], o[1]), cvtpk(o[2], o[3]), cvtpk(o[4], o[5]), cvtpk(o[6], o[7])}, w1 = {cvtpk(o[8], o[9]), cvtpk(o[10], o[11]), cvtpk(o[12], o[13]), cvtpk(o[14], o[15])};
            *(u32x4*)p = w0; *(u32x4*)(p + 512) = w1; }
    }
}

__device__ __forceinline__ void compress_item(const Args& a, int l, LAS unsigned char* lds, int item) {
    unsigned char* ws = launder_s(a.ws);
    const int tid = LTID, wid = __builtin_amdgcn_readfirstlane(tid >> 6), lane = tid & 63, r32 = lane & 31, hi = lane >> 5;
    const int kv = item >> 5, rt = item & 31;
    const int R = rt * 32 + r32, bh = R >> 7; int i = R & 127; if (i > 126) i = 126;
    const int b = bh >> 1, hkv = bh & 1;
    const bf16_t* src = (const bf16_t*)(ws + WS_KV) + ((size_t)b * SEQ + 16 * i + 4 * wid) * 1536 + kv * 256 + hkv * 128 + hi * 8;
    const bf16_t* w1 = (const bf16_t*)(ws + WS_W1) + ((size_t)l * 2 + kv) * 128 * 4096 + (size_t)r32 * 4096 + wid * 512 + hi * 8;
    f32x16 acc[4] = {};
    bf16x8 A0[4], B0[4][4], A1[4], B1[4][4];
#define CMP_LOAD(A_, B_, c_) do { _Pragma("unroll") for (int jj = 0; jj < 4; ++jj) { const int s_ = (c_) * 4 + jj, tk_ = s_ >> 3, dk_ = s_ & 7; \
        A_[jj] = *(const bf16x8*)(src + (size_t)tk_ * 1536 + dk_ * 16); \
        _Pragma("unroll") for (int nb = 0; nb < 4; ++nb) B_[jj][nb] = *(const bf16x8*)(w1 + (size_t)nb * 32 * 4096 + tk_ * 128 + dk_ * 16); } } while (0)
#define CMP_MMA(A_, B_) do { _Pragma("unroll") for (int jj = 0; jj < 4; ++jj) _Pragma("unroll") for (int nb = 0; nb < 4; ++nb) acc[nb] = MFMA32(A_[jj], B_[jj][nb], acc[nb]); } while (0)
    CMP_LOAD(A0, B0, 0);
#pragma unroll 1
    for (int c = 0; c < 8; c += 2) {
        CMP_LOAD(A1, B1, c + 1); CMP_MMA(A0, B0);
        if (c + 2 < 8) CMP_LOAD(A0, B0, c + 2);
        CMP_MMA(A1, B1);
    }
#undef CMP_LOAD
#undef CMP_MMA
    LAS float* red = (LAS float*)lds;
#pragma unroll
    for (int nb = 0; nb < 4; ++nb)
#pragma unroll
        for (int r = 0; r < 16; ++r) red[((wid * 4 + nb) * 16 + r) * 64 + lane] = acc[nb][r];
    __syncthreads();
    LAS bf16_t* G = (LAS bf16_t*)(lds + 131072);
    const float* c1 = (const float*)(ws + WS_C1) + ((size_t)l * 2 + kv) * 16 * 128;
    for (int idx = tid; idx < 4096; idx += 512) {
        float s = 0.f;
#pragma unroll
        for (int w = 0; w < 8; ++w) s += red[w * 4096 + idx];
        const int ln = idx & 63, r = (idx >> 6) & 15, nb = idx >> 10;
        const int row = crow(r, ln >> 5), n = nb * 32 + (ln & 31);
        float cb = 0.f;
#pragma unroll
        for (int sl = 0; sl < 16; ++sl) cb += c1[sl * 128 + n];
        G[row * 136 + n] = f2bf(gelu_tanh(s + cb));
    }
    __syncthreads();
    if (wid < 4) {
        const bf16_t* w2 = (const bf16_t*)(ws + WS_W2) + ((size_t)l * 2 + kv) * 128 * 128 + (size_t)(wid * 32 + r32) * 128 + hi * 8;
        f32x16 o = {};
#pragma unroll
        for (int ks = 0; ks < 8; ++ks) { const bf16x8 af = *(LAS const bf16x8*)(G + r32 * 136 + ks * 16 + hi * 8); const bf16x8 bfr = *(const bf16x8*)(w2 + ks * 16); o = MFMA32(af, bfr, o); }
        bf16_t* dst = (bf16_t*)(ws + WS_KC) + (size_t)kv * 8 * 128 * 128;
#pragma unroll
        for (int r = 0; r < 16; ++r) { const int RR = rt * 32 + crow(r, hi); dst[(size_t)RR * 128 + wid * 32 + r32] = f2bf(o[r]); }
    }
    __syncthreads();
}

__device__ __forceinline__ unsigned sortable(float f) { unsigned u = __float_as_uint(f); if ((u << 1) == 0u) u = 0u; return (u & 0x80000000u) ? ~u : (u | 0x80000000u); }
__device__ __forceinline__ void indexer_item(const Args& a, LAS unsigned char* lds, int item) {
    unsigned char* ws = launder_s(a.ws);
    const int tid = LTID, wid = __builtin_amdgcn_readfirstlane(tid >> 6), lane = tid & 63, r32 = lane & 31, hi = lane >> 5;
    const int b = item >> 7, t0 = (item & 127) * 16;
    unsigned long long* MASK = (unsigned long long*)(ws + WS_MASK);
    if (t0 + 16 <= 256) {
        for (int q = wid * 2; q < wid * 2 + 2; ++q) { const int t = t0 + q;
            if (lane < 32) { const int lo = lane * 64; unsigned long long w = 0ull; if (t >= lo + 63) w = ~0ull; else if (t >= lo) w = (2ull << (t - lo)) - 1ull;
                MASK[((size_t)b * SEQ + t) * 32 + lane] = w; } }
        return;
    }
    LAS unsigned* SC = (LAS unsigned*)lds;
    LAS float* WI = (LAS float*)(lds + 131072);
    if (tid < 64) WI[tid] = ((const float*)(ws + WS_SKF))[((size_t)b * SEQ + t0 + (tid >> 2)) * 32 + 24 + (tid & 3)];
    bf16x8 aq[2][4];
#pragma unroll
    for (int rb = 0; rb < 2; ++rb) { const bf16_t* qp = (const bf16_t*)(ws + WS_QI) + ((size_t)b * SEQ + t0 + rb * 8 + (r32 >> 2)) * 256 + (r32 & 3) * 64 + hi * 8;
#pragma unroll
        for (int ks = 0; ks < 4; ++ks) aq[rb][ks] = *(const bf16x8*)(qp + ks * 16); }
    __syncthreads();
    const int nch = (t0 + 16 + 31) >> 5;
    const bf16_t* KI = (const bf16_t*)(ws + WS_KI) + (size_t)b * SEQ * 64;
    bf16x8 bkA[4], bkB[4];
#define IDX_LOAD(bk_, ch_) do { const bf16_t* kp_ = KI + (size_t)((ch_) * 32 + r32) * 64 + hi * 8; _Pragma("unroll") for (int ks = 0; ks < 4; ++ks) bk_[ks] = *(const bf16x8*)(kp_ + ks * 16); } while (0)
#define IDX_COMPUTE(bk_, ch_) do { _Pragma("unroll") for (int rb = 0; rb < 2; ++rb) { f32x16 s = {}; \
            _Pragma("unroll") for (int ks = 0; ks < 4; ++ks) s = MFMA32(aq[rb][ks], bk_[ks], s); \
              \
            _Pragma("unroll") for (int mq = 0; mq < 4; ++mq) { const int q = rb * 8 + 2 * mq + hi; float sc = 0.f; \
                _Pragma("unroll") for (int h = 0; h < 4; ++h) sc += fmaxf(s[mq * 4 + h], 0.f) * WI[q * 4 + h]; \
                const int key = (ch_) * 32 + r32; SC[q * 2048 + key] = (key <= t0 + q) ? sortable(sc) : 0u; } } } while (0)
    if (wid < nch) IDX_LOAD(bkA, wid);
#pragma unroll 1
    for (int ch = wid; ch < nch; ch += 16) {
        if (ch + 8 < nch) IDX_LOAD(bkB, ch + 8);
        IDX_COMPUTE(bkA, ch);
        if (ch + 8 < nch) { if (ch + 16 < nch) IDX_LOAD(bkA, ch + 16); IDX_COMPUTE(bkB, ch + 8); }
    }
#undef IDX_LOAD
#undef IDX_COMPUTE
    __syncthreads();
    for (int q = wid * 2; q < wid * 2 + 2; ++q) {
        const int t = t0 + q; const int nw = (t >> 6) + 1;
        unsigned kk[32];
#pragma unroll
        for (int i = 0; i < 32; ++i) kk[i] = (i < nw && (i * 64 + lane) < nch * 32) ? SC[q * 2048 + i * 64 + lane] : 0u;
        unsigned T = 0u; bool exact = false;
        for (int bit = 31; bit >= 0; --bit) {
            const unsigned cand = T | (1u << bit); int cnt = 0;
#pragma unroll
            for (int i = 0; i < 32; ++i) cnt += __popcll(__ballot(kk[i] >= cand));
            if (cnt >= 256) { T = cand; if (cnt == 256) { exact = true; break; } }
        }
        int need = 0;
        if (!exact) { int ngt = 0;
#pragma unroll
            for (int i = 0; i < 32; ++i) ngt += __popcll(__ballot(kk[i] > T));
            need = 256 - ngt; }
        unsigned long long mine = 0ull;
#pragma unroll
        for (int i = 0; i < 32; ++i) {
            unsigned long long w;
            if (exact) w = __ballot(kk[i] >= T);
            else { w = __ballot(kk[i] > T); unsigned long long eq = __ballot(kk[i] == T);
                   const int ne = __popcll(eq);
                   if (ne <= need) { w |= eq; need -= ne; }
                   else { while (need > 0) { const unsigned long long low = eq & (0ull - eq); w |= low; eq ^= low; --need; } } }
            if (lane == i) mine = w;
        }
        if (lane < 32) MASK[((size_t)b * SEQ + t) * 32 + lane] = mine;
    }
    __syncthreads();
}

struct BranchSched {
    int G, c;
    __device__ __forceinline__ bool next(int i, pg8::Unit& u) const {
        const int n = i % 3, idx = (i / 3) * G + c; if (idx >= 256) return false;
        pg8::StaticOrder so; so.init(NTOK, DM, 256, idx); so.next(0, u); u.pm += n * 32; u.pn += n * 8; return true;
    }
    __device__ __forceinline__ void a_ready(const pg8::Unit&) const {}
    __device__ __forceinline__ void done(const pg8::Unit&) const {}
};
struct EpiBranch {
    static constexpr bool PERM = true, AFTER_DRAIN = false;
    unsigned char* ws;
    __device__ __forceinline__ bool keep(const pg8::Unit& u) const { return (u.pm >> 5) < 2; }
    __device__ __forceinline__ void operator()(f32x4 (&acc)[2][2][4][2], const pg8::Unit& u, int wr, int wc, int fr, int fq) const {
        const int n = u.pm >> 5, pm = u.pm & 31, pn = u.pn & 7;
        bf16_t* O = (bf16_t*)(ws + WS_MIXB); const bf16_t* Gt = (const bf16_t*)(ws + WS_HG) + n * 2048;
        const int row0 = pm * 256 + wr * 64 + fr, col0 = pn * 256 + wc * 32 + 8 * fq;
        u32x4 gcur[2], hcur[2], gnxt[2], hnxt[2];
#define LOADG(G_, H_, ai_, m_) do { const size_t row_ = (size_t)(row0 + (ai_) * 128 + (m_) * 16); \
            G_[0] = *(const u32x4*)(Gt + row_ * 6144 + col0); G_[1] = *(const u32x4*)(Gt + row_ * 6144 + col0 + 128); \
            if (n < 2) { H_[0] = *(const u32x4*)(Gt + 2048 + row_ * 6144 + col0); H_[1] = *(const u32x4*)(Gt + 2048 + row_ * 6144 + col0 + 128); } } while (0)
        LOADG(gcur, hcur, 0, 0);
#pragma unroll
        for (int ai = 0; ai < 2; ++ai)
#pragma unroll
            for (int m = 0; m < 4; ++m) { const size_t row = (size_t)(row0 + ai * 128 + m * 16);
                if (ai * 4 + m < 7) LOADG(gnxt, hnxt, (ai * 4 + m + 1) >> 2, (ai * 4 + m + 1) & 3);
#pragma unroll
                for (int bj = 0; bj < 2; ++bj) { const int col = col0 + bj * 128;
                    const u32x4 gw = gcur[bj];
                    float gv[8] = {__uint_as_float(gw.x << 16), __uint_as_float(gw.x & 0xffff0000u), __uint_as_float(gw.y << 16), __uint_as_float(gw.y & 0xffff0000u),
                                   __uint_as_float(gw.z << 16), __uint_as_float(gw.z & 0xffff0000u), __uint_as_float(gw.w << 16), __uint_as_float(gw.w & 0xffff0000u)};
                    if (n < 2) {
                        const u32x4 hw = hcur[bj];
                        const float hv[8] = {__uint_as_float(hw.x << 16), __uint_as_float(hw.x & 0xffff0000u), __uint_as_float(hw.y << 16), __uint_as_float(hw.y & 0xffff0000u),
                                             __uint_as_float(hw.z << 16), __uint_as_float(hw.z & 0xffff0000u), __uint_as_float(hw.w << 16), __uint_as_float(hw.w & 0xffff0000u)};
#pragma unroll
                        for (int e = 0; e < 8; ++e) gv[e] *= __builtin_amdgcn_rcpf(fmaxf(hv[e], 1e-30f));
#pragma unroll
                        for (int e = 0; e < 4; ++e) { acc[ai][bj][m][0][e] *= gv[e]; acc[ai][bj][m][1][e] *= gv[4 + e]; }
                    } else {
                        const f32x4 v0 = acc[ai][bj][m][0], v1 = acc[ai][bj][m][1];
                        u32x4 w; w.x = cvtpk(v0[0] * gv[0], v0[1] * gv[1]); w.y = cvtpk(v0[2] * gv[2], v0[3] * gv[3]); w.z = cvtpk(v1[0] * gv[4], v1[1] * gv[5]); w.w = cvtpk(v1[2] * gv[6], v1[3] * gv[7]);
                        *(u32x4*)(O + row * 2048 + col) = w; } }
                gcur[0] = gnxt[0]; gcur[1] = gnxt[1]; hcur[0] = hnxt[0]; hcur[1] = hnxt[1];
            }
#undef LOADG
    }
};
struct EpiOut {
    static constexpr bool PERM = false, AFTER_DRAIN = false;
    const float* x; float* pre;
    __device__ __forceinline__ void operator()(const f32x4 (&acc)[2][2][4][2], const pg8::Unit& u, int wr, int wc, int fr, int fq) const {
        const int row0 = u.pm * 256 + wr * 64 + fr, col0 = u.pn * 256 + wc * 32 + 4 * fq;
        f32x4 xc[4], xn[4];
#define LOADX(X_, ai_, m_) do { const size_t off_ = (size_t)(row0 + (ai_) * 128 + (m_) * 16) * 2048 + col0; \
            X_[0] = *(const f32x4*)(x + off_); X_[1] = *(const f32x4*)(x + off_ + 16); X_[2] = *(const f32x4*)(x + off_ + 128); X_[3] = *(const f32x4*)(x + off_ + 144); } while (0)
        LOADX(xc, 0, 0);
#pragma unroll
        for (int ai = 0; ai < 2; ++ai)
#pragma unroll
            for (int m = 0; m < 4; ++m) { const size_t off = (size_t)(row0 + ai * 128 + m * 16) * 2048 + col0;
                if (ai * 4 + m < 7) LOADX(xn, (ai * 4 + m + 1) >> 2, (ai * 4 + m + 1) & 3);
#pragma unroll
                for (int bj = 0; bj < 2; ++bj)
#pragma unroll
                    for (int n = 0; n < 2; ++n) *(f32x4*)(pre + off + bj * 128 + n * 16) = xc[bj * 2 + n] * ALPHA + acc[ai][bj][m][n];
#pragma unroll
                for (int k = 0; k < 4; ++k) xc[k] = xn[k];
            }
#undef LOADX
    }
};

__device__ __forceinline__ void ln_row(f32x4 (&v)[8], const float* g, const float* bta, int lane) {
    float s = 0.f;
#pragma unroll
    for (int i = 0; i < 8; ++i) s += (v[i][0] + v[i][1]) + (v[i][2] + v[i][3]);
    const float mean = wave_sum(s) * (1.0f / 2048.0f);
    float q = 0.f;
#pragma unroll
    for (int i = 0; i < 8; ++i) { const f32x4 d = v[i] - mean; q += (d[0] * d[0] + d[1] * d[1]) + (d[2] * d[2] + d[3] * d[3]); }
    const float rstd = 1.0f / sqrtf(wave_sum(q) * (1.0f / 2048.0f) + LN_EPS);
#pragma unroll
    for (int i = 0; i < 8; ++i) { const f32x4 gg = *(const f32x4*)(g + i * 256 + lane * 4), bb = *(const f32x4*)(bta + i * 256 + lane * 4); v[i] = (v[i] - mean) * rstd * gg + bb; }
}

__device__ __forceinline__ void p6_ln1_route(const Args& a, int l, LAS unsigned char* lds) {
    unsigned char* ws = launder_s(a.ws);
    const int tid = LTID, wid = __builtin_amdgcn_readfirstlane(tid >> 6), lane = tid & 63, r32 = lane & 31, hi = lane >> 5;
    const float* pre = (const float*)(ws + WS_MIXT); float* x1f = (float*)(ws + WS_X1F); bf16_t* x1b = (bf16_t*)(ws + WS_X1B);
    const float* g = a.in[14] + (size_t)l * DM; const float* bta = a.in[15] + (size_t)l * DM;
    unsigned* cnt = (unsigned*)(ws + WS_CTL) + CW_CNT + l * 1024;
    for (int it = LBID; it < NTOK / 32; it += gridDim.x) {
        const int row0 = it * 32;
        { f32x4 v[4][8];
#pragma unroll
          for (int rr = 0; rr < 4; ++rr)
#pragma unroll
              for (int i = 0; i < 8; ++i) v[rr][i] = *(const f32x4*)(pre + (size_t)(row0 + wid * 4 + rr) * DM + i * 256 + lane * 4);
#pragma unroll
          for (int rr = 0; rr < 4; ++rr) { const size_t row = (size_t)(row0 + wid * 4 + rr);
              ln_row(v[rr], g, bta, lane);
#pragma unroll
              for (int i = 0; i < 8; ++i) { *(f32x4*)(x1f + row * DM + i * 256 + lane * 4) = v[rr][i]; u32x2 w; w.x = cvtpk(v[rr][i][0], v[rr][i][1]); w.y = cvtpk(v[rr][i][2], v[rr][i][3]); *(u32x2*)(x1b + row * DM + i * 256 + lane * 4) = w; } } }
        asm volatile("s_waitcnt vmcnt(0)" ::: "memory");
        __syncthreads();
        f32x16 acc = {};
        { const float* xp = x1f + (size_t)(row0 + r32) * DM + 256 * wid + 8 * hi;
          const bf16_t* wh = (const bf16_t*)(ws + WS_WR) + (size_t)l * 2 * 32 * DM + (size_t)r32 * DM + 256 * wid + 8 * hi; const bf16_t* wl = wh + 32 * DM;
#pragma unroll 8
          for (int ks = 0; ks < 16; ++ks) {
              const f32x4 x0 = *(const f32x4*)(xp + ks * 16), x1 = *(const f32x4*)(xp + ks * 16 + 4);
              const bf16x8 xh = pack8(x0, x1);
              f32x4 r0, r1;
#pragma unroll
              for (int e = 0; e < 4; ++e) { r0[e] = x0[e] - bf2f((bf16_t)xh[e]); r1[e] = x1[e] - bf2f((bf16_t)xh[4 + e]); }
              const bf16x8 xl = pack8(r0, r1);
              const bf16x8 bh = *(const bf16x8*)(wh + ks * 16), bl = *(const bf16x8*)(wl + ks * 16);
              acc = MFMA32(xh, bh, acc); acc = MFMA32(xl, bh, acc); acc = MFMA32(xh, bl, acc);
          } }
        LAS float* red = (LAS float*)lds;
#pragma unroll
        for (int r = 0; r < 16; ++r) red[(wid * 16 + r) * 64 + lane] = acc[r];
        __syncthreads();
        LAS float* LG = (LAS float*)(lds + 32768);
        if (tid < 32) ((LAS unsigned*)(lds + 40960))[tid] = 0u;
        for (int idx = tid; idx < 1024; idx += 512) { float s = 0.f;
#pragma unroll
            for (int w = 0; w < 8; ++w) s += red[w * 1024 + idx];
            const int ln = idx & 63, r = idx >> 6; LG[crow(r, ln >> 5) * 33 + (ln & 31)] = s; }
        __syncthreads();
        if (tid < 32) {
            const int row = row0 + tid; LAS const float* lg = LG + tid * 33;
            float gl[4];
#pragma unroll
            for (int j = 0; j < 4; ++j) gl[j] = lg[j] + a.in[17][l * 4 + j];
            int gi = 0; float gm = gl[0];
#pragma unroll
            for (int j = 1; j < 4; ++j) if (gl[j] > gm) { gm = gl[j]; gi = j; }
            float den = 0.f;
#pragma unroll
            for (int j = 0; j < 4; ++j) den += expf(gl[j] - gm);
            const float gp = 1.0f / den;
            float el[4];
#pragma unroll
            for (int j = 0; j < 4; ++j) el[j] = lg[4 + gi * 4 + j] + a.in[19][l * 16 + gi * 4 + j];
            int e1 = 0; float m1 = el[0];
#pragma unroll
            for (int j = 1; j < 4; ++j) if (el[j] > m1) { m1 = el[j]; e1 = j; }
            int e2 = -1; float m2 = 0.f;
#pragma unroll
            for (int j = 0; j < 4; ++j) if (j != e1 && (e2 < 0 || el[j] > m2)) { m2 = el[j]; e2 = j; }
            const float ex = expf(m2 - m1), w1 = 1.0f / (1.0f + ex), w2 = ex / (1.0f + ex);
            const int E1 = gi * 4 + e1, E2 = gi * 4 + e2;
            LAS unsigned* lc = (LAS unsigned*)(lds + 40960);
            const unsigned p1 = __hip_atomic_fetch_add(lc + E1, 1u, __ATOMIC_RELAXED, __HIP_MEMORY_SCOPE_WORKGROUP);
            const unsigned p2 = __hip_atomic_fetch_add(lc + E2, 1u, __ATOMIC_RELAXED, __HIP_MEMORY_SCOPE_WORKGROUP);
            asm volatile("s_waitcnt lgkmcnt(0)" ::: "memory");
            if (tid < 16) ((unsigned*)(ws + WS_CTL) + CW_CNTW)[it * 16 + tid] = lc[tid];
            int* tk = (int*)(ws + WS_TOK); float* tw = (float*)(ws + WS_TOK) + 4 * NTOK;
            tk[row * 2] = E1; tk[row * 2 + 1] = E2; tk[2 * NTOK + row * 2] = (int)p1; tk[2 * NTOK + row * 2 + 1] = (int)p2;
            tw[row * 2] = gp * w1; tw[row * 2 + 1] = gp * w2;
        }
        __syncthreads();
    }
}

__device__ __forceinline__ int moe_offsets(const Args& a, int l, LAS int* off) {
    const unsigned* cnt = (const unsigned*)(a.ws + WS_CTL) + CW_CNT + l * 1024;
    const int tid_ = LTID;
    if (tid_ < 16) off[32 + tid_] = ((int)__hip_atomic_load(cnt + 64 * tid_, __ATOMIC_RELAXED, __HIP_MEMORY_SCOPE_AGENT) + 255) & ~255;
    __syncthreads();
    if (tid_ == 0) { int o = 0; for (int e = 0; e < NEXP; ++e) { off[e] = o; o += off[32 + e]; } off[NEXP] = o; }
    __syncthreads();
    return off[NEXP] >> 8;
}
__device__ __forceinline__ void p7_gather(const Args& a, int l, LAS unsigned char* lds) {
    unsigned char* ws = launder_s(a.ws);
    const int tid = LTID, wid = tid >> 6, lane = tid & 63;
    LAS int* off = (LAS int*)lds; LAS int* PS = off + 32; LAS int* PP = PS + 512; LAS int* BASE = PP + 512;
    const unsigned* cntw = (const unsigned*)(ws + WS_CTL) + CW_CNTW;
    { const int e = tid & 15, part = tid >> 4; int s = 0;
#pragma unroll
      for (int k = 0; k < 8; ++k) s += (int)cntw[(part * 8 + k) * 16 + e];
      PS[part * 16 + e] = s; }
    __syncthreads();
    if (tid < 16) { int run = 0; for (int part = 0; part < 32; ++part) { PP[part * 16 + tid] = run; run += PS[part * 16 + tid]; } PS[tid] = run;
        if (LBID == 0) __hip_atomic_store((unsigned*)(ws + WS_CTL) + CW_CNT + l * 1024 + 64 * tid, (unsigned)run, __ATOMIC_RELAXED, __HIP_MEMORY_SCOPE_AGENT); }
    __syncthreads();
    if (tid == 0) { int o = 0; for (int e = 0; e < NEXP; ++e) { off[e] = o; o += (PS[e] + 255) & ~255; } off[NEXP] = o; }
    const int* tk = (const int*)(ws + WS_TOK); const float* tw = (const float*)(ws + WS_TOK) + 4 * NTOK; int* trow = (int*)(ws + WS_TOK) + 6 * NTOK;
    const bf16_t* x1b = (const bf16_t*)(ws + WS_X1B); bf16_t* xs = (bf16_t*)(ws + WS_XS); float* roww = (float*)(ws + WS_ROWW);
    for (int wt = LBID; wt < NTOK / 32; wt += gridDim.x) {
        __syncthreads();
        if (tid < 16) { int b = PP[(wt >> 3) * 16 + tid]; int cv[7];
#pragma unroll
            for (int k = 0; k < 7; ++k) cv[k] = ((wt & ~7) + k < wt) ? (int)cntw[((wt & ~7) + k) * 16 + tid] : 0;
#pragma unroll
            for (int k = 0; k < 7; ++k) b += cv[k];
            BASE[tid] = b; }
        __syncthreads();
        for (int q0 = wid * 8; q0 < wid * 8 + 8; q0 += 4) {
            u32x4 buf[4][4]; int rows[4];
#pragma unroll
            for (int k = 0; k < 4; ++k) { const int p = wt * 64 + q0 + k; const int e = tk[p]; rows[k] = off[e] + BASE[e] + tk[2 * NTOK + p];
                const u32x4* s = (const u32x4*)(x1b + (size_t)(p >> 1) * DM);
#pragma unroll
                for (int i = 0; i < 4; ++i) buf[k][i] = s[i * 64 + lane]; }
#pragma unroll
            for (int k = 0; k < 4; ++k) { const int p = wt * 64 + q0 + k; u32x4* d = (u32x4*)(xs + (size_t)rows[k] * DM);
#pragma unroll
                for (int i = 0; i < 4; ++i) d[i * 64 + lane] = buf[k][i];
                if (lane == 0) { roww[rows[k]] = tw[p]; trow[p] = rows[k]; } }
        }
    }
}
struct MoeSched {
    LAS const int* te; int ntiles, ncol, G, c;
    __device__ __forceinline__ bool next(int i, pg8::Unit& u) const {
        const int L = i * G + c; if (L >= ntiles * ncol) return false;
        const int pm = L / ncol, pl = L % ncol; u.pm = pm; u.pn = te[pm] * ncol + pl; return true;
    }
    __device__ __forceinline__ void a_ready(const pg8::Unit&) const {}
    __device__ __forceinline__ void done(const pg8::Unit&) const {}
};
__device__ __forceinline__ int moe_tile_table(const Args& a, int l, LAS int* off, LAS int* te) {
    const int nt = moe_offsets(a, l, off);
    const int tid_ = LTID;
    if (tid_ < 128) { const int pm = tid_; if (pm < nt) { int e = 0; for (int k = 1; k < NEXP; ++k) if ((off[k] >> 8) <= pm) e = k; te[pm] = e; } }
    __syncthreads();
    return nt;
}
struct EpiGateUp {
    static constexpr bool PERM = true, AFTER_DRAIN = false;
    unsigned char* ws;
    __device__ __forceinline__ void operator()(const f32x4 (&acc)[2][2][4][2], const pg8::Unit& u, int wr, int wc, int fr, int fq) const {
        bf16_t* hm = (bf16_t*)(ws + WS_HM); const float* roww = (const float*)(ws + WS_ROWW);
        const int row0 = u.pm * 256 + wr * 64 + fr, col0 = (u.pn & 3) * 128 + wc * 32 + 8 * fq;
        float rwv[8];
#pragma unroll
        for (int k = 0; k < 8; ++k) rwv[k] = roww[row0 + (k >> 2) * 128 + (k & 3) * 16];
#pragma unroll
        for (int ai = 0; ai < 2; ++ai)
#pragma unroll
            for (int m = 0; m < 4; ++m) { const int row = row0 + ai * 128 + m * 16; const float rw = rwv[ai * 4 + m];
                float o[8];
#pragma unroll
                for (int n = 0; n < 2; ++n)
#pragma unroll
                    for (int e = 0; e < 4; ++e) { const float gt = acc[ai][0][m][n][e], up = acc[ai][1][m][n][e]; o[n * 4 + e] = gt * fast_sigmoid(gt) * up * rw; }
                u32x4 w = {cvtpk(o[0], o[1]), cvtpk(o[2], o[3]), cvtpk(o[4], o[5]), cvtpk(o[6], o[7])};
                *(u32x4*)(hm + (size_t)row * DEXP + col0) = w; }
    }
};
struct EpiDown {
    static constexpr bool PERM = true, AFTER_DRAIN = false;
    unsigned char* ws;
    __device__ __forceinline__ void operator()(const f32x4 (&acc)[2][2][4][2], const pg8::Unit& u, int wr, int wc, int fr, int fq) const {
        bf16_t* y = (bf16_t*)(ws + WS_Y);
        const int row0 = u.pm * 256 + wr * 64 + fr, col0 = (u.pn & 7) * 256 + wc * 32 + 8 * fq;
#pragma unroll
        for (int ai = 0; ai < 2; ++ai)
#pragma unroll
            for (int m = 0; m < 4; ++m) { bf16_t* rowp = y + (size_t)(row0 + ai * 128 + m * 16) * DM + col0;
#pragma unroll
                for (int bj = 0; bj < 2; ++bj) { const f32x4 v0 = acc[ai][bj][m][0], v1 = acc[ai][bj][m][1];
                    u32x4 w = {cvtpk(v0[0], v0[1]), cvtpk(v0[2], v0[3]), cvtpk(v1[0], v1[1]), cvtpk(v1[2], v1[3])};
                    *(u32x4*)(rowp + bj * 128) = w; } }
    }
};
__device__ __forceinline__ void p10_ln2(const Args& a, int l) {
    unsigned char* ws = launder_s(a.ws); const int tid = LTID, wid = tid >> 6, lane = tid & 63;
    const float* x1f = (const float*)(ws + WS_X1F); const bf16_t* y = (const bf16_t*)(ws + WS_Y); const int* trow = (const int*)(ws + WS_TOK) + 6 * NTOK;
    float* xo = (l == NL - 1) ? a.out : (float*)(ws + WS_XF); bf16_t* xb = (bf16_t*)(ws + WS_XB);
    const float* g = a.in[23] + (size_t)l * DM; const float* bta = a.in[24] + (size_t)l * DM;
    const int rstep = gridDim.x * 8; int row = LBID * 8 + wid;
    int tr0 = row < NTOK ? trow[row * 2] : 0, tr1 = row < NTOK ? trow[row * 2 + 1] : 0;
    for (; row < NTOK; row += rstep) {
        const bf16_t* y0 = y + (size_t)tr0 * DM; const bf16_t* y1 = y + (size_t)tr1 * DM;
        if (row + rstep < NTOK) { tr0 = trow[(row + rstep) * 2]; tr1 = trow[(row + rstep) * 2 + 1]; }
        f32x4 v[8];
#pragma unroll
        for (int i = 0; i < 8; ++i) { const int cidx = i * 256 + lane * 4; const f32x4 xv = *(const f32x4*)(x1f + (size_t)row * DM + cidx);
            const u32x2 a0 = *(const u32x2*)(y0 + cidx), a1 = *(const u32x2*)(y1 + cidx);
            const f32x4 f0 = {__uint_as_float(a0.x << 16), __uint_as_float(a0.x & 0xffff0000u), __uint_as_float(a0.y << 16), __uint_as_float(a0.y & 0xffff0000u)};
            const f32x4 f1 = {__uint_as_float(a1.x << 16), __uint_as_float(a1.x & 0xffff0000u), __uint_as_float(a1.y << 16), __uint_as_float(a1.y & 0xffff0000u)};
            v[i] = xv * ALPHA + (f0 + f1); }
        ln_row(v, g, bta, lane);
#pragma unroll
        for (int i = 0; i < 8; ++i) { const int cidx = i * 256 + lane * 4; *(f32x4*)(xo + (size_t)row * DM + cidx) = v[i];
            u32x2 w; w.x = cvtpk(v[i][0], v[i][1]); w.y = cvtpk(v[i][2], v[i][3]); *(u32x2*)(xb + (size_t)row * DM + cidx) = w; }
    }
}

#if defined(DBG_STAGE)
__device__ __forceinline__ void dbg_accum(unsigned* ctl, int k, float err, float ref) {
    err = wave_sum(err); ref = wave_sum(ref);
    if ((threadIdx.x & 63) == 0) { atomicAdd((float*)(ctl + CW_DBG) + 2 * k, err); atomicAdd((float*)(ctl + CW_DBG) + 2 * k + 1, ref); }
}
__device__ __forceinline__ float ldbf(const bf16_t* p) { return bf2f(*p); }
__device__ __forceinline__ float gelu_ref(float x) { return 0.5f * x * (1.0f + tanhf(0.7978845608028654f * (x + 0.044715f * x * x * x))); }
__device__ __forceinline__ float sigm_ref(float x) { return 1.0f / (1.0f + expf(-x)); }

__device__ void dbg_inproj(const Args& a, unsigned* ctl) {
    unsigned char* ws = a.ws; const int tid = threadIdx.x; const int r = (blockIdx.x * 32 + 5) % NTOK;
    const float* x = a.in[0] + (size_t)r * DM; const float* w = a.in[1];
    float err = 0.f, ref = 0.f;
    for (int c = tid; c < IN_COLS; c += 512) {
        float s = 0.f; for (int k = 0; k < DM; ++k) s += x[k] * w[(size_t)k * IN_COLS + c];
        float rv, gv; bool skip = false;
        if (c < 1024) { rv = s; gv = ldbf((const bf16_t*)(ws + WS_QA) + (size_t)r * 1024 + c); }
        else if (c < 2560) { rv = s; gv = ldbf((const bf16_t*)(ws + WS_KV) + (size_t)r * 1536 + (c - 1024)); }
        else if (c < 2584) { rv = sigm_ref(s); gv = ((const float*)(ws + WS_SKF))[(size_t)r * 32 + (c - 2560)]; }
        else if (c < 3608) { rv = s; gv = ldbf((const bf16_t*)(ws + WS_QB) + (size_t)r * 1024 + (c - 2584)); }
        else if (c < 3864) { rv = s; gv = ldbf((const bf16_t*)(ws + WS_HC) + (size_t)r * 256 + (c - 3608)); }
        else if (c < 4120) { rv = s; gv = ldbf((const bf16_t*)(ws + WS_QI) + (size_t)r * 256 + (c - 3864)); }
        else if (c < 4184) { rv = s; gv = ldbf((const bf16_t*)(ws + WS_KI) + (size_t)r * 64 + (c - 4120)); }
        else if (c < 4188) { rv = s; gv = ((const float*)(ws + WS_SKF))[(size_t)r * 32 + 24 + (c - 4184)]; }
        else if (c < 5212) { rv = gelu_ref(s); gv = ldbf((const bf16_t*)(ws + WS_HU) + (size_t)r * 1024 + (c - 4188)); }
        else if (c < 6236) { skip = true; rv = gv = 0.f; }
        else { rv = sigm_ref(s); gv = ldbf((const bf16_t*)(ws + WS_HG) + (size_t)r * 6144 + (c - 6236)); }
        if (!skip) { err += (gv - rv) * (gv - rv); ref += rv * rv; }
    }
    dbg_accum(ctl, 5, err, ref);
}
__device__ void dbg_compress(const Args& a, unsigned* ctl, LAS unsigned char* lds) {
    unsigned char* ws = a.ws; const int tid = threadIdx.x; LAS float* sh = (LAS float*)lds;
    const int kv = blockIdx.x & 1; int R = ((blockIdx.x >> 1) * 8 + 3) % 1024; if ((R & 127) == 127) R -= 1;
    const int bh = R >> 7, i = R & 127, b = bh >> 1, hkv = bh & 1;
    const float* pe = a.in[4] + (size_t)kv * 4096; const float* w1 = a.in[2] + (size_t)kv * 4096 * 128; const float* w2 = a.in[3] + (size_t)kv * 128 * 128;
    const int n = tid & 127, q = tid >> 7; float s = 0.f;
    for (int k = q * 1024; k < (q + 1) * 1024; ++k) { const int l = k >> 7, d = k & 127;
        const float xv = ldbf((const bf16_t*)(ws + WS_KV) + ((size_t)b * SEQ + 16 * i + l) * 1536 + kv * 256 + hkv * 128 + d) + pe[k]; s += xv * w1[(size_t)k * 128 + n]; }
    sh[q * 128 + n] = s; __syncthreads();
    if (tid < 128) sh[512 + tid] = gelu_ref((sh[tid] + sh[128 + tid]) + (sh[256 + tid] + sh[384 + tid]));
    __syncthreads();
    float err = 0.f, ref = 0.f;
    if (tid < 128) { float o = 0.f; for (int j = 0; j < 128; ++j) o += sh[512 + j] * w2[j * 128 + tid];
        const float gv = ldbf((const bf16_t*)(ws + WS_KC) + ((size_t)kv * 1024 + R) * 128 + tid); err = (gv - o) * (gv - o); ref = o * o; }
    dbg_accum(ctl, 2, err, ref); __syncthreads();
}
__device__ void dbg_nsa(const Args& a, unsigned* ctl, LAS unsigned char* lds) {
    unsigned char* ws = a.ws; const int tid = threadIdx.x;
    const int b = blockIdx.x & 3, hkv = (blockIdx.x >> 2) & 1, t = (blockIdx.x * 131 + 77) % SEQ, cur = t >> 6;
    LAS float* P = (LAS float*)lds;
    LAS float* O = P + 4 * 2048;
    LAS float* IMPv = O + 512;
    LAS unsigned* SEL = (LAS unsigned*)(IMPv + 32);
    LAS float* Q = IMPv + 64;
    const size_t tok = (size_t)b * SEQ + t;
    { const int g = tid >> 7, d = tid & 127; Q[tid] = ldbf((const bf16_t*)(ws + WS_QA) + tok * 1024 + (hkv * 4 + g) * 128 + d); O[tid] = 0.f; }
    __syncthreads();
    const float scale = 0.08838834764831845f;
    const bf16_t* KC = (const bf16_t*)(ws + WS_KC) + (size_t)(b * 2 + hkv) * 128 * 128; const bf16_t* VC = KC + (size_t)8 * 128 * 128;
    const bf16_t* KVb = (const bf16_t*)(ws + WS_KV) + (size_t)b * SEQ * 1536 + hkv * 128;
    { const int g = tid >> 7, i = tid & 127; const float slope = exp2f(-(float)(hkv * 4 + g + 1)); float s = -INFINITY;
      if (i < 127 && t - (16 * i + 31) >= 0) { float d = 0.f; for (int k = 0; k < 128; ++k) d += Q[g * 128 + k] * ldbf(KC + i * 128 + k); s = d * scale - slope * (float)(t - (16 * i + 31)); }
      P[g * 2048 + i] = s; }
    __syncthreads();
    if (tid < 4) { float m = -INFINITY; for (int i = 0; i < 127; ++i) m = fmaxf(m, P[tid * 2048 + i]); float l = 0.f;
        for (int i = 0; i < 128; ++i) { const float e = (i < 127 && P[tid * 2048 + i] > -INFINITY) ? expf(P[tid * 2048 + i] - m) : 0.f; P[tid * 2048 + i] = e; l += e; }
        const float inv = l > 0.f ? 1.f / l : 0.f; for (int i = 0; i < 128; ++i) P[tid * 2048 + i] *= inv; }
    __syncthreads();
    { const int g = tid >> 7, d = tid & 127; float o = 0.f; for (int i = 0; i < 127; ++i) o += P[g * 2048 + i] * ldbf(VC + i * 128 + d);
      O[tid] += ((const float*)(ws + WS_SKF))[tok * 32 + (hkv * 4 + g) * 3 + 0] * o; }
    if (tid < 32) { float v = 0.f; for (int g = 0; g < 4; ++g) for (int i = 4 * tid - 1; i <= 4 * tid + 3; ++i) if (i >= 0 && i < 127) v += P[g * 2048 + i]; IMPv[tid] = v; }
    __syncthreads();
    if (tid < 32) { const int j = tid; const bool forced = (j == 0) || (j == cur) || (j == cur - 1); IMPv[j] = (j <= cur) ? IMPv[j] + (forced ? 1e4f : 0.f) : -1e30f; }
    __syncthreads();
    if (tid == 0) {
        unsigned sel = 0; for (int n = 0; n < 16; ++n) { int bj = -1; float bv = 0.f; for (int j = 0; j < 32; ++j) { const float vj = IMPv[j]; if (!((sel >> j) & 1u) && (bj < 0 || vj > bv)) { bj = j; bv = vj; } } sel |= 1u << bj; }
        SEL[0] = sel; }
    __syncthreads();
    const unsigned sel = SEL[0];
    for (int br = 1; br <= 2; ++br) {
        const bf16_t* Kp = KVb + (br == 1 ? 512 : 1024); const bf16_t* Vp = KVb + (br == 1 ? 768 : 1280);
        for (int idx = tid; idx < 4 * 2048; idx += 512) { const int g = idx >> 11, s = idx & 2047; const float slope = exp2f(-(float)(hkv * 4 + g + 1));
            const bool ok = (s <= t) && (br == 1 ? ((sel >> (s >> 6)) & 1u) : (t - s < 512)); float sc = -INFINITY;
            if (ok) { float d = 0.f; for (int k = 0; k < 128; ++k) d += Q[g * 128 + k] * ldbf(Kp + (size_t)s * 1536 + k); sc = d * scale - slope * (float)(t - s); }
            P[idx] = sc; }
        __syncthreads();
        if (tid < 4) { float m = -INFINITY; for (int s = 0; s < 2048; ++s) m = fmaxf(m, P[tid * 2048 + s]); float l = 0.f;
            for (int s = 0; s < 2048; ++s) { const float e = P[tid * 2048 + s] > -INFINITY ? expf(P[tid * 2048 + s] - m) : 0.f; P[tid * 2048 + s] = e; l += e; }
            const float inv = l > 0.f ? 1.f / l : 0.f; for (int s = 0; s < 2048; ++s) P[tid * 2048 + s] *= inv; }
        __syncthreads();
        { const int g = tid >> 7, d = tid & 127; float o = 0.f; for (int s = 0; s <= t; ++s) { const float p = P[g * 2048 + s]; if (p != 0.f) o += p * ldbf(Vp + (size_t)s * 1536 + d); }
          O[tid] += ((const float*)(ws + WS_SKF))[tok * 32 + (hkv * 4 + g) * 3 + br] * o; }
        __syncthreads();
    }
    { const int g = tid >> 7, d = tid & 127; const float rv = O[tid], gv = ldbf((const bf16_t*)(ws + WS_BR) + tok * 1024 + (hkv * 4 + g) * 128 + d);
      dbg_accum(ctl, 1, (gv - rv) * (gv - rv), rv * rv); }
    __syncthreads();
}
__device__ void dbg_dsa(const Args& a, unsigned* ctl, LAS unsigned char* lds) {
    unsigned char* ws = a.ws; const int tid = threadIdx.x;
    const int b = blockIdx.x & 3, t = (blockIdx.x * 197 + 301) % SEQ; const size_t tok = (size_t)b * SEQ + t;
    LAS float* LG = (LAS float*)lds;
    LAS float* SC = LG + 8 * 2048;
    LAS float* QL = SC + 2048;
    LAS float* OL = QL + 2048;
    LAS unsigned char* SL = (LAS unsigned char*)(OL + 2048);
    const bf16_t* HC = (const bf16_t*)(ws + WS_HC) + (size_t)b * SEQ * 256; const float* PSQ = (const float*)(ws + WS_PSQ) + (size_t)b * SEQ * 4;
    const float* gk = a.in[7];
    for (int s = tid; s < 2048; s += 512) { float sc = -INFINITY;
        if (s <= t) { sc = 0.f; for (int h = 0; h < 4; ++h) { float d = 0.f; for (int k = 0; k < 64; ++k) d += ldbf((const bf16_t*)(ws + WS_QI) + tok * 256 + h * 64 + k) * ldbf((const bf16_t*)(ws + WS_KI) + ((size_t)b * SEQ + s) * 64 + k);
            sc += fmaxf(d, 0.f) * ((const float*)(ws + WS_SKF))[tok * 32 + 24 + h]; } }
        SC[s] = sc; }
    for (int idx = tid; idx < 2048; idx += 512) { const int h = idx >> 8, c = idx & 255; float s = 0.f;
        for (int d = 0; d < 128; ++d) s += ldbf((const bf16_t*)(ws + WS_QB) + tok * 1024 + h * 128 + d) * a.in[5][((size_t)h * 256 + c) * 128 + d];
        QL[idx] = s * 0.08838834764831845f; }
    __syncthreads();
    for (int s = tid; s < 2048; s += 512) { bool selv = false;
        if (s <= t) { if (t + 1 <= 256) selv = true; else { int rank = 0; const float v = SC[s]; for (int s2 = 0; s2 <= t; ++s2) { const float v2 = SC[s2]; rank += (v2 > v || (v2 == v && s2 < s)) ? 1 : 0; } selv = rank < 256; } }
        SL[s] = selv ? 1 : 0; }
    __syncthreads();
    for (int idx = tid; idx < 8 * 2048; idx += 512) { const int h = idx >> 11, s = idx & 2047; float lg = -INFINITY;
        if (SL[s]) { const f32x4 q4 = *(const f32x4*)(PSQ + (size_t)s * 4); const float rs = 1.0f / sqrtf(((q4[0] + q4[1]) + (q4[2] + q4[3])) / 256.f + LN_EPS);
            float d = 0.f; for (int c = 0; c < 256; ++c) d += QL[h * 256 + c] * (ldbf(HC + (size_t)s * 256 + c) * rs * gk[c]); lg = d - exp2f(-(float)(h + 1)) * (float)(t - s); }
        LG[idx] = lg; }
    __syncthreads();
    if (tid < 8) { float m = -INFINITY; for (int s = 0; s < 2048; ++s) m = fmaxf(m, LG[tid * 2048 + s]); float l = 0.f;
        for (int s = 0; s < 2048; ++s) { const float e = LG[tid * 2048 + s] > -INFINITY ? expf(LG[tid * 2048 + s] - m) : 0.f; LG[tid * 2048 + s] = e; l += e; }
        const float inv = l > 0.f ? 1.f / l : 0.f; for (int s = 0; s < 2048; ++s) LG[tid * 2048 + s] *= inv; }
    __syncthreads();
    for (int idx = tid; idx < 2048; idx += 512) { const int h = idx >> 8, c = idx & 255; float o = 0.f;
        for (int s = 0; s <= t; ++s) { const float p = LG[h * 2048 + s]; if (p != 0.f) { const f32x4 q4 = *(const f32x4*)(PSQ + (size_t)s * 4); const float rs = 1.0f / sqrtf(((q4[0] + q4[1]) + (q4[2] + q4[3])) / 256.f + LN_EPS);
            o += p * ldbf(HC + (size_t)s * 256 + c) * rs * gk[c]; } }
        OL[idx] = o; }
    __syncthreads();
    float err = 0.f, ref = 0.f;
    for (int idx = tid; idx < 1024; idx += 512) { const int h = idx >> 7, d = idx & 127; float o = 0.f; for (int c = 0; c < 256; ++c) o += OL[h * 256 + c] * a.in[6][((size_t)h * 256 + c) * 128 + d];
        const float gv = ldbf((const bf16_t*)(ws + WS_BR) + (size_t)NTOK * 1024 + tok * 1024 + idx); err += (gv - o) * (gv - o); ref += o * o; }
    dbg_accum(ctl, 3, err, ref); __syncthreads();
}
__device__ void dbg_gmlp(const Args& a, unsigned* ctl) {
    unsigned char* ws = a.ws; const int tid = threadIdx.x;
    const int b = blockIdx.x & 3, t = (blockIdx.x * 89 + 40) % SEQ, ch = t >> 7, tl = t & 127; const size_t tok = (size_t)b * SEQ + t;
    float err = 0.f, ref = 0.f;
    for (int c = tid; c < 1024; c += 512) { const int g = c >> 7; float m = a.in[11][g * 128 + tl];
        for (int s = 0; s <= tl; ++s) m += a.in[10][((size_t)g * 128 + tl) * 128 + s] * ldbf((const bf16_t*)(ws + WS_HV) + ((size_t)b * SEQ + ch * 128 + s) * 1024 + c);
        const float rv = m * ldbf((const bf16_t*)(ws + WS_HU) + tok * 1024 + c), gv = ldbf((const bf16_t*)(ws + WS_BR) + (size_t)2 * NTOK * 1024 + tok * 1024 + c);
        err += (gv - rv) * (gv - rv); ref += rv * rv; }
    dbg_accum(ctl, 4, err, ref);
}
__device__ void dbg_merge(const Args& a, unsigned* ctl, LAS unsigned char* lds) {
    unsigned char* ws = a.ws; const int tid = threadIdx.x; const int r = (blockIdx.x * 32 + 9) % NTOK; LAS float* MP = (LAS float*)lds;
    for (int d = tid; d < DM; d += 512) { float acc = 0.f;
        for (int n = 0; n < 3; ++n) { float y = 0.f; const bf16_t* br = (const bf16_t*)(ws + WS_BR) + (size_t)n * NTOK * 1024 + (size_t)r * 1024; const float* wb = a.in[12] + (size_t)n * 1024 * 2048;
            for (int w = 0; w < 1024; ++w) y += ldbf(br + w) * wb[(size_t)w * 2048 + d];
            acc += ldbf((const bf16_t*)(ws + WS_HG) + (size_t)r * 6144 + n * 2048 + d) * y; }
        MP[d] = acc; }
    __syncthreads();
    float err = 0.f, ref = 0.f;
    for (int d = tid; d < DM; d += 512) { float s = 0.f; for (int k = 0; k < DM; ++k) s += MP[k] * a.in[13][(size_t)k * 2048 + d];
        const float rv = ALPHA * a.in[0][(size_t)r * DM + d] + s, gv = ((const float*)(ws + WS_MIXT))[(size_t)r * DM + d]; err += (gv - rv) * (gv - rv); ref += rv * rv; }
    dbg_accum(ctl, 6, err, ref); __syncthreads();
}
__device__ void dbg_moe(const Args& a, unsigned* ctl, LAS unsigned char* lds) {
    unsigned char* ws = a.ws; const int tid = threadIdx.x; const int r = (blockIdx.x * 32 + 17) % NTOK;
    LAS float* X1 = (LAS float*)lds; LAS float* RED = X1 + 2048; LAS float* HH = RED + 1024; LAS float* YY = HH + 1024; LAS float* LOG = YY + 2048;
    const float* pre = (const float*)(ws + WS_MIXT) + (size_t)r * DM;
    float s = 0.f; for (int d = tid; d < DM; d += 512) s += pre[d]; RED[tid] = s; __syncthreads();
    if (tid == 0) { float m = 0.f; for (int i = 0; i < 512; ++i) m += RED[i]; RED[512] = m / DM; } __syncthreads();
    const float mean = RED[512]; __syncthreads();
    s = 0.f; for (int d = tid; d < DM; d += 512) s += (pre[d] - mean) * (pre[d] - mean); RED[tid] = s; __syncthreads();
    if (tid == 0) { float m = 0.f; for (int i = 0; i < 512; ++i) m += RED[i]; RED[513] = 1.0f / sqrtf(m / DM + LN_EPS); } __syncthreads();
    const float rstd = RED[513];
    for (int d = tid; d < DM; d += 512) X1[d] = (pre[d] - mean) * rstd * a.in[14][d] + a.in[15][d];
    __syncthreads();
    if (tid < 20) { float lg = 0.f; if (tid < 4) { for (int k = 0; k < DM; ++k) lg += X1[k] * a.in[16][(size_t)k * 4 + tid]; lg += a.in[17][tid]; } else { for (int k = 0; k < DM; ++k) lg += X1[k] * a.in[18][(size_t)k * 16 + (tid - 4)]; lg += a.in[19][tid - 4]; } LOG[tid] = lg; }
    __syncthreads();
    int gi = 0; for (int j = 1; j < 4; ++j) if (LOG[j] > LOG[gi]) gi = j;
    float den = 0.f; for (int j = 0; j < 4; ++j) den += expf(LOG[j] - LOG[gi]); const float gp = 1.f / den;
    int e1 = 0; for (int j = 1; j < 4; ++j) if (LOG[4 + gi * 4 + j] > LOG[4 + gi * 4 + e1]) e1 = j;
    int e2 = -1; for (int j = 0; j < 4; ++j) if (j != e1 && (e2 < 0 || LOG[4 + gi * 4 + j] > LOG[4 + gi * 4 + e2])) e2 = j;
    const float ex = expf(LOG[4 + gi * 4 + e2] - LOG[4 + gi * 4 + e1]); const float wv0 = gp / (1.f + ex), wv1 = gp * ex / (1.f + ex); const int ev0 = gi * 4 + e1, ev1 = gi * 4 + e2;
    for (int q = 0; q < 2; ++q) { const int e = q ? ev1 : ev0; const float* wg = a.in[20] + (size_t)e * 2048 * 512; const float* wu = a.in[21] + (size_t)e * 2048 * 512;
        float g = 0.f, u = 0.f; for (int k = 0; k < DM; ++k) { g += X1[k] * wg[(size_t)k * 512 + tid]; u += X1[k] * wu[(size_t)k * 512 + tid]; }
        HH[q * 512 + tid] = g / (1.f + expf(-g)) * u * (q ? wv1 : wv0); }
    __syncthreads();
    for (int d = tid; d < DM; d += 512) { float y = 0.f; for (int q = 0; q < 2; ++q) { const float* wd = a.in[22] + (size_t)(q ? ev1 : ev0) * 512 * 2048; for (int f = 0; f < 512; ++f) y += HH[q * 512 + f] * wd[(size_t)f * 2048 + d]; } YY[d] = ALPHA * X1[d] + y; }
    __syncthreads();
    s = 0.f; for (int d = tid; d < DM; d += 512) s += YY[d]; RED[tid] = s; __syncthreads();
    if (tid == 0) { float m = 0.f; for (int i = 0; i < 512; ++i) m += RED[i]; RED[514] = m / DM; } __syncthreads();
    const float mean2 = RED[514]; __syncthreads();
    s = 0.f; for (int d = tid; d < DM; d += 512) s += (YY[d] - mean2) * (YY[d] - mean2); RED[tid] = s; __syncthreads();
    if (tid == 0) { float m = 0.f; for (int i = 0; i < 512; ++i) m += RED[i]; RED[515] = 1.0f / sqrtf(m / DM + LN_EPS); } __syncthreads();
    const float rstd2 = RED[515];
    float err = 0.f, ref = 0.f;
    const int* trow = (const int*)(ws + WS_TOK) + 6 * NTOK; const bf16_t* Y = (const bf16_t*)(ws + WS_Y);
    for (int d = tid; d < DM; d += 512) {
#if DBG_STAGE == 8
        const float rv = (YY[d] - mean2) * rstd2 * a.in[23][d] + a.in[24][d], gv = ((const float*)(ws + WS_XF))[(size_t)r * DM + d];
#else
        const float rv = YY[d] - ALPHA * X1[d], gv = ldbf(Y + (size_t)trow[r * 2] * DM + d) + ldbf(Y + (size_t)trow[r * 2 + 1] * DM + d);
#endif
        err += (gv - rv) * (gv - rv); ref += rv * rv; }
    dbg_accum(ctl, 7, err, ref); __syncthreads();
}
__device__ void dbg_checks(const Args& a, unsigned* ctl, LAS unsigned char* lds) {
#if DBG_STAGE == 5
    dbg_inproj(a, ctl);
#elif DBG_STAGE == 2
    dbg_compress(a, ctl, lds);
#elif DBG_STAGE == 1
    dbg_nsa(a, ctl, lds);
#elif DBG_STAGE == 3
    dbg_dsa(a, ctl, lds);
#elif DBG_STAGE == 4
    dbg_gmlp(a, ctl);
#elif DBG_STAGE == 6
    dbg_merge(a, ctl, lds);
#else
    dbg_moe(a, ctl, lds);
#endif
}
__device__ void dbg_scale_output(const Args& a, unsigned* ctl) {
    const int k = (DBG_STAGE == 8) ? 7 : DBG_STAGE;
    const float err = __hip_atomic_load((float*)(ctl + CW_DBG) + 2 * k, __ATOMIC_RELAXED, __HIP_MEMORY_SCOPE_AGENT), ref = __hip_atomic_load((float*)(ctl + CW_DBG) + 2 * k + 1, __ATOMIC_RELAXED, __HIP_MEMORY_SCOPE_AGENT);
    const float E = ref > 0.f ? sqrtf(err / ref) : 1.0f; const float f = 1.0f + 3.0f * fminf(E, 1.0f);
    for (size_t i = (size_t)blockIdx.x * 512 + threadIdx.x; i < (size_t)NTOK * DM; i += (size_t)gridDim.x * 512) a.out[i] *= f;
}
#endif

struct ItemTable { unsigned short v[768]; };
constexpr int item_cost(int type, int idx) {
    if (type == 0) { const int qb = idx & 31; return 4 + qb + ((qb + 1) < 9 ? (qb + 1) : 9); }
    if (type == 1) { const int qb = idx & 7; return 4 * (qb + 1) + 1; }
    return 1;
}
constexpr ItemTable make_items() {
    ItemTable t{}; int pos = 0;
    for (int cst = 64; cst >= 0; --cst) for (int id = 0; id < 768; ++id) { const int type = id >> 8, idx = id & 255; if (item_cost(type, idx) == cst) t.v[pos++] = (unsigned short)((type << 12) | idx); }
    return t;
}
__device__ const ItemTable g_items = make_items();

constexpr int N_PHASES = 1 + NL * 10;
#ifndef PH_MASK
#define PH_MASK 0x7ff
#endif
#define PH_ON(k) (((PH_MASK) >> (k)) & 1)
#if defined(PROBE_DOUBLE) && MK_SINGLE
#define PH_REPS(k) ((((PROBE_DOUBLE) >> (k)) & 1) ? 2 : 1)
#else
#define PH_REPS(k) 1
#endif
#ifndef PROBE_SUB
#define PROBE_SUB 0xff
#endif
__global__ void __launch_bounds__(512, 2) mk_fwd(Args a_unused) {
    extern __shared__ __attribute__((aligned(16))) unsigned char lds_raw[];
    LAS unsigned char* lds = (LAS unsigned char*)lds_raw;
    typedef const __attribute__((address_space(4))) Args KArgs;
    KArgs* const ka0 = (KArgs*)__builtin_amdgcn_kernarg_segment_ptr();
#define KA() (*(const Args*)(KArgs*)((unsigned long long)ka0 + opaque_zero()))
    const Args& a = KA();
    unsigned char* ws0 = a.ws;
    unsigned* ctl = (unsigned*)(ws0 + WS_CTL);
    const int tid = threadIdx.x, G = gridDim.x, wg = blockIdx.x;
#if MK_SINGLE
    if (tid < 4) ((LAS unsigned*)(lds + LDS_BYTES - 16))[tid] = 0u;
#if defined(PROBE_TS)
    if (tid < 4) ((LAS unsigned*)(lds + LDS_BYTES - 64))[tid] = 0u;
#endif
    __syncthreads();
    XcdBarrier bar = xcd_barrier_post(ctl + CW_BAR, (volatile LAS unsigned*)(lds + LDS_BYTES - 16));
#define GRID_BAR() do { XcdBarrier bb_ = bar; bb_.bar = launder_s(bb_.bar); bb_.x = bar.x + opaque_zero(); xcd_barrier(bb_); } while (0)
#else
#define GRID_BAR() do { } while (0)
#endif
#if defined(PROBE_TS)
#define TS_BEGIN(k) do { if ((k) == (PROBE_TS) && wg == 0 && tid == 0) { const unsigned long long t_ = __builtin_amdgcn_s_memrealtime(); ((LAS unsigned*)(lds + LDS_BYTES - 64))[0] = (unsigned)t_; } } while (0)
#define TS_END(k) do { if ((k) == (PROBE_TS) && wg == 0 && tid == 0) { const unsigned t_ = (unsigned)__builtin_amdgcn_s_memrealtime(); LAS unsigned* s_ = (LAS unsigned*)(lds + LDS_BYTES - 64); s_[1] += t_ - s_[0]; } } while (0)
#else
#define TS_BEGIN(k) do { } while (0)
#define TS_END(k) do { } while (0)
#endif
#if MK_SINGLE
#define IN(k) true
#else
    const int lo = a.ph_lo, hi = a.ph_hi;
#define IN(k) (lo <= (k) && (k) < hi)
#endif
#if defined(PROBE_BAR2)
#define SEAM(k) do { if (IN(k) && IN((k) + 1)) { GRID_BAR(); GRID_BAR(); } } while (0)
#else
#define SEAM(k) do { if (IN(k) && IN((k) + 1)) GRID_BAR(); } while (0)
#endif

    TS_BEGIN(10);
    if (PH_ON(10) && IN(0)) for (int rep = 0; rep < PH_REPS(10); ++rep) { if (rep) GRID_BAR();
#if defined(PROBE_P0_NOSTORE)
        p0_prologue(a, lds, rep != 0);
#else
        p0_prologue(a, lds);
#endif
    }
    SEAM(0);
    TS_END(10);
    for (int l = 0; l < NL; ++l) {
        const int p = 1 + l * 10;
        unsigned char* ws = launder_s(ws0);
        TS_BEGIN(0);
        if (PH_ON(0) && IN(p + 0)) for (int rep = 0; rep < PH_REPS(0); ++rep) { if (rep) GRID_BAR(); ws = launder_s(ws); const Args& a = KA();
            skinny_item(a, l, lds);
            pg8::Gemm g{(const bf16_t*)(ws + WS_XB), (const bf16_t*)(ws + WS_WIN) + (size_t)l * NMAIN * DM, NTOK, NMAIN, DM};
            pg8::StaticOrder S; S.init(NTOK, NMAIN, G, wg); EpiInProj E{ws};
            pg8::gemm_phase<EpiInProj, pg8::StaticOrder, false>(lds, g, S, E, nullptr);
        }
        SEAM(p + 0);
        TS_END(0);
        TS_BEGIN(1);
        if (PH_ON(1) && IN(p + 1)) for (int rep = 0; rep < PH_REPS(1); ++rep) { if (rep) GRID_BAR(); ws = launder_s(ws); const Args& a = KA();
            const int subm = rep ? (PROBE_SUB) : 0xff;
            if (subm & 1) { pg8::Gemm g{(const bf16_t*)(ws + WS_HC), (const bf16_t*)(ws + WS_WKVUP) + (size_t)l * 2048 * 256, NTOK, 2048, 256};
              pg8::StaticOrder S; S.init(NTOK, 2048, G, wg);
              EpiKvUp E{ws};
              pg8::gemm_phase<EpiKvUp, pg8::StaticOrder, false>(lds, g, S, E, nullptr); }
            if (subm & 2) gmlp_ln_rows(a, l);
            if ((subm & 12) == 12) {
                LAS unsigned* slot = (LAS unsigned*)(lds + att::L_MISC); const int tq = LTID;
                unsigned qi = (unsigned)wg;
                for (;;) {
                    if (qi >= 576u) break;
                    unsigned nxt = 0u;
                    if (tq == 0) nxt = (unsigned)G + __hip_atomic_fetch_add(ctl + CW_Q + (8 + l * 2 + rep) * 64, 1u, __ATOMIC_RELAXED, __HIP_MEMORY_SCOPE_AGENT);
                    if (qi < 64u) compress_item(a, l, lds, (int)qi);
                    else { const int j = (int)qi - 64; indexer_item(a, lds, (j & 3) * 128 + (127 - (j >> 2))); }
                    if (tq == 0) slot[0] = nxt;
                    __syncthreads();
                    qi = slot[0];
                    __syncthreads();
                }
            } else {
                if (subm & 4) for (int it = wg; it < 64; it += G) compress_item(a, l, lds, it);
                if (subm & 8) for (int it = wg; it < 256; it += G) { indexer_item(a, lds, it); indexer_item(a, lds, 511 - it); }
            }
        }
        SEAM(p + 1);
        TS_END(1);
        TS_BEGIN(2);
        if (PH_ON(2) && IN(p + 2)) for (int rep = 0; rep < PH_REPS(2); ++rep) { if (rep) GRID_BAR(); ws = launder_s(ws); const Args& a = KA();
            LAS unsigned* slot = (LAS unsigned*)(lds + att::L_MISC); const int tq = LTID;
            unsigned qi = (unsigned)wg;
            for (;;) {
                if (qi >= 768u) break;
                unsigned nxt = 0u;
                if (tq == 0) nxt = (unsigned)G + __hip_atomic_fetch_add(ctl + CW_Q + (l * 2 + rep) * 64, 1u, __ATOMIC_RELAXED, __HIP_MEMORY_SCOPE_AGENT);
                const unsigned it = g_items.v[qi]; const int type = it >> 12, idx = it & 255;
                if (type == 0) att::nsa_item(a, lds, idx >> 6, (idx >> 5) & 1, idx & 31);
                else if (type == 1) att::dsa_item(a, lds, idx >> 6, (idx >> 3) & 7, idx & 7);
                else att::gmlp_item(a, lds, l, idx >> 6, (idx >> 2) & 15, idx & 3);
                if (tq == 0) slot[0] = nxt;
                __syncthreads();
                qi = slot[0];
                __syncthreads();
            }
        }
        SEAM(p + 2);
        TS_END(2);
        TS_BEGIN(3);
        if (PH_ON(3) && IN(p + 3)) for (int rep = 0; rep < PH_REPS(3); ++rep) { if (rep) GRID_BAR(); ws = launder_s(ws); const Args& a = KA();
            pg8::Gemm g{(const bf16_t*)(ws + WS_BR), (const bf16_t*)(ws + WS_WB) + (size_t)l * 3 * 2048 * 1024, 0, 0, 1024};
            BranchSched S{G, wg}; EpiBranch E{ws};
            pg8::gemm_phase<EpiBranch, BranchSched, false>(lds, g, S, E, nullptr);
        }
        SEAM(p + 3);
        TS_END(3);
        TS_BEGIN(4);
        if (PH_ON(4) && IN(p + 4)) for (int rep = 0; rep < PH_REPS(4); ++rep) { if (rep) GRID_BAR(); ws = launder_s(ws); const Args& a = KA();
            pg8::Gemm g{(const bf16_t*)(ws + WS_MIXB), (const bf16_t*)(ws + WS_WO) + (size_t)l * DM * DM, NTOK, DM, DM};
            pg8::StaticOrder S; S.init(NTOK, DM, G, wg); EpiOut E{l == 0 ? a.in[0] : (const float*)(ws + WS_XF), (float*)(ws + WS_MIXT)};
            pg8::gemm_phase<EpiOut, pg8::StaticOrder, false>(lds, g, S, E, nullptr);
        }
        SEAM(p + 4);
        TS_END(4);
        TS_BEGIN(5);
        if (PH_ON(5) && IN(p + 5)) { const Args& a = KA(); p6_ln1_route(a, l, lds); }
        SEAM(p + 5);
        TS_END(5);
        TS_BEGIN(6);
        if (PH_ON(6) && IN(p + 6)) for (int rep = 0; rep < PH_REPS(6); ++rep) { if (rep) GRID_BAR(); const Args& a = KA(); p7_gather(a, l, lds); }
        SEAM(p + 6);
        TS_END(6);
        TS_BEGIN(7);
        if (PH_ON(7) && IN(p + 7)) for (int rep = 0; rep < PH_REPS(7); ++rep) { if (rep) GRID_BAR(); ws = launder_s(ws); const Args& a = KA();
            LAS int* off = (LAS int*)(lds + 131072); LAS int* te = off + 64;
            const int nt = moe_tile_table(a, l, off, te);
            pg8::Gemm g{(const bf16_t*)(ws + WS_XS), (const bf16_t*)(ws + WS_WGU) + (size_t)l * 16 * 1024 * 2048, 0, 0, DM};
            MoeSched S{te, nt, 4, G, wg}; EpiGateUp E{ws};
            pg8::gemm_phase<EpiGateUp, MoeSched, false>(lds, g, S, E, nullptr);
        }
        SEAM(p + 7);
        TS_END(7);
        TS_BEGIN(8);
        if (PH_ON(8) && IN(p + 8)) for (int rep = 0; rep < PH_REPS(8); ++rep) { if (rep) GRID_BAR(); ws = launder_s(ws); const Args& a = KA();
            LAS int* off = (LAS int*)(lds + 131072); LAS int* te = off + 64;
            const int nt = moe_tile_table(a, l, off, te);
            pg8::Gemm g{(const bf16_t*)(ws + WS_HM), (const bf16_t*)(ws + WS_WD) + (size_t)l * 16 * 2048 * 512, 0, 0, DEXP};
            MoeSched S{te, nt, 8, G, wg}; EpiDown E{ws};
            pg8::gemm_phase<EpiDown, MoeSched, false>(lds, g, S, E, nullptr);
        }
        SEAM(p + 8);
        TS_END(8);
        TS_BEGIN(9);
        if (PH_ON(9) && IN(p + 9)) for (int rep = 0; rep < PH_REPS(9); ++rep) { if (rep) GRID_BAR(); const Args& a = KA(); p10_ln2(a, l); }
        SEAM(p + 9);
        TS_END(9);
    }
#if defined(PROBE_TS)
    if (wg == 0 && tid == 0) { const unsigned acc_ = ((LAS unsigned*)(lds + LDS_BYTES - 64))[1]; const unsigned long long t0_ = __builtin_amdgcn_s_memrealtime();
        while (__builtin_amdgcn_s_memrealtime() - t0_ < 8ull * acc_) __builtin_amdgcn_s_sleep(8); }
#endif
#undef IN
#undef SEAM
}

#if defined(DBG_STAGE)
__global__ void __launch_bounds__(512, 2) dbg_k(Args a, int what) {
    extern __shared__ __attribute__((aligned(16))) unsigned char lds_raw[];
    LAS unsigned char* lds = (LAS unsigned char*)lds_raw; unsigned* ctl = (unsigned*)(a.ws + WS_CTL);
    if (what == 0) dbg_checks(a, ctl, lds); else dbg_scale_output(a, ctl);
}
#endif
extern "C" void kernel_launch(void* const* d_in, const int* in_sizes, int n_in, void* d_out, int out_size, void* d_ws, size_t ws_size, hipStream_t stream) {
    static int grid = 0;
    if (grid == 0) {
        if (n_in != 25 || out_size != NTOK * DM || ws_size < WS_END) { fprintf(stderr, "kernel_launch: expected 25 inputs, out %d, ws >= %zu; got n_in %d out %d ws %zu\n", NTOK * DM, (size_t)WS_END, n_in, out_size, ws_size); grid = -1; return; }
        int dev = 0, cus = 0, per_cu = 0;
        if (hipGetDevice(&dev) != hipSuccess || hipDeviceGetAttribute(&cus, hipDeviceAttributeMultiprocessorCount, dev) != hipSuccess) { fprintf(stderr, "kernel_launch: device query failed\n"); grid = -1; return; }
#if defined(DBG_STAGE)
        (void)hipFuncSetAttribute((const void*)dbg_k, hipFuncAttributeMaxDynamicSharedMemorySize, LDS_BYTES);
#endif
        if (hipFuncSetAttribute((const void*)mk_fwd, hipFuncAttributeMaxDynamicSharedMemorySize, LDS_BYTES) != hipSuccess) { fprintf(stderr, "kernel_launch: hipFuncSetAttribute failed\n"); grid = -1; return; }
        if (hipOccupancyMaxActiveBlocksPerMultiprocessor(&per_cu, (const void*)mk_fwd, 512, LDS_BYTES) != hipSuccess || per_cu < 1) fprintf(stderr, "kernel_launch: occupancy query reports %d blocks per CU\n", per_cu);
        (void)hipGetLastError();
        grid = cus;
    }
    if (grid < 0) return;
    (void)hipMemsetAsync((char*)d_ws + WS_CTL, 0, CTL_BYTES, stream);
    Args a{};
    for (int i = 0; i < 25; ++i) a.in[i] = (const float*)d_in[i];
    a.out = (float*)d_out; a.ws = (unsigned char*)d_ws; a.rep = 0; a.sub = 0xff;
#if MK_SINGLE
    a.ph_lo = 0; a.ph_hi = N_PHASES;
    hipLaunchKernelGGL(mk_fwd, dim3(grid), dim3(512), LDS_BYTES, stream, a);
#else
    for (int p = 0; p < N_PHASES; ++p) { a.ph_lo = p; a.ph_hi = p + 1; hipLaunchKernelGGL(mk_fwd, dim3(grid), dim3(512), LDS_BYTES, stream, a);
#if defined(PROBE_DOUBLE)
        { const int k = p == 0 ? 10 : (p - 1) % 10; if ((PROBE_DOUBLE >> k) & 1) { a.rep = 1;
#if defined(PROBE_SUB)
            a.sub = PROBE_SUB;
#endif
            hipLaunchKernelGGL(mk_fwd, dim3(grid), dim3(512), LDS_BYTES, stream, a); a.rep = 0; a.sub = 0xff; } }
#endif
#if defined(DBG_STAGE)
        if (p == 10) hipLaunchKernelGGL(dbg_k, dim3(grid), dim3(512), LDS_BYTES, stream, a, 0);
        if (p == N_PHASES - 1) hipLaunchKernelGGL(dbg_k, dim3(grid), dim3(512), LDS_BYTES, stream, a, 1);
#endif
    }
#endif
    const hipError_t le = hipPeekAtLastError();
    if (le != hipSuccess) fprintf(stderr, "kernel_launch: launch failed: %s\n", hipGetErrorName(le));
}
```
